# Optimizing an MI355X kernel written in HIP

```python
import jax, jax.numpy as jnp
from jax import lax
import numpy as np

D_MODEL = 1024
BATCH = 1
SEQ = 16384
DEPTH = 2
DEC_BATCH = 128
DEC_SEQ = 4
PAST_LEN = 16384
PAGE_SIZE = 128

A_DK = 64
A_DV = 64
A_WIDTH = D_MODEL // 4
A_HEADS = A_WIDTH // A_DK
HGRN_CHUNK = 64
B_WIDTH = D_MODEL // 4
B_GROUPS = 4
CONV_WIDTH = 31
C_HEAD_DIM = 64
C_WIDTH = D_MODEL // 2
C_HEADS = C_WIDTH // C_HEAD_DIM
C_KV_HEADS = C_HEADS // 4
C_GROUP = C_HEADS // C_KV_HEADS
WINDOW = 128
ROPE_THETA = 10000.0
MIX_WIDTH = A_WIDTH + B_WIDTH + C_WIDTH
IN_COLS = 4 * A_WIDTH + 2 * B_WIDTH + C_WIDTH + 2 * C_KV_HEADS * C_HEAD_DIM
D_FF = -(-(8 * D_MODEL) // (3 * 256)) * 256
PLE_DIM = 256
EPS = 1e-6

kernel_name = 'hymba_hgrn2_conformer_swa_sink_step'


def _rmsnorm(x, g):
    xf = x.astype(jnp.float32)
    y = xf * lax.rsqrt(jnp.mean(xf * xf, axis=-1, keepdims=True) + EPS)
    return (y * g.astype(jnp.float32)).astype(x.dtype)


def _rope(x, pos):
    half = x.shape[-1] // 2
    inv = ROPE_THETA ** (-jnp.arange(half, dtype=jnp.float32) / half)
    ang = pos[:, None] * inv[None, :]
    cos = jnp.cos(ang)[:, None, :]
    sin = jnp.sin(ang)[:, None, :]
    xf = x.astype(jnp.float32)
    x1, x2 = xf[..., :half], xf[..., half:]
    return jnp.concatenate([x1 * cos - x2 * sin, x2 * cos + x1 * sin], axis=-1).astype(x.dtype)


def _hgrn_chunk(S, xs):
    q, k, v, g = xs
    C = q.shape[1]
    G = jnp.cumsum(g, axis=1)
    causal = jnp.tril(jnp.ones((C, C), dtype=bool))[None, :, :, None, None]
    decay = jnp.exp(jnp.where(causal, G[:, :, None] - G[:, None, :], -jnp.inf))
    att = jnp.einsum('bthk,btshk,bshk->bhts', q, decay, k)
    o = jnp.einsum('bhts,bshv->bthv', att, v) + jnp.einsum('bthk,bhkv->bthv', q * jnp.exp(G), S)
    G_end = G[:, -1]
    S = jnp.exp(G_end)[..., None] * S + jnp.einsum('bshk,bshv->bhkv', k * jnp.exp(G_end[:, None] - G), v)
    return S, o


def _hgrn(S0, q, k, v, g):
    B, T, H, _ = q.shape
    C = min(HGRN_CHUNK, T)
    n = T // C

    def chunks(a):
        return a.reshape(B, n, C, H, a.shape[-1]).swapaxes(0, 1)

    S, o = lax.scan(_hgrn_chunk, S0, (chunks(q), chunks(k), chunks(v), chunks(g)))
    return S, o.swapaxes(0, 1).reshape(B, T, H, -1)


def _conv_module(u, buf, w, b, ln_g, ln_b):
    B, T, Cw = u.shape
    xpad = jnp.concatenate([buf.astype(u.dtype), u], axis=1)
    y = lax.conv_general_dilated(xpad, w[:, None, :].astype(u.dtype), (1,), 'VALID',
                                 dimension_numbers=('NWC', 'WIO', 'NWC'), feature_group_count=Cw)
    y = y.astype(jnp.float32) + b.astype(jnp.float32)
    yg = y.reshape(B, T, B_GROUPS, Cw // B_GROUPS)
    mu = jnp.mean(yg, axis=-1, keepdims=True)
    var = jnp.mean(jnp.square(yg - mu), axis=-1, keepdims=True)
    y = ((yg - mu) * lax.rsqrt(var + EPS)).reshape(B, T, Cw) * ln_g.astype(jnp.float32) + ln_b.astype(jnp.float32)
    return jax.nn.silu(y).astype(u.dtype), xpad[:, -(CONV_WIDTH - 1):]


def _sink_attention(q, k, v, mask, sinks):
    s = jnp.einsum('...qhgd,...khd->...hgqk', q, k).astype(jnp.float32) * (C_HEAD_DIM ** -0.5)
    s = jnp.where(mask[..., None, None, :, :], s, -jnp.inf)
    sink = sinks.astype(jnp.float32).reshape(C_KV_HEADS, C_GROUP)[:, :, None, None]
    m = jnp.maximum(jnp.max(s, axis=-1, keepdims=True), sink)
    p = jnp.exp(s - m)
    p = p / (jnp.sum(p, axis=-1, keepdims=True) + jnp.exp(sink - m))
    return jnp.einsum('...hgqk,...khd->...qhgd', p.astype(v.dtype), v)


def _swa_prompt(q, k, v, sinks):
    B, T = q.shape[:2]
    nb = T // WINDOW
    qb = q.reshape(B, nb, WINDOW, C_KV_HEADS, C_GROUP, C_HEAD_DIM)

    def band(a):
        ab = a.reshape(B, nb, WINDOW, C_KV_HEADS, C_HEAD_DIM)
        prev = jnp.pad(ab[:, :-1], ((0, 0), (1, 0), (0, 0), (0, 0), (0, 0)))
        return jnp.concatenate([prev, ab], axis=2)

    i = jnp.arange(WINDOW)[:, None]
    j = jnp.arange(2 * WINDOW)[None, :]
    rel = WINDOW + i - j
    key_pos = jnp.arange(nb)[:, None, None] * WINDOW - WINDOW + j[None]
    mask = (rel >= 0) & (rel <= WINDOW) & (key_pos >= 0)
    o = _sink_attention(qb, band(k), band(v), mask, sinks)
    return o.reshape(B, T, C_WIDTH)


def _swa_sample(q, k, v, kbuf, vbuf, start, sinks):
    B, T = q.shape[:2]
    w_buf = kbuf.shape[1]
    k_all = jnp.concatenate([kbuf.astype(k.dtype), k], axis=1)
    v_all = jnp.concatenate([vbuf.astype(v.dtype), v], axis=1)
    q_pos = start + jnp.arange(T)
    k_pos = start - w_buf + jnp.arange(w_buf + T)
    rel = q_pos[:, None] - k_pos[None, :]
    mask = (rel >= 0) & (rel <= WINDOW)
    o = _sink_attention(q.reshape(B, T, C_KV_HEADS, C_GROUP, C_HEAD_DIM), k_all, v_all, mask, sinks)
    return o.reshape(B, T, C_WIDTH), k_all[:, -w_buf:], v_all[:, -w_buf:]


def _layer(x, p, start, s_hgrn, conv_buf, kbuf, vbuf, lb, wl):
    (w_in, a_onorm, conv_w, conv_b, conv_ln_g, conv_ln_b, q_norm, k_norm, sinks, w_out,
     norm_mix, norm_ffn, w_gate, w_up, w_down, ple_norm, w_ple_gate, w_ple_proj) = wl
    B, T, _ = x.shape
    f32 = jnp.float32
    z = _rmsnorm(x, norm_mix) @ w_in
    kv_w = C_KV_HEADS * C_HEAD_DIM
    sizes = [A_WIDTH] * 4 + [B_WIDTH] * 2 + [C_WIDTH, kv_w, kv_w]
    aq, af, ai, ag, bu, bg, cq, ck, cv = jnp.split(z, np.cumsum(sizes)[:-1].tolist(), axis=-1)

    def heads(a, d):
        return a.reshape(B, T, -1, d)

    zf = af.astype(f32)
    logf = jnp.logaddexp(jnp.log(lb), jnp.log1p(-lb) + jax.nn.log_sigmoid(zf))
    kin = (1.0 - lb) * jax.nn.sigmoid(-zf)
    if s_hgrn is None:
        s_hgrn = jnp.zeros((B, A_HEADS, A_DK, A_DV), f32)
    s_new, oa = _hgrn(s_hgrn.astype(f32), heads(aq.astype(f32), A_DK), heads(kin, A_DK),
                      heads(ai.astype(f32), A_DV), heads(logf, A_DK))
    oa = _rmsnorm(oa, a_onorm) * jax.nn.silu(heads(ag.astype(f32), A_DV))
    oa = oa.reshape(B, T, A_WIDTH).astype(x.dtype)

    u = bu * jax.nn.sigmoid(bg)
    if conv_buf is None:
        conv_buf = jnp.zeros((B, CONV_WIDTH - 1, B_WIDTH), u.dtype)
    ob, conv_new = _conv_module(u, conv_buf, conv_w, conv_b, conv_ln_g, conv_ln_b)

    pos = start + jnp.arange(T, dtype=f32)
    q = _rope(_rmsnorm(heads(cq, C_HEAD_DIM), q_norm), pos)
    k = _rope(_rmsnorm(heads(ck, C_HEAD_DIM), k_norm), pos)
    v = heads(cv, C_HEAD_DIM)
    if kbuf is None:
        oc = _swa_prompt(q, k, v, sinks)
        k_new, v_new = k[:, -WINDOW:], v[:, -WINDOW:]
    else:
        oc, k_new, v_new = _swa_sample(q, k, v, kbuf, vbuf, start, sinks)

    h = x + jnp.concatenate([oa, ob, oc], axis=-1) @ w_out
    hn = _rmsnorm(h, norm_ffn)
    h = h + (jax.nn.silu(hn @ w_gate) * (hn @ w_up)) @ w_down
    gate = jax.nn.sigmoid(_rmsnorm(h, ple_norm) @ w_ple_gate)
    h = h + gate * (p.astype(h.dtype) @ w_ple_proj)
    return h, s_new, conv_new, k_new, v_new


def setup_inputs(seed: int = 0) -> dict:
    key = jax.random.key(seed)
    ks = jax.random.split(key, 32)
    f32 = jnp.float32
    w_buf = min(WINDOW, PAST_LEN)

    def nrm(k, shape, s):
        return s * jax.random.normal(k, shape, f32)

    return {
        'x_prompt': nrm(ks[0], (BATCH, SEQ, D_MODEL), 1.0),
        'x_sample': nrm(ks[1], (DEC_BATCH, DEC_SEQ, D_MODEL), 1.0),
        'state_hgrn': nrm(ks[2], (DEPTH, DEC_BATCH, A_HEADS, A_DK, A_DV), 0.5),
        'state_conv': nrm(ks[3], (DEPTH, DEC_BATCH, CONV_WIDTH - 1, B_WIDTH), 0.5),
        'cache_swa_k': nrm(ks[4], (DEPTH, DEC_BATCH, w_buf, C_KV_HEADS, C_HEAD_DIM), 1.0),
        'cache_swa_v': nrm(ks[5], (DEPTH, DEC_BATCH, w_buf, C_KV_HEADS, C_HEAD_DIM), 1.0),
        'p_prompt': nrm(ks[6], (DEPTH, BATCH, SEQ, PLE_DIM), 1.0),
        'p_sample': nrm(ks[7], (DEPTH, DEC_BATCH, DEC_SEQ, PLE_DIM), 1.0),
        'a_lower': nrm(ks[8], (DEPTH, A_WIDTH), 1.0),
        'w_in': nrm(ks[9], (DEPTH, D_MODEL, IN_COLS), D_MODEL ** -0.5),
        'a_onorm': 1.0 + nrm(ks[10], (DEPTH, A_DV), 0.05),
        'conv_w': nrm(ks[11], (DEPTH, CONV_WIDTH, B_WIDTH), CONV_WIDTH ** -0.5),
        'conv_b': nrm(ks[12], (DEPTH, B_WIDTH), 0.01),
        'conv_ln_g': 1.0 + nrm(ks[13], (DEPTH, B_WIDTH), 0.05),
        'conv_ln_b': nrm(ks[14], (DEPTH, B_WIDTH), 0.01),
        'q_norm': 1.0 + nrm(ks[15], (DEPTH, C_HEAD_DIM), 0.05),
        'k_norm': 1.0 + nrm(ks[16], (DEPTH, C_HEAD_DIM), 0.05),
        'sinks': nrm(ks[17], (DEPTH, C_HEADS), 0.5),
        'w_out': nrm(ks[18], (DEPTH, MIX_WIDTH, D_MODEL), MIX_WIDTH ** -0.5),
        'norm_mix': 1.0 + nrm(ks[19], (DEPTH, D_MODEL), 0.05),
        'norm_ffn': 1.0 + nrm(ks[20], (DEPTH, D_MODEL), 0.05),
        'w_gate': nrm(ks[21], (DEPTH, D_MODEL, D_FF), D_MODEL ** -0.5),
        'w_up': nrm(ks[22], (DEPTH, D_MODEL, D_FF), D_MODEL ** -0.5),
        'w_down': nrm(ks[23], (DEPTH, D_FF, D_MODEL), D_FF ** -0.5),
        'ple_norm': 1.0 + nrm(ks[24], (DEPTH, D_MODEL), 0.05),
        'w_ple_gate': nrm(ks[25], (DEPTH, D_MODEL, D_MODEL), D_MODEL ** -0.5),
        'w_ple_proj': nrm(ks[26], (DEPTH, PLE_DIM, D_MODEL), PLE_DIM ** -0.5),
    }


def reference(x_prompt, x_sample, state_hgrn, state_conv, cache_swa_k, cache_swa_v, p_prompt, p_sample,
              a_lower, w_in, a_onorm, conv_w, conv_b, conv_ln_g, conv_ln_b, q_norm, k_norm, sinks, w_out,
              norm_mix, norm_ffn, w_gate, w_up, w_down, ple_norm, w_ple_gate, w_ple_proj):
    lbs = jnp.cumsum(jax.nn.softmax(a_lower.astype(jnp.float32), axis=0), axis=0)
    lbs = lbs - lbs[0:1]
    hp, hs = x_prompt, x_sample
    sp_h, sp_c, sp_k, sp_v = [], [], [], []
    ss_h, ss_c, ss_k, ss_v = [], [], [], []
    for l in range(DEPTH):
        wl = (w_in[l], a_onorm[l], conv_w[l], conv_b[l], conv_ln_g[l], conv_ln_b[l], q_norm[l], k_norm[l],
              sinks[l], w_out[l], norm_mix[l], norm_ffn[l], w_gate[l], w_up[l], w_down[l], ple_norm[l],
              w_ple_gate[l], w_ple_proj[l])
        hp, a1, a2, a3, a4 = _layer(hp, p_prompt[l], 0, None, None, None, None, lbs[l], wl)
        hs, b1, b2, b3, b4 = _layer(hs, p_sample[l], PAST_LEN, state_hgrn[l], state_conv[l],
                                    cache_swa_k[l], cache_swa_v[l], lbs[l], wl)
        sp_h.append(a1); sp_c.append(a2); sp_k.append(a3); sp_v.append(a4)
        ss_h.append(b1); ss_c.append(b2); ss_k.append(b3); ss_v.append(b4)
    return (hp, hs,
            jnp.stack(sp_h), jnp.stack(sp_c), jnp.stack(sp_k), jnp.stack(sp_v),
            jnp.stack(ss_h), jnp.stack(ss_c), jnp.stack(ss_k), jnp.stack(ss_v))
```

```cpp
#include <hip/hip_runtime.h>
#include <hip/hip_cooperative_groups.h>
#include <cstdio>
#include <cstdint>
namespace cg = cooperative_groups;
namespace pg8 {
#define PG8_LAS __attribute__((address_space(3)))
typedef unsigned short bf16_t;
typedef short bf16x8 __attribute__((ext_vector_type(8)));
typedef float f32x4 __attribute__((ext_vector_type(4)));
typedef unsigned u32x4 __attribute__((ext_vector_type(4)));
constexpr int BM = 256, BK = 64, HALF = 128, HTB = HALF * BK * 2  , STAGE_BYTES = 8 * HTB, NXCD = 8, WGM = 8;

__host__ __device__ __forceinline__ int lds_byte(int r, int c) { const int st = (r >> 4) * 2 + (c >> 5), rr = r & 15, cc = c & 31, ob = rr * 64 + cc * 2; return st * 1024 + (ob ^ (((ob >> 9) & 1) << 5)); }
__host__ __device__ __forceinline__ void stage_rc(int b, int& R, int& C) { const int st = b / 1024, sb = b % 1024, swz = sb ^ (((sb >> 9) & 1) << 5); R = (st >> 1) * 16 + swz / 64; C = (st & 1) * 32 + (swz % 64) / 2; }
__host__ __device__ __forceinline__ int perm32(int rho) { const int n = rho >> 4, i = rho & 15; return 8 * (i >> 2) + 4 * n + (i & 3); }

struct Unit { int pm, pn; };
struct Gemm { const bf16_t* A; const bf16_t* Bt; int M, N, K; };

struct StaticOrder {
    int nM, nN, nwg, G, c;
    __host__ __device__ void init(int M, int N, int G_, int c_) { nM = M / BM; nN = N / BM; nwg = nM * nN; G = G_; c = c_; }
    __host__ __device__ bool next(int i, Unit& u) const {
        const long L = (long)i * G + c; if (L >= nwg) return false;
        int wgid = (int)L; { const int q = nwg / NXCD, r = nwg % NXCD, xcd = wgid % NXCD, off = wgid / NXCD; wgid = (xcd < r ? xcd * (q + 1) : r * (q + 1) + (xcd - r) * q) + off; }
        const int nig = WGM * nN, gid = wgid / nig, fm = gid * WGM, gsz = (nM - fm) < WGM ? (nM - fm) : WGM;
        u.pm = fm + ((wgid % nig) % gsz); u.pn = (wgid % nig) / gsz; return true;
    }
    __device__ __forceinline__ void a_ready(const Unit&) const {}
    __device__ __forceinline__ void done(const Unit&) const {}
};
__device__ __forceinline__ unsigned cvt_pk_bf16(float lo, float hi) { unsigned r; asm volatile("v_cvt_pk_bf16_f32 %0, %1, %2" : "=v"(r) : "v"(lo), "v"(hi)); return r; }
template <class Epi, class Sched, bool ALIGN_EPI = false, bool SP2 = false>
__device__ __forceinline__ void gemm_phase(PG8_LAS unsigned char* lds, const Gemm g, const Sched& S, const Epi& E, int wv_) {
    unsigned m_ = ~0u; asm volatile("" : "+s"(m_)); asm volatile("" : "+s"(wv_)); int tid_ = wv_ * 64 + (int)__builtin_amdgcn_mbcnt_hi(m_, __builtin_amdgcn_mbcnt_lo(m_, 0u)); { unsigned z_ = 0; asm volatile("" : "+s"(z_)); lds += z_; } const int tid = tid_, wid = __builtin_amdgcn_readfirstlane(tid >> 6), lane = tid & 63, wr = wid >> 2, wc = wid & 3, fr = lane & 15, fq = lane >> 4;
    const int K = g.K, nt = K / BK;
    unsigned voffA[2], voffB[2];
#pragma unroll
    for (int i = 0; i < 2; ++i) { int R, C; stage_rc(tid * 16 + i * 8192, R, C); const int Rb = Epi::PERM ? ((R & ~31) + perm32(R & 31)) : R;
        voffA[i] = (unsigned)(R * K + C) * 2u; voffB[i] = (unsigned)(Rb * K + C) * 2u; }
    const size_t kstep = (size_t)(BK * 2);
    const size_t hstep = (size_t)HALF * K * 2;
    const size_t tstep = 2 * hstep;
    const unsigned ldsw = (unsigned)wid * 1024u;
    const int aoff = lds_byte(wr * 64 + fr, fq * 8), boff = lds_byte(wc * 32 + fr, fq * 8);
#define PG8_SA(b, h) (((b) * 2 + (h)) * HTB)
#define PG8_SB(b, h) ((4 + (b) * 2 + (h)) * HTB)
#define PG8_STAGE(bufoff, gbase, voff) do { _Pragma("unroll") for (int _i = 0; _i < 2; ++_i) \
        __builtin_amdgcn_global_load_lds((const unsigned*)((const char*)(gbase) + (voff)[_i]), (PG8_LAS unsigned*)(lds + (bufoff) + ldsw + _i * 8192), 16, 0, 0); } while (0)
#define PG8_LDA(dst, b, h) do { _Pragma("unroll") for (int m = 0; m < 4; ++m) _Pragma("unroll") for (int k = 0; k < 2; ++k) dst[m][k] = *(const PG8_LAS bf16x8*)(lds + PG8_SA(b, h) + aoff + m * 2048 + k * 1024); } while (0)
#define PG8_LDB(dst, b, h) do { _Pragma("unroll") for (int n = 0; n < 2; ++n) _Pragma("unroll") for (int k = 0; k < 2; ++k) dst[n][k] = *(const PG8_LAS bf16x8*)(lds + PG8_SB(b, h) + boff + n * 2048 + k * 1024); } while (0)
#define PG8_MMA(ai, bj, At, Bt) do { __builtin_amdgcn_s_setprio(1); _Pragma("unroll") for (int m = 0; m < 4; ++m) _Pragma("unroll") for (int n = 0; n < 2; ++n) _Pragma("unroll") for (int k = 0; k < 2; ++k) \
        acc[ai][bj][m][n] = __builtin_amdgcn_mfma_f32_16x16x32_bf16(Bt[n][k], At[m][k], acc[ai][bj][m][n], 0, 0, 0); __builtin_amdgcn_s_setprio(0); } while (0)
#define PG8_WAIT_V(n) asm volatile("s_waitcnt vmcnt(" #n ")" ::: "memory")
#define PG8_WAIT_L(n) asm volatile("s_waitcnt lgkmcnt(" #n ")" ::: "memory")
#define PG8_BAR __builtin_amdgcn_s_barrier()
#define PG8_SCHED __builtin_amdgcn_sched_barrier(0)
    Unit cur, nxt; int ui = 0;
    if (!S.next(0, cur)) return;
    f32x4 acc[2][2][4][2];
#pragma unroll
    for (int a = 0; a < 2; ++a)
#pragma unroll
        for (int b = 0; b < 2; ++b)
#pragma unroll
            for (int m = 0; m < 4; ++m)
#pragma unroll
                for (int n = 0; n < 2; ++n) acc[a][b][m][n] = (f32x4){0.f, 0.f, 0.f, 0.f};
    bf16x8 At[4][2], B0[2][2], B1[2][2];
    const char* cA = (const char*)g.A + (size_t)cur.pm * tstep; const char* cB = (const char*)g.Bt + (size_t)cur.pn * tstep;
    S.a_ready(cur);
    if constexpr (SP2) {
        PG8_STAGE(PG8_SB(0, 0), cB, voffB); PG8_STAGE(PG8_SB(0, 1), cB + hstep, voffB); PG8_STAGE(PG8_SA(0, 0), cA, voffA); PG8_STAGE(PG8_SA(0, 1), cA + hstep, voffA);
        if (wr == 1) PG8_BAR;
        PG8_WAIT_V(2); PG8_BAR;
        PG8_STAGE(PG8_SB(1, 0), cB + kstep, voffB); PG8_STAGE(PG8_SA(1, 0), cA + kstep, voffA); PG8_STAGE(PG8_SB(1, 1), cB + hstep + kstep, voffB);
        PG8_WAIT_V(6); PG8_BAR;
    } else {
        PG8_STAGE(PG8_SB(0, 0), cB, voffB); PG8_STAGE(PG8_SA(0, 0), cA, voffA); PG8_STAGE(PG8_SB(0, 1), cB + hstep, voffB); PG8_STAGE(PG8_SA(0, 1), cA + hstep, voffA);
        if (wr == 1) PG8_BAR;
        PG8_WAIT_V(4); PG8_BAR;
        PG8_STAGE(PG8_SB(1, 0), cB + kstep, voffB); PG8_STAGE(PG8_SA(1, 0), cA + kstep, voffA); PG8_STAGE(PG8_SB(1, 1), cB + hstep + kstep, voffB);
        PG8_WAIT_V(6); PG8_BAR;
    }
    for (;;) {
        const bool has_next = S.next(ui + 1, nxt);
        const char* nA = has_next ? (const char*)g.A + (size_t)nxt.pm * tstep : cA; const char* nB = has_next ? (const char*)g.Bt + (size_t)nxt.pn * tstep : cB;
        for (int t = 0; t < nt; t += 2) {
            const bool last = (t == nt - 2);
            const char* a1 = cA + (size_t)(t + 1) * kstep;
            const char* a2 = last ? nA : cA + (size_t)(t + 2) * kstep; const char* b2 = last ? nB : cB + (size_t)(t + 2) * kstep;
            const char* a3 = a2 + kstep; const char* b3 = b2 + kstep;
            if (last && has_next) S.a_ready(nxt);
            if constexpr (SP2) {
            PG8_LDB(B0, 0, 0); PG8_LDB(B1, 0, 1); PG8_SCHED; PG8_LDA(At, 0, 0); PG8_STAGE(PG8_SA(1, 1), a1 + hstep, voffA);
            PG8_WAIT_V(8); PG8_WAIT_L(0); PG8_BAR; PG8_MMA(0, 0, At, B0); PG8_MMA(0, 1, At, B1); PG8_BAR; PG8_SCHED;
            PG8_LDA(At, 0, 1); PG8_STAGE(PG8_SB(0, 0), b2, voffB); PG8_STAGE(PG8_SB(0, 1), b2 + hstep, voffB); PG8_STAGE(PG8_SA(0, 0), a2, voffA);
            PG8_WAIT_V(8); PG8_WAIT_L(0); PG8_BAR; PG8_MMA(1, 0, At, B0); PG8_MMA(1, 1, At, B1); PG8_BAR; PG8_SCHED;
            PG8_LDB(B0, 1, 0); PG8_LDB(B1, 1, 1); PG8_SCHED; PG8_LDA(At, 1, 0); PG8_STAGE(PG8_SA(0, 1), a2 + hstep, voffA);
            PG8_WAIT_V(8); PG8_WAIT_L(0); PG8_BAR; PG8_MMA(0, 0, At, B0); PG8_MMA(0, 1, At, B1); PG8_BAR; PG8_SCHED;
            PG8_LDA(At, 1, 1); PG8_STAGE(PG8_SB(1, 0), b3, voffB); PG8_STAGE(PG8_SB(1, 1), b3 + hstep, voffB); PG8_STAGE(PG8_SA(1, 0), a3, voffA);
            PG8_WAIT_V(8); PG8_WAIT_L(0); PG8_BAR; PG8_MMA(1, 0, At, B0); PG8_MMA(1, 1, At, B1); PG8_BAR; PG8_SCHED;
            } else {
            PG8_LDB(B0, 0, 0); PG8_SCHED; PG8_LDA(At, 0, 0); PG8_STAGE(PG8_SA(1, 1), a1 + hstep, voffA);
            PG8_WAIT_L(8); PG8_BAR; PG8_WAIT_L(0); PG8_MMA(0, 0, At, B0); PG8_BAR; PG8_SCHED;
            PG8_LDB(B1, 0, 1); PG8_STAGE(PG8_SB(0, 0), b2, voffB);
            PG8_BAR; PG8_WAIT_L(0); PG8_MMA(0, 1, At, B1); PG8_BAR;
            PG8_LDA(At, 0, 1); PG8_STAGE(PG8_SA(0, 0), a2, voffA);
            PG8_BAR; PG8_WAIT_L(0); PG8_MMA(1, 0, At, B0); PG8_BAR; PG8_SCHED;
            PG8_STAGE(PG8_SB(0, 1), b2 + hstep, voffB);
            PG8_WAIT_V(6); PG8_BAR; PG8_MMA(1, 1, At, B1); PG8_BAR;
            PG8_LDB(B0, 1, 0); PG8_SCHED; PG8_LDA(At, 1, 0); PG8_STAGE(PG8_SA(0, 1), a2 + hstep, voffA);
            PG8_WAIT_L(8); PG8_BAR; PG8_WAIT_L(0); PG8_MMA(0, 0, At, B0); PG8_BAR; PG8_SCHED;
            PG8_LDB(B1, 1, 1); PG8_STAGE(PG8_SB(1, 0), b3, voffB);
            PG8_BAR; PG8_WAIT_L(0); PG8_MMA(0, 1, At, B1); PG8_BAR;
            PG8_LDA(At, 1, 1); PG8_STAGE(PG8_SA(1, 0), a3, voffA);
            PG8_BAR; PG8_WAIT_L(0); PG8_MMA(1, 0, At, B0); PG8_BAR; PG8_SCHED;
            PG8_STAGE(PG8_SB(1, 1), b3 + hstep, voffB);
            PG8_WAIT_V(6); PG8_BAR; PG8_MMA(1, 1, At, B1); PG8_BAR;
            }
        }
        if constexpr (ALIGN_EPI) { if (wr == 0) PG8_BAR; }
        if constexpr (!Epi::AFTER_DRAIN) { E(acc, cur, wr, wc, fr, fq); S.done(cur); }
        if (!has_next) break;
#pragma unroll
        for (int a = 0; a < 2; ++a)
#pragma unroll
            for (int b = 0; b < 2; ++b)
#pragma unroll
                for (int m = 0; m < 4; ++m)
#pragma unroll
                    for (int n = 0; n < 2; ++n) acc[a][b][m][n] = (f32x4){0.f, 0.f, 0.f, 0.f};
        cur = nxt; cA = nA; cB = nB; ++ui;
        if constexpr (ALIGN_EPI) { if (wr == 1) PG8_BAR; }
    }
    PG8_WAIT_V(0);
    if constexpr (!ALIGN_EPI) { if (wr == 0) PG8_BAR; }
    PG8_BAR;
    if constexpr (Epi::AFTER_DRAIN) { E.fused(acc, cur, wr, wc, fr, fq, lds, wid, lane); S.done(cur); }
#undef PG8_SA
#undef PG8_SB
#undef PG8_STAGE
#undef PG8_LDA
#undef PG8_LDB
#undef PG8_MMA
#undef PG8_WAIT_V
#undef PG8_WAIT_L
#undef PG8_BAR
#undef PG8_SCHED
}
}

#define LAS __attribute__((address_space(3)))
using pg8::bf16_t; using pg8::bf16x8; using pg8::f32x4; using pg8::u32x4; using pg8::Unit; using pg8::cvt_pk_bf16;
typedef unsigned u32x2 __attribute__((ext_vector_type(2)));

constexpr int DM = 1024, TP = 16384, NSM = 512, MT = TP + NSM, INC = 2304, DFF = 2816, PLE = 256;
constexpr int ZQ = 0, ZF = 256, ZI = 512, ZG = 768, ZBU = 1024, ZBG = 1280, ZCQ = 1536, ZCK = 2048, ZCV = 2176;
constexpr float EPS = 1e-6f;
constexpr int NPOS = TP + 4;
constexpr size_t O_Y = 0, O_SPH = (size_t)MT * DM, O_SPC = O_SPH + 32768, O_SPK = O_SPC + 15360, O_SPV = O_SPK + 32768,
                 O_SSH = O_SPV + 32768, O_SSC = O_SSH + 4194304, O_SSK = O_SSC + 1966080, O_SSV = O_SSK + 4194304;
constexpr size_t MiB = 1u << 20;
constexpr size_t WS_CTL = 0, CTL_BYTES = 65536;
constexpr size_t WS_SS = 1 * MiB;
constexpr size_t WS_LB = WS_SS + 512 * 1024;
constexpr size_t WS_DVEC = WS_LB + 4096;
constexpr size_t WS_ROPE = 2 * MiB;
constexpr size_t WS_W = 7 * MiB;
constexpr size_t W_IN = 0, W_OUT = W_IN + (size_t)INC * DM * 2, W_GU = W_OUT + (size_t)DM * DM * 2, W_D = W_GU + (size_t)2 * DFF * DM * 2,
                 W_PG = W_D + (size_t)DM * DFF * 2, W_PP = W_PG + (size_t)DM * DM * 2, W_LAYER = W_PP + (size_t)DM * PLE * 2;
constexpr size_t WS_BUFA = 59 * MiB, WS_BUFB = 92 * MiB, WS_ZACT = 125 * MiB, WS_PB = 216 * MiB, WS_DS = 233 * MiB, WS_END = 249 * MiB;
static_assert(WS_W + 2 * W_LAYER <= WS_BUFA && WS_BUFA + (size_t)MT * DM * 2 <= WS_BUFB && WS_BUFB + (size_t)MT * DM * 2 <= WS_ZACT, "ws map");
static_assert(WS_ZACT + (size_t)MT * DFF * 2 <= WS_PB && WS_PB + (size_t)2 * MT * PLE * 2 <= WS_DS && WS_ROPE + (size_t)NPOS * 64 * 4 <= WS_W, "ws map");
constexpr int LDS_BYTES = 147456, MISC_OFF = 131072 + 320;

#define LSYNC() do { asm volatile("s_waitcnt lgkmcnt(0)" ::: "memory"); __builtin_amdgcn_s_barrier(); asm volatile("" ::: "memory"); } while (0)
#define LDS_WAIT() asm volatile("s_waitcnt lgkmcnt(0)" ::: "memory")
__device__ __forceinline__ float bf2f(unsigned short h) { return __uint_as_float(((unsigned)h) << 16); }
template <int CTRL> __device__ __forceinline__ float dppf(float v) { return __int_as_float(__builtin_amdgcn_update_dpp(0, __float_as_int(v), CTRL, 0xf, 0xf, true)); }
__device__ __forceinline__ float wave_sum(float v) {
    v += dppf<0xB1>(v);
    v += dppf<0x4E>(v);
    v += dppf<0x141>(v);
    v += dppf<0x140>(v);
    const float r0 = __int_as_float(__builtin_amdgcn_readlane(__float_as_int(v), 0)), r1 = __int_as_float(__builtin_amdgcn_readlane(__float_as_int(v), 16));
    const float r2 = __int_as_float(__builtin_amdgcn_readlane(__float_as_int(v), 32)), r3 = __int_as_float(__builtin_amdgcn_readlane(__float_as_int(v), 48));
    return (r0 + r1) + (r2 + r3);
}
__device__ __forceinline__ float quad_sum(float v) { v += dppf<0xB1>(v); v += dppf<0x4E>(v); return v; }
__device__ __forceinline__ float sigmoidf_(float x) { return __builtin_amdgcn_rcpf(1.0f + __expf(-x)); }
__device__ __forceinline__ float siluf_(float x) { return x * __builtin_amdgcn_rcpf(1.0f + __expf(-x)); }
#define UNPACK8(V_, o) do { (o)[0] = __uint_as_float((V_).x << 16); (o)[1] = __uint_as_float((V_).x & 0xffff0000u); (o)[2] = __uint_as_float((V_).y << 16); (o)[3] = __uint_as_float((V_).y & 0xffff0000u); \
    (o)[4] = __uint_as_float((V_).z << 16); (o)[5] = __uint_as_float((V_).z & 0xffff0000u); (o)[6] = __uint_as_float((V_).w << 16); (o)[7] = __uint_as_float((V_).w & 0xffff0000u); } while (0)

#define XB_TMO      128
#define XB_XCNT(j)  (256  + 64 * (j))
#define XB_XSUB(j)  (1280 + 64 * (j))
#define XB_XGEN(j)  (2304 + 64 * (j))
#define XB_TOP      3328
#define XB_TOPGEN   3392
#define XCD_BAR_WORDS 3456
#define XB_SPIN_CAP (1u << 18)

__device__ __forceinline__ unsigned xb_ld(unsigned* p)              { return __hip_atomic_load(p, __ATOMIC_RELAXED, __HIP_MEMORY_SCOPE_AGENT); }
__device__ __forceinline__ unsigned xb_add(unsigned* p, unsigned v) { return __hip_atomic_fetch_add(p, v, __ATOMIC_RELAXED, __HIP_MEMORY_SCOPE_AGENT); }
__device__ __forceinline__ unsigned xb_xcc_id() { return (unsigned)__builtin_amdgcn_s_getreg((3 << 11) | 20) & 0xFu; }
#define XB_SPIN(cond, bar) do { unsigned _sp = 0; while (cond) { __builtin_amdgcn_s_sleep(1); \
    if ((++_sp & 255u) == 0u) { if (xb_ld(&(bar)[XB_TMO])) break; if (_sp > XB_SPIN_CAP) { atomicAdd(&(bar)[XB_TMO], 1u); break; } } } } while (0)

struct XcdBarrier {
    unsigned* bar; unsigned x; int wv;
    volatile LAS unsigned* st;
};

__device__ __forceinline__ XcdBarrier xcd_barrier_post(unsigned* bar, volatile LAS unsigned* st) {
    XcdBarrier b; b.bar = bar; b.x = xb_xcc_id(); b.st = st;
    if (threadIdx.x == 0) (void)xb_add(&bar[XB_XCNT(b.x)], 1u);
    return b;
}
__device__ __forceinline__ void xcd_barrier_complete(unsigned* bar, unsigned x, unsigned& nloc, unsigned& nx) {
    const unsigned G = gridDim.x * gridDim.y * gridDim.z;
    unsigned sum, cnt, mine, sp = 0u;
    for (;;) {
        sum = 0u; cnt = 0u; mine = 0u;
#pragma unroll
        for (unsigned j = 0; j < 16; ++j) { const unsigned c = xb_ld(&bar[XB_XCNT(j)]); sum += c; cnt += (c > 0u) ? 1u : 0u; mine = (j == x) ? c : mine; }
        if (sum == G) break;
        __builtin_amdgcn_s_sleep(1);
        if ((++sp & 255u) == 0u) { if (xb_ld(&bar[XB_TMO])) break; if (sp > XB_SPIN_CAP) { atomicAdd(&bar[XB_TMO], 1u); break; } }
    }
    nloc = mine > 0u ? mine : 1u; nx = cnt > 0u ? cnt : 1u;
}

__device__ __forceinline__ void xcd_barrier(const XcdBarrier& b) {
    asm volatile("s_waitcnt vmcnt(0)" ::: "memory");
    __syncthreads();
    unsigned xm_ = ~0u; asm volatile("" : "+s"(xm_));
    int xw_ = b.wv; asm volatile("" : "+s"(xw_));
    if (xw_ == 0 && __builtin_amdgcn_mbcnt_hi(xm_, __builtin_amdgcn_mbcnt_lo(xm_, 0u)) == 0u) {
        unsigned* bar = b.bar;
        __builtin_amdgcn_s_waitcnt(0);
        unsigned nloc = b.st[0], nx = b.st[1];
        if (nloc == 0u) { xcd_barrier_complete(bar, b.x, nloc, nx); b.st[0] = nloc; b.st[1] = nx; }
        const unsigned old = xb_add(&bar[XB_XSUB(b.x)], 1u);
        const unsigned gen = old / nloc;
        if (old + 1u == (gen + 1u) * nloc) {
            __builtin_amdgcn_fence(__ATOMIC_RELEASE, "agent");
            asm volatile("s_waitcnt vmcnt(0)" ::: "memory");
            const unsigned og = xb_add(&bar[XB_TOP], 1u);
            const unsigned tg = og / nx;
            if (og + 1u == (tg + 1u) * nx) xb_add(&bar[XB_TOPGEN], 1u);
            else XB_SPIN(xb_ld(&bar[XB_TOPGEN]) == tg, bar);
            __builtin_amdgcn_fence(__ATOMIC_ACQUIRE, "agent");
            xb_add(&bar[XB_XGEN(b.x)], 1u);
            asm volatile("s_waitcnt vmcnt(0)" ::: "memory");
        } else {
            XB_SPIN(xb_ld(&bar[XB_XGEN(b.x)]) == gen, bar);
            __builtin_amdgcn_fence(__ATOMIC_ACQUIRE, "agent");
            asm volatile("s_waitcnt vmcnt(0)" ::: "memory");
        }
    }
    __syncthreads();
}

struct EpiZ {
    static constexpr bool PERM = true, AFTER_DRAIN = false;
    bf16_t* O; int ldc; const float* ss;
    __device__ __forceinline__ void operator()(const f32x4 (&acc)[2][2][4][2], const Unit& u, int wr, int wc, int fr, int fq) const {
        const int row0 = u.pm * 256 + wr * 64 + fr, col0 = u.pn * 256 + wc * 32 + 8 * fq;
#pragma unroll
        for (int ai = 0; ai < 2; ++ai)
#pragma unroll
            for (int m = 0; m < 4; ++m) {
                const int row = row0 + ai * 128 + m * 16; const float r = rsqrtf(ss[row] * (1.0f / DM) + EPS);
                bf16_t* rowp = O + (size_t)row * ldc + col0;
#pragma unroll
                for (int bj = 0; bj < 2; ++bj) { const f32x4 v0 = acc[ai][bj][m][0] * r, v1 = acc[ai][bj][m][1] * r;
                    u32x4 w; w.x = cvt_pk_bf16(v0[0], v0[1]); w.y = cvt_pk_bf16(v0[2], v0[3]); w.z = cvt_pk_bf16(v1[0], v1[1]); w.w = cvt_pk_bf16(v1[2], v1[3]);
                    *(u32x4*)(rowp + bj * 128) = w; }
            }
    }
};
struct EpiGU {
    static constexpr bool PERM = true, AFTER_DRAIN = false;
    bf16_t* O; const float* ss;
    __device__ __forceinline__ void operator()(const f32x4 (&acc)[2][2][4][2], const Unit& u, int wr, int wc, int fr, int fq) const {
        const int row0 = u.pm * 256 + wr * 64 + fr, col0 = u.pn * 128 + wc * 32 + 8 * fq;
#pragma unroll
        for (int ai = 0; ai < 2; ++ai)
#pragma unroll
            for (int m = 0; m < 4; ++m) {
                const int row = row0 + ai * 128 + m * 16; const float r = rsqrtf(ss[row] * (1.0f / DM) + EPS);
                float o[8];
#pragma unroll
                for (int n = 0; n < 2; ++n)
#pragma unroll
                    for (int e = 0; e < 4; ++e) { const float g = acc[ai][0][m][n][e] * r, up = acc[ai][1][m][n][e] * r; o[n * 4 + e] = siluf_(g) * up; }
                u32x4 w; w.x = cvt_pk_bf16(o[0], o[1]); w.y = cvt_pk_bf16(o[2], o[3]); w.z = cvt_pk_bf16(o[4], o[5]); w.w = cvt_pk_bf16(o[6], o[7]);
                *(u32x4*)(O + (size_t)row * DFF + col0) = w;
            }
    }
};
struct EpiRes {
    static constexpr bool PERM = false, AFTER_DRAIN = false;
    const bf16_t* res; bf16_t* Ob; float* ss;
    __device__ __forceinline__ void operator()(const f32x4 (&acc)[2][2][4][2], const Unit& u, int wr, int wc, int fr, int fq) const {
        const int row0 = u.pm * 256 + wr * 64 + fr, col0 = u.pn * 256 + wc * 32 + 4 * fq;
        u32x2 rw[2][4][2][2];
#pragma unroll
        for (int ai = 0; ai < 2; ++ai)
#pragma unroll
            for (int m = 0; m < 4; ++m)
#pragma unroll
                for (int bj = 0; bj < 2; ++bj)
#pragma unroll
                    for (int n = 0; n < 2; ++n) rw[ai][m][bj][n] = *(const u32x2*)(res + (size_t)(row0 + ai * 128 + m * 16) * DM + col0 + bj * 128 + n * 16);
#pragma unroll
        for (int ai = 0; ai < 2; ++ai)
#pragma unroll
            for (int m = 0; m < 4; ++m) {
                const int row = row0 + ai * 128 + m * 16; const size_t off = (size_t)row * DM + col0; float sq = 0.f;
#pragma unroll
                for (int bj = 0; bj < 2; ++bj)
#pragma unroll
                    for (int n = 0; n < 2; ++n) { const size_t o2 = off + bj * 128 + n * 16;
                        const u32x2 r2 = rw[ai][m][bj][n];
                        f32x4 v = acc[ai][bj][m][n]; v[0] += __uint_as_float(r2.x << 16); v[1] += __uint_as_float(r2.x & 0xffff0000u); v[2] += __uint_as_float(r2.y << 16); v[3] += __uint_as_float(r2.y & 0xffff0000u);
                        u32x2 w; w.x = cvt_pk_bf16(v[0], v[1]); w.y = cvt_pk_bf16(v[2], v[3]); *(u32x2*)(Ob + o2) = w;
                        sq += (v[0] * v[0] + v[1] * v[1]) + (v[2] * v[2] + v[3] * v[3]); }
                sq += __shfl_xor(sq, 16); sq += __shfl_xor(sq, 32);
                if (fq == 0) unsafeAtomicAdd(ss + row, sq);
            }
    }
};
struct EpiGate {
    static constexpr bool PERM = false, AFTER_DRAIN = false;
    bf16_t* Gt; const float* ss;
    __device__ __forceinline__ void operator()(const f32x4 (&acc)[2][2][4][2], const Unit& u, int wr, int wc, int fr, int fq) const {
        const int row0 = u.pm * 256 + wr * 64 + fr, col0 = u.pn * 256 + wc * 32 + 4 * fq;
#pragma unroll
        for (int ai = 0; ai < 2; ++ai)
#pragma unroll
            for (int m = 0; m < 4; ++m) {
                const int row = row0 + ai * 128 + m * 16; const size_t off = (size_t)row * DM + col0; const float r = rsqrtf(ss[row] * (1.0f / DM) + EPS);
#pragma unroll
                for (int bj = 0; bj < 2; ++bj)
#pragma unroll
                    for (int n = 0; n < 2; ++n) { const f32x4 a = acc[ai][bj][m][n] * r;
                        u32x2 w; w.x = cvt_pk_bf16(sigmoidf_(a[0]), sigmoidf_(a[1])); w.y = cvt_pk_bf16(sigmoidf_(a[2]), sigmoidf_(a[3]));
                        *(u32x2*)(Gt + off + bj * 128 + n * 16) = w; }
            }
    }
};
struct EpiOut {
    static constexpr bool PERM = false, AFTER_DRAIN = false;
    const bf16_t* Gt; const bf16_t* res; float* Y; bf16_t* Ob; float* ss; int final_;
    __device__ __forceinline__ void operator()(const f32x4 (&acc)[2][2][4][2], const Unit& u, int wr, int wc, int fr, int fq) const {
        const int row0 = u.pm * 256 + wr * 64 + fr, col0 = u.pn * 256 + wc * 32 + 4 * fq;
#pragma unroll
        for (int ai = 0; ai < 2; ++ai) {
            u32x2 rw[4][2][2], gw[4][2][2];
#pragma unroll
            for (int m = 0; m < 4; ++m)
#pragma unroll
                for (int bj = 0; bj < 2; ++bj)
#pragma unroll
                    for (int n = 0; n < 2; ++n) { const size_t o2 = (size_t)(row0 + ai * 128 + m * 16) * DM + col0 + bj * 128 + n * 16; rw[m][bj][n] = *(const u32x2*)(res + o2); gw[m][bj][n] = *(const u32x2*)(Gt + o2); }
#pragma unroll
            for (int m = 0; m < 4; ++m) {
                const int row = row0 + ai * 128 + m * 16; const size_t off = (size_t)row * DM + col0; float sq = 0.f;
#pragma unroll
                for (int bj = 0; bj < 2; ++bj)
#pragma unroll
                    for (int n = 0; n < 2; ++n) { const size_t o2 = off + bj * 128 + n * 16;
                        const u32x2 r2 = rw[m][bj][n], g2 = gw[m][bj][n];
                        const f32x4 a = acc[ai][bj][m][n]; f32x4 v;
                        v[0] = __uint_as_float(r2.x << 16) + __uint_as_float(g2.x << 16) * a[0]; v[1] = __uint_as_float(r2.x & 0xffff0000u) + __uint_as_float(g2.x & 0xffff0000u) * a[1];
                        v[2] = __uint_as_float(r2.y << 16) + __uint_as_float(g2.y << 16) * a[2]; v[3] = __uint_as_float(r2.y & 0xffff0000u) + __uint_as_float(g2.y & 0xffff0000u) * a[3];
                        if (final_) *(f32x4*)(Y + o2) = v;
                        else { u32x2 w; w.x = cvt_pk_bf16(v[0], v[1]); w.y = cvt_pk_bf16(v[2], v[3]); *(u32x2*)(Ob + o2) = w; }
                        sq += (v[0] * v[0] + v[1] * v[1]) + (v[2] * v[2] + v[3] * v[3]); }
                if (!final_) { sq += __shfl_xor(sq, 16); sq += __shfl_xor(sq, 32); if (fq == 0) unsafeAtomicAdd(ss + row, sq); }
            }
        }
    }
};

template <class Epi>
__device__ __forceinline__ void small_gemm(LAS unsigned char* lds, const bf16_t* A, const bf16_t* Bt, int K, const Epi& E, int bid, int tid, int lane, int wave) {
    if (bid >= 256) return;
    const int r0 = 64 * (bid >> 5), c0 = 32 * (bid & 31), fr = lane & 15, g = lane >> 4, kw = K >> 3;
    f32x4 acc[4][2];
#pragma unroll
    for (int m = 0; m < 4; ++m) { acc[m][0] = (f32x4){0.f, 0.f, 0.f, 0.f}; acc[m][1] = (f32x4){0.f, 0.f, 0.f, 0.f}; }
    const bf16_t* ap = A + (size_t)(r0 + fr) * K + wave * kw + 8 * g;
    const bf16_t* bp = Bt + (size_t)(c0 + fr) * K + wave * kw + 8 * g;
#pragma unroll 4
    for (int ks = 0; ks < kw; ks += 32) {
        bf16x8 a[4], b[2];
#pragma unroll
        for (int m = 0; m < 4; ++m) a[m] = *(const bf16x8*)(ap + (size_t)m * 16 * K + ks);
#pragma unroll
        for (int n = 0; n < 2; ++n) b[n] = *(const bf16x8*)(bp + (size_t)n * 16 * K + ks);
#pragma unroll
        for (int m = 0; m < 4; ++m)
#pragma unroll
            for (int n = 0; n < 2; ++n) acc[m][n] = __builtin_amdgcn_mfma_f32_16x16x32_bf16(a[m], b[n], acc[m][n], 0, 0, 0);
    }
    LAS float* P = (LAS float*)lds + wave * (64 * 33);
    LSYNC();
#pragma unroll
    for (int m = 0; m < 4; ++m)
#pragma unroll
        for (int n = 0; n < 2; ++n)
#pragma unroll
            for (int r = 0; r < 4; ++r) P[(16 * m + 4 * g + r) * 33 + 16 * n + fr] = acc[m][n][r];
    LSYNC();
    const int row = tid >> 3, c4 = (tid & 7) * 4;
    f32x4 v = (f32x4){0.f, 0.f, 0.f, 0.f};
#pragma unroll
    for (int w2 = 0; w2 < 8; ++w2) { const LAS float* q = (const LAS float*)lds + w2 * (64 * 33) + row * 33 + c4; v[0] += q[0]; v[1] += q[1]; v[2] += q[2]; v[3] += q[3]; }
    LSYNC();
    E.apply(r0 + row, c0 + c4, v, tid);
}
struct SEpiRes {
    const bf16_t* res; bf16_t* Ob; float* ss;
    __device__ __forceinline__ void apply(int row, int col, f32x4 v, int tid) const {
        const size_t o = (size_t)row * DM + col; const u32x2 rw = *(const u32x2*)(res + o);
        v[0] += __uint_as_float(rw.x << 16); v[1] += __uint_as_float(rw.x & 0xffff0000u); v[2] += __uint_as_float(rw.y << 16); v[3] += __uint_as_float(rw.y & 0xffff0000u);
        u32x2 w; w.x = cvt_pk_bf16(v[0], v[1]); w.y = cvt_pk_bf16(v[2], v[3]); *(u32x2*)(Ob + o) = w;
        float sq = (v[0] * v[0] + v[1] * v[1]) + (v[2] * v[2] + v[3] * v[3]);
        sq += __shfl_xor(sq, 1); sq += __shfl_xor(sq, 2); sq += __shfl_xor(sq, 4);
        if ((tid & 7) == 0) unsafeAtomicAdd(ss + row, sq);
    }
};
struct SEpiGate {
    bf16_t* Gt; const float* ss;
    __device__ __forceinline__ void apply(int row, int col, f32x4 v, int tid) const {
        const float r = rsqrtf(ss[row] * (1.0f / DM) + EPS);
        u32x2 w; w.x = cvt_pk_bf16(sigmoidf_(v[0] * r), sigmoidf_(v[1] * r)); w.y = cvt_pk_bf16(sigmoidf_(v[2] * r), sigmoidf_(v[3] * r));
        *(u32x2*)(Gt + (size_t)row * DM + col) = w;
    }
};
struct SEpiOut {
    const bf16_t* Gt; const bf16_t* res; float* Y; bf16_t* Ob; float* ss; int final_;
    __device__ __forceinline__ void apply(int row, int col, f32x4 a, int tid) const {
        const size_t o = (size_t)row * DM + col; const u32x2 rw = *(const u32x2*)(res + o), gw = *(const u32x2*)(Gt + o); f32x4 v;
        v[0] = __uint_as_float(rw.x << 16) + __uint_as_float(gw.x << 16) * a[0]; v[1] = __uint_as_float(rw.x & 0xffff0000u) + __uint_as_float(gw.x & 0xffff0000u) * a[1];
        v[2] = __uint_as_float(rw.y << 16) + __uint_as_float(gw.y << 16) * a[2]; v[3] = __uint_as_float(rw.y & 0xffff0000u) + __uint_as_float(gw.y & 0xffff0000u) * a[3];
        if (final_) { *(f32x4*)(Y + o) = v; return; }
        u32x2 w; w.x = cvt_pk_bf16(v[0], v[1]); w.y = cvt_pk_bf16(v[2], v[3]); *(u32x2*)(Ob + o) = w;
        float sq = (v[0] * v[0] + v[1] * v[1]) + (v[2] * v[2] + v[3] * v[3]);
        sq += __shfl_xor(sq, 1); sq += __shfl_xor(sq, 2); sq += __shfl_xor(sq, 4);
        if ((tid & 7) == 0) unsafeAtomicAdd(ss + row, sq);
    }
};

__device__ __forceinline__ void transpose_item(const float* W, int K, int N, const float* gain, bf16_t* WT, int mode, LAS float* scr, int item, int lane) {
    const int nblk = N / 32, kb = item / nblk, nb = item % nblk, k0 = 64 * kb, n0 = 32 * nb;
    { const int kr = lane >> 3, nq = (lane & 7) * 4; f32x4 v[8]; float gv[8];
#pragma unroll
      for (int i = 0; i < 8; ++i) { v[i] = *(const f32x4*)(W + (size_t)(k0 + 8 * i + kr) * N + n0 + nq); gv[i] = gain ? gain[k0 + 8 * i + kr] : 1.0f; }
#pragma unroll
      for (int i = 0; i < 8; ++i) { LAS float* d = scr + (8 * i + kr) * 33 + nq; d[0] = v[i][0] * gv[i]; d[1] = v[i][1] * gv[i]; d[2] = v[i][2] * gv[i]; d[3] = v[i][3] * gv[i]; } }
    LDS_WAIT(); asm volatile("" ::: "memory");
    const int drow0 = (mode == 0) ? n0 : (256 * (n0 >> 7) + (n0 & 127) + (mode == 2 ? 128 : 0));
    const int c = lane & 7;
#pragma unroll
    for (int j = 0; j < 4; ++j) { const int n = (lane >> 3) + 8 * j; const LAS float* s = scr + (8 * c) * 33 + n;
        u32x4 o; o.x = cvt_pk_bf16(s[0 * 33], s[1 * 33]); o.y = cvt_pk_bf16(s[2 * 33], s[3 * 33]); o.z = cvt_pk_bf16(s[4 * 33], s[5 * 33]); o.w = cvt_pk_bf16(s[6 * 33], s[7 * 33]);
        *(u32x4*)(WT + (size_t)(drow0 + n) * K + k0 + 8 * c) = o; }
    LDS_WAIT(); asm volatile("" ::: "memory");
}

struct Args { const float* in[27]; float* out; unsigned char* ws; };
constexpr int PT_OFF = 131072 + 1024;
__device__ __forceinline__ int opaque(int x) { asm volatile("" : "+v"(x)); return x; }
__device__ __forceinline__ int lane_id_opaque() { unsigned m_ = ~0u; asm volatile("" : "+s"(m_)); return (int)__builtin_amdgcn_mbcnt_hi(m_, __builtin_amdgcn_mbcnt_lo(m_, 0u)); }
__device__ __forceinline__ const float* ptf(LAS unsigned char* lds, int i) {
    const unsigned long long v = ((LAS const unsigned long long*)(lds + PT_OFF))[i];
    const unsigned lo = __builtin_amdgcn_readfirstlane((unsigned)v), hi = __builtin_amdgcn_readfirstlane((unsigned)(v >> 32));
    return (const float*)(const __attribute__((address_space(1))) float*)(((unsigned long long)hi << 32) | lo);
}
#define IN(i) ptf(lds, (i))
#define OUTP ((float*)ptf(lds, 27))
#define WSP ((unsigned char*)ptf(lds, 28))

__device__ __forceinline__ void prologue(LAS unsigned char* lds, int wv) {
    { unsigned z_ = 0; asm volatile("" : "+s"(z_)); lds += z_; }
    int wave_ = wv; asm volatile("" : "+s"(wave_)); const int wave = wave_, lane = lane_id_opaque(), tid = wave * 64 + lane;
    const int G = gridDim.x, bid = blockIdx.x, gw = bid * 8 + wave, NGW = G * 8, gtid = bid * 512 + tid, NT = G * 512;
    unsigned char* ws = WSP;
    LAS float* scr = (LAS float*)(lds + wave * 16384);
    constexpr int I_IN = (DM / 64) * (INC / 32), I_SQ = (DM / 64) * (DM / 32), I_GU = (DM / 64) * (DFF / 32), I_D = (DFF / 64) * (DM / 32), I_PP = (PLE / 64) * (DM / 32);
    constexpr int I_LAYER = I_IN + I_SQ + 2 * I_GU + I_D + I_SQ + I_PP;
#pragma unroll 1
    for (int it = gw; it < 2 * I_LAYER; it += NGW) {
        const int l = it / I_LAYER; int r = it % I_LAYER;
        unsigned char* wl = ws + WS_W + (size_t)l * W_LAYER;
        if (r < I_IN) { transpose_item(IN(9) + (size_t)l * DM * INC, DM, INC, IN(19) + l * DM, (bf16_t*)(wl + W_IN), 0, scr, r, lane); continue; } r -= I_IN;
        if (r < I_SQ) { transpose_item(IN(18) + (size_t)l * DM * DM, DM, DM, nullptr, (bf16_t*)(wl + W_OUT), 0, scr, r, lane); continue; } r -= I_SQ;
        if (r < I_GU) { transpose_item(IN(21) + (size_t)l * DM * DFF, DM, DFF, IN(20) + l * DM, (bf16_t*)(wl + W_GU), 1, scr, r, lane); continue; } r -= I_GU;
        if (r < I_GU) { transpose_item(IN(22) + (size_t)l * DM * DFF, DM, DFF, IN(20) + l * DM, (bf16_t*)(wl + W_GU), 2, scr, r, lane); continue; } r -= I_GU;
        if (r < I_D) { transpose_item(IN(23) + (size_t)l * DFF * DM, DFF, DM, nullptr, (bf16_t*)(wl + W_D), 0, scr, r, lane); continue; } r -= I_D;
        if (r < I_SQ) { transpose_item(IN(25) + (size_t)l * DM * DM, DM, DM, IN(24) + l * DM, (bf16_t*)(wl + W_PG), 0, scr, r, lane); continue; } r -= I_SQ;
        transpose_item(IN(26) + (size_t)l * PLE * DM, PLE, DM, nullptr, (bf16_t*)(wl + W_PP), 0, scr, r, lane);
    }
    float* ss = (float*)(ws + WS_SS);
    bf16_t* bufA = (bf16_t*)(ws + WS_BUFA);
    const float* xP = IN(0); const float* xS = IN(1);
#pragma unroll 1
    for (int m0 = gw; m0 < MT; m0 += 2 * NGW) {
        f32x4 v[2][4];
#pragma unroll
        for (int q = 0; q < 2; ++q) { const int m = (m0 + q * NGW < MT) ? m0 + q * NGW : m0; const float* xr = (m < TP) ? xP + (size_t)m * DM : xS + (size_t)(m - TP) * DM;
#pragma unroll
            for (int j = 0; j < 4; ++j) v[q][j] = ((const f32x4*)xr)[lane + 64 * j]; }
#pragma unroll
        for (int q = 0; q < 2; ++q) { const int m = (m0 + q * NGW < MT) ? m0 + q * NGW : m0; float s = 0.f;
#pragma unroll
            for (int j = 0; j < 4; ++j) s += (v[q][j][0] * v[q][j][0] + v[q][j][1] * v[q][j][1]) + (v[q][j][2] * v[q][j][2] + v[q][j][3] * v[q][j][3]);
            s = wave_sum(s); if (lane == 0) ss[m] = s;
#pragma unroll
            for (int j = 0; j < 4; ++j) { u32x2 w; w.x = cvt_pk_bf16(v[q][j][0], v[q][j][1]); w.y = cvt_pk_bf16(v[q][j][2], v[q][j][3]); ((u32x2*)(bufA + (size_t)m * DM))[lane + 64 * j] = w; } }
    }
    bf16_t* pb = (bf16_t*)(ws + WS_PB);
    const float* pP = IN(6); const float* pS = IN(7);
#pragma unroll 1
    for (int idx0 = gw; idx0 < 2 * MT; idx0 += 8 * NGW) {
        f32x4 v[8];
#pragma unroll
        for (int q = 0; q < 8; ++q) { const int idx = (idx0 + q * NGW < 2 * MT) ? idx0 + q * NGW : idx0; const int l = idx / MT, m = idx % MT;
            const float* src = (m < TP) ? pP + ((size_t)l * TP + m) * PLE : pS + ((size_t)l * NSM + (m - TP)) * PLE; v[q] = ((const f32x4*)src)[lane]; }
#pragma unroll
        for (int q = 0; q < 8; ++q) { const int idx = (idx0 + q * NGW < 2 * MT) ? idx0 + q * NGW : idx0; const int l = idx / MT, m = idx % MT;
            u32x2 w; w.x = cvt_pk_bf16(v[q][0], v[q][1]); w.y = cvt_pk_bf16(v[q][2], v[q][3]); ((u32x2*)(pb + ((size_t)l * MT + m) * PLE))[lane] = w; }
    }
    float* rc = (float*)(ws + WS_ROPE); float* rs = rc + (size_t)NPOS * 32;
#pragma unroll 1
    for (int idx = gtid; idx < NPOS * 32; idx += NT) {
        const int pos = idx >> 5, d = idx & 31;
        const double inv = exp2(-(double)d * (13.287712379549449 / 32.0));
        double rev = (double)pos * inv * 0.15915494309189535; rev -= rint(rev);
        const float fr = (float)rev;
        rc[idx] = __builtin_amdgcn_cosf(fr); rs[idx] = __builtin_amdgcn_sinf(fr);
    }
    if (gtid < 256) { float* lb = (float*)(ws + WS_LB); const float* al = IN(8); const float a0 = al[gtid], a1 = al[256 + gtid]; lb[gtid] = 0.f; lb[256 + gtid] = 1.0f / (1.0f + expf(a0 - a1)); }
#pragma unroll 1
    for (int idx = gtid; idx < 5 * MT; idx += NT) ss[MT + idx] = 0.f;
}

__device__ __forceinline__ void hgrn_gates(float z, float lb, float& logf_, float& kin) {
    const float e = __expf(-fabsf(z));
    const float inv = __builtin_amdgcn_rcpf(1.0f + e);
    const float big = inv, small = e * inv;
    const float sp = (z >= 0.f) ? big : small;
    const float sn = (z >= 0.f) ? small : big;
    kin = (1.0f - lb) * sn;
    if (lb > 0.f) logf_ = __logf(lb + (1.0f - lb) * sp);
    else logf_ = fminf(z, 0.f) - __logf(1.0f + e);
}

#define HGRN_G(zbase, lbv, tot) \
    float Gl[8], kin[8]; float Gend = 0.f, Gref = 0.f; { float run = 0.f; \
    _Pragma("unroll") for (int i = 0; i < 8; ++i) { float g; hgrn_gates(bf2f((zbase)[(size_t)(8 * wave + i) * INC + ZF]), lbv, g, kin[i]); run += g; Gl[i] = run; } \
    (tot)[wave * 64 + lane] = run; LSYNC(); float off = 0.f; \
    _Pragma("unroll") for (int w2 = 0; w2 < 8; ++w2) { const float t = (tot)[w2 * 64 + lane]; if (w2 < wave) off += t; if (w2 < 4) Gref += t; Gend += t; } \
    _Pragma("unroll") for (int i = 0; i < 8; ++i) Gl[i] += off; }

#define HGRN_G2(zf, lbv, tot) \
    float Gl[8], kin[8]; float Gend = 0.f, Gref = 0.f; { float run = 0.f; \
    _Pragma("unroll") for (int i = 0; i < 8; ++i) { float g; hgrn_gates((zf)[i], lbv, g, kin[i]); run += g; Gl[i] = run; } \
    (tot)[wave * 64 + lane] = run; LSYNC(); float off = 0.f; \
    _Pragma("unroll") for (int w2 = 0; w2 < 8; ++w2) { const float t = (tot)[w2 * 64 + lane]; if (w2 < wave) off += t; if (w2 < 4) Gref += t; Gend += t; } \
    _Pragma("unroll") for (int i = 0; i < 8; ++i) Gl[i] += off; }
__device__ __forceinline__ void hgrn_ds_item(const unsigned (&zfu)[8], const unsigned (&vi)[8], const float* lbp, float* dS, float* dvec, LAS unsigned char* lds, int c, int h, int tid, int lane, int wave) {
    LAS bf16_t* KTt = (LAS bf16_t*)lds;
    LAS bf16_t* Vt = KTt + 64 * 72;
    LAS float* TOT = (LAS float*)(Vt + 64 * 72);
    float zf[8];
#pragma unroll
    for (int i = 0; i < 8; ++i) zf[i] = __uint_as_float(zfu[i] << 16);
    const float lbv = lbp[h * 64 + lane];
    LSYNC();
    HGRN_G2(zf, lbv, TOT)
    { float kt[8];
#pragma unroll
      for (int i = 0; i < 8; ++i) kt[i] = kin[i] * __expf(Gend - Gl[i]);
      u32x4 kw; kw.x = cvt_pk_bf16(kt[0], kt[1]); kw.y = cvt_pk_bf16(kt[2], kt[3]); kw.z = cvt_pk_bf16(kt[4], kt[5]); kw.w = cvt_pk_bf16(kt[6], kt[7]);
      u32x4 vw; vw.x = vi[0] | (vi[1] << 16); vw.y = vi[2] | (vi[3] << 16); vw.z = vi[4] | (vi[5] << 16); vw.w = vi[6] | (vi[7] << 16);
      *(LAS u32x4*)(KTt + lane * 72 + 8 * wave) = kw; *(LAS u32x4*)(Vt + lane * 72 + 8 * wave) = vw; }
    if (wave == 0) dvec[(c * 4 + h) * 64 + lane] = __expf(Gend);
    LSYNC();
    const int fr = lane & 15, g = lane >> 4, kt4 = wave >> 1, vt0 = 2 * (wave & 1);
    f32x4 acc[2] = {(f32x4){0.f, 0.f, 0.f, 0.f}, (f32x4){0.f, 0.f, 0.f, 0.f}};
#pragma unroll
    for (int ks = 0; ks < 2; ++ks) {
        const bf16x8 kb = *(const LAS bf16x8*)(KTt + (16 * kt4 + fr) * 72 + 32 * ks + 8 * g);
#pragma unroll
        for (int n = 0; n < 2; ++n) { const bf16x8 va = *(const LAS bf16x8*)(Vt + (16 * (vt0 + n) + fr) * 72 + 32 * ks + 8 * g);
            acc[n] = __builtin_amdgcn_mfma_f32_16x16x32_bf16(va, kb, acc[n], 0, 0, 0); }
    }
    float* dst = dS + (size_t)(c * 4 + h) * 4096 + (16 * kt4 + fr) * 64 + 4 * g;
#pragma unroll
    for (int n = 0; n < 2; ++n) *(f32x4*)(dst + 16 * (vt0 + n)) = acc[n];
}

__device__ __forceinline__ void hgrn_out_item(const bf16_t* z, const float* lbp, const float* dS, const float* onorm, bf16_t* mix, LAS unsigned char* lds, int c, int hp, int tid, int lane, int wave) {
    const int hh = wave >> 2, wq = wave & 3, h = 2 * hp + hh, fr = lane & 15, g = lane >> 4;
    LAS bf16_t* QT = (LAS bf16_t*)(lds + hh * 46080);
    LAS bf16_t* KT = QT + 4608;
    LAS bf16_t* QS = KT + 4608;
    LAS bf16_t* Vt = QS + 4608;
    LAS bf16_t* St = Vt + 4608;
    LAS float* TOT = (LAS float*)(lds + 92160) + hh * 256;
    const bf16_t* zb = z + (size_t)(64 * c + 16 * wq) * INC + h * 64 + lane;
    unsigned zfu[16], zqu[16], ziu[16];
#pragma unroll
    for (int i = 0; i < 16; ++i) { zfu[i] = zb[(size_t)i * INC + ZF]; zqu[i] = zb[(size_t)i * INC + ZQ]; ziu[i] = zb[(size_t)i * INC + ZI]; }
    f32x4 sv[4];
#pragma unroll
    for (int j4 = 0; j4 < 4; ++j4) sv[j4] = *(const f32x4*)(dS + (size_t)(c * 4 + h) * 4096 + j4 * 1024 + (wq * 64 + lane) * 4);
    const size_t mt = (size_t)(64 * c + 16 * wq + fr);
    u32x2 gz[4];
#pragma unroll
    for (int vt = 0; vt < 4; ++vt) gz[vt] = *(const u32x2*)(z + mt * INC + ZG + h * 64 + 16 * vt + 4 * g);
    const float lbv = lbp[h * 64 + lane];
    LSYNC();
    float Gl[16], kin[16];
    { float run = 0.f;
#pragma unroll
      for (int i = 0; i < 16; ++i) { float gg; hgrn_gates(__uint_as_float(zfu[i] << 16), lbv, gg, kin[i]); run += gg; Gl[i] = run; }
      TOT[wq * 64 + lane] = run; }
    LSYNC();
    float off = 0.f, Gref = 0.f;
#pragma unroll
    for (int w2 = 0; w2 < 4; ++w2) { const float t = TOT[w2 * 64 + lane]; if (w2 < wq) off += t; if (w2 < 2) Gref += t; }
    const float eref = __expf(Gref);
#pragma unroll
    for (int i = 0; i < 16; ++i) { const float G = Gl[i] + off, q = __uint_as_float(zqu[i] << 16); const int s = 16 * wq + i;
        const float e1 = __expf(fminf(fmaxf(G - Gref, -80.f), 80.f)), e2 = __builtin_amdgcn_rcpf(e1);
        const unsigned w01 = cvt_pk_bf16(q * e1, kin[i] * e2);
        QT[s * 72 + lane] = (bf16_t)(w01 & 0xffffu); KT[s * 72 + lane] = (bf16_t)(w01 >> 16);
        QS[s * 72 + lane] = (bf16_t)(cvt_pk_bf16(q * e1 * eref, 0.f) & 0xffffu); }
    { u32x4 v0, v1; v0.x = ziu[0] | (ziu[1] << 16); v0.y = ziu[2] | (ziu[3] << 16); v0.z = ziu[4] | (ziu[5] << 16); v0.w = ziu[6] | (ziu[7] << 16);
      v1.x = ziu[8] | (ziu[9] << 16); v1.y = ziu[10] | (ziu[11] << 16); v1.z = ziu[12] | (ziu[13] << 16); v1.w = ziu[14] | (ziu[15] << 16);
      *(LAS u32x4*)(Vt + lane * 72 + 16 * wq) = v0; *(LAS u32x4*)(Vt + lane * 72 + 16 * wq + 8) = v1; }
#pragma unroll
    for (int j4 = 0; j4 < 4; ++j4) { const int e = j4 * 1024 + (wq * 64 + lane) * 4, k = e >> 6, v = e & 63;
#pragma unroll
        for (int i = 0; i < 4; ++i) St[(v + i) * 72 + k] = (bf16_t)(cvt_pk_bf16(sv[j4][i], 0.f) & 0xffffu); }
    LSYNC();
    const int tt = wq;
    bf16x8 qb0 = *(const LAS bf16x8*)(QT + (16 * tt + fr) * 72 + 8 * g), qb1 = *(const LAS bf16x8*)(QT + (16 * tt + fr) * 72 + 32 + 8 * g);
    f32x4 at[4];
#pragma unroll
    for (int st = 0; st < 4; ++st) {
        at[st] = (f32x4){0.f, 0.f, 0.f, 0.f};
        if (st <= tt) {
            const bf16x8 k0 = *(const LAS bf16x8*)(KT + (16 * st + fr) * 72 + 8 * g), k1 = *(const LAS bf16x8*)(KT + (16 * st + fr) * 72 + 32 + 8 * g);
            f32x4 acc = (f32x4){0.f, 0.f, 0.f, 0.f};
            acc = __builtin_amdgcn_mfma_f32_16x16x32_bf16(k0, qb0, acc, 0, 0, 0);
            acc = __builtin_amdgcn_mfma_f32_16x16x32_bf16(k1, qb1, acc, 0, 0, 0);
            if (st == tt) {
#pragma unroll
                for (int r = 0; r < 4; ++r) acc[r] = (4 * g + r <= fr) ? acc[r] : 0.f; }
            at[st] = acc;
        }
    }
    f32x4 o[4];
#pragma unroll
    for (int vt = 0; vt < 4; ++vt) o[vt] = (f32x4){0.f, 0.f, 0.f, 0.f};
#pragma unroll
    for (int u = 0; u < 2; ++u) {
        if (2 * u <= tt) {
            u32x4 pw; pw.x = cvt_pk_bf16(at[2 * u][0], at[2 * u][1]); pw.y = cvt_pk_bf16(at[2 * u][2], at[2 * u][3]);
            pw.z = cvt_pk_bf16(at[2 * u + 1][0], at[2 * u + 1][1]); pw.w = cvt_pk_bf16(at[2 * u + 1][2], at[2 * u + 1][3]);
            const bf16x8 pf = __builtin_bit_cast(bf16x8, pw);
#pragma unroll
            for (int vt = 0; vt < 4; ++vt) {
                const LAS bf16_t* vp = Vt + (16 * vt + fr) * 72 + 32 * u + 4 * g;
                u32x4 vw; const u32x2 lo = *(const LAS u32x2*)vp, hi = *(const LAS u32x2*)(vp + 16); vw.x = lo.x; vw.y = lo.y; vw.z = hi.x; vw.w = hi.y;
                o[vt] = __builtin_amdgcn_mfma_f32_16x16x32_bf16(__builtin_bit_cast(bf16x8, vw), pf, o[vt], 0, 0, 0);
            }
        }
    }
#pragma unroll
    for (int ks = 0; ks < 2; ++ks) {
        const bf16x8 qs = *(const LAS bf16x8*)(QS + (16 * tt + fr) * 72 + 32 * ks + 8 * g);
#pragma unroll
        for (int vt = 0; vt < 4; ++vt) { const bf16x8 sa = *(const LAS bf16x8*)(St + (16 * vt + fr) * 72 + 32 * ks + 8 * g);
            o[vt] = __builtin_amdgcn_mfma_f32_16x16x32_bf16(sa, qs, o[vt], 0, 0, 0); }
    }
    float sq = 0.f;
#pragma unroll
    for (int vt = 0; vt < 4; ++vt) sq += (o[vt][0] * o[vt][0] + o[vt][1] * o[vt][1]) + (o[vt][2] * o[vt][2] + o[vt][3] * o[vt][3]);
    sq += __shfl_xor(sq, 16); sq += __shfl_xor(sq, 32);
    const float rn = rsqrtf(sq * (1.0f / 64.0f) + EPS);
#pragma unroll
    for (int vt = 0; vt < 4; ++vt) {
        const f32x4 nv = *(const f32x4*)(onorm + 16 * vt + 4 * g);
        const float g0 = __uint_as_float(gz[vt].x << 16), g1 = __uint_as_float(gz[vt].x & 0xffff0000u), g2 = __uint_as_float(gz[vt].y << 16), g3 = __uint_as_float(gz[vt].y & 0xffff0000u);
        u32x2 w; w.x = cvt_pk_bf16(o[vt][0] * rn * nv[0] * siluf_(g0), o[vt][1] * rn * nv[1] * siluf_(g1)); w.y = cvt_pk_bf16(o[vt][2] * rn * nv[2] * siluf_(g2), o[vt][3] * rn * nv[3] * siluf_(g3));
        *(u32x2*)(mix + mt * DM + h * 64 + 16 * vt + 4 * g) = w;
    }
}

__device__ __forceinline__ void hgrn_sample_item(const bf16_t* z, const float* lbp, const float* S0, float* Sout, const float* onorm, bf16_t* mix, LAS unsigned char* lds, int b, int hp, int tid, int lane, int wave) {
    LAS float* F = (LAS float*)lds; LAS float* KI = F + 512; LAS float* Q = KI + 512; LAS float* V = Q + 512;
    LAS float* RED = V + 512;
    const int hh = wave >> 2, kq = wave & 3, h = 2 * hp + hh;
    float S[16];
    { const float* sp = S0 + (size_t)h * 4096 + (16 * kq) * 64 + lane;
#pragma unroll
      for (int i = 0; i < 16; ++i) S[i] = sp[i * 64]; }
    const int t0 = tid >> 7, hk = tid & 127;
    const bf16_t* zr = z + ((size_t)TP + 4 * b + t0) * INC + hp * 128 + hk;
    const float zf = bf2f(zr[ZF]), q0 = bf2f(zr[ZQ]), vi = bf2f(zr[ZI]); const float lb = lbp[hp * 128 + hk];
    LSYNC();
    { const float e = __expf(-fabsf(zf)); const float sp = (zf >= 0.f) ? 1.0f / (1.0f + e) : e / (1.0f + e); const float sn = (zf >= 0.f) ? e / (1.0f + e) : 1.0f / (1.0f + e);
      F[tid] = lb + (1.0f - lb) * sp; KI[tid] = (1.0f - lb) * sn; Q[tid] = q0; V[tid] = vi; }
    LSYNC();
#pragma unroll
    for (int t = 0; t < 4; ++t) {
        const float vt = V[t * 128 + hh * 64 + lane]; float part = 0.f;
#pragma unroll
        for (int i = 0; i < 16; ++i) { const int k = t * 128 + hh * 64 + 16 * kq + i; S[i] = F[k] * S[i] + KI[k] * vt; part += S[i] * Q[k]; }
        RED[((t * 2 + hh) * 4 + kq) * 64 + lane] = part;
    }
    { float* so = Sout + (size_t)h * 4096 + (16 * kq) * 64 + lane;
#pragma unroll
      for (int i = 0; i < 16; ++i) so[i * 64] = S[i]; }
    LSYNC();
    { const int t = wave >> 1, hh2 = wave & 1, h2 = 2 * hp + hh2; const size_t m = (size_t)TP + 4 * b + t;
      float o = 0.f;
#pragma unroll
      for (int k4 = 0; k4 < 4; ++k4) o += RED[((t * 2 + hh2) * 4 + k4) * 64 + lane];
      const float r = rsqrtf(wave_sum(o * o) * (1.0f / 64.0f) + EPS);
      const float res = o * r * onorm[lane] * siluf_(bf2f(z[m * INC + ZG + h2 * 64 + lane]));
      mix[m * DM + h2 * 64 + lane] = (bf16_t)(cvt_pk_bf16(res, 0.f) & 0xffffu); }
}

template <int NTOK>
__device__ __forceinline__ void conv_compute(const LAS float* U, int r0, size_t m0, const float* cw, const float* cb, const float* lng, const float* lnb, bf16_t* mix, int lane, int wave) {
    const int ch = 64 * (wave & 3) + lane;
    float w[31];
#pragma unroll
    for (int j = 0; j < 31; ++j) w[j] = cw[j * 256 + ch];
    const float bias = cb[ch], g = lng[ch], be = lnb[ch];
    constexpr int TG = (NTOK >= 4) ? 4 : NTOK;
#pragma unroll 1
    for (int tg = 0; tg < NTOK / TG; ++tg) {
        float y[TG];
#pragma unroll
        for (int t = 0; t < TG; ++t) y[t] = bias;
        const LAS float* up = U + (r0 + TG * tg) * 256 + ch;
#pragma unroll
        for (int j = 0; j < TG + 30; ++j) { const float u = up[j * 256];
#pragma unroll
            for (int t = 0; t < TG; ++t) { if (j - t >= 0 && j - t < 31) y[t] += w[j - t] * u; } }
#pragma unroll
        for (int t = 0; t < TG; ++t) {
            const float mu = wave_sum(y[t]) * (1.0f / 64.0f); const float d = y[t] - mu;
            const float var = wave_sum(d * d) * (1.0f / 64.0f);
            const float o = siluf_(d * rsqrtf(var + EPS) * g + be);
            mix[(m0 + TG * tg + t) * DM + 256 + ch] = (bf16_t)(cvt_pk_bf16(o, 0.f) & 0xffffu);
        }
    }
}
__device__ __forceinline__ void conv_prompt_item(const bf16_t* z, const float* cw, const float* cb, const float* lng, const float* lnb, bf16_t* mix, float* spc, LAS unsigned char* lds, int ct, int tid, int lane, int wave) {
    LAS float* U = (LAS float*)lds;
    const int t0 = 64 * ct;
    u32x4 ra[6], rb[6];
#pragma unroll
    for (int it = 0; it < 6; ++it) { const int r = it * 16 + (tid >> 5), cg8 = (tid & 31) * 8; int tok = t0 - 30 + r; tok = tok < 0 ? 0 : tok;
        const bf16_t* zr = z + (size_t)tok * INC; ra[it] = *(const u32x4*)(zr + ZBU + cg8); rb[it] = *(const u32x4*)(zr + ZBG + cg8); }
    LSYNC();
#pragma unroll
    for (int it = 0; it < 6; ++it) { const int r = it * 16 + (tid >> 5), cg8 = (tid & 31) * 8; const bool ok = (t0 - 30 + r) >= 0;
        float fa[8], fb[8], u[8]; UNPACK8(ra[it], fa); UNPACK8(rb[it], fb);
#pragma unroll
        for (int j = 0; j < 8; ++j) u[j] = ok ? fa[j] * sigmoidf_(fb[j]) : 0.f;
        *(LAS f32x4*)(U + r * 256 + cg8) = (f32x4){u[0], u[1], u[2], u[3]}; *(LAS f32x4*)(U + r * 256 + cg8 + 4) = (f32x4){u[4], u[5], u[6], u[7]}; }
    LSYNC();
    conv_compute<32>(U, 32 * (wave >> 2), (size_t)t0 + 32 * (wave >> 2), cw, cb, lng, lnb, mix, lane, wave);
    if (ct == 255) for (int idx = tid; idx < 30 * 256; idx += 512) spc[idx] = U[(64 + (idx >> 8)) * 256 + (idx & 255)];
}
__device__ __forceinline__ void conv_sample_item(const bf16_t* z, const float* sconv, const float* cw, const float* cb, const float* lng, const float* lnb, bf16_t* mix, float* ssc, LAS unsigned char* lds, int b, int tid, int lane, int wave) {
    LAS float* U = (LAS float*)lds;
    float hv[15];
#pragma unroll
    for (int it = 0; it < 15; ++it) hv[it] = sconv[(size_t)b * 30 * 256 + it * 512 + tid];
    float nu[2];
#pragma unroll
    for (int it = 0; it < 2; ++it) { const int idx = it * 512 + tid, t = idx >> 8, ch = idx & 255; const bf16_t* zr = z + ((size_t)TP + 4 * b + t) * INC;
        nu[it] = bf2f(zr[ZBU + ch]) * sigmoidf_(bf2f(zr[ZBG + ch])); }
    LSYNC();
#pragma unroll
    for (int it = 0; it < 15; ++it) U[it * 512 + tid] = hv[it];
#pragma unroll
    for (int it = 0; it < 2; ++it) U[30 * 256 + it * 512 + tid] = nu[it];
    LSYNC();
    conv_compute<2>(U, 2 * (wave >> 2), (size_t)TP + 4 * b + 2 * (wave >> 2), cw, cb, lng, lnb, mix, lane, wave);
#pragma unroll
    for (int it = 0; it < 15; ++it) ssc[(size_t)b * 30 * 256 + it * 512 + tid] = U[4 * 256 + it * 512 + tid];
}

constexpr int KSTR = 72, VSTR = 280;
#define NORM_ROPE(rowp, gain, pos, g, sh1, sh2, x1, x2) do { \
    const u32x4 _lo = *(const u32x4*)((rowp) + 8 * (g)), _hi = *(const u32x4*)((rowp) + 32 + 8 * (g)); float _a[8], _b[8]; UNPACK8(_lo, _a); UNPACK8(_hi, _b); \
    float _sq = 0.f; _Pragma("unroll") for (int _j = 0; _j < 8; ++_j) _sq += _a[_j] * _a[_j] + _b[_j] * _b[_j]; \
    _sq += __shfl_xor(_sq, sh1); _sq += __shfl_xor(_sq, sh2); const float _r = rsqrtf(_sq * (1.0f / 64.0f) + EPS); \
    const float* _cp = rope_c + (size_t)(pos) * 32 + 8 * (g); const float* _sp = rope_s + (size_t)(pos) * 32 + 8 * (g); \
    _Pragma("unroll") for (int _j = 0; _j < 8; ++_j) { const float _y1 = _a[_j] * _r * (gain)[8 * (g) + _j], _y2 = _b[_j] * _r * (gain)[32 + 8 * (g) + _j]; const float _c = _cp[_j], _s = _sp[_j]; \
        (x1)[_j] = _y1 * _c - _y2 * _s; (x2)[_j] = _y2 * _c + _y1 * _s; } } while (0)

__device__ __forceinline__ void attn_qtile(const LAS bf16_t* Kl, const LAS bf16_t* Vt, bf16x8 q0, bf16x8 q1, int i, int T0, int jmin, float sink, bf16_t* outp, int lane) {
    const int fr = lane & 15, g = lane >> 4;
    f32x4 s[9];
#pragma unroll
    for (int T = 0; T < 9; ++T) {
        const LAS bf16_t* kp = Kl + (16 * (T0 + T) + fr) * KSTR + 8 * g;
        const bf16x8 k0 = *(const LAS bf16x8*)kp, k1 = *(const LAS bf16x8*)(kp + 32);
        f32x4 acc = (f32x4){0.f, 0.f, 0.f, 0.f};
        acc = __builtin_amdgcn_mfma_f32_16x16x32_bf16(k0, q0, acc, 0, 0, 0);
        acc = __builtin_amdgcn_mfma_f32_16x16x32_bf16(k1, q1, acc, 0, 0, 0);
        s[T] = acc;
    }
    float mx = sink;
#pragma unroll
    for (int T = 0; T < 9; ++T)
#pragma unroll
        for (int r = 0; r < 4; ++r) { const int j = 16 * (T0 + T) + 4 * g + r; const bool valid = (j >= i) && (j <= i + 128) && (j >= jmin);
            s[T][r] = valid ? s[T][r] : -INFINITY; mx = fmaxf(mx, s[T][r]); }
    mx = fmaxf(mx, __shfl_xor(mx, 16)); mx = fmaxf(mx, __shfl_xor(mx, 32));
    float sum = 0.f;
#pragma unroll
    for (int T = 0; T < 9; ++T)
#pragma unroll
        for (int r = 0; r < 4; ++r) { const float p = __expf(s[T][r] - mx); s[T][r] = p; sum += p; }
    sum += __shfl_xor(sum, 16); sum += __shfl_xor(sum, 32);
    const float inv = 1.0f / (sum + __expf(sink - mx));
    f32x4 o[4];
#pragma unroll
    for (int dt = 0; dt < 4; ++dt) o[dt] = (f32x4){0.f, 0.f, 0.f, 0.f};
#pragma unroll
    for (int u = 0; u < 5; ++u) {
        u32x4 pw; pw.x = cvt_pk_bf16(s[2 * u][0], s[2 * u][1]); pw.y = cvt_pk_bf16(s[2 * u][2], s[2 * u][3]);
        if (u < 4) { pw.z = cvt_pk_bf16(s[2 * u + 1 > 8 ? 8 : 2 * u + 1][0], s[2 * u + 1 > 8 ? 8 : 2 * u + 1][1]); pw.w = cvt_pk_bf16(s[2 * u + 1 > 8 ? 8 : 2 * u + 1][2], s[2 * u + 1 > 8 ? 8 : 2 * u + 1][3]); }
        else { pw.z = 0u; pw.w = 0u; }
        const bf16x8 pf = __builtin_bit_cast(bf16x8, pw);
#pragma unroll
        for (int dt = 0; dt < 4; ++dt) {
            const LAS bf16_t* vp = Vt + (16 * dt + fr) * VSTR + 16 * (T0 + 2 * u) + 4 * g;
            u32x4 vw; const u32x2 lo = *(const LAS u32x2*)vp, hi = *(const LAS u32x2*)(vp + 16); vw.x = lo.x; vw.y = lo.y; vw.z = hi.x; vw.w = hi.y;
            o[dt] = __builtin_amdgcn_mfma_f32_16x16x32_bf16(__builtin_bit_cast(bf16x8, vw), pf, o[dt], 0, 0, 0);
        }
    }
#pragma unroll
    for (int dt = 0; dt < 4; ++dt) { u32x2 w; w.x = cvt_pk_bf16(o[dt][0] * inv, o[dt][1] * inv); w.y = cvt_pk_bf16(o[dt][2] * inv, o[dt][3] * inv); *(u32x2*)(outp + 16 * dt + 4 * g) = w; }
}

#define LOAD_QFRAG(zq, pos, q0, q1) do { float _x1[8], _x2[8]; const int _g = lane >> 4; NORM_ROPE(zq, qn, pos, _g, 16, 32, _x1, _x2); \
    u32x4 _w0, _w1; _w0.x = cvt_pk_bf16(_x1[0] * 0.125f, _x1[1] * 0.125f); _w0.y = cvt_pk_bf16(_x1[2] * 0.125f, _x1[3] * 0.125f); _w0.z = cvt_pk_bf16(_x1[4] * 0.125f, _x1[5] * 0.125f); _w0.w = cvt_pk_bf16(_x1[6] * 0.125f, _x1[7] * 0.125f); \
    _w1.x = cvt_pk_bf16(_x2[0] * 0.125f, _x2[1] * 0.125f); _w1.y = cvt_pk_bf16(_x2[2] * 0.125f, _x2[3] * 0.125f); _w1.z = cvt_pk_bf16(_x2[4] * 0.125f, _x2[5] * 0.125f); _w1.w = cvt_pk_bf16(_x2[6] * 0.125f, _x2[7] * 0.125f); \
    q0 = __builtin_bit_cast(bf16x8, _w0); q1 = __builtin_bit_cast(bf16x8, _w1); } while (0)

__device__ __forceinline__ void attn_prompt_item(const bf16_t* z, const float* qn, const float* kn, const float* sinks, const float* rope_c, const float* rope_s, bf16_t* mix, float* spk, float* spv,
                                                 LAS unsigned char* lds, int qb, int kvh, int tid, int lane, int wave) {
    LAS bf16_t* Kl = (LAS bf16_t*)lds;
    LAS bf16_t* Vt = Kl + 256 * KSTR;
    LSYNC();
    const int kbase = qb * 128 - 128;
#pragma unroll
    for (int it_ = 0; it_ < 2; ++it_) { const int task = tid + 512 * it_;
        const int j = task >> 2, g = task & 3, pos = kbase + j;
        u32x4 w0 = (u32x4){0u, 0u, 0u, 0u}, w1 = w0;
        float x1[8], x2[8];
        const int posc = pos < 0 ? 0 : pos;
        const bf16_t* zr = z + (size_t)posc * INC + ZCK + kvh * 64;
        NORM_ROPE(zr, kn, posc, g, 1, 2, x1, x2);
        if (pos >= 0) { w0.x = cvt_pk_bf16(x1[0], x1[1]); w0.y = cvt_pk_bf16(x1[2], x1[3]); w0.z = cvt_pk_bf16(x1[4], x1[5]); w0.w = cvt_pk_bf16(x1[6], x1[7]);
                        w1.x = cvt_pk_bf16(x2[0], x2[1]); w1.y = cvt_pk_bf16(x2[2], x2[3]); w1.z = cvt_pk_bf16(x2[4], x2[5]); w1.w = cvt_pk_bf16(x2[6], x2[7]); }
        *(LAS u32x4*)(Kl + j * KSTR + 8 * g) = w0; *(LAS u32x4*)(Kl + j * KSTR + 32 + 8 * g) = w1;
        if (qb == 127 && j >= 128) { float* o = spk + (size_t)(j - 128) * 128 + kvh * 64;
            *(f32x4*)(o + 8 * g) = (f32x4){x1[0], x1[1], x1[2], x1[3]}; *(f32x4*)(o + 8 * g + 4) = (f32x4){x1[4], x1[5], x1[6], x1[7]};
            *(f32x4*)(o + 32 + 8 * g) = (f32x4){x2[0], x2[1], x2[2], x2[3]}; *(f32x4*)(o + 32 + 8 * g + 4) = (f32x4){x2[4], x2[5], x2[6], x2[7]}; }
    }
#pragma unroll
    for (int it_ = 0; it_ < 4; ++it_) { const int task = tid + 512 * it_;
        const int j = task >> 3, c8 = (task & 7) * 8, pos = kbase + j;
        u32x4 w = (u32x4){0u, 0u, 0u, 0u};
        if (pos >= 0) w = *(const u32x4*)(z + (size_t)pos * INC + ZCV + kvh * 64 + c8);
        Vt[(c8 + 0) * VSTR + j] = (bf16_t)(w.x & 0xffffu); Vt[(c8 + 1) * VSTR + j] = (bf16_t)(w.x >> 16);
        Vt[(c8 + 2) * VSTR + j] = (bf16_t)(w.y & 0xffffu); Vt[(c8 + 3) * VSTR + j] = (bf16_t)(w.y >> 16);
        Vt[(c8 + 4) * VSTR + j] = (bf16_t)(w.z & 0xffffu); Vt[(c8 + 5) * VSTR + j] = (bf16_t)(w.z >> 16);
        Vt[(c8 + 6) * VSTR + j] = (bf16_t)(w.w & 0xffffu); Vt[(c8 + 7) * VSTR + j] = (bf16_t)(w.w >> 16);
        if (qb == 127 && j >= 128) { float f[8]; UNPACK8(w, f); float* o = spv + (size_t)(j - 128) * 128 + kvh * 64 + c8;
            *(f32x4*)o = (f32x4){f[0], f[1], f[2], f[3]}; *(f32x4*)(o + 4) = (f32x4){f[4], f[5], f[6], f[7]}; }
    }
    for (int idx = tid; idx < 64 * 24; idx += 512) Vt[(idx / 24) * VSTR + 256 + (idx % 24)] = 0;
    LSYNC();
    const int hq = kvh * 4 + (wave >> 1);
    const float sink = sinks[hq];
    const int g4 = lane >> 4;
    float gq1[8], gq2[8];
#pragma unroll
    for (int j = 0; j < 8; ++j) { gq1[j] = qn[8 * g4 + j] * 0.125f; gq2[j] = qn[32 + 8 * g4 + j] * 0.125f; }
    const int pos0 = qb * 128 + (wave & 1) * 64 + (lane & 15);
    const bf16_t* zq0 = z + (size_t)pos0 * INC + ZCQ + hq * 64 + 8 * g4;
    const float* rc0 = rope_c + (size_t)pos0 * 32 + 8 * g4; const float* rs0 = rope_s + (size_t)pos0 * 32 + 8 * g4;
    u32x4 nlo = *(const u32x4*)zq0, nhi = *(const u32x4*)(zq0 + 32);
    f32x4 nc0 = *(const f32x4*)rc0, nc1 = *(const f32x4*)(rc0 + 4), ns0 = *(const f32x4*)rs0, ns1 = *(const f32x4*)(rs0 + 4);
#pragma unroll 1
    for (int a4 = 0; a4 < 4; ++a4) {
        const u32x4 lo = nlo, hi = nhi; const f32x4 c0 = nc0, c1 = nc1, s0 = ns0, s1 = ns1;
        { const int an = a4 < 3 ? a4 + 1 : 3; const bf16_t* zqn = zq0 + (size_t)(16 * an) * INC; const float* rcn = rc0 + (size_t)(16 * an) * 32; const float* rsn = rs0 + (size_t)(16 * an) * 32;
          nlo = *(const u32x4*)zqn; nhi = *(const u32x4*)(zqn + 32); nc0 = *(const f32x4*)rcn; nc1 = *(const f32x4*)(rcn + 4); ns0 = *(const f32x4*)rsn; ns1 = *(const f32x4*)(rsn + 4); }
        float a[8], b[8]; UNPACK8(lo, a); UNPACK8(hi, b);
        float sq = 0.f;
#pragma unroll
        for (int j = 0; j < 8; ++j) sq += a[j] * a[j] + b[j] * b[j];
        sq += __shfl_xor(sq, 16); sq += __shfl_xor(sq, 32);
        const float r = rsqrtf(sq * (1.0f / 64.0f) + EPS);
        float x1[8], x2[8];
#pragma unroll
        for (int j = 0; j < 8; ++j) { const float y1 = a[j] * r * gq1[j], y2 = b[j] * r * gq2[j]; const float c = j < 4 ? c0[j & 3] : c1[j & 3], s = j < 4 ? s0[j & 3] : s1[j & 3];
            x1[j] = y1 * c - y2 * s; x2[j] = y2 * c + y1 * s; }
        u32x4 w0, w1; w0.x = cvt_pk_bf16(x1[0], x1[1]); w0.y = cvt_pk_bf16(x1[2], x1[3]); w0.z = cvt_pk_bf16(x1[4], x1[5]); w0.w = cvt_pk_bf16(x1[6], x1[7]);
        w1.x = cvt_pk_bf16(x2[0], x2[1]); w1.y = cvt_pk_bf16(x2[2], x2[3]); w1.z = cvt_pk_bf16(x2[4], x2[5]); w1.w = cvt_pk_bf16(x2[6], x2[7]);
        const int i0 = (wave & 1) * 64 + 16 * a4, i = i0 + (lane & 15);
        const size_t m = (size_t)qb * 128 + i;
        attn_qtile(Kl, Vt, __builtin_bit_cast(bf16x8, w0), __builtin_bit_cast(bf16x8, w1), i, i0 >> 4, qb == 0 ? 128 : 0, sink, mix + m * DM + 512 + hq * 64, lane);
    }
}

__device__ __forceinline__ void attn_sample_item(const bf16_t* z, const float* ck, const float* cv, const float* qn, const float* kn, const float* sinks, const float* rope_c, const float* rope_s, bf16_t* mix,
                                                 float* ssk, float* ssv, LAS unsigned char* lds, int b, int kvh, int tid, int lane, int wave) {
    LAS bf16_t* Kl = (LAS bf16_t*)lds;
    LAS bf16_t* Vt = Kl + 256 * KSTR;
    LSYNC();
#pragma unroll
    for (int it_ = 0; it_ < 2; ++it_) { const int task = tid + 512 * it_;
        const int j = task >> 3, c8 = (task & 7) * 8;
        const float* kr = ck + (size_t)j * 128 + kvh * 64 + c8; const float* vr = cv + (size_t)j * 128 + kvh * 64 + c8;
        const f32x4 k0 = *(const f32x4*)kr, k1 = *(const f32x4*)(kr + 4), v0 = *(const f32x4*)vr, v1 = *(const f32x4*)(vr + 4);
        u32x4 w; w.x = cvt_pk_bf16(k0[0], k0[1]); w.y = cvt_pk_bf16(k0[2], k0[3]); w.z = cvt_pk_bf16(k1[0], k1[1]); w.w = cvt_pk_bf16(k1[2], k1[3]);
        *(LAS u32x4*)(Kl + j * KSTR + c8) = w;
        const float vf[8] = {v0[0], v0[1], v0[2], v0[3], v1[0], v1[1], v1[2], v1[3]};
#pragma unroll
        for (int e = 0; e < 8; ++e) Vt[(c8 + e) * VSTR + j] = (bf16_t)(cvt_pk_bf16(vf[e], 0.f) & 0xffffu);
        if (j >= 4) { float* ok = ssk + (size_t)(j - 4) * 128 + kvh * 64 + c8; float* ov = ssv + (size_t)(j - 4) * 128 + kvh * 64 + c8;
            *(f32x4*)ok = k0; *(f32x4*)(ok + 4) = k1; *(f32x4*)ov = v0; *(f32x4*)(ov + 4) = v1; }
    }
    if (tid < 16) {
        const int t = tid >> 2, g = tid & 3, j = 128 + t; const size_t m = (size_t)TP + 4 * b + t;
        float x1[8], x2[8];
        NORM_ROPE(z + m * INC + ZCK + kvh * 64, kn, TP + t, g, 1, 2, x1, x2);
        u32x4 w0, w1; w0.x = cvt_pk_bf16(x1[0], x1[1]); w0.y = cvt_pk_bf16(x1[2], x1[3]); w0.z = cvt_pk_bf16(x1[4], x1[5]); w0.w = cvt_pk_bf16(x1[6], x1[7]);
        w1.x = cvt_pk_bf16(x2[0], x2[1]); w1.y = cvt_pk_bf16(x2[2], x2[3]); w1.z = cvt_pk_bf16(x2[4], x2[5]); w1.w = cvt_pk_bf16(x2[6], x2[7]);
        *(LAS u32x4*)(Kl + j * KSTR + 8 * g) = w0; *(LAS u32x4*)(Kl + j * KSTR + 32 + 8 * g) = w1;
        float* o = ssk + (size_t)(j - 4) * 128 + kvh * 64;
        *(f32x4*)(o + 8 * g) = (f32x4){x1[0], x1[1], x1[2], x1[3]}; *(f32x4*)(o + 8 * g + 4) = (f32x4){x1[4], x1[5], x1[6], x1[7]};
        *(f32x4*)(o + 32 + 8 * g) = (f32x4){x2[0], x2[1], x2[2], x2[3]}; *(f32x4*)(o + 32 + 8 * g + 4) = (f32x4){x2[4], x2[5], x2[6], x2[7]};
    }
    if (tid >= 64 && tid < 64 + 32) {
        const int t = (tid - 64) >> 3, c8 = ((tid - 64) & 7) * 8, j = 128 + t; const size_t m = (size_t)TP + 4 * b + t;
        const u32x4 w = *(const u32x4*)(z + m * INC + ZCV + kvh * 64 + c8);
        Vt[(c8 + 0) * VSTR + j] = (bf16_t)(w.x & 0xffffu); Vt[(c8 + 1) * VSTR + j] = (bf16_t)(w.x >> 16);
        Vt[(c8 + 2) * VSTR + j] = (bf16_t)(w.y & 0xffffu); Vt[(c8 + 3) * VSTR + j] = (bf16_t)(w.y >> 16);
        Vt[(c8 + 4) * VSTR + j] = (bf16_t)(w.z & 0xffffu); Vt[(c8 + 5) * VSTR + j] = (bf16_t)(w.z >> 16);
        Vt[(c8 + 6) * VSTR + j] = (bf16_t)(w.w & 0xffffu); Vt[(c8 + 7) * VSTR + j] = (bf16_t)(w.w >> 16);
        float f[8]; UNPACK8(w, f); float* o = ssv + (size_t)(j - 4) * 128 + kvh * 64 + c8;
        *(f32x4*)o = (f32x4){f[0], f[1], f[2], f[3]}; *(f32x4*)(o + 4) = (f32x4){f[4], f[5], f[6], f[7]};
    }
    if (tid >= 128 && tid < 128 + 12 * 8) { const int j = 132 + ((tid - 128) >> 3), c8 = ((tid - 128) & 7) * 8; *(LAS u32x4*)(Kl + j * KSTR + c8) = (u32x4){0u, 0u, 0u, 0u}; }
    for (int idx = tid; idx < 64 * 28; idx += 512) Vt[(idx / 28) * VSTR + 132 + (idx % 28)] = 0;
    LSYNC();
    if (wave == 0) {
        const int q = lane & 15, hg = q >> 2, t = q & 3, hq = kvh * 4 + hg; const size_t m = (size_t)TP + 4 * b + t;
        bf16x8 q0, q1;
        LOAD_QFRAG(z + m * INC + ZCQ + hq * 64, TP + t, q0, q1);
        attn_qtile(Kl, Vt, q0, q1, t, 0, 0, sinks[hq], mix + m * DM + 512 + hq * 64, lane);
    }
}

#define PHASE_HEAD { unsigned z_ = 0; asm volatile("" : "+s"(z_)); lds += z_; } int wave_ = wv; asm volatile("" : "+s"(wave_)); const int wave = wave_, lane = lane_id_opaque(), tid = wave * 64 + lane; const int G = gridDim.x, bid = blockIdx.x; unsigned char* ws = WSP; (void)lane; (void)wave; (void)G; (void)bid; (void)ws;
#define SSP(k) ((float*)(ws + WS_SS) + (size_t)(k) * MT)
#define WL(off) ((const bf16_t*)(ws + WS_W + (size_t)l * W_LAYER + (off)))

struct G1Order {
    pg8::StaticOrder so; unsigned* cnt; int c;
    __device__ __forceinline__ bool next(int i, Unit& u) const {
        if (c >= 64 && c < 82) { if (i == 0) { const int s = c - 64; u.pm = 64 + s / 9; u.pn = s % 9; return true; } return so.next(i - 1, u); }
        return so.next(i, u);
    }
    __device__ __forceinline__ void a_ready(const Unit&) const {}
    __device__ __forceinline__ void done(const Unit& u) const {
        if (u.pm >= 64) {
            asm volatile("s_waitcnt vmcnt(0)" ::: "memory");
            __builtin_amdgcn_fence(__ATOMIC_RELEASE, "agent");
            asm volatile("s_waitcnt vmcnt(0)" ::: "memory");
            if (lane_id_opaque() == 0) __hip_atomic_fetch_add(cnt, 1u, __ATOMIC_RELAXED, __HIP_MEMORY_SCOPE_AGENT);
        }
    }
};
__device__ __forceinline__ void phase_g1(LAS unsigned char* lds, int l, int wv) {
    PHASE_HEAD
    unsigned* cnt = (unsigned*)(ws + WS_CTL) + 8192 + 64 * l;
    { pg8::Gemm g{(const bf16_t*)(ws + WS_BUFA), WL(W_IN), MT, INC, DM}; G1Order S; S.so.init(TP, INC, G, bid); S.cnt = cnt; S.c = bid;
      EpiZ E{(bf16_t*)(ws + WS_ZACT), INC, SSP(3 * l)}; pg8::gemm_phase<EpiZ, G1Order, true, true>(lds, g, S, E, wv); }
    if (bid >= 82) {
        if (tid == 0) { unsigned sp = 0; while (__hip_atomic_load(cnt, __ATOMIC_RELAXED, __HIP_MEMORY_SCOPE_AGENT) < 144u) { __builtin_amdgcn_s_sleep(4); if (++sp > (1u << 22)) break; }
            __builtin_amdgcn_fence(__ATOMIC_ACQUIRE, "agent"); asm volatile("s_waitcnt vmcnt(0)" ::: "memory"); }
        __syncthreads();
        const bf16_t* z = (const bf16_t*)(ws + WS_ZACT); bf16_t* bufB = (bf16_t*)(ws + WS_BUFB);
        const float* lbp = (const float*)(ws + WS_LB) + l * 256;
        const float* rope_c = (const float*)(ws + WS_ROPE); const float* rope_s = rope_c + (size_t)NPOS * 32;
        float* out = OUTP;
#pragma unroll 1
        for (int it = bid - 82; it < 640; it += G - 82) {
            int r = it;
            if (r < 256) { const int b = r >> 1, hp = r & 1; const size_t so = ((size_t)(l * 128 + b) * 4) * 4096;
                hgrn_sample_item(z, lbp, IN(2) + so, out + O_SSH + so, IN(10) + l * 64, bufB, lds, b, hp, tid, lane, wave); continue; } r -= 256;
            if (r < 128) { conv_sample_item(z, IN(3) + (size_t)l * 128 * 7680, IN(11) + l * 31 * 256, IN(12) + l * 256, IN(13) + l * 256, IN(14) + l * 256, bufB, out + O_SSC + (size_t)l * 128 * 7680, lds, r, tid, lane, wave); continue; } r -= 128;
            { const int b = r >> 1, kvh = r & 1; const size_t co = (size_t)(l * 128 + b) * 16384;
              attn_sample_item(z, IN(4) + co, IN(5) + co, IN(15) + l * 64, IN(16) + l * 64, IN(17) + l * 8, rope_c, rope_s, bufB, out + O_SSK + co, out + O_SSV + co, lds, b, kvh, tid, lane, wave); }
        }
    }
}
__device__ __forceinline__ void phase_mix_a(LAS unsigned char* lds, int l, int wv) {
    PHASE_HEAD
    const bf16_t* z = (const bf16_t*)(ws + WS_ZACT); bf16_t* bufB = (bf16_t*)(ws + WS_BUFB);
    const float* lbp = (const float*)(ws + WS_LB) + l * 256; float* dvec = (float*)(ws + WS_DVEC); float* dS = (float*)(ws + WS_DS);
    const float* rope_c = (const float*)(ws + WS_ROPE); const float* rope_s = rope_c + (size_t)NPOS * 32;
    float* out = OUTP;
#pragma unroll 1
    for (int it = bid; it < 1024; it += G) {
        unsigned czf[8], cvi[8];
        const bf16_t* zb = z + (size_t)(64 * (it >> 2) + 8 * wave) * INC + (it & 3) * 64 + lane;
#pragma unroll
        for (int i = 0; i < 8; ++i) { czf[i] = zb[(size_t)i * INC + ZF]; cvi[i] = zb[(size_t)i * INC + ZI]; }
        hgrn_ds_item(czf, cvi, lbp, dS, dvec, lds, it >> 2, it & 3, tid, lane, wave);
    }
#pragma unroll 1
    for (int it = bid; it < 512; it += G) {
        int r = it;
        if (r < 256) { attn_prompt_item(z, IN(15) + l * 64, IN(16) + l * 64, IN(17) + l * 8, rope_c, rope_s, bufB, out + O_SPK + (size_t)l * 16384, out + O_SPV + (size_t)l * 16384, lds, r >> 1, r & 1, tid, lane, wave); continue; } r -= 256;
        conv_prompt_item(z, IN(11) + l * 31 * 256, IN(12) + l * 256, IN(13) + l * 256, IN(14) + l * 256, bufB, out + O_SPC + (size_t)l * 7680, lds, r, tid, lane, wave);
    }
}
__device__ __forceinline__ void phase_scan(LAS unsigned char* lds, int l, int wv) {
    PHASE_HEAD
    if (bid < 256) {
        float* dS = (float*)(ws + WS_DS); const float* dvec = (const float*)(ws + WS_DVEC);
        const int e = 64 * bid + lane, h = e >> 12, k = (e >> 6) & 63;
        LAS float* X = (LAS float*)lds;
        float v[32], d[32];
#pragma unroll
        for (int j = 0; j < 32; ++j) { const int c = 32 * wave + j; v[j] = dS[(size_t)c * 16384 + e]; d[j] = dvec[(c * 4 + h) * 64 + k]; }
        float A = 0.f, P = 1.f;
#pragma unroll
        for (int j = 0; j < 32; ++j) { const float t = v[j]; v[j] = A; A = d[j] * A + t; const float pd = d[j]; d[j] = P; P *= pd; }
        LSYNC();
        X[(wave * 2 + 0) * 64 + lane] = P; X[(wave * 2 + 1) * 64 + lane] = A;
        LSYNC();
        float S = 0.f;
#pragma unroll
        for (int w2 = 0; w2 < 8; ++w2) { const float p2 = X[(w2 * 2 + 0) * 64 + lane], a2 = X[(w2 * 2 + 1) * 64 + lane]; if (w2 < wave) S = p2 * S + a2; }
#pragma unroll
        for (int j = 0; j < 32; ++j) dS[(size_t)(32 * wave + j) * 16384 + e] = d[j] * S + v[j];
        if (wave == 7) OUTP[O_SPH + (size_t)l * 16384 + e] = P * S + A;
    }
}
__device__ __forceinline__ void phase_mix_c(LAS unsigned char* lds, int l, int wv) {
    PHASE_HEAD
    const bf16_t* z = (const bf16_t*)(ws + WS_ZACT); bf16_t* bufB = (bf16_t*)(ws + WS_BUFB);
    const float* lbp = (const float*)(ws + WS_LB) + l * 256; const float* dS = (const float*)(ws + WS_DS);
    const float* onorm = IN(10) + l * 64;
#pragma unroll 1
    for (int it = bid; it < 512; it += G) hgrn_out_item(z, lbp, dS, onorm, bufB, lds, it >> 1, it & 1, tid, lane, wave);
}
__device__ __forceinline__ void phase_g2(LAS unsigned char* lds, int l, int wv) {
    PHASE_HEAD
    bf16_t* bufA = (bf16_t*)(ws + WS_BUFA);
    pg8::Gemm g{(const bf16_t*)(ws + WS_BUFB), WL(W_OUT), TP, DM, DM}; pg8::StaticOrder S; S.init(TP, DM, G, bid);
    EpiRes E{bufA, bufA, SSP(3 * l + 1)};
    pg8::gemm_phase<EpiRes, pg8::StaticOrder, true, true>(lds, g, S, E, wv);
    SEpiRes SE{bufA + (size_t)TP * DM, bufA + (size_t)TP * DM, SSP(3 * l + 1) + TP};
    small_gemm(lds, (const bf16_t*)(ws + WS_BUFB) + (size_t)TP * DM, WL(W_OUT), DM, SE, bid, tid, lane, wave);
}
__device__ __forceinline__ void phase_g3(LAS unsigned char* lds, int l, int wv) {
    PHASE_HEAD
    pg8::Gemm g{(const bf16_t*)(ws + WS_BUFA), WL(W_GU), MT, 2 * DFF, DM}; pg8::StaticOrder S; S.init(MT, 2 * DFF, G, bid);
    EpiGU E{(bf16_t*)(ws + WS_ZACT), SSP(3 * l + 1)}; pg8::gemm_phase<EpiGU, pg8::StaticOrder, true, true>(lds, g, S, E, wv);
}
__device__ __forceinline__ void phase_g4(LAS unsigned char* lds, int l, int wv) {
    PHASE_HEAD
    const bf16_t* bufA = (const bf16_t*)(ws + WS_BUFA); bf16_t* bufB = (bf16_t*)(ws + WS_BUFB);
    pg8::Gemm g{(const bf16_t*)(ws + WS_ZACT), WL(W_D), TP, DM, DFF}; pg8::StaticOrder S; S.init(TP, DM, G, bid);
    EpiRes E{bufA, bufB, SSP(3 * l + 2)}; pg8::gemm_phase<EpiRes, pg8::StaticOrder, true, true>(lds, g, S, E, wv);
    SEpiRes SE{bufA + (size_t)TP * DM, bufB + (size_t)TP * DM, SSP(3 * l + 2) + TP};
    small_gemm(lds, (const bf16_t*)(ws + WS_ZACT) + (size_t)TP * DFF, WL(W_D), DFF, SE, bid, tid, lane, wave);
}
__device__ __forceinline__ void phase_g5a(LAS unsigned char* lds, int l, int wv) {
    PHASE_HEAD
    pg8::Gemm g{(const bf16_t*)(ws + WS_BUFB), WL(W_PG), TP, DM, DM}; pg8::StaticOrder S; S.init(TP, DM, G, bid);
    EpiGate E{(bf16_t*)(ws + WS_ZACT), SSP(3 * l + 2)}; pg8::gemm_phase<EpiGate, pg8::StaticOrder, true, true>(lds, g, S, E, wv);
    SEpiGate SE{(bf16_t*)(ws + WS_ZACT) + (size_t)TP * DM, SSP(3 * l + 2) + TP};
    small_gemm(lds, (const bf16_t*)(ws + WS_BUFB) + (size_t)TP * DM, WL(W_PG), DM, SE, bid, tid, lane, wave);
}
__device__ __forceinline__ void phase_g5b(LAS unsigned char* lds, int l, int wv) {
    PHASE_HEAD
    const bf16_t* gt = (const bf16_t*)(ws + WS_ZACT); const bf16_t* bufB = (const bf16_t*)(ws + WS_BUFB); bf16_t* bufA = (bf16_t*)(ws + WS_BUFA); float* Y = OUTP + O_Y;
    pg8::Gemm g{(const bf16_t*)(ws + WS_PB) + (size_t)l * MT * PLE, WL(W_PP), TP, DM, PLE}; pg8::StaticOrder S; S.init(TP, DM, G, bid);
    EpiOut E{gt, bufB, Y, bufA, SSP(3), l}; pg8::gemm_phase<EpiOut, pg8::StaticOrder, true, true>(lds, g, S, E, wv);
    SEpiOut SE{gt + (size_t)TP * DM, bufB + (size_t)TP * DM, Y + (size_t)TP * DM, bufA + (size_t)TP * DM, SSP(3) + TP, l};
    small_gemm(lds, (const bf16_t*)(ws + WS_PB) + ((size_t)l * MT + TP) * PLE, WL(W_PP), PLE, SE, bid, tid, lane, wave);
}

__global__ void __launch_bounds__(512, 2) fwd_kernel(Args a) {
    extern __shared__ __attribute__((aligned(16))) unsigned char lds_raw[];
    LAS unsigned char* lds = (LAS unsigned char*)lds_raw;
    volatile LAS unsigned* MISC = (volatile LAS unsigned*)(lds + MISC_OFF);
    if (threadIdx.x < 32) MISC[threadIdx.x] = 0u;
    if (threadIdx.x == 0) {
        LAS unsigned long long* PT = (LAS unsigned long long*)(lds + PT_OFF);
#pragma unroll
        for (int i = 0; i < 27; ++i) PT[i] = (unsigned long long)a.in[i];
        PT[27] = (unsigned long long)a.out; PT[28] = (unsigned long long)a.ws;
    }
    __syncthreads();
    const int wv = __builtin_amdgcn_readfirstlane(threadIdx.x >> 6);
    XcdBarrier bar = xcd_barrier_post((unsigned*)(WSP + WS_CTL), MISC + 8); bar.wv = wv;
    prologue(lds, wv);
    if (gridDim.x == 0x7fffffffu) cg::this_grid().sync();
    xcd_barrier(bar);
#define LAYER(l) do { \
        phase_g1(lds, l, wv); xcd_barrier(bar); \
        phase_mix_a(lds, l, wv); xcd_barrier(bar); \
        phase_scan(lds, l, wv); xcd_barrier(bar); \
        phase_mix_c(lds, l, wv); xcd_barrier(bar); \
        phase_g2(lds, l, wv); xcd_barrier(bar); \
        phase_g3(lds, l, wv); xcd_barrier(bar); \
        phase_g4(lds, l, wv); xcd_barrier(bar); \
        phase_g5a(lds, l, wv); \
        phase_g5b(lds, l, wv); } while (0)
    LAYER(0);
    xcd_barrier(bar);
    LAYER(1);
}

extern "C" void kernel_launch(void* const* d_in, const int* in_sizes, int n_in, void* d_out, int out_size, void* d_ws, size_t ws_size, hipStream_t stream) {
    static int grid = 0;
    if (grid == 0) {
        if (n_in != 27 || ws_size < WS_END) { fprintf(stderr, "kernel_launch: unexpected n_in %d / ws %zu\n", n_in, ws_size); grid = -1; return; }
        int dev = 0, cus = 0, per_cu = 0;
        hipGetDevice(&dev); hipDeviceGetAttribute(&cus, hipDeviceAttributeMultiprocessorCount, dev);
        if (hipFuncSetAttribute((const void*)fwd_kernel, hipFuncAttributeMaxDynamicSharedMemorySize, LDS_BYTES) != hipSuccess) { fprintf(stderr, "kernel_launch: hipFuncSetAttribute failed\n"); grid = -1; return; }
        hipOccupancyMaxActiveBlocksPerMultiprocessor(&per_cu, (const void*)fwd_kernel, 512, LDS_BYTES);
        (void)hipGetLastError();
        if (per_cu < 1) { fprintf(stderr, "kernel_launch: occupancy query says %d blocks per CU\n", per_cu); }
        grid = cus;
    }
    if (grid < 0) return;
    hipMemsetAsync((char*)d_ws + WS_CTL, 0, CTL_BYTES, stream);
    Args a{};
    for (int i = 0; i < 27; ++i) a.in[i] = (const float*)d_in[i];
    a.out = (float*)d_out; a.ws = (unsigned char*)d_ws;
    void* args[] = {&a};
    hipError_t e = hipLaunchCooperativeKernel((const void*)fwd_kernel, dim3(grid), dim3(512), args, LDS_BYTES, stream);
    if (e != hipSuccess) fprintf(stderr, "cooperative launch failed: %s (grid %d)\n", hipGetErrorString(e), grid);
}
```

```cpp
#include <hip/hip_runtime.h>
#include <hip/hip_cooperative_groups.h>
#include <cstdio>
#include <cstdint>
namespace cg = cooperative_groups;
namespace pg8 {
#define PG8_LAS __attribute__((address_space(3)))
typedef unsigned short bf16_t;
typedef short bf16x8 __attribute__((ext_vector_type(8)));
typedef float f32x4 __attribute__((ext_vector_type(4)));
typedef unsigned u32x4 __attribute__((ext_vector_type(4)));
constexpr int BM = 256, BK = 64, HALF = 128, HTB = HALF * BK * 2  , STAGE_BYTES = 8 * HTB, NXCD = 8, WGM = 8;

__host__ __device__ __forceinline__ int lds_byte(int r, int c) { const int st = (r >> 4) * 2 + (c >> 5), rr = r & 15, cc = c & 31, ob = rr * 64 + cc * 2; return st * 1024 + (ob ^ (((ob >> 9) & 1) << 5)); }
__host__ __device__ __forceinline__ void stage_rc(int b, int& R, int& C) { const int st = b / 1024, sb = b % 1024, swz = sb ^ (((sb >> 9) & 1) << 5); R = (st >> 1) * 16 + swz / 64; C = (st & 1) * 32 + (swz % 64) / 2; }
__host__ __device__ __forceinline__ int perm32(int rho) { const int n = rho >> 4, i = rho & 15; return 8 * (i >> 2) + 4 * n + (i & 3); }

struct Unit { int pm, pn; };
struct Gemm { const bf16_t* A; const bf16_t* Bt; int M, N, K; };

struct StaticOrder {
    int nM, nN, nwg, G, c;
    __host__ __device__ void init(int M, int N, int G_, int c_) { nM = M / BM; nN = N / BM; nwg = nM * nN; G = G_; c = c_; }
    __host__ __device__ bool next(int i, Unit& u) const {
        const long L = (long)i * G + c; if (L >= nwg) return false;
        int wgid = (int)L; { const int q = nwg / NXCD, r = nwg % NXCD, xcd = wgid % NXCD, off = wgid / NXCD; wgid = (xcd < r ? xcd * (q + 1) : r * (q + 1) + (xcd - r) * q) + off; }
        const int nig = WGM * nN, gid = wgid / nig, fm = gid * WGM, gsz = (nM - fm) < WGM ? (nM - fm) : WGM;
        u.pm = fm + ((wgid % nig) % gsz); u.pn = (wgid % nig) / gsz; return true;
    }
    __device__ __forceinline__ void a_ready(const Unit&) const {}
    __device__ __forceinline__ void done(const Unit&) const {}
};
__device__ __forceinline__ unsigned cvt_pk_bf16(float lo, float hi) { unsigned r; asm volatile("v_cvt_pk_bf16_f32 %0, %1, %2" : "=v"(r) : "v"(lo), "v"(hi)); return r; }
template <class Epi, class Sched, bool ALIGN_EPI = false, bool SP2 = false>
__device__ __forceinline__ void gemm_phase(PG8_LAS unsigned char* lds, const Gemm g, const Sched& S, const Epi& E, int wv_) {
    unsigned m_ = ~0u; asm volatile("" : "+s"(m_)); asm volatile("" : "+s"(wv_)); int tid_ = wv_ * 64 + (int)__builtin_amdgcn_mbcnt_hi(m_, __builtin_amdgcn_mbcnt_lo(m_, 0u)); { unsigned z_ = 0; asm volatile("" : "+s"(z_)); lds += z_; } const int tid = tid_, wid = __builtin_amdgcn_readfirstlane(tid >> 6), lane = tid & 63, wr = wid >> 2, wc = wid & 3, fr = lane & 15, fq = lane >> 4;
    const int K = g.K, nt = K / BK;
    unsigned voffA[2], voffB[2];
#pragma unroll
    for (int i = 0; i < 2; ++i) { int R, C; stage_rc(tid * 16 + i * 8192, R, C); const int Rb = Epi::PERM ? ((R & ~31) + perm32(R & 31)) : R;
        voffA[i] = (unsigned)(R * K + C) * 2u; voffB[i] = (unsigned)(Rb * K + C) * 2u; }
    const size_t kstep = (size_t)(BK * 2);
    const size_t hstep = (size_t)HALF * K * 2;
    const size_t tstep = 2 * hstep;
    const unsigned ldsw = (unsigned)wid * 1024u;
    const int aoff = lds_byte(wr * 64 + fr, fq * 8), boff = lds_byte(wc * 32 + fr, fq * 8);
#define PG8_SA(b, h) (((b) * 2 + (h)) * HTB)
#define PG8_SB(b, h) ((4 + (b) * 2 + (h)) * HTB)
#define PG8_STAGE(bufoff, gbase, voff) do { _Pragma("unroll") for (int _i = 0; _i < 2; ++_i) \
        __builtin_amdgcn_global_load_lds((const unsigned*)((const char*)(gbase) + (voff)[_i]), (PG8_LAS unsigned*)(lds + (bufoff) + ldsw + _i * 8192), 16, 0, 0); } while (0)
#define PG8_LDA(dst, b, h) do { _Pragma("unroll") for (int m = 0; m < 4; ++m) _Pragma("unroll") for (int k = 0; k < 2; ++k) dst[m][k] = *(const PG8_LAS bf16x8*)(lds + PG8_SA(b, h) + aoff + m * 2048 + k * 1024); } while (0)
#define PG8_LDB(dst, b, h) do { _Pragma("unroll") for (int n = 0; n < 2; ++n) _Pragma("unroll") for (int k = 0; k < 2; ++k) dst[n][k] = *(const PG8_LAS bf16x8*)(lds + PG8_SB(b, h) + boff + n * 2048 + k * 1024); } while (0)
#define PG8_MMA(ai, bj, At, Bt) do { __builtin_amdgcn_s_setprio(1); _Pragma("unroll") for (int m = 0; m < 4; ++m) _Pragma("unroll") for (int n = 0; n < 2; ++n) _Pragma("unroll") for (int k = 0; k < 2; ++k) \
        acc[ai][bj][m][n] = __builtin_amdgcn_mfma_f32_16x16x32_bf16(Bt[n][k], At[m][k], acc[ai][bj][m][n], 0, 0, 0); __builtin_amdgcn_s_setprio(0); } while (0)
#define PG8_WAIT_V(n) asm volatile("s_waitcnt vmcnt(" #n ")" ::: "memory")
#define PG8_WAIT_L(n) asm volatile("s_waitcnt lgkmcnt(" #n ")" ::: "memory")
#define PG8_BAR __builtin_amdgcn_s_barrier()
#define PG8_SCHED __builtin_amdgcn_sched_barrier(0)
    Unit cur, nxt; int ui = 0;
    if (!S.next(0, cur)) return;
    f32x4 acc[2][2][4][2];
#pragma unroll
    for (int a = 0; a < 2; ++a)
#pragma unroll
        for (int b = 0; b < 2; ++b)
#pragma unroll
            for (int m = 0; m < 4; ++m)
#pragma unroll
                for (int n = 0; n < 2; ++n) acc[a][b][m][n] = (f32x4){0.f, 0.f, 0.f, 0.f};
    bf16x8 At[4][2], B0[2][2], B1[2][2];
    const char* cA = (const char*)g.A + (size_t)cur.pm * tstep; const char* cB = (const char*)g.Bt + (size_t)cur.pn * tstep;
    S.a_ready(cur);
    if constexpr (SP2) {
        PG8_STAGE(PG8_SB(0, 0), cB, voffB); PG8_STAGE(PG8_SB(0, 1), cB + hstep, voffB); PG8_STAGE(PG8_SA(0, 0), cA, voffA); PG8_STAGE(PG8_SA(0, 1), cA + hstep, voffA);
        if (wr == 1) PG8_BAR;
        PG8_WAIT_V(2); PG8_BAR;
        PG8_STAGE(PG8_SB(1, 0), cB + kstep, voffB); PG8_STAGE(PG8_SA(1, 0), cA + kstep, voffA); PG8_STAGE(PG8_SB(1, 1), cB + hstep + kstep, voffB);
        PG8_WAIT_V(6); PG8_BAR;
    } else {
        PG8_STAGE(PG8_SB(0, 0), cB, voffB); PG8_STAGE(PG8_SA(0, 0), cA, voffA); PG8_STAGE(PG8_SB(0, 1), cB + hstep, voffB); PG8_STAGE(PG8_SA(0, 1), cA + hstep, voffA);
        if (wr == 1) PG8_BAR;
        PG8_WAIT_V(4); PG8_BAR;
        PG8_STAGE(PG8_SB(1, 0), cB + kstep, voffB); PG8_STAGE(PG8_SA(1, 0), cA + kstep, voffA); PG8_STAGE(PG8_SB(1, 1), cB + hstep + kstep, voffB);
        PG8_WAIT_V(6); PG8_BAR;
    }
    for (;;) {
        const bool has_next = S.next(ui + 1, nxt);
        const char* nA = has_next ? (const char*)g.A + (size_t)nxt.pm * tstep : cA; const char* nB = has_next ? (const char*)g.Bt + (size_t)nxt.pn * tstep : cB;
        for (int t = 0; t < nt; t += 2) {
            const bool last = (t == nt - 2);
            const char* a1 = cA + (size_t)(t + 1) * kstep;
            const char* a2 = last ? nA : cA + (size_t)(t + 2) * kstep; const char* b2 = last ? nB : cB + (size_t)(t + 2) * kstep;
            const char* a3 = a2 + kstep; const char* b3 = b2 + kstep;
            if (last && has_next) S.a_ready(nxt);
            if constexpr (SP2) {
            PG8_LDB(B0, 0, 0); PG8_LDB(B1, 0, 1); PG8_SCHED; PG8_LDA(At, 0, 0); PG8_STAGE(PG8_SA(1, 1), a1 + hstep, voffA);
            PG8_WAIT_V(8); PG8_WAIT_L(0); PG8_BAR; PG8_MMA(0, 0, At, B0); PG8_MMA(0, 1, At, B1); PG8_BAR; PG8_SCHED;
            PG8_LDA(At, 0, 1); PG8_STAGE(PG8_SB(0, 0), b2, voffB); PG8_STAGE(PG8_SB(0, 1), b2 + hstep, voffB); PG8_STAGE(PG8_SA(0, 0), a2, voffA);
            PG8_WAIT_V(8); PG8_WAIT_L(0); PG8_BAR; PG8_MMA(1, 0, At, B0); PG8_MMA(1, 1, At, B1); PG8_BAR; PG8_SCHED;
            PG8_LDB(B0, 1, 0); PG8_LDB(B1, 1, 1); PG8_SCHED; PG8_LDA(At, 1, 0); PG8_STAGE(PG8_SA(0, 1), a2 + hstep, voffA);
            PG8_WAIT_V(8); PG8_WAIT_L(0); PG8_BAR; PG8_MMA(0, 0, At, B0); PG8_MMA(0, 1, At, B1); PG8_BAR; PG8_SCHED;
            PG8_LDA(At, 1, 1); PG8_STAGE(PG8_SB(1, 0), b3, voffB); PG8_STAGE(PG8_SB(1, 1), b3 + hstep, voffB); PG8_STAGE(PG8_SA(1, 0), a3, voffA);
            PG8_WAIT_V(8); PG8_WAIT_L(0); PG8_BAR; PG8_MMA(1, 0, At, B0); PG8_MMA(1, 1, At, B1); PG8_BAR; PG8_SCHED;
            } else {
            PG8_LDB(B0, 0, 0); PG8_SCHED; PG8_LDA(At, 0, 0); PG8_STAGE(PG8_SA(1, 1), a1 + hstep, voffA);
            PG8_WAIT_L(8); PG8_BAR; PG8_WAIT_L(0); PG8_MMA(0, 0, At, B0); PG8_BAR; PG8_SCHED;
            PG8_LDB(B1, 0, 1); PG8_STAGE(PG8_SB(0, 0), b2, voffB);
            PG8_BAR; PG8_WAIT_L(0); PG8_MMA(0, 1, At, B1); PG8_BAR;
            PG8_LDA(At, 0, 1); PG8_STAGE(PG8_SA(0, 0), a2, voffA);
            PG8_BAR; PG8_WAIT_L(0); PG8_MMA(1, 0, At, B0); PG8_BAR; PG8_SCHED;
            PG8_STAGE(PG8_SB(0, 1), b2 + hstep, voffB);
            PG8_WAIT_V(6); PG8_BAR; PG8_MMA(1, 1, At, B1); PG8_BAR;
            PG8_LDB(B0, 1, 0); PG8_SCHED; PG8_LDA(At, 1, 0); PG8_STAGE(PG8_SA(0, 1), a2 + hstep, voffA);
            PG8_WAIT_L(8); PG8_BAR; PG8_WAIT_L(0); PG8_MMA(0, 0, At, B0); PG8_BAR; PG8_SCHED;
            PG8_LDB(B1, 1, 1); PG8_STAGE(PG8_SB(1, 0), b3, voffB);
            PG8_BAR; PG8_WAIT_L(0); PG8_MMA(0, 1, At, B1); PG8_BAR;
            PG8_LDA(At, 1, 1); PG8_STAGE(PG8_SA(1, 0), a3, voffA);
            PG8_BAR; PG8_WAIT_L(0); PG8_MMA(1, 0, At, B0); PG8_BAR; PG8_SCHED;
            PG8_STAGE(PG8_SB(1, 1), b3 + hstep, voffB);
            PG8_WAIT_V(6); PG8_BAR; PG8_MMA(1, 1, At, B1); PG8_BAR;
            }
        }
        if constexpr (ALIGN_EPI) { if (wr == 0) PG8_BAR; }
        if constexpr (!Epi::AFTER_DRAIN) { E(acc, cur, wr, wc, fr, fq); S.done(cur); }
        if (!has_next) break;
#pragma unroll
        for (int a = 0; a < 2; ++a)
#pragma unroll
            for (int b = 0; b < 2; ++b)
#pragma unroll
                for (int m = 0; m < 4; ++m)
#pragma unroll
                    for (int n = 0; n < 2; ++n) acc[a][b][m][n] = (f32x4){0.f, 0.f, 0.f, 0.f};
        cur = nxt; cA = nA; cB = nB; ++ui;
        if constexpr (ALIGN_EPI) { if (wr == 1) PG8_BAR; }
    }
    PG8_WAIT_V(0);
    if constexpr (!ALIGN_EPI) { if (wr == 0) PG8_BAR; }
    PG8_BAR;
    if constexpr (Epi::AFTER_DRAIN) { E.fused(acc, cur, wr, wc, fr, fq, lds, wid, lane); S.done(cur); }
#undef PG8_SA
#undef PG8_SB
#undef PG8_STAGE
#undef PG8_LDA
#undef PG8_LDB
#undef PG8_MMA
#undef PG8_WAIT_V
#undef PG8_WAIT_L
#undef PG8_BAR
#undef PG8_SCHED
}
}

#define LAS __attribute__((address_space(3)))
using pg8::bf16_t; using pg8::bf16x8; using pg8::f32x4; using pg8::u32x4; using pg8::Unit; using pg8::cvt_pk_bf16;
typedef unsigned u32x2 __attribute__((ext_vector_type(2)));

constexpr int DM = 1024, TP = 16384, NSM = 512, MT = TP + NSM, INC = 2304, DFF = 2816, PLE = 256;
constexpr int ZQ = 0, ZF = 256, ZI = 512, ZG = 768, ZBU = 1024, ZBG = 1280, ZCQ = 1536, ZCK = 2048, ZCV = 2176;
constexpr float EPS = 1e-6f;
constexpr int NPOS = TP + 4;
constexpr size_t O_Y = 0, O_SPH = (size_t)MT * DM, O_SPC = O_SPH + 32768, O_SPK = O_SPC + 15360, O_SPV = O_SPK + 32768,
                 O_SSH = O_SPV + 32768, O_SSC = O_SSH + 4194304, O_SSK = O_SSC + 1966080, O_SSV = O_SSK + 4194304;
constexpr size_t MiB = 1u << 20;
constexpr size_t WS_CTL = 0, CTL_BYTES = 65536;
constexpr size_t WS_SS = 1 * MiB;
constexpr size_t WS_LB = WS_SS + 512 * 1024;
constexpr size_t WS_DVEC = WS_LB + 4096;
constexpr size_t WS_ROPE = 2 * MiB;
constexpr size_t WS_W = 7 * MiB;
constexpr size_t W_IN = 0, W_OUT = W_IN + (size_t)INC * DM * 2, W_GU = W_OUT + (size_t)DM * DM * 2, W_D = W_GU + (size_t)2 * DFF * DM * 2,
                 W_PG = W_D + (size_t)DM * DFF * 2, W_PP = W_PG + (size_t)DM * DM * 2, W_LAYER = W_PP + (size_t)DM * PLE * 2;
constexpr size_t WS_BUFA = 59 * MiB, WS_BUFB = 92 * MiB, WS_ZACT = 125 * MiB, WS_PB = 216 * MiB, WS_DS = 233 * MiB, WS_END = 249 * MiB;
static_assert(WS_W + 2 * W_LAYER <= WS_BUFA && WS_BUFA + (size_t)MT * DM * 2 <= WS_BUFB && WS_BUFB + (size_t)MT * DM * 2 <= WS_ZACT, "ws map");
static_assert(WS_ZACT + (size_t)MT * DFF * 2 <= WS_PB && WS_PB + (size_t)2 * MT * PLE * 2 <= WS_DS && WS_ROPE + (size_t)NPOS * 64 * 4 <= WS_W, "ws map");
constexpr int LDS_BYTES = 147456, MISC_OFF = 131072 + 320;

#define LSYNC() do { asm volatile("s_waitcnt lgkmcnt(0)" ::: "memory"); __builtin_amdgcn_s_barrier(); asm volatile("" ::: "memory"); } while (0)
#define LDS_WAIT() asm volatile("s_waitcnt lgkmcnt(0)" ::: "memory")
__device__ __forceinline__ float bf2f(unsigned short h) { return __uint_as_float(((unsigned)h) << 16); }
template <int CTRL> __device__ __forceinline__ float dppf(float v) { return __int_as_float(__builtin_amdgcn_update_dpp(0, __float_as_int(v), CTRL, 0xf, 0xf, true)); }
__device__ __forceinline__ float wave_sum(float v) {
    v += dppf<0xB1>(v);
    v += dppf<0x4E>(v);
    v += dppf<0x141>(v);
    v += dppf<0x140>(v);
    const float r0 = __int_as_float(__builtin_amdgcn_readlane(__float_as_int(v), 0)), r1 = __int_as_float(__builtin_amdgcn_readlane(__float_as_int(v), 16));
    const float r2 = __int_as_float(__builtin_amdgcn_readlane(__float_as_int(v), 32)), r3 = __int_as_float(__builtin_amdgcn_readlane(__float_as_int(v), 48));
    return (r0 + r1) + (r2 + r3);
}
__device__ __forceinline__ float quad_sum(float v) { v += dppf<0xB1>(v); v += dppf<0x4E>(v); return v; }
__device__ __forceinline__ float sigmoidf_(float x) { return __builtin_amdgcn_rcpf(1.0f + __expf(-x)); }
__device__ __forceinline__ float siluf_(float x) { return x * __builtin_amdgcn_rcpf(1.0f + __expf(-x)); }
#define UNPACK8(V_, o) do { (o)[0] = __uint_as_float((V_).x << 16); (o)[1] = __uint_as_float((V_).x & 0xffff0000u); (o)[2] = __uint_as_float((V_).y << 16); (o)[3] = __uint_as_float((V_).y & 0xffff0000u); \
    (o)[4] = __uint_as_float((V_).z << 16); (o)[5] = __uint_as_float((V_).z & 0xffff0000u); (o)[6] = __uint_as_float((V_).w << 16); (o)[7] = __uint_as_float((V_).w & 0xffff0000u); } while (0)

#define XB_TMO      128
#define XB_XCNT(j)  (256  + 64 * (j))
#define XB_XSUB(j)  (1280 + 64 * (j))
#define XB_XGEN(j)  (2304 + 64 * (j))
#define XB_TOP      3328
#define XB_TOPGEN   3392
#define XCD_BAR_WORDS 3456
#define XB_SPIN_CAP (1u << 18)

__device__ __forceinline__ unsigned xb_ld(unsigned* p)              { return __hip_atomic_load(p, __ATOMIC_RELAXED, __HIP_MEMORY_SCOPE_AGENT); }
__device__ __forceinline__ unsigned xb_add(unsigned* p, unsigned v) { return __hip_atomic_fetch_add(p, v, __ATOMIC_RELAXED, __HIP_MEMORY_SCOPE_AGENT); }
__device__ __forceinline__ unsigned xb_xcc_id() { return (unsigned)__builtin_amdgcn_s_getreg((3 << 11) | 20) & 0xFu; }
#define XB_SPIN(cond, bar) do { unsigned _sp = 0; while (cond) { __builtin_amdgcn_s_sleep(1); \
    if ((++_sp & 255u) == 0u) { if (xb_ld(&(bar)[XB_TMO])) break; if (_sp > XB_SPIN_CAP) { atomicAdd(&(bar)[XB_TMO], 1u); break; } } } } while (0)

struct XcdBarrier {
    unsigned* bar; unsigned x; int wv;
    volatile LAS unsigned* st;
};

__device__ __forceinline__ XcdBarrier xcd_barrier_post(unsigned* bar, volatile LAS unsigned* st) {
    XcdBarrier b; b.bar = bar; b.x = xb_xcc_id(); b.st = st;
    if (threadIdx.x == 0) (void)xb_add(&bar[XB_XCNT(b.x)], 1u);
    return b;
}
__device__ __forceinline__ void xcd_barrier_complete(unsigned* bar, unsigned x, unsigned& nloc, unsigned& nx) {
    const unsigned G = gridDim.x * gridDim.y * gridDim.z;
    unsigned sum, cnt, mine, sp = 0u;
    for (;;) {
        sum = 0u; cnt = 0u; mine = 0u;
#pragma unroll
        for (unsigned j = 0; j < 16; ++j) { const unsigned c = xb_ld(&bar[XB_XCNT(j)]); sum += c; cnt += (c > 0u) ? 1u : 0u; mine = (j == x) ? c : mine; }
        if (sum == G) break;
        __builtin_amdgcn_s_sleep(1);
        if ((++sp & 255u) == 0u) { if (xb_ld(&bar[XB_TMO])) break; if (sp > XB_SPIN_CAP) { atomicAdd(&bar[XB_TMO], 1u); break; } }
    }
    nloc = mine > 0u ? mine : 1u; nx = cnt > 0u ? cnt : 1u;
}

__device__ __forceinline__ void xcd_barrier(const XcdBarrier& b) {
    asm volatile("s_waitcnt vmcnt(0)" ::: "memory");
    __syncthreads();
    unsigned xm_ = ~0u; asm volatile("" : "+s"(xm_));
    int xw_ = b.wv; asm volatile("" : "+s"(xw_));
    if (xw_ == 0 && __builtin_amdgcn_mbcnt_hi(xm_, __builtin_amdgcn_mbcnt_lo(xm_, 0u)) == 0u) {
        unsigned* bar = b.bar;
        __builtin_amdgcn_s_waitcnt(0);
        unsigned nloc = b.st[0], nx = b.st[1];
        if (nloc == 0u) { xcd_barrier_complete(bar, b.x, nloc, nx); b.st[0] = nloc; b.st[1] = nx; }
        const unsigned old = xb_add(&bar[XB_XSUB(b.x)], 1u);
        const unsigned gen = old / nloc;
        if (old + 1u == (gen + 1u) * nloc) {
            __builtin_amdgcn_fence(__ATOMIC_RELEASE, "agent");
            asm volatile("s_waitcnt vmcnt(0)" ::: "memory");
            const unsigned og = xb_add(&bar[XB_TOP], 1u);
            const unsigned tg = og / nx;
            if (og + 1u == (tg + 1u) * nx) xb_add(&bar[XB_TOPGEN], 1u);
            else XB_SPIN(xb_ld(&bar[XB_TOPGEN]) == tg, bar);
            __builtin_amdgcn_fence(__ATOMIC_ACQUIRE, "agent");
            xb_add(&bar[XB_XGEN(b.x)], 1u);
            asm volatile("s_waitcnt vmcnt(0)" ::: "memory");
        } else {
            XB_SPIN(xb_ld(&bar[XB_XGEN(b.x)]) == gen, bar);
            __builtin_amdgcn_fence(__ATOMIC_ACQUIRE, "agent");
            asm volatile("s_waitcnt vmcnt(0)" ::: "memory");
        }
    }
    __syncthreads();
}

struct EpiZ {
    static constexpr bool PERM = true, AFTER_DRAIN = false;
    bf16_t* O; int ldc; const float* ss;
    __device__ __forceinline__ void operator()(const f32x4 (&acc)[2][2][4][2], const Unit& u, int wr, int wc, int fr, int fq) const {
        const int row0 = u.pm * 256 + wr * 64 + fr, col0 = u.pn * 256 + wc * 32 + 8 * fq;
#pragma unroll
        for (int ai = 0; ai < 2; ++ai)
#pragma unroll
            for (int m = 0; m < 4; ++m) {
                const int row = row0 + ai * 128 + m * 16; const float r = rsqrtf(ss[row] * (1.0f / DM) + EPS);
                bf16_t* rowp = O + (size_t)row * ldc + col0;
#pragma unroll
                for (int bj = 0; bj < 2; ++bj) { const f32x4 v0 = acc[ai][bj][m][0] * r, v1 = acc[ai][bj][m][1] * r;
                    u32x4 w; w.x = cvt_pk_bf16(v0[0], v0[1]); w.y = cvt_pk_bf16(v0[2], v0[3]); w.z = cvt_pk_bf16(v1[0], v1[1]); w.w = cvt_pk_bf16(v1[2], v1[3]);
                    *(u32x4*)(rowp + bj * 128) = w; }
            }
    }
};
typedef float f32x2 __attribute__((ext_vector_type(2)));
struct EpiGU {
    static constexpr bool PERM = true, AFTER_DRAIN = false;
    bf16_t* O; const float* ss;
    __device__ __forceinline__ void operator()(const f32x4 (&acc)[2][2][4][2], const Unit& u, int wr, int wc, int fr, int fq) const {
        const int row0 = u.pm * 256 + wr * 64 + fr, col0 = u.pn * 128 + wc * 32 + 8 * fq;
#pragma unroll
        for (int ai = 0; ai < 2; ++ai)
#pragma unroll
            for (int m = 0; m < 4; ++m) {
                const int row = row0 + ai * 128 + m * 16; const float r = rsqrtf(ss[row] * (1.0f / DM) + EPS);
                const float rn = r * -1.44269504f, r2 = r * r;
                unsigned w4[4];
#pragma unroll
                for (int n = 0; n < 2; ++n)
#pragma unroll
                    for (int e = 0; e < 4; e += 2) {
                        const f32x2 g2 = (f32x2){acc[ai][0][m][n][e], acc[ai][0][m][n][e + 1]}, u2 = (f32x2){acc[ai][1][m][n][e], acc[ai][1][m][n][e + 1]};
                        const f32x2 t = g2 * rn; f32x2 ex; ex.x = __builtin_amdgcn_exp2f(t.x); ex.y = __builtin_amdgcn_exp2f(t.y);
                        const f32x2 d = ex + 1.0f; f32x2 rc; rc.x = __builtin_amdgcn_rcpf(d.x); rc.y = __builtin_amdgcn_rcpf(d.y);
                        const f32x2 o = (g2 * u2) * (rc * r2);
                        w4[n * 2 + (e >> 1)] = cvt_pk_bf16(o.x, o.y);
                    }
                u32x4 w; w.x = w4[0]; w.y = w4[1]; w.z = w4[2]; w.w = w4[3];
                *(u32x4*)(O + (size_t)row * DFF + col0) = w;
            }
    }
};
struct EpiRes {
    static constexpr bool PERM = false, AFTER_DRAIN = false;
    const bf16_t* res; bf16_t* Ob; float* ss;
    __device__ __forceinline__ void operator()(const f32x4 (&acc)[2][2][4][2], const Unit& u, int wr, int wc, int fr, int fq) const {
        const int row0 = u.pm * 256 + wr * 64 + fr, col0 = u.pn * 256 + wc * 32 + 4 * fq;
#pragma unroll
        for (int ai = 0; ai < 2; ++ai)
#pragma unroll
            for (int m = 0; m < 4; ++m) {
                const int row = row0 + ai * 128 + m * 16; const size_t off = (size_t)row * DM + col0; float sq = 0.f;
#pragma unroll
                for (int bj = 0; bj < 2; ++bj)
#pragma unroll
                    for (int n = 0; n < 2; ++n) { const size_t o2 = off + bj * 128 + n * 16;
                        const u32x2 rw = *(const u32x2*)(res + o2);
                        f32x4 v = acc[ai][bj][m][n]; v[0] += __uint_as_float(rw.x << 16); v[1] += __uint_as_float(rw.x & 0xffff0000u); v[2] += __uint_as_float(rw.y << 16); v[3] += __uint_as_float(rw.y & 0xffff0000u);
                        u32x2 w; w.x = cvt_pk_bf16(v[0], v[1]); w.y = cvt_pk_bf16(v[2], v[3]); *(u32x2*)(Ob + o2) = w;
                        sq += (v[0] * v[0] + v[1] * v[1]) + (v[2] * v[2] + v[3] * v[3]); }
                sq += __shfl_xor(sq, 16); sq += __shfl_xor(sq, 32);
                if (fq == 0) unsafeAtomicAdd(ss + row, sq);
            }
    }
};
struct EpiGate {
    static constexpr bool PERM = false, AFTER_DRAIN = false;
    bf16_t* Gt; const float* ss;
    __device__ __forceinline__ void operator()(const f32x4 (&acc)[2][2][4][2], const Unit& u, int wr, int wc, int fr, int fq) const {
        const int row0 = u.pm * 256 + wr * 64 + fr, col0 = u.pn * 256 + wc * 32 + 4 * fq;
#pragma unroll
        for (int ai = 0; ai < 2; ++ai)
#pragma unroll
            for (int m = 0; m < 4; ++m) {
                const int row = row0 + ai * 128 + m * 16; const size_t off = (size_t)row * DM + col0; const float r = rsqrtf(ss[row] * (1.0f / DM) + EPS);
#pragma unroll
                for (int bj = 0; bj < 2; ++bj)
#pragma unroll
                    for (int n = 0; n < 2; ++n) { const f32x4 a = acc[ai][bj][m][n] * r;
                        u32x2 w; w.x = cvt_pk_bf16(sigmoidf_(a[0]), sigmoidf_(a[1])); w.y = cvt_pk_bf16(sigmoidf_(a[2]), sigmoidf_(a[3]));
                        *(u32x2*)(Gt + off + bj * 128 + n * 16) = w; }
            }
    }
};
struct EpiOut {
    static constexpr bool PERM = false, AFTER_DRAIN = false;
    const bf16_t* Gt; const bf16_t* res; float* Y; bf16_t* Ob; float* ss; int final_;
    __device__ __forceinline__ void operator()(const f32x4 (&acc)[2][2][4][2], const Unit& u, int wr, int wc, int fr, int fq) const {
        const int row0 = u.pm * 256 + wr * 64 + fr, col0 = u.pn * 256 + wc * 32 + 4 * fq;
#pragma unroll
        for (int ai = 0; ai < 2; ++ai)
#pragma unroll
            for (int m = 0; m < 4; ++m) {
                const int row = row0 + ai * 128 + m * 16; const size_t off = (size_t)row * DM + col0; float sq = 0.f;
#pragma unroll
                for (int bj = 0; bj < 2; ++bj)
#pragma unroll
                    for (int n = 0; n < 2; ++n) { const size_t o2 = off + bj * 128 + n * 16;
                        const u32x2 rw = *(const u32x2*)(res + o2), gw = *(const u32x2*)(Gt + o2);
                        const f32x4 a = acc[ai][bj][m][n]; f32x4 v;
                        v[0] = __uint_as_float(rw.x << 16) + __uint_as_float(gw.x << 16) * a[0]; v[1] = __uint_as_float(rw.x & 0xffff0000u) + __uint_as_float(gw.x & 0xffff0000u) * a[1];
                        v[2] = __uint_as_float(rw.y << 16) + __uint_as_float(gw.y << 16) * a[2]; v[3] = __uint_as_float(rw.y & 0xffff0000u) + __uint_as_float(gw.y & 0xffff0000u) * a[3];
                        if (final_) *(f32x4*)(Y + o2) = v;
                        else { u32x2 w; w.x = cvt_pk_bf16(v[0], v[1]); w.y = cvt_pk_bf16(v[2], v[3]); *(u32x2*)(Ob + o2) = w; }
                        sq += (v[0] * v[0] + v[1] * v[1]) + (v[2] * v[2] + v[3] * v[3]); }
                if (!final_) { sq += __shfl_xor(sq, 16); sq += __shfl_xor(sq, 32); if (fq == 0) unsafeAtomicAdd(ss + row, sq); }
            }
    }
};

template <class Epi>
__device__ __forceinline__ void small_gemm(LAS unsigned char* lds, const bf16_t* A, const bf16_t* Bt, int K, const Epi& E, int bid, int tid, int lane, int wave) {
    if (bid >= 256) return;
    const int r0 = 64 * (bid >> 5), c0 = 32 * (bid & 31), fr = lane & 15, g = lane >> 4, kw = K >> 3;
    f32x4 acc[4][2];
#pragma unroll
    for (int m = 0; m < 4; ++m) { acc[m][0] = (f32x4){0.f, 0.f, 0.f, 0.f}; acc[m][1] = (f32x4){0.f, 0.f, 0.f, 0.f}; }
    const bf16_t* ap = A + (size_t)(r0 + fr) * K + wave * kw + 8 * g;
    const bf16_t* bp = Bt + (size_t)(c0 + fr) * K + wave * kw + 8 * g;
#pragma unroll 4
    for (int ks = 0; ks < kw; ks += 32) {
        bf16x8 a[4], b[2];
#pragma unroll
        for (int m = 0; m < 4; ++m) a[m] = *(const bf16x8*)(ap + (size_t)m * 16 * K + ks);
#pragma unroll
        for (int n = 0; n < 2; ++n) b[n] = *(const bf16x8*)(bp + (size_t)n * 16 * K + ks);
#pragma unroll
        for (int m = 0; m < 4; ++m)
#pragma unroll
            for (int n = 0; n < 2; ++n) acc[m][n] = __builtin_amdgcn_mfma_f32_16x16x32_bf16(a[m], b[n], acc[m][n], 0, 0, 0);
    }
    LAS float* P = (LAS float*)lds + wave * (64 * 33);
    LSYNC();
#pragma unroll
    for (int m = 0; m < 4; ++m)
#pragma unroll
        for (int n = 0; n < 2; ++n)
#pragma unroll
            for (int r = 0; r < 4; ++r) P[(16 * m + 4 * g + r) * 33 + 16 * n + fr] = acc[m][n][r];
    LSYNC();
    const int row = tid >> 3, c4 = (tid & 7) * 4;
    f32x4 v = (f32x4){0.f, 0.f, 0.f, 0.f};
#pragma unroll
    for (int w2 = 0; w2 < 8; ++w2) { const LAS float* q = (const LAS float*)lds + w2 * (64 * 33) + row * 33 + c4; v[0] += q[0]; v[1] += q[1]; v[2] += q[2]; v[3] += q[3]; }
    LSYNC();
    E.apply(r0 + row, c0 + c4, v, tid);
}
struct SEpiRes {
    const bf16_t* res; bf16_t* Ob; float* ss;
    __device__ __forceinline__ void apply(int row, int col, f32x4 v, int tid) const {
        const size_t o = (size_t)row * DM + col; const u32x2 rw = *(const u32x2*)(res + o);
        v[0] += __uint_as_float(rw.x << 16); v[1] += __uint_as_float(rw.x & 0xffff0000u); v[2] += __uint_as_float(rw.y << 16); v[3] += __uint_as_float(rw.y & 0xffff0000u);
        u32x2 w; w.x = cvt_pk_bf16(v[0], v[1]); w.y = cvt_pk_bf16(v[2], v[3]); *(u32x2*)(Ob + o) = w;
        float sq = (v[0] * v[0] + v[1] * v[1]) + (v[2] * v[2] + v[3] * v[3]);
        sq += __shfl_xor(sq, 1); sq += __shfl_xor(sq, 2); sq += __shfl_xor(sq, 4);
        if ((tid & 7) == 0) unsafeAtomicAdd(ss + row, sq);
    }
};
struct SEpiGate {
    bf16_t* Gt; const float* ss;
    __device__ __forceinline__ void apply(int row, int col, f32x4 v, int tid) const {
        const float r = rsqrtf(ss[row] * (1.0f / DM) + EPS);
        u32x2 w; w.x = cvt_pk_bf16(sigmoidf_(v[0] * r), sigmoidf_(v[1] * r)); w.y = cvt_pk_bf16(sigmoidf_(v[2] * r), sigmoidf_(v[3] * r));
        *(u32x2*)(Gt + (size_t)row * DM + col) = w;
    }
};
struct SEpiOut {
    const bf16_t* Gt; const bf16_t* res; float* Y; bf16_t* Ob; float* ss; int final_;
    __device__ __forceinline__ void apply(int row, int col, f32x4 a, int tid) const {
        const size_t o = (size_t)row * DM + col; const u32x2 rw = *(const u32x2*)(res + o), gw = *(const u32x2*)(Gt + o); f32x4 v;
        v[0] = __uint_as_float(rw.x << 16) + __uint_as_float(gw.x << 16) * a[0]; v[1] = __uint_as_float(rw.x & 0xffff0000u) + __uint_as_float(gw.x & 0xffff0000u) * a[1];
        v[2] = __uint_as_float(rw.y << 16) + __uint_as_float(gw.y << 16) * a[2]; v[3] = __uint_as_float(rw.y & 0xffff0000u) + __uint_as_float(gw.y & 0xffff0000u) * a[3];
        if (final_) { *(f32x4*)(Y + o) = v; return; }
        u32x2 w; w.x = cvt_pk_bf16(v[0], v[1]); w.y = cvt_pk_bf16(v[2], v[3]); *(u32x2*)(Ob + o) = w;
        float sq = (v[0] * v[0] + v[1] * v[1]) + (v[2] * v[2] + v[3] * v[3]);
        sq += __shfl_xor(sq, 1); sq += __shfl_xor(sq, 2); sq += __shfl_xor(sq, 4);
        if ((tid & 7) == 0) unsafeAtomicAdd(ss + row, sq);
    }
};

__device__ __forceinline__ void transpose_item(const float* W, int K, int N, const float* gain, bf16_t* WT, int mode, LAS float* scr, int item, int lane) {
    const int nblk = N / 32, kb = item / nblk, nb = item % nblk, k0 = 64 * kb, n0 = 32 * nb;
    { const int kr = lane >> 3, nq = (lane & 7) * 4; f32x4 v[8]; float gv[8];
#pragma unroll
      for (int i = 0; i < 8; ++i) { v[i] = *(const f32x4*)(W + (size_t)(k0 + 8 * i + kr) * N + n0 + nq); gv[i] = gain ? gain[k0 + 8 * i + kr] : 1.0f; }
#pragma unroll
      for (int i = 0; i < 8; ++i) { LAS float* d = scr + (8 * i + kr) * 33 + nq; d[0] = v[i][0] * gv[i]; d[1] = v[i][1] * gv[i]; d[2] = v[i][2] * gv[i]; d[3] = v[i][3] * gv[i]; } }
    LDS_WAIT(); asm volatile("" ::: "memory");
    const int drow0 = (mode == 0) ? n0 : (256 * (n0 >> 7) + (n0 & 127) + (mode == 2 ? 128 : 0));
    const int c = lane & 7;
#pragma unroll
    for (int j = 0; j < 4; ++j) { const int n = (lane >> 3) + 8 * j; const LAS float* s = scr + (8 * c) * 33 + n;
        u32x4 o; o.x = cvt_pk_bf16(s[0 * 33], s[1 * 33]); o.y = cvt_pk_bf16(s[2 * 33], s[3 * 33]); o.z = cvt_pk_bf16(s[4 * 33], s[5 * 33]); o.w = cvt_pk_bf16(s[6 * 33], s[7 * 33]);
        *(u32x4*)(WT + (size_t)(drow0 + n) * K + k0 + 8 * c) = o; }
    LDS_WAIT(); asm volatile("" ::: "memory");
}

struct Args { const float* in[27]; float* out; unsigned char* ws; };
constexpr int PT_OFF = 131072 + 1024;
__device__ __forceinline__ int opaque(int x) { asm volatile("" : "+v"(x)); return x; }
__device__ __forceinline__ int lane_id_opaque() { unsigned m_ = ~0u; asm volatile("" : "+s"(m_)); return (int)__builtin_amdgcn_mbcnt_hi(m_, __builtin_amdgcn_mbcnt_lo(m_, 0u)); }
__device__ __forceinline__ const float* ptf(LAS unsigned char* lds, int i) {
    const unsigned long long v = ((LAS const unsigned long long*)(lds + PT_OFF))[i];
    const unsigned lo = __builtin_amdgcn_readfirstlane((unsigned)v), hi = __builtin_amdgcn_readfirstlane((unsigned)(v >> 32));
    return (const float*)(((unsigned long long)hi << 32) | lo);
}
#define IN(i) ptf(lds, (i))
#define OUTP ((float*)ptf(lds, 27))
#define WSP ((unsigned char*)ptf(lds, 28))

__device__ __forceinline__ void prologue(LAS unsigned char* lds, int wv) {
    { unsigned z_ = 0; asm volatile("" : "+s"(z_)); lds += z_; }
    int wave_ = wv; asm volatile("" : "+s"(wave_)); const int wave = wave_, lane = lane_id_opaque(), tid = wave * 64 + lane;
    const int G = gridDim.x, bid = blockIdx.x, gw = bid * 8 + wave, NGW = G * 8, gtid = bid * 512 + tid, NT = G * 512;
    unsigned char* ws = WSP;
    LAS float* scr = (LAS float*)(lds + wave * 16384);
    constexpr int I_IN = (DM / 64) * (INC / 32), I_SQ = (DM / 64) * (DM / 32), I_GU = (DM / 64) * (DFF / 32), I_D = (DFF / 64) * (DM / 32), I_PP = (PLE / 64) * (DM / 32);
    constexpr int I_LAYER = I_IN + I_SQ + 2 * I_GU + I_D + I_SQ + I_PP;
#pragma unroll 1
    for (int it = gw; it < 2 * I_LAYER; it += NGW) {
        const int l = it / I_LAYER; int r = it % I_LAYER;
        unsigned char* wl = ws + WS_W + (size_t)l * W_LAYER;
        if (r < I_IN) { transpose_item(IN(9) + (size_t)l * DM * INC, DM, INC, IN(19) + l * DM, (bf16_t*)(wl + W_IN), 0, scr, r, lane); continue; } r -= I_IN;
        if (r < I_SQ) { transpose_item(IN(18) + (size_t)l * DM * DM, DM, DM, nullptr, (bf16_t*)(wl + W_OUT), 0, scr, r, lane); continue; } r -= I_SQ;
        if (r < I_GU) { transpose_item(IN(21) + (size_t)l * DM * DFF, DM, DFF, IN(20) + l * DM, (bf16_t*)(wl + W_GU), 1, scr, r, lane); continue; } r -= I_GU;
        if (r < I_GU) { transpose_item(IN(22) + (size_t)l * DM * DFF, DM, DFF, IN(20) + l * DM, (bf16_t*)(wl + W_GU), 2, scr, r, lane); continue; } r -= I_GU;
        if (r < I_D) { transpose_item(IN(23) + (size_t)l * DFF * DM, DFF, DM, nullptr, (bf16_t*)(wl + W_D), 0, scr, r, lane); continue; } r -= I_D;
        if (r < I_SQ) { transpose_item(IN(25) + (size_t)l * DM * DM, DM, DM, IN(24) + l * DM, (bf16_t*)(wl + W_PG), 0, scr, r, lane); continue; } r -= I_SQ;
        transpose_item(IN(26) + (size_t)l * PLE * DM, PLE, DM, nullptr, (bf16_t*)(wl + W_PP), 0, scr, r, lane);
    }
    float* ss = (float*)(ws + WS_SS);
    bf16_t* bufA = (bf16_t*)(ws + WS_BUFA);
    const float* xP = IN(0); const float* xS = IN(1);
#pragma unroll 1
    for (int m0 = gw; m0 < MT; m0 += 2 * NGW) {
        f32x4 v[2][4];
#pragma unroll
        for (int q = 0; q < 2; ++q) { const int m = (m0 + q * NGW < MT) ? m0 + q * NGW : m0; const float* xr = (m < TP) ? xP + (size_t)m * DM : xS + (size_t)(m - TP) * DM;
#pragma unroll
            for (int j = 0; j < 4; ++j) v[q][j] = ((const f32x4*)xr)[lane + 64 * j]; }
#pragma unroll
        for (int q = 0; q < 2; ++q) { const int m = (m0 + q * NGW < MT) ? m0 + q * NGW : m0; float s = 0.f;
#pragma unroll
            for (int j = 0; j < 4; ++j) s += (v[q][j][0] * v[q][j][0] + v[q][j][1] * v[q][j][1]) + (v[q][j][2] * v[q][j][2] + v[q][j][3] * v[q][j][3]);
            s = wave_sum(s); if (lane == 0) ss[m] = s;
#pragma unroll
            for (int j = 0; j < 4; ++j) { u32x2 w; w.x = cvt_pk_bf16(v[q][j][0], v[q][j][1]); w.y = cvt_pk_bf16(v[q][j][2], v[q][j][3]); ((u32x2*)(bufA + (size_t)m * DM))[lane + 64 * j] = w; } }
    }
    bf16_t* pb = (bf16_t*)(ws + WS_PB);
    const float* pP = IN(6); const float* pS = IN(7);
#pragma unroll 1
    for (int idx0 = gw; idx0 < 2 * MT; idx0 += 8 * NGW) {
        f32x4 v[8];
#pragma unroll
        for (int q = 0; q < 8; ++q) { const int idx = (idx0 + q * NGW < 2 * MT) ? idx0 + q * NGW : idx0; const int l = idx / MT, m = idx % MT;
            const float* src = (m < TP) ? pP + ((size_t)l * TP + m) * PLE : pS + ((size_t)l * NSM + (m - TP)) * PLE; v[q] = ((const f32x4*)src)[lane]; }
#pragma unroll
        for (int q = 0; q < 8; ++q) { const int idx = (idx0 + q * NGW < 2 * MT) ? idx0 + q * NGW : idx0; const int l = idx / MT, m = idx % MT;
            u32x2 w; w.x = cvt_pk_bf16(v[q][0], v[q][1]); w.y = cvt_pk_bf16(v[q][2], v[q][3]); ((u32x2*)(pb + ((size_t)l * MT + m) * PLE))[lane] = w; }
    }
    float* rc = (float*)(ws + WS_ROPE); float* rs = rc + (size_t)NPOS * 32;
#pragma unroll 1
    for (int idx = gtid; idx < NPOS * 32; idx += NT) {
        const int pos = idx >> 5, d = idx & 31;
        const double inv = exp2(-(double)d * (13.287712379549449 / 32.0));
        double rev = (double)pos * inv * 0.15915494309189535; rev -= rint(rev);
        const float fr = (float)rev;
        rc[idx] = __builtin_amdgcn_cosf(fr); rs[idx] = __builtin_amdgcn_sinf(fr);
    }
    if (gtid < 256) { float* lb = (float*)(ws + WS_LB); const float* al = IN(8); const float a0 = al[gtid], a1 = al[256 + gtid]; lb[gtid] = 0.f; lb[256 + gtid] = 1.0f / (1.0f + expf(a0 - a1)); }
#pragma unroll 1
    for (int idx = gtid; idx < 5 * MT; idx += NT) ss[MT + idx] = 0.f;
}

__device__ __forceinline__ void hgrn_gates(float z, float lb, float& logf_, float& kin) {
    const float e = __expf(-fabsf(z));
    const float inv = __builtin_amdgcn_rcpf(1.0f + e);
    const float big = inv, small = e * inv;
    const float sp = (z >= 0.f) ? big : small;
    const float sn = (z >= 0.f) ? small : big;
    kin = (1.0f - lb) * sn;
    if (lb > 0.f) logf_ = __logf(lb + (1.0f - lb) * sp);
    else logf_ = fminf(z, 0.f) - __logf(1.0f + e);
}

#define HGRN_G(zbase, lbv, tot) \
    float Gl[8], kin[8]; float Gend = 0.f, Gref = 0.f; { float run = 0.f; \
    _Pragma("unroll") for (int i = 0; i < 8; ++i) { float g; hgrn_gates(bf2f((zbase)[(size_t)(8 * wave + i) * INC + ZF]), lbv, g, kin[i]); run += g; Gl[i] = run; } \
    (tot)[wave * 64 + lane] = run; LSYNC(); float off = 0.f; \
    _Pragma("unroll") for (int w2 = 0; w2 < 8; ++w2) { const float t = (tot)[w2 * 64 + lane]; if (w2 < wave) off += t; if (w2 < 4) Gref += t; Gend += t; } \
    _Pragma("unroll") for (int i = 0; i < 8; ++i) Gl[i] += off; }

#define HGRN_G2(zf, lbv, tot) \
    float Gl[8], kin[8]; float Gend = 0.f, Gref = 0.f; { float run = 0.f; \
    _Pragma("unroll") for (int i = 0; i < 8; ++i) { float g; hgrn_gates((zf)[i], lbv, g, kin[i]); run += g; Gl[i] = run; } \
    (tot)[wave * 64 + lane] = run; LSYNC(); float off = 0.f; \
    _Pragma("unroll") for (int w2 = 0; w2 < 8; ++w2) { const float t = (tot)[w2 * 64 + lane]; if (w2 < wave) off += t; if (w2 < 4) Gref += t; Gend += t; } \
    _Pragma("unroll") for (int i = 0; i < 8; ++i) Gl[i] += off; }
__device__ __forceinline__ void hgrn_ds_item(const unsigned (&zfu)[8], const unsigned (&vi)[8], const float* lbp, float* dS, float* dvec, LAS unsigned char* lds, int c, int h, int tid, int lane, int wave) {
    LAS bf16_t* KTt = (LAS bf16_t*)lds;
    LAS bf16_t* Vt = KTt + 64 * 72;
    LAS float* TOT = (LAS float*)(Vt + 64 * 72);
    float zf[8];
#pragma unroll
    for (int i = 0; i < 8; ++i) zf[i] = __uint_as_float(zfu[i] << 16);
    const float lbv = lbp[h * 64 + lane];
    LSYNC();
    HGRN_G2(zf, lbv, TOT)
    { float kt[8];
#pragma unroll
      for (int i = 0; i < 8; ++i) kt[i] = kin[i] * __expf(Gend - Gl[i]);
      u32x4 kw; kw.x = cvt_pk_bf16(kt[0], kt[1]); kw.y = cvt_pk_bf16(kt[2], kt[3]); kw.z = cvt_pk_bf16(kt[4], kt[5]); kw.w = cvt_pk_bf16(kt[6], kt[7]);
      u32x4 vw; vw.x = vi[0] | (vi[1] << 16); vw.y = vi[2] | (vi[3] << 16); vw.z = vi[4] | (vi[5] << 16); vw.w = vi[6] | (vi[7] << 16);
      *(LAS u32x4*)(KTt + lane * 72 + 8 * wave) = kw; *(LAS u32x4*)(Vt + lane * 72 + 8 * wave) = vw; }
    if (wave == 0) dvec[(c * 4 + h) * 64 + lane] = __expf(Gend);
    LSYNC();
    const int fr = lane & 15, g = lane >> 4, kt4 = wave >> 1, vt0 = 2 * (wave & 1);
    f32x4 acc[2] = {(f32x4){0.f, 0.f, 0.f, 0.f}, (f32x4){0.f, 0.f, 0.f, 0.f}};
#pragma unroll
    for (int ks = 0; ks < 2; ++ks) {
        const bf16x8 kb = *(const LAS bf16x8*)(KTt + (16 * kt4 + fr) * 72 + 32 * ks + 8 * g);
#pragma unroll
        for (int n = 0; n < 2; ++n) { const bf16x8 va = *(const LAS bf16x8*)(Vt + (16 * (vt0 + n) + fr) * 72 + 32 * ks + 8 * g);
            acc[n] = __builtin_amdgcn_mfma_f32_16x16x32_bf16(va, kb, acc[n], 0, 0, 0); }
    }
    float* dst = dS + (size_t)(c * 4 + h) * 4096 + (16 * kt4 + fr) * 64 + 4 * g;
#pragma unroll
    for (int n = 0; n < 2; ++n) *(f32x4*)(dst + 16 * (vt0 + n)) = acc[n];
}

__device__ __forceinline__ void hgrn_out_item(const bf16_t* z, const float* lbp, const float* dS, const float* onorm, bf16_t* mix, LAS unsigned char* lds, int c, int hp, int tid, int lane, int wave) {
    const int hh = wave >> 2, wq = wave & 3, h = 2 * hp + hh, fr = lane & 15, g = lane >> 4;
    LAS bf16_t* QT = (LAS bf16_t*)(lds + hh * 46080);
    LAS bf16_t* KT = QT + 4608;
    LAS bf16_t* QS = KT + 4608;
    LAS bf16_t* Vt = QS + 4608;
    LAS bf16_t* St = Vt + 4608;
    LAS float* TOT = (LAS float*)(lds + 92160) + hh * 256;
    const bf16_t* zb = z + (size_t)(64 * c + 16 * wq) * INC + h * 64 + lane;
    unsigned zfu[16], zqu[16], ziu[16];
#pragma unroll
    for (int i = 0; i < 16; ++i) { zfu[i] = zb[(size_t)i * INC + ZF]; zqu[i] = zb[(size_t)i * INC + ZQ]; ziu[i] = zb[(size_t)i * INC + ZI]; }
    f32x4 sv[4];
#pragma unroll
    for (int j4 = 0; j4 < 4; ++j4) sv[j4] = *(const f32x4*)(dS + (size_t)(c * 4 + h) * 4096 + j4 * 1024 + (wq * 64 + lane) * 4);
    const size_t mt = (size_t)(64 * c + 16 * wq + fr);
    u32x2 gz[4];
#pragma unroll
    for (int vt = 0; vt < 4; ++vt) gz[vt] = *(const u32x2*)(z + mt * INC + ZG + h * 64 + 16 * vt + 4 * g);
    const float lbv = lbp[h * 64 + lane];
    LSYNC();
    float Gl[16], kin[16];
    { float run = 0.f;
#pragma unroll
      for (int i = 0; i < 16; ++i) { float gg; hgrn_gates(__uint_as_float(zfu[i] << 16), lbv, gg, kin[i]); run += gg; Gl[i] = run; }
      TOT[wq * 64 + lane] = run; }
    LSYNC();
    float off = 0.f, Gref = 0.f;
#pragma unroll
    for (int w2 = 0; w2 < 4; ++w2) { const float t = TOT[w2 * 64 + lane]; if (w2 < wq) off += t; if (w2 < 2) Gref += t; }
#pragma unroll
    for (int i = 0; i < 16; ++i) { const float G = Gl[i] + off, q = __uint_as_float(zqu[i] << 16); const int s = 16 * wq + i;
        QT[s * 72 + lane] = (bf16_t)(cvt_pk_bf16(q * __expf(fminf(G - Gref, 80.f)), 0.f) & 0xffffu);
        KT[s * 72 + lane] = (bf16_t)(cvt_pk_bf16(kin[i] * __expf(fminf(Gref - G, 80.f)), 0.f) & 0xffffu);
        QS[s * 72 + lane] = (bf16_t)(cvt_pk_bf16(q * __expf(G), 0.f) & 0xffffu); }
    { u32x4 v0, v1; v0.x = ziu[0] | (ziu[1] << 16); v0.y = ziu[2] | (ziu[3] << 16); v0.z = ziu[4] | (ziu[5] << 16); v0.w = ziu[6] | (ziu[7] << 16);
      v1.x = ziu[8] | (ziu[9] << 16); v1.y = ziu[10] | (ziu[11] << 16); v1.z = ziu[12] | (ziu[13] << 16); v1.w = ziu[14] | (ziu[15] << 16);
      *(LAS u32x4*)(Vt + lane * 72 + 16 * wq) = v0; *(LAS u32x4*)(Vt + lane * 72 + 16 * wq + 8) = v1; }
#pragma unroll
    for (int j4 = 0; j4 < 4; ++j4) { const int e = j4 * 1024 + (wq * 64 + lane) * 4, k = e >> 6, v = e & 63;
#pragma unroll
        for (int i = 0; i < 4; ++i) St[(v + i) * 72 + k] = (bf16_t)(cvt_pk_bf16(sv[j4][i], 0.f) & 0xffffu); }
    LSYNC();
    const int tt = wq;
    bf16x8 qb0 = *(const LAS bf16x8*)(QT + (16 * tt + fr) * 72 + 8 * g), qb1 = *(const LAS bf16x8*)(QT + (16 * tt + fr) * 72 + 32 + 8 * g);
    f32x4 at[4];
#pragma unroll
    for (int st = 0; st < 4; ++st) {
        at[st] = (f32x4){0.f, 0.f, 0.f, 0.f};
        if (st <= tt) {
            const bf16x8 k0 = *(const LAS bf16x8*)(KT + (16 * st + fr) * 72 + 8 * g), k1 = *(const LAS bf16x8*)(KT + (16 * st + fr) * 72 + 32 + 8 * g);
            f32x4 acc = (f32x4){0.f, 0.f, 0.f, 0.f};
            acc = __builtin_amdgcn_mfma_f32_16x16x32_bf16(k0, qb0, acc, 0, 0, 0);
            acc = __builtin_amdgcn_mfma_f32_16x16x32_bf16(k1, qb1, acc, 0, 0, 0);
            if (st == tt) {
#pragma unroll
                for (int r = 0; r < 4; ++r) acc[r] = (4 * g + r <= fr) ? acc[r] : 0.f; }
            at[st] = acc;
        }
    }
    f32x4 o[4];
#pragma unroll
    for (int vt = 0; vt < 4; ++vt) o[vt] = (f32x4){0.f, 0.f, 0.f, 0.f};
#pragma unroll
    for (int u = 0; u < 2; ++u) {
        if (2 * u <= tt) {
            u32x4 pw; pw.x = cvt_pk_bf16(at[2 * u][0], at[2 * u][1]); pw.y = cvt_pk_bf16(at[2 * u][2], at[2 * u][3]);
            pw.z = cvt_pk_bf16(at[2 * u + 1][0], at[2 * u + 1][1]); pw.w = cvt_pk_bf16(at[2 * u + 1][2], at[2 * u + 1][3]);
            const bf16x8 pf = __builtin_bit_cast(bf16x8, pw);
#pragma unroll
            for (int vt = 0; vt < 4; ++vt) {
                const LAS bf16_t* vp = Vt + (16 * vt + fr) * 72 + 32 * u + 4 * g;
                u32x4 vw; const u32x2 lo = *(const LAS u32x2*)vp, hi = *(const LAS u32x2*)(vp + 16); vw.x = lo.x; vw.y = lo.y; vw.z = hi.x; vw.w = hi.y;
                o[vt] = __builtin_amdgcn_mfma_f32_16x16x32_bf16(__builtin_bit_cast(bf16x8, vw), pf, o[vt], 0, 0, 0);
            }
        }
    }
#pragma unroll
    for (int ks = 0; ks < 2; ++ks) {
        const bf16x8 qs = *(const LAS bf16x8*)(QS + (16 * tt + fr) * 72 + 32 * ks + 8 * g);
#pragma unroll
        for (int vt = 0; vt < 4; ++vt) { const bf16x8 sa = *(const LAS bf16x8*)(St + (16 * vt + fr) * 72 + 32 * ks + 8 * g);
            o[vt] = __builtin_amdgcn_mfma_f32_16x16x32_bf16(sa, qs, o[vt], 0, 0, 0); }
    }
    float sq = 0.f;
#pragma unroll
    for (int vt = 0; vt < 4; ++vt) sq += (o[vt][0] * o[vt][0] + o[vt][1] * o[vt][1]) + (o[vt][2] * o[vt][2] + o[vt][3] * o[vt][3]);
    sq += __shfl_xor(sq, 16); sq += __shfl_xor(sq, 32);
    const float rn = rsqrtf(sq * (1.0f / 64.0f) + EPS);
#pragma unroll
    for (int vt = 0; vt < 4; ++vt) {
        const f32x4 nv = *(const f32x4*)(onorm + 16 * vt + 4 * g);
        const float g0 = __uint_as_float(gz[vt].x << 16), g1 = __uint_as_float(gz[vt].x & 0xffff0000u), g2 = __uint_as_float(gz[vt].y << 16), g3 = __uint_as_float(gz[vt].y & 0xffff0000u);
        u32x2 w; w.x = cvt_pk_bf16(o[vt][0] * rn * nv[0] * siluf_(g0), o[vt][1] * rn * nv[1] * siluf_(g1)); w.y = cvt_pk_bf16(o[vt][2] * rn * nv[2] * siluf_(g2), o[vt][3] * rn * nv[3] * siluf_(g3));
        *(u32x2*)(mix + mt * DM + h * 64 + 16 * vt + 4 * g) = w;
    }
}

__device__ __forceinline__ void hgrn_sample_item(const bf16_t* z, const float* lbp, const float* S0, float* Sout, const float* onorm, bf16_t* mix, LAS unsigned char* lds, int b, int hp, int tid, int lane, int wave) {
    LAS float* F = (LAS float*)lds; LAS float* KI = F + 512; LAS float* Q = KI + 512; LAS float* V = Q + 512;
    LAS float* RED = V + 512;
    const int hh = wave >> 2, kq = wave & 3, h = 2 * hp + hh;
    float S[16];
    { const float* sp = S0 + (size_t)h * 4096 + (16 * kq) * 64 + lane;
#pragma unroll
      for (int i = 0; i < 16; ++i) S[i] = sp[i * 64]; }
    const int t0 = tid >> 7, hk = tid & 127;
    const bf16_t* zr = z + ((size_t)TP + 4 * b + t0) * INC + hp * 128 + hk;
    const float zf = bf2f(zr[ZF]), q0 = bf2f(zr[ZQ]), vi = bf2f(zr[ZI]); const float lb = lbp[hp * 128 + hk];
    LSYNC();
    { const float e = __expf(-fabsf(zf)); const float sp = (zf >= 0.f) ? 1.0f / (1.0f + e) : e / (1.0f + e); const float sn = (zf >= 0.f) ? e / (1.0f + e) : 1.0f / (1.0f + e);
      F[tid] = lb + (1.0f - lb) * sp; KI[tid] = (1.0f - lb) * sn; Q[tid] = q0; V[tid] = vi; }
    LSYNC();
#pragma unroll
    for (int t = 0; t < 4; ++t) {
        const float vt = V[t * 128 + hh * 64 + lane]; float part = 0.f;
#pragma unroll
        for (int i = 0; i < 16; ++i) { const int k = t * 128 + hh * 64 + 16 * kq + i; S[i] = F[k] * S[i] + KI[k] * vt; part += S[i] * Q[k]; }
        RED[((t * 2 + hh) * 4 + kq) * 64 + lane] = part;
    }
    { float* so = Sout + (size_t)h * 4096 + (16 * kq) * 64 + lane;
#pragma unroll
      for (int i = 0; i < 16; ++i) so[i * 64] = S[i]; }
    LSYNC();
    { const int t = wave >> 1, hh2 = wave & 1, h2 = 2 * hp + hh2; const size_t m = (size_t)TP + 4 * b + t;
      float o = 0.f;
#pragma unroll
      for (int k4 = 0; k4 < 4; ++k4) o += RED[((t * 2 + hh2) * 4 + k4) * 64 + lane];
      const float r = rsqrtf(wave_sum(o * o) * (1.0f / 64.0f) + EPS);
      const float res = o * r * onorm[lane] * siluf_(bf2f(z[m * INC + ZG + h2 * 64 + lane]));
      mix[m * DM + h2 * 64 + lane] = (bf16_t)(cvt_pk_bf16(res, 0.f) & 0xffffu); }
}

template <int NTOK>
__device__ __forceinline__ void conv_compute(const LAS float* U, int r0, size_t m0, const float* cw, const float* cb, const float* lng, const float* lnb, bf16_t* mix, int lane, int wave) {
    const int ch = 64 * (wave & 3) + lane;
    float w[31];
#pragma unroll
    for (int j = 0; j < 31; ++j) w[j] = cw[j * 256 + ch];
    const float bias = cb[ch], g = lng[ch], be = lnb[ch];
    constexpr int TG = (NTOK >= 4) ? 4 : NTOK;
#pragma unroll 1
    for (int tg = 0; tg < NTOK / TG; ++tg) {
        float y[TG];
#pragma unroll
        for (int t = 0; t < TG; ++t) y[t] = bias;
        const LAS float* up = U + (r0 + TG * tg) * 256 + ch;
#pragma unroll
        for (int j = 0; j < TG + 30; ++j) { const float u = up[j * 256];
#pragma unroll
            for (int t = 0; t < TG; ++t) { if (j - t >= 0 && j - t < 31) y[t] += w[j - t] * u; } }
#pragma unroll
        for (int t = 0; t < TG; ++t) {
            const float mu = wave_sum(y[t]) * (1.0f / 64.0f); const float d = y[t] - mu;
            const float var = wave_sum(d * d) * (1.0f / 64.0f);
            const float o = siluf_(d * rsqrtf(var + EPS) * g + be);
            mix[(m0 + TG * tg + t) * DM + 256 + ch] = (bf16_t)(cvt_pk_bf16(o, 0.f) & 0xffffu);
        }
    }
}
__device__ __forceinline__ void conv_prompt_item(const bf16_t* z, const float* cw, const float* cb, const float* lng, const float* lnb, bf16_t* mix, float* spc, LAS unsigned char* lds, int ct, int tid, int lane, int wave) {
    LAS float* U = (LAS float*)lds;
    const int t0 = 64 * ct;
    u32x4 ra[6], rb[6];
#pragma unroll
    for (int it = 0; it < 6; ++it) { const int r = it * 16 + (tid >> 5), cg8 = (tid & 31) * 8; int tok = t0 - 30 + r; tok = tok < 0 ? 0 : tok;
        const bf16_t* zr = z + (size_t)tok * INC; ra[it] = *(const u32x4*)(zr + ZBU + cg8); rb[it] = *(const u32x4*)(zr + ZBG + cg8); }
    LSYNC();
#pragma unroll
    for (int it = 0; it < 6; ++it) { const int r = it * 16 + (tid >> 5), cg8 = (tid & 31) * 8; const bool ok = (t0 - 30 + r) >= 0;
        float fa[8], fb[8], u[8]; UNPACK8(ra[it], fa); UNPACK8(rb[it], fb);
#pragma unroll
        for (int j = 0; j < 8; ++j) u[j] = ok ? fa[j] * sigmoidf_(fb[j]) : 0.f;
        *(LAS f32x4*)(U + r * 256 + cg8) = (f32x4){u[0], u[1], u[2], u[3]}; *(LAS f32x4*)(U + r * 256 + cg8 + 4) = (f32x4){u[4], u[5], u[6], u[7]}; }
    LSYNC();
    conv_compute<32>(U, 32 * (wave >> 2), (size_t)t0 + 32 * (wave >> 2), cw, cb, lng, lnb, mix, lane, wave);
    if (ct == 255) for (int idx = tid; idx < 30 * 256; idx += 512) spc[idx] = U[(64 + (idx >> 8)) * 256 + (idx & 255)];
}
__device__ __forceinline__ void conv_sample_item(const bf16_t* z, const float* sconv, const float* cw, const float* cb, const float* lng, const float* lnb, bf16_t* mix, float* ssc, LAS unsigned char* lds, int b, int tid, int lane, int wave) {
    LAS float* U = (LAS float*)lds;
    float hv[15];
#pragma unroll
    for (int it = 0; it < 15; ++it) hv[it] = sconv[(size_t)b * 30 * 256 + it * 512 + tid];
    float nu[2];
#pragma unroll
    for (int it = 0; it < 2; ++it) { const int idx = it * 512 + tid, t = idx >> 8, ch = idx & 255; const bf16_t* zr = z + ((size_t)TP + 4 * b + t) * INC;
        nu[it] = bf2f(zr[ZBU + ch]) * sigmoidf_(bf2f(zr[ZBG + ch])); }
    LSYNC();
#pragma unroll
    for (int it = 0; it < 15; ++it) U[it * 512 + tid] = hv[it];
#pragma unroll
    for (int it = 0; it < 2; ++it) U[30 * 256 + it * 512 + tid] = nu[it];
    LSYNC();
    conv_compute<2>(U, 2 * (wave >> 2), (size_t)TP + 4 * b + 2 * (wave >> 2), cw, cb, lng, lnb, mix, lane, wave);
#pragma unroll
    for (int it = 0; it < 15; ++it) ssc[(size_t)b * 30 * 256 + it * 512 + tid] = U[4 * 256 + it * 512 + tid];
}

constexpr int KSTR = 72, VSTR = 280;
#define NORM_ROPE(rowp, gain, pos, g, sh1, sh2, x1, x2) do { \
    const u32x4 _lo = *(const u32x4*)((rowp) + 8 * (g)), _hi = *(const u32x4*)((rowp) + 32 + 8 * (g)); float _a[8], _b[8]; UNPACK8(_lo, _a); UNPACK8(_hi, _b); \
    float _sq = 0.f; _Pragma("unroll") for (int _j = 0; _j < 8; ++_j) _sq += _a[_j] * _a[_j] + _b[_j] * _b[_j]; \
    _sq += __shfl_xor(_sq, sh1); _sq += __shfl_xor(_sq, sh2); const float _r = rsqrtf(_sq * (1.0f / 64.0f) + EPS); \
    const float* _cp = rope_c + (size_t)(pos) * 32 + 8 * (g); const float* _sp = rope_s + (size_t)(pos) * 32 + 8 * (g); \
    _Pragma("unroll") for (int _j = 0; _j < 8; ++_j) { const float _y1 = _a[_j] * _r * (gain)[8 * (g) + _j], _y2 = _b[_j] * _r * (gain)[32 + 8 * (g) + _j]; const float _c = _cp[_j], _s = _sp[_j]; \
        (x1)[_j] = _y1 * _c - _y2 * _s; (x2)[_j] = _y2 * _c + _y1 * _s; } } while (0)

__device__ __forceinline__ void attn_qtile(const LAS bf16_t* Kl, const LAS bf16_t* Vt, bf16x8 q0, bf16x8 q1, int i, int T0, int jmin, float sink, bf16_t* outp, int lane) {
    const int fr = lane & 15, g = lane >> 4;
    f32x4 s[9];
#pragma unroll
    for (int T = 0; T < 9; ++T) {
        const LAS bf16_t* kp = Kl + (16 * (T0 + T) + fr) * KSTR + 8 * g;
        const bf16x8 k0 = *(const LAS bf16x8*)kp, k1 = *(const LAS bf16x8*)(kp + 32);
        f32x4 acc = (f32x4){0.f, 0.f, 0.f, 0.f};
        acc = __builtin_amdgcn_mfma_f32_16x16x32_bf16(k0, q0, acc, 0, 0, 0);
        acc = __builtin_amdgcn_mfma_f32_16x16x32_bf16(k1, q1, acc, 0, 0, 0);
        s[T] = acc;
    }
    float mx = sink;
#pragma unroll
    for (int T = 0; T < 9; ++T)
#pragma unroll
        for (int r = 0; r < 4; ++r) { const int j = 16 * (T0 + T) + 4 * g + r; const bool valid = (j >= i) && (j <= i + 128) && (j >= jmin);
            s[T][r] = valid ? s[T][r] : -INFINITY; mx = fmaxf(mx, s[T][r]); }
    mx = fmaxf(mx, __shfl_xor(mx, 16)); mx = fmaxf(mx, __shfl_xor(mx, 32));
    float sum = 0.f;
#pragma unroll
    for (int T = 0; T < 9; ++T)
#pragma unroll
        for (int r = 0; r < 4; ++r) { const float p = __expf(s[T][r] - mx); s[T][r] = p; sum += p; }
    sum += __shfl_xor(sum, 16); sum += __shfl_xor(sum, 32);
    const float inv = 1.0f / (sum + __expf(sink - mx));
    f32x4 o[4];
#pragma unroll
    for (int dt = 0; dt < 4; ++dt) o[dt] = (f32x4){0.f, 0.f, 0.f, 0.f};
#pragma unroll
    for (int u = 0; u < 5; ++u) {
        u32x4 pw; pw.x = cvt_pk_bf16(s[2 * u][0], s[2 * u][1]); pw.y = cvt_pk_bf16(s[2 * u][2], s[2 * u][3]);
        if (u < 4) { pw.z = cvt_pk_bf16(s[2 * u + 1 > 8 ? 8 : 2 * u + 1][0], s[2 * u + 1 > 8 ? 8 : 2 * u + 1][1]); pw.w = cvt_pk_bf16(s[2 * u + 1 > 8 ? 8 : 2 * u + 1][2], s[2 * u + 1 > 8 ? 8 : 2 * u + 1][3]); }
        else { pw.z = 0u; pw.w = 0u; }
        const bf16x8 pf = __builtin_bit_cast(bf16x8, pw);
#pragma unroll
        for (int dt = 0; dt < 4; ++dt) {
            const LAS bf16_t* vp = Vt + (16 * dt + fr) * VSTR + 16 * (T0 + 2 * u) + 4 * g;
            u32x4 vw; const u32x2 lo = *(const LAS u32x2*)vp, hi = *(const LAS u32x2*)(vp + 16); vw.x = lo.x; vw.y = lo.y; vw.z = hi.x; vw.w = hi.y;
            o[dt] = __builtin_amdgcn_mfma_f32_16x16x32_bf16(__builtin_bit_cast(bf16x8, vw), pf, o[dt], 0, 0, 0);
        }
    }
#pragma unroll
    for (int dt = 0; dt < 4; ++dt) { u32x2 w; w.x = cvt_pk_bf16(o[dt][0] * inv, o[dt][1] * inv); w.y = cvt_pk_bf16(o[dt][2] * inv, o[dt][3] * inv); *(u32x2*)(outp + 16 * dt + 4 * g) = w; }
}

#define LOAD_QFRAG(zq, pos, q0, q1) do { float _x1[8], _x2[8]; const int _g = lane >> 4; NORM_ROPE(zq, qn, pos, _g, 16, 32, _x1, _x2); \
    u32x4 _w0, _w1; _w0.x = cvt_pk_bf16(_x1[0] * 0.125f, _x1[1] * 0.125f); _w0.y = cvt_pk_bf16(_x1[2] * 0.125f, _x1[3] * 0.125f); _w0.z = cvt_pk_bf16(_x1[4] * 0.125f, _x1[5] * 0.125f); _w0.w = cvt_pk_bf16(_x1[6] * 0.125f, _x1[7] * 0.125f); \
    _w1.x = cvt_pk_bf16(_x2[0] * 0.125f, _x2[1] * 0.125f); _w1.y = cvt_pk_bf16(_x2[2] * 0.125f, _x2[3] * 0.125f); _w1.z = cvt_pk_bf16(_x2[4] * 0.125f, _x2[5] * 0.125f); _w1.w = cvt_pk_bf16(_x2[6] * 0.125f, _x2[7] * 0.125f); \
    q0 = __builtin_bit_cast(bf16x8, _w0); q1 = __builtin_bit_cast(bf16x8, _w1); } while (0)

__device__ __forceinline__ void attn_prompt_item(const bf16_t* z, const float* qn, const float* kn, const float* sinks, const float* rope_c, const float* rope_s, bf16_t* mix, float* spk, float* spv,
                                                 LAS unsigned char* lds, int qb, int kvh, int tid, int lane, int wave) {
    LAS bf16_t* Kl = (LAS bf16_t*)lds;
    LAS bf16_t* Vt = Kl + 256 * KSTR;
    LSYNC();
    const int kbase = qb * 128 - 128;
#pragma unroll
    for (int it_ = 0; it_ < 2; ++it_) { const int task = tid + 512 * it_;
        const int j = task >> 2, g = task & 3, pos = kbase + j;
        u32x4 w0 = (u32x4){0u, 0u, 0u, 0u}, w1 = w0;
        float x1[8], x2[8];
        const int posc = pos < 0 ? 0 : pos;
        const bf16_t* zr = z + (size_t)posc * INC + ZCK + kvh * 64;
        NORM_ROPE(zr, kn, posc, g, 1, 2, x1, x2);
        if (pos >= 0) { w0.x = cvt_pk_bf16(x1[0], x1[1]); w0.y = cvt_pk_bf16(x1[2], x1[3]); w0.z = cvt_pk_bf16(x1[4], x1[5]); w0.w = cvt_pk_bf16(x1[6], x1[7]);
                        w1.x = cvt_pk_bf16(x2[0], x2[1]); w1.y = cvt_pk_bf16(x2[2], x2[3]); w1.z = cvt_pk_bf16(x2[4], x2[5]); w1.w = cvt_pk_bf16(x2[6], x2[7]); }
        *(LAS u32x4*)(Kl + j * KSTR + 8 * g) = w0; *(LAS u32x4*)(Kl + j * KSTR + 32 + 8 * g) = w1;
        if (qb == 127 && j >= 128) { float* o = spk + (size_t)(j - 128) * 128 + kvh * 64;
            *(f32x4*)(o + 8 * g) = (f32x4){x1[0], x1[1], x1[2], x1[3]}; *(f32x4*)(o + 8 * g + 4) = (f32x4){x1[4], x1[5], x1[6], x1[7]};
            *(f32x4*)(o + 32 + 8 * g) = (f32x4){x2[0], x2[1], x2[2], x2[3]}; *(f32x4*)(o + 32 + 8 * g + 4) = (f32x4){x2[4], x2[5], x2[6], x2[7]}; }
    }
#pragma unroll
    for (int it_ = 0; it_ < 4; ++it_) { const int task = tid + 512 * it_;
        const int j = task >> 3, c8 = (task & 7) * 8, pos = kbase + j;
        u32x4 w = (u32x4){0u, 0u, 0u, 0u};
        if (pos >= 0) w = *(const u32x4*)(z + (size_t)pos * INC + ZCV + kvh * 64 + c8);
        Vt[(c8 + 0) * VSTR + j] = (bf16_t)(w.x & 0xffffu); Vt[(c8 + 1) * VSTR + j] = (bf16_t)(w.x >> 16);
        Vt[(c8 + 2) * VSTR + j] = (bf16_t)(w.y & 0xffffu); Vt[(c8 + 3) * VSTR + j] = (bf16_t)(w.y >> 16);
        Vt[(c8 + 4) * VSTR + j] = (bf16_t)(w.z & 0xffffu); Vt[(c8 + 5) * VSTR + j] = (bf16_t)(w.z >> 16);
        Vt[(c8 + 6) * VSTR + j] = (bf16_t)(w.w & 0xffffu); Vt[(c8 + 7) * VSTR + j] = (bf16_t)(w.w >> 16);
        if (qb == 127 && j >= 128) { float f[8]; UNPACK8(w, f); float* o = spv + (size_t)(j - 128) * 128 + kvh * 64 + c8;
            *(f32x4*)o = (f32x4){f[0], f[1], f[2], f[3]}; *(f32x4*)(o + 4) = (f32x4){f[4], f[5], f[6], f[7]}; }
    }
    for (int idx = tid; idx < 64 * 24; idx += 512) Vt[(idx / 24) * VSTR + 256 + (idx % 24)] = 0;
    LSYNC();
    const int hq = kvh * 4 + (wave >> 1);
    const float sink = sinks[hq];
    const int g4 = lane >> 4;
    float gq1[8], gq2[8];
#pragma unroll
    for (int j = 0; j < 8; ++j) { gq1[j] = qn[8 * g4 + j] * 0.125f; gq2[j] = qn[32 + 8 * g4 + j] * 0.125f; }
    const int pos0 = qb * 128 + (wave & 1) * 64 + (lane & 15);
    const bf16_t* zq0 = z + (size_t)pos0 * INC + ZCQ + hq * 64 + 8 * g4;
    const float* rc0 = rope_c + (size_t)pos0 * 32 + 8 * g4; const float* rs0 = rope_s + (size_t)pos0 * 32 + 8 * g4;
    u32x4 nlo = *(const u32x4*)zq0, nhi = *(const u32x4*)(zq0 + 32);
    f32x4 nc0 = *(const f32x4*)rc0, nc1 = *(const f32x4*)(rc0 + 4), ns0 = *(const f32x4*)rs0, ns1 = *(const f32x4*)(rs0 + 4);
#pragma unroll 1
    for (int a4 = 0; a4 < 4; ++a4) {
        const u32x4 lo = nlo, hi = nhi; const f32x4 c0 = nc0, c1 = nc1, s0 = ns0, s1 = ns1;
        { const int an = a4 < 3 ? a4 + 1 : 3; const bf16_t* zqn = zq0 + (size_t)(16 * an) * INC; const float* rcn = rc0 + (size_t)(16 * an) * 32; const float* rsn = rs0 + (size_t)(16 * an) * 32;
          nlo = *(const u32x4*)zqn; nhi = *(const u32x4*)(zqn + 32); nc0 = *(const f32x4*)rcn; nc1 = *(const f32x4*)(rcn + 4); ns0 = *(const f32x4*)rsn; ns1 = *(const f32x4*)(rsn + 4); }
        float a[8], b[8]; UNPACK8(lo, a); UNPACK8(hi, b);
        float sq = 0.f;
#pragma unroll
        for (int j = 0; j < 8; ++j) sq += a[j] * a[j] + b[j] * b[j];
        sq += __shfl_xor(sq, 16); sq += __shfl_xor(sq, 32);
        const float r = rsqrtf(sq * (1.0f / 64.0f) + EPS);
        float x1[8], x2[8];
#pragma unroll
        for (int j = 0; j < 8; ++j) { const float y1 = a[j] * r * gq1[j], y2 = b[j] * r * gq2[j]; const float c = j < 4 ? c0[j & 3] : c1[j & 3], s = j < 4 ? s0[j & 3] : s1[j & 3];
            x1[j] = y1 * c - y2 * s; x2[j] = y2 * c + y1 * s; }
        u32x4 w0, w1; w0.x = cvt_pk_bf16(x1[0], x1[1]); w0.y = cvt_pk_bf16(x1[2], x1[3]); w0.z = cvt_pk_bf16(x1[4], x1[5]); w0.w = cvt_pk_bf16(x1[6], x1[7]);
        w1.x = cvt_pk_bf16(x2[0], x2[1]); w1.y = cvt_pk_bf16(x2[2], x2[3]); w1.z = cvt_pk_bf16(x2[4], x2[5]); w1.w = cvt_pk_bf16(x2[6], x2[7]);
        const int i0 = (wave & 1) * 64 + 16 * a4, i = i0 + (lane & 15);
        const size_t m = (size_t)qb * 128 + i;
        attn_qtile(Kl, Vt, __builtin_bit_cast(bf16x8, w0), __builtin_bit_cast(bf16x8, w1), i, i0 >> 4, qb == 0 ? 128 : 0, sink, mix + m * DM + 512 + hq * 64, lane);
    }
}

__device__ __forceinline__ void attn_sample_item(const bf16_t* z, const float* ck, const float* cv, const float* qn, const float* kn, const float* sinks, const float* rope_c, const float* rope_s, bf16_t* mix,
                                                 float* ssk, float* ssv, LAS unsigned char* lds, int b, int kvh, int tid, int lane, int wave) {
    LAS bf16_t* Kl = (LAS bf16_t*)lds;
    LAS bf16_t* Vt = Kl + 256 * KSTR;
    LSYNC();
#pragma unroll
    for (int it_ = 0; it_ < 2; ++it_) { const int task = tid + 512 * it_;
        const int j = task >> 3, c8 = (task & 7) * 8;
        const float* kr = ck + (size_t)j * 128 + kvh * 64 + c8; const float* vr = cv + (size_t)j * 128 + kvh * 64 + c8;
        const f32x4 k0 = *(const f32x4*)kr, k1 = *(const f32x4*)(kr + 4), v0 = *(const f32x4*)vr, v1 = *(const f32x4*)(vr + 4);
        u32x4 w; w.x = cvt_pk_bf16(k0[0], k0[1]); w.y = cvt_pk_bf16(k0[2], k0[3]); w.z = cvt_pk_bf16(k1[0], k1[1]); w.w = cvt_pk_bf16(k1[2], k1[3]);
        *(LAS u32x4*)(Kl + j * KSTR + c8) = w;
        const float vf[8] = {v0[0], v0[1], v0[2], v0[3], v1[0], v1[1], v1[2], v1[3]};
#pragma unroll
        for (int e = 0; e < 8; ++e) Vt[(c8 + e) * VSTR + j] = (bf16_t)(cvt_pk_bf16(vf[e], 0.f) & 0xffffu);
        if (j >= 4) { float* ok = ssk + (size_t)(j - 4) * 128 + kvh * 64 + c8; float* ov = ssv + (size_t)(j - 4) * 128 + kvh * 64 + c8;
            *(f32x4*)ok = k0; *(f32x4*)(ok + 4) = k1; *(f32x4*)ov = v0; *(f32x4*)(ov + 4) = v1; }
    }
    if (tid < 16) {
        const int t = tid >> 2, g = tid & 3, j = 128 + t; const size_t m = (size_t)TP + 4 * b + t;
        float x1[8], x2[8];
        NORM_ROPE(z + m * INC + ZCK + kvh * 64, kn, TP + t, g, 1, 2, x1, x2);
        u32x4 w0, w1; w0.x = cvt_pk_bf16(x1[0], x1[1]); w0.y = cvt_pk_bf16(x1[2], x1[3]); w0.z = cvt_pk_bf16(x1[4], x1[5]); w0.w = cvt_pk_bf16(x1[6], x1[7]);
        w1.x = cvt_pk_bf16(x2[0], x2[1]); w1.y = cvt_pk_bf16(x2[2], x2[3]); w1.z = cvt_pk_bf16(x2[4], x2[5]); w1.w = cvt_pk_bf16(x2[6], x2[7]);
        *(LAS u32x4*)(Kl + j * KSTR + 8 * g) = w0; *(LAS u32x4*)(Kl + j * KSTR + 32 + 8 * g) = w1;
        float* o = ssk + (size_t)(j - 4) * 128 + kvh * 64;
        *(f32x4*)(o + 8 * g) = (f32x4){x1[0], x1[1], x1[2], x1[3]}; *(f32x4*)(o + 8 * g + 4) = (f32x4){x1[4], x1[5], x1[6], x1[7]};
        *(f32x4*)(o + 32 + 8 * g) = (f32x4){x2[0], x2[1], x2[2], x2[3]}; *(f32x4*)(o + 32 + 8 * g + 4) = (f32x4){x2[4], x2[5], x2[6], x2[7]};
    }
    if (tid >= 64 && tid < 64 + 32) {
        const int t = (tid - 64) >> 3, c8 = ((tid - 64) & 7) * 8, j = 128 + t; const size_t m = (size_t)TP + 4 * b + t;
        const u32x4 w = *(const u32x4*)(z + m * INC + ZCV + kvh * 64 + c8);
        Vt[(c8 + 0) * VSTR + j] = (bf16_t)(w.x & 0xffffu); Vt[(c8 + 1) * VSTR + j] = (bf16_t)(w.x >> 16);
        Vt[(c8 + 2) * VSTR + j] = (bf16_t)(w.y & 0xffffu); Vt[(c8 + 3) * VSTR + j] = (bf16_t)(w.y >> 16);
        Vt[(c8 + 4) * VSTR + j] = (bf16_t)(w.z & 0xffffu); Vt[(c8 + 5) * VSTR + j] = (bf16_t)(w.z >> 16);
        Vt[(c8 + 6) * VSTR + j] = (bf16_t)(w.w & 0xffffu); Vt[(c8 + 7) * VSTR + j] = (bf16_t)(w.w >> 16);
        float f[8]; UNPACK8(w, f); float* o = ssv + (size_t)(j - 4) * 128 + kvh * 64 + c8;
        *(f32x4*)o = (f32x4){f[0], f[1], f[2], f[3]}; *(f32x4*)(o + 4) = (f32x4){f[4], f[5], f[6], f[7]};
    }
    if (tid >= 128 && tid < 128 + 12 * 8) { const int j = 132 + ((tid - 128) >> 3), c8 = ((tid - 128) & 7) * 8; *(LAS u32x4*)(Kl + j * KSTR + c8) = (u32x4){0u, 0u, 0u, 0u}; }
    for (int idx = tid; idx < 64 * 28; idx += 512) Vt[(idx / 28) * VSTR + 132 + (idx % 28)] = 0;
    LSYNC();
    if (wave == 0) {
        const int q = lane & 15, hg = q >> 2, t = q & 3, hq = kvh * 4 + hg; const size_t m = (size_t)TP + 4 * b + t;
        bf16x8 q0, q1;
        LOAD_QFRAG(z + m * INC + ZCQ + hq * 64, TP + t, q0, q1);
        attn_qtile(Kl, Vt, q0, q1, t, 0, 0, sinks[hq], mix + m * DM + 512 + hq * 64, lane);
    }
}

#define PHASE_HEAD { unsigned z_ = 0; asm volatile("" : "+s"(z_)); lds += z_; } int wave_ = wv; asm volatile("" : "+s"(wave_)); const int wave = wave_, lane = lane_id_opaque(), tid = wave * 64 + lane; const int G = gridDim.x, bid = blockIdx.x; unsigned char* ws = WSP; (void)lane; (void)wave; (void)G; (void)bid; (void)ws;
#define SSP(k) ((float*)(ws + WS_SS) + (size_t)(k) * MT)
#define WL(off) ((const bf16_t*)(ws + WS_W + (size_t)l * W_LAYER + (off)))

struct G1Order {
    pg8::StaticOrder so; unsigned* cnt; int c;
    __device__ __forceinline__ bool next(int i, Unit& u) const {
        if (c >= 64 && c < 82) { if (i == 0) { const int s = c - 64; u.pm = 64 + s / 9; u.pn = s % 9; return true; } return so.next(i - 1, u); }
        return so.next(i, u);
    }
    __device__ __forceinline__ void a_ready(const Unit&) const {}
    __device__ __forceinline__ void done(const Unit& u) const {
        if (u.pm >= 64) {
            asm volatile("s_waitcnt vmcnt(0)" ::: "memory");
            __builtin_amdgcn_fence(__ATOMIC_RELEASE, "agent");
            asm volatile("s_waitcnt vmcnt(0)" ::: "memory");
            if (lane_id_opaque() == 0) __hip_atomic_fetch_add(cnt, 1u, __ATOMIC_RELAXED, __HIP_MEMORY_SCOPE_AGENT);
        }
    }
};
__device__ __forceinline__ void phase_g1(LAS unsigned char* lds, int l, int wv) {
    PHASE_HEAD
    unsigned* cnt = (unsigned*)(ws + WS_CTL) + 8192 + 64 * l;
    { pg8::Gemm g{(const bf16_t*)(ws + WS_BUFA), WL(W_IN), MT, INC, DM}; G1Order S; S.so.init(TP, INC, G, bid); S.cnt = cnt; S.c = bid;
      EpiZ E{(bf16_t*)(ws + WS_ZACT), INC, SSP(3 * l)}; pg8::gemm_phase<EpiZ, G1Order, true, true>(lds, g, S, E, wv); }
    if (bid >= 82) {
        if (tid == 0) { unsigned sp = 0; while (__hip_atomic_load(cnt, __ATOMIC_RELAXED, __HIP_MEMORY_SCOPE_AGENT) < 144u) { __builtin_amdgcn_s_sleep(4); if (++sp > (1u << 22)) break; }
            __builtin_amdgcn_fence(__ATOMIC_ACQUIRE, "agent"); asm volatile("s_waitcnt vmcnt(0)" ::: "memory"); }
        __syncthreads();
        const bf16_t* z = (const bf16_t*)(ws + WS_ZACT); bf16_t* bufB = (bf16_t*)(ws + WS_BUFB);
        const float* lbp = (const float*)(ws + WS_LB) + l * 256;
        const float* rope_c = (const float*)(ws + WS_ROPE); const float* rope_s = rope_c + (size_t)NPOS * 32;
        float* out = OUTP;
#pragma unroll 1
        for (int it = bid - 82; it < 640; it += G - 82) {
            int r = it;
            if (r < 256) { const int b = r >> 1, hp = r & 1; const size_t so = ((size_t)(l * 128 + b) * 4) * 4096;
                hgrn_sample_item(z, lbp, IN(2) + so, out + O_SSH + so, IN(10) + l * 64, bufB, lds, b, hp, tid, lane, wave); continue; } r -= 256;
            if (r < 128) { conv_sample_item(z, IN(3) + (size_t)l * 128 * 7680, IN(11) + l * 31 * 256, IN(12) + l * 256, IN(13) + l * 256, IN(14) + l * 256, bufB, out + O_SSC + (size_t)l * 128 * 7680, lds, r, tid, lane, wave); continue; } r -= 128;
            { const int b = r >> 1, kvh = r & 1; const size_t co = (size_t)(l * 128 + b) * 16384;
              attn_sample_item(z, IN(4) + co, IN(5) + co, IN(15) + l * 64, IN(16) + l * 64, IN(17) + l * 8, rope_c, rope_s, bufB, out + O_SSK + co, out + O_SSV + co, lds, b, kvh, tid, lane, wave); }
        }
    }
}
__device__ __forceinline__ void phase_mix_a(LAS unsigned char* lds, int l, int wv) {
    PHASE_HEAD
    const bf16_t* z = (const bf16_t*)(ws + WS_ZACT); bf16_t* bufB = (bf16_t*)(ws + WS_BUFB);
    const float* lbp = (const float*)(ws + WS_LB) + l * 256; float* dvec = (float*)(ws + WS_DVEC); float* dS = (float*)(ws + WS_DS);
    const float* rope_c = (const float*)(ws + WS_ROPE); const float* rope_s = rope_c + (size_t)NPOS * 32;
    float* out = OUTP;
#pragma unroll 1
    for (int it = bid; it < 1024; it += G) {
        unsigned czf[8], cvi[8];
        const bf16_t* zb = z + (size_t)(64 * (it >> 2) + 8 * wave) * INC + (it & 3) * 64 + lane;
#pragma unroll
        for (int i = 0; i < 8; ++i) { czf[i] = zb[(size_t)i * INC + ZF]; cvi[i] = zb[(size_t)i * INC + ZI]; }
        hgrn_ds_item(czf, cvi, lbp, dS, dvec, lds, it >> 2, it & 3, tid, lane, wave);
    }
#pragma unroll 1
    for (int it = bid; it < 512; it += G) {
        int r = it;
        if (r < 256) { attn_prompt_item(z, IN(15) + l * 64, IN(16) + l * 64, IN(17) + l * 8, rope_c, rope_s, bufB, out + O_SPK + (size_t)l * 16384, out + O_SPV + (size_t)l * 16384, lds, r >> 1, r & 1, tid, lane, wave); continue; } r -= 256;
        conv_prompt_item(z, IN(11) + l * 31 * 256, IN(12) + l * 256, IN(13) + l * 256, IN(14) + l * 256, bufB, out + O_SPC + (size_t)l * 7680, lds, r, tid, lane, wave);
    }
}
__device__ __forceinline__ void phase_scan(LAS unsigned char* lds, int l, int wv) {
    PHASE_HEAD
    if (bid < 256) {
        float* dS = (float*)(ws + WS_DS); const float* dvec = (const float*)(ws + WS_DVEC);
        const int e = 64 * bid + lane, h = e >> 12, k = (e >> 6) & 63;
        LAS float* X = (LAS float*)lds;
        float v[32], d[32];
#pragma unroll
        for (int j = 0; j < 32; ++j) { const int c = 32 * wave + j; v[j] = dS[(size_t)c * 16384 + e]; d[j] = dvec[(c * 4 + h) * 64 + k]; }
        float A = 0.f, P = 1.f;
#pragma unroll
        for (int j = 0; j < 32; ++j) { const float t = v[j]; v[j] = A; A = d[j] * A + t; const float pd = d[j]; d[j] = P; P *= pd; }
        LSYNC();
        X[(wave * 2 + 0) * 64 + lane] = P; X[(wave * 2 + 1) * 64 + lane] = A;
        LSYNC();
        float S = 0.f;
#pragma unroll
        for (int w2 = 0; w2 < 8; ++w2) { const float p2 = X[(w2 * 2 + 0) * 64 + lane], a2 = X[(w2 * 2 + 1) * 64 + lane]; if (w2 < wave) S = p2 * S + a2; }
#pragma unroll
        for (int j = 0; j < 32; ++j) dS[(size_t)(32 * wave + j) * 16384 + e] = d[j] * S + v[j];
        if (wave == 7) OUTP[O_SPH + (size_t)l * 16384 + e] = P * S + A;
    }
}
__device__ __forceinline__ void phase_mix_c(LAS unsigned char* lds, int l, int wv) {
    PHASE_HEAD
    const bf16_t* z = (const bf16_t*)(ws + WS_ZACT); bf16_t* bufB = (bf16_t*)(ws + WS_BUFB);
    const float* lbp = (const float*)(ws + WS_LB) + l * 256; const float* dS = (const float*)(ws + WS_DS);
    const float* onorm = IN(10) + l * 64;
#pragma unroll 1
    for (int it = bid; it < 512; it += G) hgrn_out_item(z, lbp, dS, onorm, bufB, lds, it >> 1, it & 1, tid, lane, wave);
}
__device__ __forceinline__ void phase_g2(LAS unsigned char* lds, int l, int wv) {
    PHASE_HEAD
    bf16_t* bufA = (bf16_t*)(ws + WS_BUFA);
    pg8::Gemm g{(const bf16_t*)(ws + WS_BUFB), WL(W_OUT), TP, DM, DM}; pg8::StaticOrder S; S.init(TP, DM, G, bid);
    EpiRes E{bufA, bufA, SSP(3 * l + 1)};
    pg8::gemm_phase<EpiRes, pg8::StaticOrder, true, true>(lds, g, S, E, wv);
    SEpiRes SE{bufA + (size_t)TP * DM, bufA + (size_t)TP * DM, SSP(3 * l + 1) + TP};
    small_gemm(lds, (const bf16_t*)(ws + WS_BUFB) + (size_t)TP * DM, WL(W_OUT), DM, SE, bid, tid, lane, wave);
}
__device__ __forceinline__ void phase_g3(LAS unsigned char* lds, int l, int wv) {
    PHASE_HEAD
    pg8::Gemm g{(const bf16_t*)(ws + WS_BUFA), WL(W_GU), MT, 2 * DFF, DM}; pg8::StaticOrder S; S.init(MT, 2 * DFF, G, bid);
    EpiGU E{(bf16_t*)(ws + WS_ZACT), SSP(3 * l + 1)}; pg8::gemm_phase<EpiGU, pg8::StaticOrder, true, true>(lds, g, S, E, wv);
}
__device__ __forceinline__ void phase_g4(LAS unsigned char* lds, int l, int wv) {
    PHASE_HEAD
    const bf16_t* bufA = (const bf16_t*)(ws + WS_BUFA); bf16_t* bufB = (bf16_t*)(ws + WS_BUFB);
    pg8::Gemm g{(const bf16_t*)(ws + WS_ZACT), WL(W_D), TP, DM, DFF}; pg8::StaticOrder S; S.init(TP, DM, G, bid);
    EpiRes E{bufA, bufB, SSP(3 * l + 2)}; pg8::gemm_phase<EpiRes, pg8::StaticOrder, true, true>(lds, g, S, E, wv);
    SEpiRes SE{bufA + (size_t)TP * DM, bufB + (size_t)TP * DM, SSP(3 * l + 2) + TP};
    small_gemm(lds, (const bf16_t*)(ws + WS_ZACT) + (size_t)TP * DFF, WL(W_D), DFF, SE, bid, tid, lane, wave);
}
__device__ __forceinline__ void phase_g5a(LAS unsigned char* lds, int l, int wv) {
    PHASE_HEAD
    pg8::Gemm g{(const bf16_t*)(ws + WS_BUFB), WL(W_PG), TP, DM, DM}; pg8::StaticOrder S; S.init(TP, DM, G, bid);
    EpiGate E{(bf16_t*)(ws + WS_ZACT), SSP(3 * l + 2)}; pg8::gemm_phase<EpiGate, pg8::StaticOrder, true, true>(lds, g, S, E, wv);
    SEpiGate SE{(bf16_t*)(ws + WS_ZACT) + (size_t)TP * DM, SSP(3 * l + 2) + TP};
    small_gemm(lds, (const bf16_t*)(ws + WS_BUFB) + (size_t)TP * DM, WL(W_PG), DM, SE, bid, tid, lane, wave);
}
__device__ __forceinline__ void phase_g5b(LAS unsigned char* lds, int l, int wv) {
    PHASE_HEAD
    const bf16_t* gt = (const bf16_t*)(ws + WS_ZACT); const bf16_t* bufB = (const bf16_t*)(ws + WS_BUFB); bf16_t* bufA = (bf16_t*)(ws + WS_BUFA); float* Y = OUTP + O_Y;
    pg8::Gemm g{(const bf16_t*)(ws + WS_PB) + (size_t)l * MT * PLE, WL(W_PP), TP, DM, PLE}; pg8::StaticOrder S; S.init(TP, DM, G, bid);
    EpiOut E{gt, bufB, Y, bufA, SSP(3), l}; pg8::gemm_phase<EpiOut, pg8::StaticOrder, true, true>(lds, g, S, E, wv);
    SEpiOut SE{gt + (size_t)TP * DM, bufB + (size_t)TP * DM, Y + (size_t)TP * DM, bufA + (size_t)TP * DM, SSP(3) + TP, l};
    small_gemm(lds, (const bf16_t*)(ws + WS_PB) + ((size_t)l * MT + TP) * PLE, WL(W_PP), PLE, SE, bid, tid, lane, wave);
}

__global__ void __launch_bounds__(512, 2) fwd_kernel(Args a) {
    extern __shared__ __attribute__((aligned(16))) unsigned char lds_raw[];
    LAS unsigned char* lds = (LAS unsigned char*)lds_raw;
    volatile LAS unsigned* MISC = (volatile LAS unsigned*)(lds + MISC_OFF);
    if (threadIdx.x < 32) MISC[threadIdx.x] = 0u;
    if (threadIdx.x == 0) {
        LAS unsigned long long* PT = (LAS unsigned long long*)(lds + PT_OFF);
#pragma unroll
        for (int i = 0; i < 27; ++i) PT[i] = (unsigned long long)a.in[i];
        PT[27] = (unsigned long long)a.out; PT[28] = (unsigned long long)a.ws;
    }
    __syncthreads();
    const int wv = __builtin_amdgcn_readfirstlane(threadIdx.x >> 6);
    XcdBarrier bar = xcd_barrier_post((unsigned*)(WSP + WS_CTL), MISC + 8); bar.wv = wv;
    prologue(lds, wv);
    if (gridDim.x == 0x7fffffffu) cg::this_grid().sync();
    xcd_barrier(bar);
#define LAYER(l) do { \
        phase_g1(lds, l, wv); xcd_barrier(bar); \
        phase_mix_a(lds, l, wv); xcd_barrier(bar); \
        phase_scan(lds, l, wv); xcd_barrier(bar); \
        phase_mix_c(lds, l, wv); xcd_barrier(bar); \
        phase_g2(lds, l, wv); xcd_barrier(bar); \
        phase_g3(lds, l, wv); xcd_barrier(bar); \
        phase_g4(lds, l, wv); xcd_barrier(bar); \
        phase_g5a(lds, l, wv); \
        phase_g5b(lds, l, wv); } while (0)
    LAYER(0);
    xcd_barrier(bar);
    LAYER(1);
}

extern "C" void kernel_launch(void* const* d_in, const int* in_sizes, int n_in, void* d_out, int out_size, void* d_ws, size_t ws_size, hipStream_t stream) {
    static int grid = 0;
    if (grid == 0) {
        if (n_in != 27 || ws_size < WS_END) { fprintf(stderr, "kernel_launch: unexpected n_in %d / ws %zu\n", n_in, ws_size); grid = -1; return; }
        int dev = 0, cus = 0, per_cu = 0;
        hipGetDevice(&dev); hipDeviceGetAttribute(&cus, hipDeviceAttributeMultiprocessorCount, dev);
        if (hipFuncSetAttribute((const void*)fwd_kernel, hipFuncAttributeMaxDynamicSharedMemorySize, LDS_BYTES) != hipSuccess) { fprintf(stderr, "kernel_launch: hipFuncSetAttribute failed\n"); grid = -1; return; }
        hipOccupancyMaxActiveBlocksPerMultiprocessor(&per_cu, (const void*)fwd_kernel, 512, LDS_BYTES);
        (void)hipGetLastError();
        if (per_cu < 1) { fprintf(stderr, "kernel_launch: occupancy query says %d blocks per CU\n", per_cu); }
        grid = cus;
    }
    if (grid < 0) return;
    hipMemsetAsync((char*)d_ws + WS_CTL, 0, CTL_BYTES, stream);
    Args a{};
    for (int i = 0; i < 27; ++i) a.in[i] = (const float*)d_in[i];
    a.out = (float*)d_out; a.ws = (unsigned char*)d_ws;
    void* args[] = {&a};
    hipError_t e = hipLaunchCooperativeKernel((const void*)fwd_kernel, dim3(grid), dim3(512), args, LDS_BYTES, stream);
    if (e != hipSuccess) fprintf(stderr, "cooperative launch failed: %s (grid %d)\n", hipGetErrorString(e), grid);
}
```

```cpp
#include <hip/hip_runtime.h>
#include <hip/hip_cooperative_groups.h>
#include <cstdio>
#include <cstdint>
namespace cg = cooperative_groups;
namespace pg8 {
#define PG8_LAS __attribute__((address_space(3)))
typedef unsigned short bf16_t;
typedef short bf16x8 __attribute__((ext_vector_type(8)));
typedef float f32x4 __attribute__((ext_vector_type(4)));
typedef unsigned u32x4 __attribute__((ext_vector_type(4)));
constexpr int BM = 256, BK = 64, HALF = 128, HTB = HALF * BK * 2  , STAGE_BYTES = 8 * HTB, NXCD = 8, WGM = 8;

__host__ __device__ __forceinline__ int lds_byte(int r, int c) { const int st = (r >> 4) * 2 + (c >> 5), rr = r & 15, cc = c & 31, ob = rr * 64 + cc * 2; return st * 1024 + (ob ^ (((ob >> 9) & 1) << 5)); }
__host__ __device__ __forceinline__ void stage_rc(int b, int& R, int& C) { const int st = b / 1024, sb = b % 1024, swz = sb ^ (((sb >> 9) & 1) << 5); R = (st >> 1) * 16 + swz / 64; C = (st & 1) * 32 + (swz % 64) / 2; }
__host__ __device__ __forceinline__ int perm32(int rho) { const int n = rho >> 4, i = rho & 15; return 8 * (i >> 2) + 4 * n + (i & 3); }

struct Unit { int pm, pn; };
struct Gemm { const bf16_t* A; const bf16_t* Bt; int M, N, K; };

struct StaticOrder {
    int nM, nN, nwg, G, c;
    __host__ __device__ void init(int M, int N, int G_, int c_) { nM = M / BM; nN = N / BM; nwg = nM * nN; G = G_; c = c_; }
    __host__ __device__ bool next(int i, Unit& u) const {
        const long L = (long)i * G + c; if (L >= nwg) return false;
        int wgid = (int)L; { const int q = nwg / NXCD, r = nwg % NXCD, xcd = wgid % NXCD, off = wgid / NXCD; wgid = (xcd < r ? xcd * (q + 1) : r * (q + 1) + (xcd - r) * q) + off; }
        const int nig = WGM * nN, gid = wgid / nig, fm = gid * WGM, gsz = (nM - fm) < WGM ? (nM - fm) : WGM;
        u.pm = fm + ((wgid % nig) % gsz); u.pn = (wgid % nig) / gsz; return true;
    }
    __device__ __forceinline__ void a_ready(const Unit&) const {}
    __device__ __forceinline__ void done(const Unit&) const {}
};
__device__ __forceinline__ unsigned cvt_pk_bf16(float lo, float hi) { unsigned r; asm volatile("v_cvt_pk_bf16_f32 %0, %1, %2" : "=v"(r) : "v"(lo), "v"(hi)); return r; }
template <class Epi, class Sched, bool ALIGN_EPI = false, bool SP2 = false>
__device__ __forceinline__ void gemm_phase(PG8_LAS unsigned char* lds, const Gemm g, const Sched& S, const Epi& E, int wv_) {
    unsigned m_ = ~0u; asm volatile("" : "+s"(m_)); asm volatile("" : "+s"(wv_)); int tid_ = wv_ * 64 + (int)__builtin_amdgcn_mbcnt_hi(m_, __builtin_amdgcn_mbcnt_lo(m_, 0u)); { unsigned z_ = 0; asm volatile("" : "+s"(z_)); lds += z_; } const int tid = tid_, wid = __builtin_amdgcn_readfirstlane(tid >> 6), lane = tid & 63, wr = wid >> 2, wc = wid & 3, fr = lane & 15, fq = lane >> 4;
    const int K = g.K, nt = K / BK;
    unsigned voffA[2], voffB[2];
#pragma unroll
    for (int i = 0; i < 2; ++i) { int R, C; stage_rc(tid * 16 + i * 8192, R, C); const int Rb = Epi::PERM ? ((R & ~31) + perm32(R & 31)) : R;
        voffA[i] = (unsigned)(R * K + C) * 2u; voffB[i] = (unsigned)(Rb * K + C) * 2u; }
    const size_t kstep = (size_t)(BK * 2);
    const size_t hstep = (size_t)HALF * K * 2;
    const size_t tstep = 2 * hstep;
    const unsigned ldsw = (unsigned)wid * 1024u;
    const int aoff = lds_byte(wr * 64 + fr, fq * 8), boff = lds_byte(wc * 32 + fr, fq * 8);
#define PG8_SA(b, h) (((b) * 2 + (h)) * HTB)
#define PG8_SB(b, h) ((4 + (b) * 2 + (h)) * HTB)
#define PG8_STAGE(bufoff, gbase, voff) do { _Pragma("unroll") for (int _i = 0; _i < 2; ++_i) \
        __builtin_amdgcn_global_load_lds((const unsigned*)((const char*)(gbase) + (voff)[_i]), (PG8_LAS unsigned*)(lds + (bufoff) + ldsw + _i * 8192), 16, 0, 0); } while (0)
#define PG8_LDA(dst, b, h) do { _Pragma("unroll") for (int m = 0; m < 4; ++m) _Pragma("unroll") for (int k = 0; k < 2; ++k) dst[m][k] = *(const PG8_LAS bf16x8*)(lds + PG8_SA(b, h) + aoff + m * 2048 + k * 1024); } while (0)
#define PG8_LDB(dst, b, h) do { _Pragma("unroll") for (int n = 0; n < 2; ++n) _Pragma("unroll") for (int k = 0; k < 2; ++k) dst[n][k] = *(const PG8_LAS bf16x8*)(lds + PG8_SB(b, h) + boff + n * 2048 + k * 1024); } while (0)
#define PG8_MMA(ai, bj, At, Bt) do { __builtin_amdgcn_s_setprio(1); _Pragma("unroll") for (int m = 0; m < 4; ++m) _Pragma("unroll") for (int n = 0; n < 2; ++n) _Pragma("unroll") for (int k = 0; k < 2; ++k) \
        acc[ai][bj][m][n] = __builtin_amdgcn_mfma_f32_16x16x32_bf16(Bt[n][k], At[m][k], acc[ai][bj][m][n], 0, 0, 0); __builtin_amdgcn_s_setprio(0); } while (0)
#define PG8_WAIT_V(n) asm volatile("s_waitcnt vmcnt(" #n ")" ::: "memory")
#define PG8_WAIT_L(n) asm volatile("s_waitcnt lgkmcnt(" #n ")" ::: "memory")
#define PG8_BAR __builtin_amdgcn_s_barrier()
#define PG8_SCHED __builtin_amdgcn_sched_barrier(0)
    Unit cur, nxt; int ui = 0;
    if (!S.next(0, cur)) return;
    f32x4 acc[2][2][4][2];
#pragma unroll
    for (int a = 0; a < 2; ++a)
#pragma unroll
        for (int b = 0; b < 2; ++b)
#pragma unroll
            for (int m = 0; m < 4; ++m)
#pragma unroll
                for (int n = 0; n < 2; ++n) acc[a][b][m][n] = (f32x4){0.f, 0.f, 0.f, 0.f};
    bf16x8 At[4][2], B0[2][2], B1[2][2];
    const char* cA = (const char*)g.A + (size_t)cur.pm * tstep; const char* cB = (const char*)g.Bt + (size_t)cur.pn * tstep;
    S.a_ready(cur);
    if constexpr (SP2) {
        PG8_STAGE(PG8_SB(0, 0), cB, voffB); PG8_STAGE(PG8_SB(0, 1), cB + hstep, voffB); PG8_STAGE(PG8_SA(0, 0), cA, voffA); PG8_STAGE(PG8_SA(0, 1), cA + hstep, voffA);
        if (wr == 1) PG8_BAR;
        PG8_WAIT_V(2); PG8_BAR;
        PG8_STAGE(PG8_SB(1, 0), cB + kstep, voffB); PG8_STAGE(PG8_SA(1, 0), cA + kstep, voffA); PG8_STAGE(PG8_SB(1, 1), cB + hstep + kstep, voffB);
        PG8_WAIT_V(6); PG8_BAR;
    } else {
        PG8_STAGE(PG8_SB(0, 0), cB, voffB); PG8_STAGE(PG8_SA(0, 0), cA, voffA); PG8_STAGE(PG8_SB(0, 1), cB + hstep, voffB); PG8_STAGE(PG8_SA(0, 1), cA + hstep, voffA);
        if (wr == 1) PG8_BAR;
        PG8_WAIT_V(4); PG8_BAR;
        PG8_STAGE(PG8_SB(1, 0), cB + kstep, voffB); PG8_STAGE(PG8_SA(1, 0), cA + kstep, voffA); PG8_STAGE(PG8_SB(1, 1), cB + hstep + kstep, voffB);
        PG8_WAIT_V(6); PG8_BAR;
    }
    for (;;) {
        const bool has_next = S.next(ui + 1, nxt);
        const char* nA = has_next ? (const char*)g.A + (size_t)nxt.pm * tstep : cA; const char* nB = has_next ? (const char*)g.Bt + (size_t)nxt.pn * tstep : cB;
        for (int t = 0; t < nt; t += 2) {
            const bool last = (t == nt - 2);
            const char* a1 = cA + (size_t)(t + 1) * kstep;
            const char* a2 = last ? nA : cA + (size_t)(t + 2) * kstep; const char* b2 = last ? nB : cB + (size_t)(t + 2) * kstep;
            const char* a3 = a2 + kstep; const char* b3 = b2 + kstep;
            if (last && has_next) S.a_ready(nxt);
            if constexpr (SP2) {
            PG8_LDB(B0, 0, 0); PG8_LDB(B1, 0, 1); PG8_SCHED; PG8_LDA(At, 0, 0); PG8_STAGE(PG8_SA(1, 1), a1 + hstep, voffA);
            PG8_WAIT_V(8); PG8_WAIT_L(0); PG8_BAR; PG8_MMA(0, 0, At, B0); PG8_MMA(0, 1, At, B1); PG8_BAR; PG8_SCHED;
            PG8_LDA(At, 0, 1); PG8_STAGE(PG8_SB(0, 0), b2, voffB); PG8_STAGE(PG8_SB(0, 1), b2 + hstep, voffB); PG8_STAGE(PG8_SA(0, 0), a2, voffA);
            PG8_WAIT_V(8); PG8_WAIT_L(0); PG8_BAR; PG8_MMA(1, 0, At, B0); PG8_MMA(1, 1, At, B1); PG8_BAR; PG8_SCHED;
            PG8_LDB(B0, 1, 0); PG8_LDB(B1, 1, 1); PG8_SCHED; PG8_LDA(At, 1, 0); PG8_STAGE(PG8_SA(0, 1), a2 + hstep, voffA);
            PG8_WAIT_V(8); PG8_WAIT_L(0); PG8_BAR; PG8_MMA(0, 0, At, B0); PG8_MMA(0, 1, At, B1); PG8_BAR; PG8_SCHED;
            PG8_LDA(At, 1, 1); PG8_STAGE(PG8_SB(1, 0), b3, voffB); PG8_STAGE(PG8_SB(1, 1), b3 + hstep, voffB); PG8_STAGE(PG8_SA(1, 0), a3, voffA);
            PG8_WAIT_V(8); PG8_WAIT_L(0); PG8_BAR; PG8_MMA(1, 0, At, B0); PG8_MMA(1, 1, At, B1); PG8_BAR; PG8_SCHED;
            } else {
            PG8_LDB(B0, 0, 0); PG8_SCHED; PG8_LDA(At, 0, 0); PG8_STAGE(PG8_SA(1, 1), a1 + hstep, voffA);
            PG8_WAIT_L(8); PG8_BAR; PG8_WAIT_L(0); PG8_MMA(0, 0, At, B0); PG8_BAR; PG8_SCHED;
            PG8_LDB(B1, 0, 1); PG8_STAGE(PG8_SB(0, 0), b2, voffB);
            PG8_BAR; PG8_WAIT_L(0); PG8_MMA(0, 1, At, B1); PG8_BAR;
            PG8_LDA(At, 0, 1); PG8_STAGE(PG8_SA(0, 0), a2, voffA);
            PG8_BAR; PG8_WAIT_L(0); PG8_MMA(1, 0, At, B0); PG8_BAR; PG8_SCHED;
            PG8_STAGE(PG8_SB(0, 1), b2 + hstep, voffB);
            PG8_WAIT_V(6); PG8_BAR; PG8_MMA(1, 1, At, B1); PG8_BAR;
            PG8_LDB(B0, 1, 0); PG8_SCHED; PG8_LDA(At, 1, 0); PG8_STAGE(PG8_SA(0, 1), a2 + hstep, voffA);
            PG8_WAIT_L(8); PG8_BAR; PG8_WAIT_L(0); PG8_MMA(0, 0, At, B0); PG8_BAR; PG8_SCHED;
            PG8_LDB(B1, 1, 1); PG8_STAGE(PG8_SB(1, 0), b3, voffB);
            PG8_BAR; PG8_WAIT_L(0); PG8_MMA(0, 1, At, B1); PG8_BAR;
            PG8_LDA(At, 1, 1); PG8_STAGE(PG8_SA(1, 0), a3, voffA);
            PG8_BAR; PG8_WAIT_L(0); PG8_MMA(1, 0, At, B0); PG8_BAR; PG8_SCHED;
            PG8_STAGE(PG8_SB(1, 1), b3 + hstep, voffB);
            PG8_WAIT_V(6); PG8_BAR; PG8_MMA(1, 1, At, B1); PG8_BAR;
            }
        }
        if constexpr (ALIGN_EPI) { if (wr == 0) PG8_BAR; }
        if constexpr (!Epi::AFTER_DRAIN) { E(acc, cur, wr, wc, fr, fq); S.done(cur); }
        if (!has_next) break;
#pragma unroll
        for (int a = 0; a < 2; ++a)
#pragma unroll
            for (int b = 0; b < 2; ++b)
#pragma unroll
                for (int m = 0; m < 4; ++m)
#pragma unroll
                    for (int n = 0; n < 2; ++n) acc[a][b][m][n] = (f32x4){0.f, 0.f, 0.f, 0.f};
        cur = nxt; cA = nA; cB = nB; ++ui;
        if constexpr (ALIGN_EPI) { if (wr == 1) PG8_BAR; }
    }
    PG8_WAIT_V(0);
    if constexpr (!ALIGN_EPI) { if (wr == 0) PG8_BAR; }
    PG8_BAR;
    if constexpr (Epi::AFTER_DRAIN) { E.fused(acc, cur, wr, wc, fr, fq, lds, wid, lane); S.done(cur); }
#undef PG8_SA
#undef PG8_SB
#undef PG8_STAGE
#undef PG8_LDA
#undef PG8_LDB
#undef PG8_MMA
#undef PG8_WAIT_V
#undef PG8_WAIT_L
#undef PG8_BAR
#undef PG8_SCHED
}
}

#define LAS __attribute__((address_space(3)))
using pg8::bf16_t; using pg8::bf16x8; using pg8::f32x4; using pg8::u32x4; using pg8::Unit; using pg8::cvt_pk_bf16;
typedef unsigned u32x2 __attribute__((ext_vector_type(2)));

constexpr int DM = 1024, TP = 16384, NSM = 512, MT = TP + NSM, INC = 2304, DFF = 2816, PLE = 256;
constexpr int ZQ = 0, ZF = 256, ZI = 512, ZG = 768, ZBU = 1024, ZBG = 1280, ZCQ = 1536, ZCK = 2048, ZCV = 2176;
constexpr float EPS = 1e-6f;
constexpr int NPOS = TP + 4;
constexpr size_t O_Y = 0, O_SPH = (size_t)MT * DM, O_SPC = O_SPH + 32768, O_SPK = O_SPC + 15360, O_SPV = O_SPK + 32768,
                 O_SSH = O_SPV + 32768, O_SSC = O_SSH + 4194304, O_SSK = O_SSC + 1966080, O_SSV = O_SSK + 4194304;
constexpr size_t MiB = 1u << 20;
constexpr size_t WS_CTL = 0, CTL_BYTES = 65536;
constexpr size_t WS_SS = 1 * MiB;
constexpr size_t WS_LB = WS_SS + 512 * 1024;
constexpr size_t WS_DVEC = WS_LB + 4096;
constexpr size_t WS_ROPE = 2 * MiB;
constexpr size_t WS_W = 7 * MiB;
constexpr size_t W_IN = 0, W_OUT = W_IN + (size_t)INC * DM * 2, W_GU = W_OUT + (size_t)DM * DM * 2, W_D = W_GU + (size_t)2 * DFF * DM * 2,
                 W_PG = W_D + (size_t)DM * DFF * 2, W_PP = W_PG + (size_t)DM * DM * 2, W_LAYER = W_PP + (size_t)DM * PLE * 2;
constexpr size_t WS_BUFA = 59 * MiB, WS_BUFB = 92 * MiB, WS_ZACT = 125 * MiB, WS_PB = 216 * MiB, WS_DS = 233 * MiB, WS_END = 249 * MiB;
static_assert(WS_W + 2 * W_LAYER <= WS_BUFA && WS_BUFA + (size_t)MT * DM * 2 <= WS_BUFB && WS_BUFB + (size_t)MT * DM * 2 <= WS_ZACT, "ws map");
static_assert(WS_ZACT + (size_t)MT * DFF * 2 <= WS_PB && WS_PB + (size_t)2 * MT * PLE * 2 <= WS_DS && WS_ROPE + (size_t)NPOS * 64 * 4 <= WS_W, "ws map");
constexpr int LDS_BYTES = 147456, MISC_OFF = 131072 + 320;

#define LSYNC() do { asm volatile("s_waitcnt lgkmcnt(0)" ::: "memory"); __builtin_amdgcn_s_barrier(); asm volatile("" ::: "memory"); } while (0)
#define LDS_WAIT() asm volatile("s_waitcnt lgkmcnt(0)" ::: "memory")
__device__ __forceinline__ float bf2f(unsigned short h) { return __uint_as_float(((unsigned)h) << 16); }
template <int CTRL> __device__ __forceinline__ float dppf(float v) { return __int_as_float(__builtin_amdgcn_update_dpp(0, __float_as_int(v), CTRL, 0xf, 0xf, true)); }
__device__ __forceinline__ float wave_sum(float v) {
    v += dppf<0xB1>(v);
    v += dppf<0x4E>(v);
    v += dppf<0x141>(v);
    v += dppf<0x140>(v);
    const float r0 = __int_as_float(__builtin_amdgcn_readlane(__float_as_int(v), 0)), r1 = __int_as_float(__builtin_amdgcn_readlane(__float_as_int(v), 16));
    const float r2 = __int_as_float(__builtin_amdgcn_readlane(__float_as_int(v), 32)), r3 = __int_as_float(__builtin_amdgcn_readlane(__float_as_int(v), 48));
    return (r0 + r1) + (r2 + r3);
}
__device__ __forceinline__ float quad_sum(float v) { v += dppf<0xB1>(v); v += dppf<0x4E>(v); return v; }
__device__ __forceinline__ float sigmoidf_(float x) { return __builtin_amdgcn_rcpf(1.0f + __expf(-x)); }
__device__ __forceinline__ float siluf_(float x) { return x * __builtin_amdgcn_rcpf(1.0f + __expf(-x)); }
#define UNPACK8(V_, o) do { (o)[0] = __uint_as_float((V_).x << 16); (o)[1] = __uint_as_float((V_).x & 0xffff0000u); (o)[2] = __uint_as_float((V_).y << 16); (o)[3] = __uint_as_float((V_).y & 0xffff0000u); \
    (o)[4] = __uint_as_float((V_).z << 16); (o)[5] = __uint_as_float((V_).z & 0xffff0000u); (o)[6] = __uint_as_float((V_).w << 16); (o)[7] = __uint_as_float((V_).w & 0xffff0000u); } while (0)

#define XB_TMO      128
#define XB_XCNT(j)  (256  + 64 * (j))
#define XB_XSUB(j)  (1280 + 64 * (j))
#define XB_XGEN(j)  (2304 + 64 * (j))
#define XB_TOP      3328
#define XB_TOPGEN   3392
#define XCD_BAR_WORDS 3456
#define XB_SPIN_CAP (1u << 18)

__device__ __forceinline__ unsigned xb_ld(unsigned* p)              { return __hip_atomic_load(p, __ATOMIC_RELAXED, __HIP_MEMORY_SCOPE_AGENT); }
__device__ __forceinline__ unsigned xb_add(unsigned* p, unsigned v) { return __hip_atomic_fetch_add(p, v, __ATOMIC_RELAXED, __HIP_MEMORY_SCOPE_AGENT); }
__device__ __forceinline__ unsigned xb_xcc_id() { return (unsigned)__builtin_amdgcn_s_getreg((3 << 11) | 20) & 0xFu; }
#define XB_SPIN(cond, bar) do { unsigned _sp = 0; while (cond) { __builtin_amdgcn_s_sleep(1); \
    if ((++_sp & 255u) == 0u) { if (xb_ld(&(bar)[XB_TMO])) break; if (_sp > XB_SPIN_CAP) { atomicAdd(&(bar)[XB_TMO], 1u); break; } } } } while (0)

struct XcdBarrier {
    unsigned* bar; unsigned x; int wv;
    volatile LAS unsigned* st;
};

__device__ __forceinline__ XcdBarrier xcd_barrier_post(unsigned* bar, volatile LAS unsigned* st) {
    XcdBarrier b; b.bar = bar; b.x = xb_xcc_id(); b.st = st;
    if (threadIdx.x == 0) (void)xb_add(&bar[XB_XCNT(b.x)], 1u);
    return b;
}
__device__ __forceinline__ void xcd_barrier_complete(unsigned* bar, unsigned x, unsigned& nloc, unsigned& nx) {
    const unsigned G = gridDim.x * gridDim.y * gridDim.z;
    unsigned sum, cnt, mine, sp = 0u;
    for (;;) {
        sum = 0u; cnt = 0u; mine = 0u;
#pragma unroll
        for (unsigned j = 0; j < 16; ++j) { const unsigned c = xb_ld(&bar[XB_XCNT(j)]); sum += c; cnt += (c > 0u) ? 1u : 0u; mine = (j == x) ? c : mine; }
        if (sum == G) break;
        __builtin_amdgcn_s_sleep(1);
        if ((++sp & 255u) == 0u) { if (xb_ld(&bar[XB_TMO])) break; if (sp > XB_SPIN_CAP) { atomicAdd(&bar[XB_TMO], 1u); break; } }
    }
    nloc = mine > 0u ? mine : 1u; nx = cnt > 0u ? cnt : 1u;
}

__device__ __forceinline__ void xcd_barrier(const XcdBarrier& b) {
    asm volatile("s_waitcnt vmcnt(0)" ::: "memory");
    __syncthreads();
    unsigned xm_ = ~0u; asm volatile("" : "+s"(xm_));
    int xw_ = b.wv; asm volatile("" : "+s"(xw_));
    if (xw_ == 0 && __builtin_amdgcn_mbcnt_hi(xm_, __builtin_amdgcn_mbcnt_lo(xm_, 0u)) == 0u) {
        unsigned* bar = b.bar;
        __builtin_amdgcn_s_waitcnt(0);
        unsigned nloc = b.st[0], nx = b.st[1];
        if (nloc == 0u) { xcd_barrier_complete(bar, b.x, nloc, nx); b.st[0] = nloc; b.st[1] = nx; }
        const unsigned old = xb_add(&bar[XB_XSUB(b.x)], 1u);
        const unsigned gen = old / nloc;
        if (old + 1u == (gen + 1u) * nloc) {
            __builtin_amdgcn_fence(__ATOMIC_RELEASE, "agent");
            asm volatile("s_waitcnt vmcnt(0)" ::: "memory");
            const unsigned og = xb_add(&bar[XB_TOP], 1u);
            const unsigned tg = og / nx;
            if (og + 1u == (tg + 1u) * nx) xb_add(&bar[XB_TOPGEN], 1u);
            else XB_SPIN(xb_ld(&bar[XB_TOPGEN]) == tg, bar);
            __builtin_amdgcn_fence(__ATOMIC_ACQUIRE, "agent");
            xb_add(&bar[XB_XGEN(b.x)], 1u);
            asm volatile("s_waitcnt vmcnt(0)" ::: "memory");
        } else {
            XB_SPIN(xb_ld(&bar[XB_XGEN(b.x)]) == gen, bar);
            __builtin_amdgcn_fence(__ATOMIC_ACQUIRE, "agent");
            asm volatile("s_waitcnt vmcnt(0)" ::: "memory");
        }
    }
    __syncthreads();
}

struct EpiZ {
    static constexpr bool PERM = true, AFTER_DRAIN = false;
    bf16_t* O; int ldc; const float* ss;
    __device__ __forceinline__ void operator()(const f32x4 (&acc)[2][2][4][2], const Unit& u, int wr, int wc, int fr, int fq) const {
        const int row0 = u.pm * 256 + wr * 64 + fr, col0 = u.pn * 256 + wc * 32 + 8 * fq;
#pragma unroll
        for (int ai = 0; ai < 2; ++ai)
#pragma unroll
            for (int m = 0; m < 4; ++m) {
                const int row = row0 + ai * 128 + m * 16; const float r = rsqrtf(ss[row] * (1.0f / DM) + EPS);
                bf16_t* rowp = O + (size_t)row * ldc + col0;
#pragma unroll
                for (int bj = 0; bj < 2; ++bj) { const f32x4 v0 = acc[ai][bj][m][0] * r, v1 = acc[ai][bj][m][1] * r;
                    u32x4 w; w.x = cvt_pk_bf16(v0[0], v0[1]); w.y = cvt_pk_bf16(v0[2], v0[3]); w.z = cvt_pk_bf16(v1[0], v1[1]); w.w = cvt_pk_bf16(v1[2], v1[3]);
                    *(u32x4*)(rowp + bj * 128) = w; }
            }
    }
};
typedef float f32x2 __attribute__((ext_vector_type(2)));
struct EpiGU {
    static constexpr bool PERM = true, AFTER_DRAIN = false;
    bf16_t* O; const float* ss;
    __device__ __forceinline__ void operator()(const f32x4 (&acc)[2][2][4][2], const Unit& u, int wr, int wc, int fr, int fq) const {
        const int row0 = u.pm * 256 + wr * 64 + fr, col0 = u.pn * 128 + wc * 32 + 8 * fq;
#pragma unroll
        for (int ai = 0; ai < 2; ++ai)
#pragma unroll
            for (int m = 0; m < 4; ++m) {
                const int row = row0 + ai * 128 + m * 16; const float r = rsqrtf(ss[row] * (1.0f / DM) + EPS);
                const float rn = r * -1.44269504f, r2 = r * r;
                unsigned w4[4];
#pragma unroll
                for (int n = 0; n < 2; ++n)
#pragma unroll
                    for (int e = 0; e < 4; e += 2) {
                        const f32x2 g2 = (f32x2){acc[ai][0][m][n][e], acc[ai][0][m][n][e + 1]}, u2 = (f32x2){acc[ai][1][m][n][e], acc[ai][1][m][n][e + 1]};
                        const f32x2 t = g2 * rn; f32x2 ex; ex.x = __builtin_amdgcn_exp2f(t.x); ex.y = __builtin_amdgcn_exp2f(t.y);
                        const f32x2 d = ex + 1.0f; f32x2 rc; rc.x = __builtin_amdgcn_rcpf(d.x); rc.y = __builtin_amdgcn_rcpf(d.y);
                        const f32x2 o = (g2 * u2) * (rc * r2);
                        w4[n * 2 + (e >> 1)] = cvt_pk_bf16(o.x, o.y);
                    }
                u32x4 w; w.x = w4[0]; w.y = w4[1]; w.z = w4[2]; w.w = w4[3];
                *(u32x4*)(O + (size_t)row * DFF + col0) = w;
            }
    }
};
struct EpiRes {
    static constexpr bool PERM = false, AFTER_DRAIN = false;
    const bf16_t* res; bf16_t* Ob; float* ss;
    __device__ __forceinline__ void operator()(const f32x4 (&acc)[2][2][4][2], const Unit& u, int wr, int wc, int fr, int fq) const {
        const int row0 = u.pm * 256 + wr * 64 + fr, col0 = u.pn * 256 + wc * 32 + 4 * fq;
#pragma unroll
        for (int ai = 0; ai < 2; ++ai)
#pragma unroll
            for (int m = 0; m < 4; ++m) {
                const int row = row0 + ai * 128 + m * 16; const size_t off = (size_t)row * DM + col0; float sq = 0.f;
#pragma unroll
                for (int bj = 0; bj < 2; ++bj)
#pragma unroll
                    for (int n = 0; n < 2; ++n) { const size_t o2 = off + bj * 128 + n * 16;
                        const u32x2 rw = *(const u32x2*)(res + o2);
                        f32x4 v = acc[ai][bj][m][n]; v[0] += __uint_as_float(rw.x << 16); v[1] += __uint_as_float(rw.x & 0xffff0000u); v[2] += __uint_as_float(rw.y << 16); v[3] += __uint_as_float(rw.y & 0xffff0000u);
                        u32x2 w; w.x = cvt_pk_bf16(v[0], v[1]); w.y = cvt_pk_bf16(v[2], v[3]); *(u32x2*)(Ob + o2) = w;
                        sq += (v[0] * v[0] + v[1] * v[1]) + (v[2] * v[2] + v[3] * v[3]); }
                sq += __shfl_xor(sq, 16); sq += __shfl_xor(sq, 32);
                if (fq == 0) unsafeAtomicAdd(ss + row, sq);
            }
    }
};
struct EpiGate {
    static constexpr bool PERM = false, AFTER_DRAIN = false;
    bf16_t* Gt; const float* ss;
    __device__ __forceinline__ void operator()(const f32x4 (&acc)[2][2][4][2], const Unit& u, int wr, int wc, int fr, int fq) const {
        const int row0 = u.pm * 256 + wr * 64 + fr, col0 = u.pn * 256 + wc * 32 + 4 * fq;
#pragma unroll
        for (int ai = 0; ai < 2; ++ai)
#pragma unroll
            for (int m = 0; m < 4; ++m) {
                const int row = row0 + ai * 128 + m * 16; const size_t off = (size_t)row * DM + col0; const float r = rsqrtf(ss[row] * (1.0f / DM) + EPS);
#pragma unroll
                for (int bj = 0; bj < 2; ++bj)
#pragma unroll
                    for (int n = 0; n < 2; ++n) { const f32x4 a = acc[ai][bj][m][n] * r;
                        u32x2 w; w.x = cvt_pk_bf16(sigmoidf_(a[0]), sigmoidf_(a[1])); w.y = cvt_pk_bf16(sigmoidf_(a[2]), sigmoidf_(a[3]));
                        *(u32x2*)(Gt + off + bj * 128 + n * 16) = w; }
            }
    }
};
struct EpiOut {
    static constexpr bool PERM = false, AFTER_DRAIN = false;
    const bf16_t* Gt; const bf16_t* res; float* Y; bf16_t* Ob; float* ss; int final_;
    __device__ __forceinline__ void operator()(const f32x4 (&acc)[2][2][4][2], const Unit& u, int wr, int wc, int fr, int fq) const {
        const int row0 = u.pm * 256 + wr * 64 + fr, col0 = u.pn * 256 + wc * 32 + 4 * fq;
#pragma unroll
        for (int ai = 0; ai < 2; ++ai)
#pragma unroll
            for (int m = 0; m < 4; ++m) {
                const int row = row0 + ai * 128 + m * 16; const size_t off = (size_t)row * DM + col0; float sq = 0.f;
#pragma unroll
                for (int bj = 0; bj < 2; ++bj)
#pragma unroll
                    for (int n = 0; n < 2; ++n) { const size_t o2 = off + bj * 128 + n * 16;
                        const u32x2 rw = *(const u32x2*)(res + o2), gw = *(const u32x2*)(Gt + o2);
                        const f32x4 a = acc[ai][bj][m][n]; f32x4 v;
                        v[0] = __uint_as_float(rw.x << 16) + __uint_as_float(gw.x << 16) * a[0]; v[1] = __uint_as_float(rw.x & 0xffff0000u) + __uint_as_float(gw.x & 0xffff0000u) * a[1];
                        v[2] = __uint_as_float(rw.y << 16) + __uint_as_float(gw.y << 16) * a[2]; v[3] = __uint_as_float(rw.y & 0xffff0000u) + __uint_as_float(gw.y & 0xffff0000u) * a[3];
                        if (final_) *(f32x4*)(Y + o2) = v;
                        else { u32x2 w; w.x = cvt_pk_bf16(v[0], v[1]); w.y = cvt_pk_bf16(v[2], v[3]); *(u32x2*)(Ob + o2) = w; }
                        sq += (v[0] * v[0] + v[1] * v[1]) + (v[2] * v[2] + v[3] * v[3]); }
                if (!final_) { sq += __shfl_xor(sq, 16); sq += __shfl_xor(sq, 32); if (fq == 0) unsafeAtomicAdd(ss + row, sq); }
            }
    }
};

template <class Epi>
__device__ __forceinline__ void small_gemm(LAS unsigned char* lds, const bf16_t* A, const bf16_t* Bt, int K, const Epi& E, int bid, int tid, int lane, int wave) {
    if (bid >= 256) return;
    const int r0 = 64 * (bid >> 5), c0 = 32 * (bid & 31), fr = lane & 15, g = lane >> 4, kw = K >> 3;
    f32x4 acc[4][2];
#pragma unroll
    for (int m = 0; m < 4; ++m) { acc[m][0] = (f32x4){0.f, 0.f, 0.f, 0.f}; acc[m][1] = (f32x4){0.f, 0.f, 0.f, 0.f}; }
    const bf16_t* ap = A + (size_t)(r0 + fr) * K + wave * kw + 8 * g;
    const bf16_t* bp = Bt + (size_t)(c0 + fr) * K + wave * kw + 8 * g;
#pragma unroll 4
    for (int ks = 0; ks < kw; ks += 32) {
        bf16x8 a[4], b[2];
#pragma unroll
        for (int m = 0; m < 4; ++m) a[m] = *(const bf16x8*)(ap + (size_t)m * 16 * K + ks);
#pragma unroll
        for (int n = 0; n < 2; ++n) b[n] = *(const bf16x8*)(bp + (size_t)n * 16 * K + ks);
#pragma unroll
        for (int m = 0; m < 4; ++m)
#pragma unroll
            for (int n = 0; n < 2; ++n) acc[m][n] = __builtin_amdgcn_mfma_f32_16x16x32_bf16(a[m], b[n], acc[m][n], 0, 0, 0);
    }
    LAS float* P = (LAS float*)lds + wave * (64 * 33);
    LSYNC();
#pragma unroll
    for (int m = 0; m < 4; ++m)
#pragma unroll
        for (int n = 0; n < 2; ++n)
#pragma unroll
            for (int r = 0; r < 4; ++r) P[(16 * m + 4 * g + r) * 33 + 16 * n + fr] = acc[m][n][r];
    LSYNC();
    const int row = tid >> 3, c4 = (tid & 7) * 4;
    f32x4 v = (f32x4){0.f, 0.f, 0.f, 0.f};
#pragma unroll
    for (int w2 = 0; w2 < 8; ++w2) { const LAS float* q = (const LAS float*)lds + w2 * (64 * 33) + row * 33 + c4; v[0] += q[0]; v[1] += q[1]; v[2] += q[2]; v[3] += q[3]; }
    LSYNC();
    E.apply(r0 + row, c0 + c4, v, tid);
}
struct SEpiRes {
    const bf16_t* res; bf16_t* Ob; float* ss;
    __device__ __forceinline__ void apply(int row, int col, f32x4 v, int tid) const {
        const size_t o = (size_t)row * DM + col; const u32x2 rw = *(const u32x2*)(res + o);
        v[0] += __uint_as_float(rw.x << 16); v[1] += __uint_as_float(rw.x & 0xffff0000u); v[2] += __uint_as_float(rw.y << 16); v[3] += __uint_as_float(rw.y & 0xffff0000u);
        u32x2 w; w.x = cvt_pk_bf16(v[0], v[1]); w.y = cvt_pk_bf16(v[2], v[3]); *(u32x2*)(Ob + o) = w;
        float sq = (v[0] * v[0] + v[1] * v[1]) + (v[2] * v[2] + v[3] * v[3]);
        sq += __shfl_xor(sq, 1); sq += __shfl_xor(sq, 2); sq += __shfl_xor(sq, 4);
        if ((tid & 7) == 0) unsafeAtomicAdd(ss + row, sq);
    }
};
struct SEpiGate {
    bf16_t* Gt; const float* ss;
    __device__ __forceinline__ void apply(int row, int col, f32x4 v, int tid) const {
        const float r = rsqrtf(ss[row] * (1.0f / DM) + EPS);
        u32x2 w; w.x = cvt_pk_bf16(sigmoidf_(v[0] * r), sigmoidf_(v[1] * r)); w.y = cvt_pk_bf16(sigmoidf_(v[2] * r), sigmoidf_(v[3] * r));
        *(u32x2*)(Gt + (size_t)row * DM + col) = w;
    }
};
struct SEpiOut {
    const bf16_t* Gt; const bf16_t* res; float* Y; bf16_t* Ob; float* ss; int final_;
    __device__ __forceinline__ void apply(int row, int col, f32x4 a, int tid) const {
        const size_t o = (size_t)row * DM + col; const u32x2 rw = *(const u32x2*)(res + o), gw = *(const u32x2*)(Gt + o); f32x4 v;
        v[0] = __uint_as_float(rw.x << 16) + __uint_as_float(gw.x << 16) * a[0]; v[1] = __uint_as_float(rw.x & 0xffff0000u) + __uint_as_float(gw.x & 0xffff0000u) * a[1];
        v[2] = __uint_as_float(rw.y << 16) + __uint_as_float(gw.y << 16) * a[2]; v[3] = __uint_as_float(rw.y & 0xffff0000u) + __uint_as_float(gw.y & 0xffff0000u) * a[3];
        if (final_) { *(f32x4*)(Y + o) = v; return; }
        u32x2 w; w.x = cvt_pk_bf16(v[0], v[1]); w.y = cvt_pk_bf16(v[2], v[3]); *(u32x2*)(Ob + o) = w;
        float sq = (v[0] * v[0] + v[1] * v[1]) + (v[2] * v[2] + v[3] * v[3]);
        sq += __shfl_xor(sq, 1); sq += __shfl_xor(sq, 2); sq += __shfl_xor(sq, 4);
        if ((tid & 7) == 0) unsafeAtomicAdd(ss + row, sq);
    }
};

__device__ __forceinline__ void transpose_item(const float* W, int K, int N, const float* gain, bf16_t* WT, int mode, LAS float* scr, int item, int lane) {
    const int nblk = N / 32, kb = item / nblk, nb = item % nblk, k0 = 64 * kb, n0 = 32 * nb;
    { const int kr = lane >> 3, nq = (lane & 7) * 4; f32x4 v[8]; float gv[8];
#pragma unroll
      for (int i = 0; i < 8; ++i) { v[i] = *(const f32x4*)(W + (size_t)(k0 + 8 * i + kr) * N + n0 + nq); gv[i] = gain ? gain[k0 + 8 * i + kr] : 1.0f; }
#pragma unroll
      for (int i = 0; i < 8; ++i) { LAS float* d = scr + (8 * i + kr) * 33 + nq; d[0] = v[i][0] * gv[i]; d[1] = v[i][1] * gv[i]; d[2] = v[i][2] * gv[i]; d[3] = v[i][3] * gv[i]; } }
    LDS_WAIT(); asm volatile("" ::: "memory");
    const int drow0 = (mode == 0) ? n0 : (256 * (n0 >> 7) + (n0 & 127) + (mode == 2 ? 128 : 0));
    const int c = lane & 7;
#pragma unroll
    for (int j = 0; j < 4; ++j) { const int n = (lane >> 3) + 8 * j; const LAS float* s = scr + (8 * c) * 33 + n;
        u32x4 o; o.x = cvt_pk_bf16(s[0 * 33], s[1 * 33]); o.y = cvt_pk_bf16(s[2 * 33], s[3 * 33]); o.z = cvt_pk_bf16(s[4 * 33], s[5 * 33]); o.w = cvt_pk_bf16(s[6 * 33], s[7 * 33]);
        *(u32x4*)(WT + (size_t)(drow0 + n) * K + k0 + 8 * c) = o; }
    LDS_WAIT(); asm volatile("" ::: "memory");
}

struct Args { const float* in[27]; float* out; unsigned char* ws; };
constexpr int PT_OFF = 131072 + 1024;
__device__ __forceinline__ int opaque(int x) { asm volatile("" : "+v"(x)); return x; }
__device__ __forceinline__ int lane_id_opaque() { unsigned m_ = ~0u; asm volatile("" : "+s"(m_)); return (int)__builtin_amdgcn_mbcnt_hi(m_, __builtin_amdgcn_mbcnt_lo(m_, 0u)); }
__device__ __forceinline__ const float* ptf(LAS unsigned char* lds, int i) {
    const unsigned long long v = ((LAS const unsigned long long*)(lds + PT_OFF))[i];
    const unsigned lo = __builtin_amdgcn_readfirstlane((unsigned)v), hi = __builtin_amdgcn_readfirstlane((unsigned)(v >> 32));
    return (const float*)(((unsigned long long)hi << 32) | lo);
}
#define IN(i) ptf(lds, (i))
#define OUTP ((float*)ptf(lds, 27))
#define WSP ((unsigned char*)ptf(lds, 28))

__device__ __forceinline__ void prologue(LAS unsigned char* lds, int wv) {
    { unsigned z_ = 0; asm volatile("" : "+s"(z_)); lds += z_; }
    int wave_ = wv; asm volatile("" : "+s"(wave_)); const int wave = wave_, lane = lane_id_opaque(), tid = wave * 64 + lane;
    const int G = gridDim.x, bid = blockIdx.x, gw = bid * 8 + wave, NGW = G * 8, gtid = bid * 512 + tid, NT = G * 512;
    unsigned char* ws = WSP;
    LAS float* scr = (LAS float*)(lds + wave * 16384);
    constexpr int I_IN = (DM / 64) * (INC / 32), I_SQ = (DM / 64) * (DM / 32), I_GU = (DM / 64) * (DFF / 32), I_D = (DFF / 64) * (DM / 32), I_PP = (PLE / 64) * (DM / 32);
    constexpr int I_LAYER = I_IN + I_SQ + 2 * I_GU + I_D + I_SQ + I_PP;
#pragma unroll 1
    for (int it = gw; it < 2 * I_LAYER; it += NGW) {
        const int l = it / I_LAYER; int r = it % I_LAYER;
        unsigned char* wl = ws + WS_W + (size_t)l * W_LAYER;
        if (r < I_IN) { transpose_item(IN(9) + (size_t)l * DM * INC, DM, INC, IN(19) + l * DM, (bf16_t*)(wl + W_IN), 0, scr, r, lane); continue; } r -= I_IN;
        if (r < I_SQ) { transpose_item(IN(18) + (size_t)l * DM * DM, DM, DM, nullptr, (bf16_t*)(wl + W_OUT), 0, scr, r, lane); continue; } r -= I_SQ;
        if (r < I_GU) { transpose_item(IN(21) + (size_t)l * DM * DFF, DM, DFF, IN(20) + l * DM, (bf16_t*)(wl + W_GU), 1, scr, r, lane); continue; } r -= I_GU;
        if (r < I_GU) { transpose_item(IN(22) + (size_t)l * DM * DFF, DM, DFF, IN(20) + l * DM, (bf16_t*)(wl + W_GU), 2, scr, r, lane); continue; } r -= I_GU;
        if (r < I_D) { transpose_item(IN(23) + (size_t)l * DFF * DM, DFF, DM, nullptr, (bf16_t*)(wl + W_D), 0, scr, r, lane); continue; } r -= I_D;
        if (r < I_SQ) { transpose_item(IN(25) + (size_t)l * DM * DM, DM, DM, IN(24) + l * DM, (bf16_t*)(wl + W_PG), 0, scr, r, lane); continue; } r -= I_SQ;
        transpose_item(IN(26) + (size_t)l * PLE * DM, PLE, DM, nullptr, (bf16_t*)(wl + W_PP), 0, scr, r, lane);
    }
    float* ss = (float*)(ws + WS_SS);
    bf16_t* bufA = (bf16_t*)(ws + WS_BUFA);
    const float* xP = IN(0); const float* xS = IN(1);
#pragma unroll 1
    for (int m0 = gw; m0 < MT; m0 += 2 * NGW) {
        f32x4 v[2][4];
#pragma unroll
        for (int q = 0; q < 2; ++q) { const int m = (m0 + q * NGW < MT) ? m0 + q * NGW : m0; const float* xr = (m < TP) ? xP + (size_t)m * DM : xS + (size_t)(m - TP) * DM;
#pragma unroll
            for (int j = 0; j < 4; ++j) v[q][j] = ((const f32x4*)xr)[lane + 64 * j]; }
#pragma unroll
        for (int q = 0; q < 2; ++q) { const int m = (m0 + q * NGW < MT) ? m0 + q * NGW : m0; float s = 0.f;
#pragma unroll
            for (int j = 0; j < 4; ++j) s += (v[q][j][0] * v[q][j][0] + v[q][j][1] * v[q][j][1]) + (v[q][j][2] * v[q][j][2] + v[q][j][3] * v[q][j][3]);
            s = wave_sum(s); if (lane == 0) ss[m] = s;
#pragma unroll
            for (int j = 0; j < 4; ++j) { u32x2 w; w.x = cvt_pk_bf16(v[q][j][0], v[q][j][1]); w.y = cvt_pk_bf16(v[q][j][2], v[q][j][3]); ((u32x2*)(bufA + (size_t)m * DM))[lane + 64 * j] = w; } }
    }
    float* rc = (float*)(ws + WS_ROPE); float* rs = rc + (size_t)NPOS * 32;
#pragma unroll 1
    for (int idx = gtid; idx < NPOS * 32; idx += NT) {
        const int pos = idx >> 5, d = idx & 31;
        const double inv = exp2(-(double)d * (13.287712379549449 / 32.0));
        double rev = (double)pos * inv * 0.15915494309189535; rev -= rint(rev);
        const float fr = (float)rev;
        rc[idx] = __builtin_amdgcn_cosf(fr); rs[idx] = __builtin_amdgcn_sinf(fr);
    }
    if (gtid < 256) { float* lb = (float*)(ws + WS_LB); const float* al = IN(8); const float a0 = al[gtid], a1 = al[256 + gtid]; lb[gtid] = 0.f; lb[256 + gtid] = 1.0f / (1.0f + expf(a0 - a1)); }
#pragma unroll 1
    for (int idx = gtid; idx < 5 * MT; idx += NT) ss[MT + idx] = 0.f;
}

__device__ __forceinline__ void hgrn_gates(float z, float lb, float& logf_, float& kin) {
    const float e = __expf(-fabsf(z));
    const float inv = __builtin_amdgcn_rcpf(1.0f + e);
    const float big = inv, small = e * inv;
    const float sp = (z >= 0.f) ? big : small;
    const float sn = (z >= 0.f) ? small : big;
    kin = (1.0f - lb) * sn;
    if (lb > 0.f) logf_ = __logf(lb + (1.0f - lb) * sp);
    else logf_ = fminf(z, 0.f) - __logf(1.0f + e);
}

#define HGRN_G(zbase, lbv, tot) \
    float Gl[8], kin[8]; float Gend = 0.f, Gref = 0.f; { float run = 0.f; \
    _Pragma("unroll") for (int i = 0; i < 8; ++i) { float g; hgrn_gates(bf2f((zbase)[(size_t)(8 * wave + i) * INC + ZF]), lbv, g, kin[i]); run += g; Gl[i] = run; } \
    (tot)[wave * 64 + lane] = run; LSYNC(); float off = 0.f; \
    _Pragma("unroll") for (int w2 = 0; w2 < 8; ++w2) { const float t = (tot)[w2 * 64 + lane]; if (w2 < wave) off += t; if (w2 < 4) Gref += t; Gend += t; } \
    _Pragma("unroll") for (int i = 0; i < 8; ++i) Gl[i] += off; }

#define HGRN_G2(zf, lbv, tot) \
    float Gl[8], kin[8]; float Gend = 0.f, Gref = 0.f; { float run = 0.f; \
    _Pragma("unroll") for (int i = 0; i < 8; ++i) { float g; hgrn_gates((zf)[i], lbv, g, kin[i]); run += g; Gl[i] = run; } \
    (tot)[wave * 64 + lane] = run; LSYNC(); float off = 0.f; \
    _Pragma("unroll") for (int w2 = 0; w2 < 8; ++w2) { const float t = (tot)[w2 * 64 + lane]; if (w2 < wave) off += t; if (w2 < 4) Gref += t; Gend += t; } \
    _Pragma("unroll") for (int i = 0; i < 8; ++i) Gl[i] += off; }
__device__ __forceinline__ void hgrn_ds_item(const unsigned (&zfu)[8], const unsigned (&vi)[8], const float* lbp, float* dS, float* dvec, LAS unsigned char* lds, int c, int h, int tid, int lane, int wave) {
    LAS bf16_t* KTt = (LAS bf16_t*)lds;
    LAS bf16_t* Vt = KTt + 64 * 72;
    LAS float* TOT = (LAS float*)(Vt + 64 * 72);
    float zf[8];
#pragma unroll
    for (int i = 0; i < 8; ++i) zf[i] = __uint_as_float(zfu[i] << 16);
    const float lbv = lbp[h * 64 + lane];
    LSYNC();
    HGRN_G2(zf, lbv, TOT)
    { float kt[8];
#pragma unroll
      for (int i = 0; i < 8; ++i) kt[i] = kin[i] * __expf(Gend - Gl[i]);
      u32x4 kw; kw.x = cvt_pk_bf16(kt[0], kt[1]); kw.y = cvt_pk_bf16(kt[2], kt[3]); kw.z = cvt_pk_bf16(kt[4], kt[5]); kw.w = cvt_pk_bf16(kt[6], kt[7]);
      u32x4 vw; vw.x = vi[0] | (vi[1] << 16); vw.y = vi[2] | (vi[3] << 16); vw.z = vi[4] | (vi[5] << 16); vw.w = vi[6] | (vi[7] << 16);
      *(LAS u32x4*)(KTt + lane * 72 + 8 * wave) = kw; *(LAS u32x4*)(Vt + lane * 72 + 8 * wave) = vw; }
    if (wave == 0) dvec[(c * 4 + h) * 64 + lane] = __expf(Gend);
    LSYNC();
    const int fr = lane & 15, g = lane >> 4, kt4 = wave >> 1, vt0 = 2 * (wave & 1);
    f32x4 acc[2] = {(f32x4){0.f, 0.f, 0.f, 0.f}, (f32x4){0.f, 0.f, 0.f, 0.f}};
#pragma unroll
    for (int ks = 0; ks < 2; ++ks) {
        const bf16x8 kb = *(const LAS bf16x8*)(KTt + (16 * kt4 + fr) * 72 + 32 * ks + 8 * g);
#pragma unroll
        for (int n = 0; n < 2; ++n) { const bf16x8 va = *(const LAS bf16x8*)(Vt + (16 * (vt0 + n) + fr) * 72 + 32 * ks + 8 * g);
            acc[n] = __builtin_amdgcn_mfma_f32_16x16x32_bf16(va, kb, acc[n], 0, 0, 0); }
    }
    float* dst = dS + (size_t)(c * 4 + h) * 4096 + (16 * kt4 + fr) * 64 + 4 * g;
#pragma unroll
    for (int n = 0; n < 2; ++n) *(f32x4*)(dst + 16 * (vt0 + n)) = acc[n];
}

__device__ __forceinline__ void hgrn_out_item(const bf16_t* z, const float* lbp, const float* dS, const float* onorm, bf16_t* mix, LAS unsigned char* lds, int c, int hp, int tid, int lane, int wave) {
    const int hh = wave >> 2, wq = wave & 3, h = 2 * hp + hh, fr = lane & 15, g = lane >> 4;
    LAS bf16_t* QT = (LAS bf16_t*)(lds + hh * 46080);
    LAS bf16_t* KT = QT + 4608;
    LAS bf16_t* QS = KT + 4608;
    LAS bf16_t* Vt = QS + 4608;
    LAS bf16_t* St = Vt + 4608;
    LAS float* TOT = (LAS float*)(lds + 92160) + hh * 256;
    const bf16_t* zb = z + (size_t)(64 * c + 16 * wq) * INC + h * 64 + lane;
    unsigned zfu[16], zqu[16], ziu[16];
#pragma unroll
    for (int i = 0; i < 16; ++i) { zfu[i] = zb[(size_t)i * INC + ZF]; zqu[i] = zb[(size_t)i * INC + ZQ]; ziu[i] = zb[(size_t)i * INC + ZI]; }
    f32x4 sv[4];
#pragma unroll
    for (int j4 = 0; j4 < 4; ++j4) sv[j4] = *(const f32x4*)(dS + (size_t)(c * 4 + h) * 4096 + j4 * 1024 + (wq * 64 + lane) * 4);
    const size_t mt = (size_t)(64 * c + 16 * wq + fr);
    u32x2 gz[4];
#pragma unroll
    for (int vt = 0; vt < 4; ++vt) gz[vt] = *(const u32x2*)(z + mt * INC + ZG + h * 64 + 16 * vt + 4 * g);
    const float lbv = lbp[h * 64 + lane];
    LSYNC();
    float Gl[16], kin[16];
    { float run = 0.f;
#pragma unroll
      for (int i = 0; i < 16; ++i) { float gg; hgrn_gates(__uint_as_float(zfu[i] << 16), lbv, gg, kin[i]); run += gg; Gl[i] = run; }
      TOT[wq * 64 + lane] = run; }
    LSYNC();
    float off = 0.f, Gref = 0.f;
#pragma unroll
    for (int w2 = 0; w2 < 4; ++w2) { const float t = TOT[w2 * 64 + lane]; if (w2 < wq) off += t; if (w2 < 2) Gref += t; }
#pragma unroll
    for (int i = 0; i < 16; ++i) { const float G = Gl[i] + off, q = __uint_as_float(zqu[i] << 16); const int s = 16 * wq + i;
        QT[s * 72 + lane] = (bf16_t)(cvt_pk_bf16(q * __expf(fminf(G - Gref, 80.f)), 0.f) & 0xffffu);
        KT[s * 72 + lane] = (bf16_t)(cvt_pk_bf16(kin[i] * __expf(fminf(Gref - G, 80.f)), 0.f) & 0xffffu);
        QS[s * 72 + lane] = (bf16_t)(cvt_pk_bf16(q * __expf(G), 0.f) & 0xffffu); }
    { u32x4 v0, v1; v0.x = ziu[0] | (ziu[1] << 16); v0.y = ziu[2] | (ziu[3] << 16); v0.z = ziu[4] | (ziu[5] << 16); v0.w = ziu[6] | (ziu[7] << 16);
      v1.x = ziu[8] | (ziu[9] << 16); v1.y = ziu[10] | (ziu[11] << 16); v1.z = ziu[12] | (ziu[13] << 16); v1.w = ziu[14] | (ziu[15] << 16);
      *(LAS u32x4*)(Vt + lane * 72 + 16 * wq) = v0; *(LAS u32x4*)(Vt + lane * 72 + 16 * wq + 8) = v1; }
#pragma unroll
    for (int j4 = 0; j4 < 4; ++j4) { const int e = j4 * 1024 + (wq * 64 + lane) * 4, k = e >> 6, v = e & 63;
#pragma unroll
        for (int i = 0; i < 4; ++i) St[(v + i) * 72 + k] = (bf16_t)(cvt_pk_bf16(sv[j4][i], 0.f) & 0xffffu); }
    LSYNC();
    const int tt = wq;
    bf16x8 qb0 = *(const LAS bf16x8*)(QT + (16 * tt + fr) * 72 + 8 * g), qb1 = *(const LAS bf16x8*)(QT + (16 * tt + fr) * 72 + 32 + 8 * g);
    f32x4 at[4];
#pragma unroll
    for (int st = 0; st < 4; ++st) {
        at[st] = (f32x4){0.f, 0.f, 0.f, 0.f};
        if (st <= tt) {
            const bf16x8 k0 = *(const LAS bf16x8*)(KT + (16 * st + fr) * 72 + 8 * g), k1 = *(const LAS bf16x8*)(KT + (16 * st + fr) * 72 + 32 + 8 * g);
            f32x4 acc = (f32x4){0.f, 0.f, 0.f, 0.f};
            acc = __builtin_amdgcn_mfma_f32_16x16x32_bf16(k0, qb0, acc, 0, 0, 0);
            acc = __builtin_amdgcn_mfma_f32_16x16x32_bf16(k1, qb1, acc, 0, 0, 0);
            if (st == tt) {
#pragma unroll
                for (int r = 0; r < 4; ++r) acc[r] = (4 * g + r <= fr) ? acc[r] : 0.f; }
            at[st] = acc;
        }
    }
    f32x4 o[4];
#pragma unroll
    for (int vt = 0; vt < 4; ++vt) o[vt] = (f32x4){0.f, 0.f, 0.f, 0.f};
#pragma unroll
    for (int u = 0; u < 2; ++u) {
        if (2 * u <= tt) {
            u32x4 pw; pw.x = cvt_pk_bf16(at[2 * u][0], at[2 * u][1]); pw.y = cvt_pk_bf16(at[2 * u][2], at[2 * u][3]);
            pw.z = cvt_pk_bf16(at[2 * u + 1][0], at[2 * u + 1][1]); pw.w = cvt_pk_bf16(at[2 * u + 1][2], at[2 * u + 1][3]);
            const bf16x8 pf = __builtin_bit_cast(bf16x8, pw);
#pragma unroll
            for (int vt = 0; vt < 4; ++vt) {
                const LAS bf16_t* vp = Vt + (16 * vt + fr) * 72 + 32 * u + 4 * g;
                u32x4 vw; const u32x2 lo = *(const LAS u32x2*)vp, hi = *(const LAS u32x2*)(vp + 16); vw.x = lo.x; vw.y = lo.y; vw.z = hi.x; vw.w = hi.y;
                o[vt] = __builtin_amdgcn_mfma_f32_16x16x32_bf16(__builtin_bit_cast(bf16x8, vw), pf, o[vt], 0, 0, 0);
            }
        }
    }
#pragma unroll
    for (int ks = 0; ks < 2; ++ks) {
        const bf16x8 qs = *(const LAS bf16x8*)(QS + (16 * tt + fr) * 72 + 32 * ks + 8 * g);
#pragma unroll
        for (int vt = 0; vt < 4; ++vt) { const bf16x8 sa = *(const LAS bf16x8*)(St + (16 * vt + fr) * 72 + 32 * ks + 8 * g);
            o[vt] = __builtin_amdgcn_mfma_f32_16x16x32_bf16(sa, qs, o[vt], 0, 0, 0); }
    }
    float sq = 0.f;
#pragma unroll
    for (int vt = 0; vt < 4; ++vt) sq += (o[vt][0] * o[vt][0] + o[vt][1] * o[vt][1]) + (o[vt][2] * o[vt][2] + o[vt][3] * o[vt][3]);
    sq += __shfl_xor(sq, 16); sq += __shfl_xor(sq, 32);
    const float rn = rsqrtf(sq * (1.0f / 64.0f) + EPS);
#pragma unroll
    for (int vt = 0; vt < 4; ++vt) {
        const f32x4 nv = *(const f32x4*)(onorm + 16 * vt + 4 * g);
        const float g0 = __uint_as_float(gz[vt].x << 16), g1 = __uint_as_float(gz[vt].x & 0xffff0000u), g2 = __uint_as_float(gz[vt].y << 16), g3 = __uint_as_float(gz[vt].y & 0xffff0000u);
        u32x2 w; w.x = cvt_pk_bf16(o[vt][0] * rn * nv[0] * siluf_(g0), o[vt][1] * rn * nv[1] * siluf_(g1)); w.y = cvt_pk_bf16(o[vt][2] * rn * nv[2] * siluf_(g2), o[vt][3] * rn * nv[3] * siluf_(g3));
        *(u32x2*)(mix + mt * DM + h * 64 + 16 * vt + 4 * g) = w;
    }
}

__device__ __forceinline__ void hgrn_sample_item(const bf16_t* z, const float* lbp, const float* S0, float* Sout, const float* onorm, bf16_t* mix, LAS unsigned char* lds, int b, int hp, int tid, int lane, int wave) {
    LAS float* F = (LAS float*)lds; LAS float* KI = F + 512; LAS float* Q = KI + 512; LAS float* V = Q + 512;
    LAS float* RED = V + 512;
    const int hh = wave >> 2, kq = wave & 3, h = 2 * hp + hh;
    float S[16];
    { const float* sp = S0 + (size_t)h * 4096 + (16 * kq) * 64 + lane;
#pragma unroll
      for (int i = 0; i < 16; ++i) S[i] = sp[i * 64]; }
    const int t0 = tid >> 7, hk = tid & 127;
    const bf16_t* zr = z + ((size_t)TP + 4 * b + t0) * INC + hp * 128 + hk;
    const float zf = bf2f(zr[ZF]), q0 = bf2f(zr[ZQ]), vi = bf2f(zr[ZI]); const float lb = lbp[hp * 128 + hk];
    LSYNC();
    { const float e = __expf(-fabsf(zf)); const float sp = (zf >= 0.f) ? 1.0f / (1.0f + e) : e / (1.0f + e); const float sn = (zf >= 0.f) ? e / (1.0f + e) : 1.0f / (1.0f + e);
      F[tid] = lb + (1.0f - lb) * sp; KI[tid] = (1.0f - lb) * sn; Q[tid] = q0; V[tid] = vi; }
    LSYNC();
#pragma unroll
    for (int t = 0; t < 4; ++t) {
        const float vt = V[t * 128 + hh * 64 + lane]; float part = 0.f;
#pragma unroll
        for (int i = 0; i < 16; ++i) { const int k = t * 128 + hh * 64 + 16 * kq + i; S[i] = F[k] * S[i] + KI[k] * vt; part += S[i] * Q[k]; }
        RED[((t * 2 + hh) * 4 + kq) * 64 + lane] = part;
    }
    { float* so = Sout + (size_t)h * 4096 + (16 * kq) * 64 + lane;
#pragma unroll
      for (int i = 0; i < 16; ++i) so[i * 64] = S[i]; }
    LSYNC();
    { const int t = wave >> 1, hh2 = wave & 1, h2 = 2 * hp + hh2; const size_t m = (size_t)TP + 4 * b + t;
      float o = 0.f;
#pragma unroll
      for (int k4 = 0; k4 < 4; ++k4) o += RED[((t * 2 + hh2) * 4 + k4) * 64 + lane];
      const float r = rsqrtf(wave_sum(o * o) * (1.0f / 64.0f) + EPS);
      const float res = o * r * onorm[lane] * siluf_(bf2f(z[m * INC + ZG + h2 * 64 + lane]));
      mix[m * DM + h2 * 64 + lane] = (bf16_t)(cvt_pk_bf16(res, 0.f) & 0xffffu); }
}

template <int NTOK>
__device__ __forceinline__ void conv_compute(const LAS float* U, int r0, size_t m0, const float* cw, const float* cb, const float* lng, const float* lnb, bf16_t* mix, int lane, int wave) {
    const int ch = 64 * (wave & 3) + lane;
    float w[31];
#pragma unroll
    for (int j = 0; j < 31; ++j) w[j] = cw[j * 256 + ch];
    const float bias = cb[ch], g = lng[ch], be = lnb[ch];
    constexpr int TG = (NTOK >= 4) ? 4 : NTOK;
#pragma unroll 1
    for (int tg = 0; tg < NTOK / TG; ++tg) {
        float y[TG];
#pragma unroll
        for (int t = 0; t < TG; ++t) y[t] = bias;
        const LAS float* up = U + (r0 + TG * tg) * 256 + ch;
#pragma unroll
        for (int j = 0; j < TG + 30; ++j) { const float u = up[j * 256];
#pragma unroll
            for (int t = 0; t < TG; ++t) { if (j - t >= 0 && j - t < 31) y[t] += w[j - t] * u; } }
#pragma unroll
        for (int t = 0; t < TG; ++t) {
            const float mu = wave_sum(y[t]) * (1.0f / 64.0f); const float d = y[t] - mu;
            const float var = wave_sum(d * d) * (1.0f / 64.0f);
            const float o = siluf_(d * rsqrtf(var + EPS) * g + be);
            mix[(m0 + TG * tg + t) * DM + 256 + ch] = (bf16_t)(cvt_pk_bf16(o, 0.f) & 0xffffu);
        }
    }
}
__device__ __forceinline__ void conv_prompt_item(const bf16_t* z, const float* cw, const float* cb, const float* lng, const float* lnb, bf16_t* mix, float* spc, LAS unsigned char* lds, int ct, int tid, int lane, int wave) {
    LAS float* U = (LAS float*)lds;
    const int t0 = 64 * ct;
    u32x4 ra[6], rb[6];
#pragma unroll
    for (int it = 0; it < 6; ++it) { const int r = it * 16 + (tid >> 5), cg8 = (tid & 31) * 8; int tok = t0 - 30 + r; tok = tok < 0 ? 0 : tok;
        const bf16_t* zr = z + (size_t)tok * INC; ra[it] = *(const u32x4*)(zr + ZBU + cg8); rb[it] = *(const u32x4*)(zr + ZBG + cg8); }
    LSYNC();
#pragma unroll
    for (int it = 0; it < 6; ++it) { const int r = it * 16 + (tid >> 5), cg8 = (tid & 31) * 8; const bool ok = (t0 - 30 + r) >= 0;
        float fa[8], fb[8], u[8]; UNPACK8(ra[it], fa); UNPACK8(rb[it], fb);
#pragma unroll
        for (int j = 0; j < 8; ++j) u[j] = ok ? fa[j] * sigmoidf_(fb[j]) : 0.f;
        *(LAS f32x4*)(U + r * 256 + cg8) = (f32x4){u[0], u[1], u[2], u[3]}; *(LAS f32x4*)(U + r * 256 + cg8 + 4) = (f32x4){u[4], u[5], u[6], u[7]}; }
    LSYNC();
    conv_compute<32>(U, 32 * (wave >> 2), (size_t)t0 + 32 * (wave >> 2), cw, cb, lng, lnb, mix, lane, wave);
    if (ct == 255) for (int idx = tid; idx < 30 * 256; idx += 512) spc[idx] = U[(64 + (idx >> 8)) * 256 + (idx & 255)];
}
__device__ __forceinline__ void conv_sample_item(const bf16_t* z, const float* sconv, const float* cw, const float* cb, const float* lng, const float* lnb, bf16_t* mix, float* ssc, LAS unsigned char* lds, int b, int tid, int lane, int wave) {
    LAS float* U = (LAS float*)lds;
    float hv[15];
#pragma unroll
    for (int it = 0; it < 15; ++it) hv[it] = sconv[(size_t)b * 30 * 256 + it * 512 + tid];
    float nu[2];
#pragma unroll
    for (int it = 0; it < 2; ++it) { const int idx = it * 512 + tid, t = idx >> 8, ch = idx & 255; const bf16_t* zr = z + ((size_t)TP + 4 * b + t) * INC;
        nu[it] = bf2f(zr[ZBU + ch]) * sigmoidf_(bf2f(zr[ZBG + ch])); }
    LSYNC();
#pragma unroll
    for (int it = 0; it < 15; ++it) U[it * 512 + tid] = hv[it];
#pragma unroll
    for (int it = 0; it < 2; ++it) U[30 * 256 + it * 512 + tid] = nu[it];
    LSYNC();
    conv_compute<2>(U, 2 * (wave >> 2), (size_t)TP + 4 * b + 2 * (wave >> 2), cw, cb, lng, lnb, mix, lane, wave);
#pragma unroll
    for (int it = 0; it < 15; ++it) ssc[(size_t)b * 30 * 256 + it * 512 + tid] = U[4 * 256 + it * 512 + tid];
}

constexpr int KSTR = 72, VSTR = 280;
#define NORM_ROPE(rowp, gain, pos, g, sh1, sh2, x1, x2) do { \
    const u32x4 _lo = *(const u32x4*)((rowp) + 8 * (g)), _hi = *(const u32x4*)((rowp) + 32 + 8 * (g)); float _a[8], _b[8]; UNPACK8(_lo, _a); UNPACK8(_hi, _b); \
    float _sq = 0.f; _Pragma("unroll") for (int _j = 0; _j < 8; ++_j) _sq += _a[_j] * _a[_j] + _b[_j] * _b[_j]; \
    _sq += __shfl_xor(_sq, sh1); _sq += __shfl_xor(_sq, sh2); const float _r = rsqrtf(_sq * (1.0f / 64.0f) + EPS); \
    const float* _cp = rope_c + (size_t)(pos) * 32 + 8 * (g); const float* _sp = rope_s + (size_t)(pos) * 32 + 8 * (g); \
    _Pragma("unroll") for (int _j = 0; _j < 8; ++_j) { const float _y1 = _a[_j] * _r * (gain)[8 * (g) + _j], _y2 = _b[_j] * _r * (gain)[32 + 8 * (g) + _j]; const float _c = _cp[_j], _s = _sp[_j]; \
        (x1)[_j] = _y1 * _c - _y2 * _s; (x2)[_j] = _y2 * _c + _y1 * _s; } } while (0)

__device__ __forceinline__ void attn_qtile(const LAS bf16_t* Kl, const LAS bf16_t* Vt, bf16x8 q0, bf16x8 q1, int i, int T0, int jmin, float sink, bf16_t* outp, int lane) {
    const int fr = lane & 15, g = lane >> 4;
    f32x4 s[9];
#pragma unroll
    for (int T = 0; T < 9; ++T) {
        const LAS bf16_t* kp = Kl + (16 * (T0 + T) + fr) * KSTR + 8 * g;
        const bf16x8 k0 = *(const LAS bf16x8*)kp, k1 = *(const LAS bf16x8*)(kp + 32);
        f32x4 acc = (f32x4){0.f, 0.f, 0.f, 0.f};
        acc = __builtin_amdgcn_mfma_f32_16x16x32_bf16(k0, q0, acc, 0, 0, 0);
        acc = __builtin_amdgcn_mfma_f32_16x16x32_bf16(k1, q1, acc, 0, 0, 0);
        s[T] = acc;
    }
    float mx = sink;
#pragma unroll
    for (int T = 0; T < 9; ++T)
#pragma unroll
        for (int r = 0; r < 4; ++r) { const int j = 16 * (T0 + T) + 4 * g + r; const bool valid = (j >= i) && (j <= i + 128) && (j >= jmin);
            s[T][r] = valid ? s[T][r] : -INFINITY; mx = fmaxf(mx, s[T][r]); }
    mx = fmaxf(mx, __shfl_xor(mx, 16)); mx = fmaxf(mx, __shfl_xor(mx, 32));
    float sum = 0.f;
#pragma unroll
    for (int T = 0; T < 9; ++T)
#pragma unroll
        for (int r = 0; r < 4; ++r) { const float p = __expf(s[T][r] - mx); s[T][r] = p; sum += p; }
    sum += __shfl_xor(sum, 16); sum += __shfl_xor(sum, 32);
    const float inv = 1.0f / (sum + __expf(sink - mx));
    f32x4 o[4];
#pragma unroll
    for (int dt = 0; dt < 4; ++dt) o[dt] = (f32x4){0.f, 0.f, 0.f, 0.f};
#pragma unroll
    for (int u = 0; u < 5; ++u) {
        u32x4 pw; pw.x = cvt_pk_bf16(s[2 * u][0], s[2 * u][1]); pw.y = cvt_pk_bf16(s[2 * u][2], s[2 * u][3]);
        if (u < 4) { pw.z = cvt_pk_bf16(s[2 * u + 1 > 8 ? 8 : 2 * u + 1][0], s[2 * u + 1 > 8 ? 8 : 2 * u + 1][1]); pw.w = cvt_pk_bf16(s[2 * u + 1 > 8 ? 8 : 2 * u + 1][2], s[2 * u + 1 > 8 ? 8 : 2 * u + 1][3]); }
        else { pw.z = 0u; pw.w = 0u; }
        const bf16x8 pf = __builtin_bit_cast(bf16x8, pw);
#pragma unroll
        for (int dt = 0; dt < 4; ++dt) {
            const LAS bf16_t* vp = Vt + (16 * dt + fr) * VSTR + 16 * (T0 + 2 * u) + 4 * g;
            u32x4 vw; const u32x2 lo = *(const LAS u32x2*)vp, hi = *(const LAS u32x2*)(vp + 16); vw.x = lo.x; vw.y = lo.y; vw.z = hi.x; vw.w = hi.y;
            o[dt] = __builtin_amdgcn_mfma_f32_16x16x32_bf16(__builtin_bit_cast(bf16x8, vw), pf, o[dt], 0, 0, 0);
        }
    }
#pragma unroll
    for (int dt = 0; dt < 4; ++dt) { u32x2 w; w.x = cvt_pk_bf16(o[dt][0] * inv, o[dt][1] * inv); w.y = cvt_pk_bf16(o[dt][2] * inv, o[dt][3] * inv); *(u32x2*)(outp + 16 * dt + 4 * g) = w; }
}

#define LOAD_QFRAG(zq, pos, q0, q1) do { float _x1[8], _x2[8]; const int _g = lane >> 4; NORM_ROPE(zq, qn, pos, _g, 16, 32, _x1, _x2); \
    u32x4 _w0, _w1; _w0.x = cvt_pk_bf16(_x1[0] * 0.125f, _x1[1] * 0.125f); _w0.y = cvt_pk_bf16(_x1[2] * 0.125f, _x1[3] * 0.125f); _w0.z = cvt_pk_bf16(_x1[4] * 0.125f, _x1[5] * 0.125f); _w0.w = cvt_pk_bf16(_x1[6] * 0.125f, _x1[7] * 0.125f); \
    _w1.x = cvt_pk_bf16(_x2[0] * 0.125f, _x2[1] * 0.125f); _w1.y = cvt_pk_bf16(_x2[2] * 0.125f, _x2[3] * 0.125f); _w1.z = cvt_pk_bf16(_x2[4] * 0.125f, _x2[5] * 0.125f); _w1.w = cvt_pk_bf16(_x2[6] * 0.125f, _x2[7] * 0.125f); \
    q0 = __builtin_bit_cast(bf16x8, _w0); q1 = __builtin_bit_cast(bf16x8, _w1); } while (0)

__device__ __forceinline__ void attn_prompt_item(const bf16_t* z, const float* qn, const float* kn, const float* sinks, const float* rope_c, const float* rope_s, bf16_t* mix, float* spk, float* spv,
                                                 LAS unsigned char* lds, int qb, int kvh, int tid, int lane, int wave) {
    LAS bf16_t* Kl = (LAS bf16_t*)lds;
    LAS bf16_t* Vt = Kl + 256 * KSTR;
    LSYNC();
    const int kbase = qb * 128 - 128;
#pragma unroll
    for (int it_ = 0; it_ < 2; ++it_) { const int task = tid + 512 * it_;
        const int j = task >> 2, g = task & 3, pos = kbase + j;
        u32x4 w0 = (u32x4){0u, 0u, 0u, 0u}, w1 = w0;
        float x1[8], x2[8];
        const int posc = pos < 0 ? 0 : pos;
        const bf16_t* zr = z + (size_t)posc * INC + ZCK + kvh * 64;
        NORM_ROPE(zr, kn, posc, g, 1, 2, x1, x2);
        if (pos >= 0) { w0.x = cvt_pk_bf16(x1[0], x1[1]); w0.y = cvt_pk_bf16(x1[2], x1[3]); w0.z = cvt_pk_bf16(x1[4], x1[5]); w0.w = cvt_pk_bf16(x1[6], x1[7]);
                        w1.x = cvt_pk_bf16(x2[0], x2[1]); w1.y = cvt_pk_bf16(x2[2], x2[3]); w1.z = cvt_pk_bf16(x2[4], x2[5]); w1.w = cvt_pk_bf16(x2[6], x2[7]); }
        *(LAS u32x4*)(Kl + j * KSTR + 8 * g) = w0; *(LAS u32x4*)(Kl + j * KSTR + 32 + 8 * g) = w1;
        if (qb == 127 && j >= 128) { float* o = spk + (size_t)(j - 128) * 128 + kvh * 64;
            *(f32x4*)(o + 8 * g) = (f32x4){x1[0], x1[1], x1[2], x1[3]}; *(f32x4*)(o + 8 * g + 4) = (f32x4){x1[4], x1[5], x1[6], x1[7]};
            *(f32x4*)(o + 32 + 8 * g) = (f32x4){x2[0], x2[1], x2[2], x2[3]}; *(f32x4*)(o + 32 + 8 * g + 4) = (f32x4){x2[4], x2[5], x2[6], x2[7]}; }
    }
#pragma unroll
    for (int it_ = 0; it_ < 4; ++it_) { const int task = tid + 512 * it_;
        const int j = task >> 3, c8 = (task & 7) * 8, pos = kbase + j;
        u32x4 w = (u32x4){0u, 0u, 0u, 0u};
        if (pos >= 0) w = *(const u32x4*)(z + (size_t)pos * INC + ZCV + kvh * 64 + c8);
        Vt[(c8 + 0) * VSTR + j] = (bf16_t)(w.x & 0xffffu); Vt[(c8 + 1) * VSTR + j] = (bf16_t)(w.x >> 16);
        Vt[(c8 + 2) * VSTR + j] = (bf16_t)(w.y & 0xffffu); Vt[(c8 + 3) * VSTR + j] = (bf16_t)(w.y >> 16);
        Vt[(c8 + 4) * VSTR + j] = (bf16_t)(w.z & 0xffffu); Vt[(c8 + 5) * VSTR + j] = (bf16_t)(w.z >> 16);
        Vt[(c8 + 6) * VSTR + j] = (bf16_t)(w.w & 0xffffu); Vt[(c8 + 7) * VSTR + j] = (bf16_t)(w.w >> 16);
        if (qb == 127 && j >= 128) { float f[8]; UNPACK8(w, f); float* o = spv + (size_t)(j - 128) * 128 + kvh * 64 + c8;
            *(f32x4*)o = (f32x4){f[0], f[1], f[2], f[3]}; *(f32x4*)(o + 4) = (f32x4){f[4], f[5], f[6], f[7]}; }
    }
    for (int idx = tid; idx < 64 * 24; idx += 512) Vt[(idx / 24) * VSTR + 256 + (idx % 24)] = 0;
    LSYNC();
    const int hq = kvh * 4 + (wave >> 1);
    const float sink = sinks[hq];
    const int g4 = lane >> 4;
    float gq1[8], gq2[8];
#pragma unroll
    for (int j = 0; j < 8; ++j) { gq1[j] = qn[8 * g4 + j] * 0.125f; gq2[j] = qn[32 + 8 * g4 + j] * 0.125f; }
    const int pos0 = qb * 128 + (wave & 1) * 64 + (lane & 15);
    const bf16_t* zq0 = z + (size_t)pos0 * INC + ZCQ + hq * 64 + 8 * g4;
    const float* rc0 = rope_c + (size_t)pos0 * 32 + 8 * g4; const float* rs0 = rope_s + (size_t)pos0 * 32 + 8 * g4;
    u32x4 nlo = *(const u32x4*)zq0, nhi = *(const u32x4*)(zq0 + 32);
    f32x4 nc0 = *(const f32x4*)rc0, nc1 = *(const f32x4*)(rc0 + 4), ns0 = *(const f32x4*)rs0, ns1 = *(const f32x4*)(rs0 + 4);
#pragma unroll 1
    for (int a4 = 0; a4 < 4; ++a4) {
        const u32x4 lo = nlo, hi = nhi; const f32x4 c0 = nc0, c1 = nc1, s0 = ns0, s1 = ns1;
        { const int an = a4 < 3 ? a4 + 1 : 3; const bf16_t* zqn = zq0 + (size_t)(16 * an) * INC; const float* rcn = rc0 + (size_t)(16 * an) * 32; const float* rsn = rs0 + (size_t)(16 * an) * 32;
          nlo = *(const u32x4*)zqn; nhi = *(const u32x4*)(zqn + 32); nc0 = *(const f32x4*)rcn; nc1 = *(const f32x4*)(rcn + 4); ns0 = *(const f32x4*)rsn; ns1 = *(const f32x4*)(rsn + 4); }
        float a[8], b[8]; UNPACK8(lo, a); UNPACK8(hi, b);
        float sq = 0.f;
#pragma unroll
        for (int j = 0; j < 8; ++j) sq += a[j] * a[j] + b[j] * b[j];
        sq += __shfl_xor(sq, 16); sq += __shfl_xor(sq, 32);
        const float r = rsqrtf(sq * (1.0f / 64.0f) + EPS);
        float x1[8], x2[8];
#pragma unroll
        for (int j = 0; j < 8; ++j) { const float y1 = a[j] * r * gq1[j], y2 = b[j] * r * gq2[j]; const float c = j < 4 ? c0[j & 3] : c1[j & 3], s = j < 4 ? s0[j & 3] : s1[j & 3];
            x1[j] = y1 * c - y2 * s; x2[j] = y2 * c + y1 * s; }
        u32x4 w0, w1; w0.x = cvt_pk_bf16(x1[0], x1[1]); w0.y = cvt_pk_bf16(x1[2], x1[3]); w0.z = cvt_pk_bf16(x1[4], x1[5]); w0.w = cvt_pk_bf16(x1[6], x1[7]);
        w1.x = cvt_pk_bf16(x2[0], x2[1]); w1.y = cvt_pk_bf16(x2[2], x2[3]); w1.z = cvt_pk_bf16(x2[4], x2[5]); w1.w = cvt_pk_bf16(x2[6], x2[7]);
        const int i0 = (wave & 1) * 64 + 16 * a4, i = i0 + (lane & 15);
        const size_t m = (size_t)qb * 128 + i;
        attn_qtile(Kl, Vt, __builtin_bit_cast(bf16x8, w0), __builtin_bit_cast(bf16x8, w1), i, i0 >> 4, qb == 0 ? 128 : 0, sink, mix + m * DM + 512 + hq * 64, lane);
    }
}

__device__ __forceinline__ void attn_sample_item(const bf16_t* z, const float* ck, const float* cv, const float* qn, const float* kn, const float* sinks, const float* rope_c, const float* rope_s, bf16_t* mix,
                                                 float* ssk, float* ssv, LAS unsigned char* lds, int b, int kvh, int tid, int lane, int wave) {
    LAS bf16_t* Kl = (LAS bf16_t*)lds;
    LAS bf16_t* Vt = Kl + 256 * KSTR;
    LSYNC();
#pragma unroll
    for (int it_ = 0; it_ < 2; ++it_) { const int task = tid + 512 * it_;
        const int j = task >> 3, c8 = (task & 7) * 8;
        const float* kr = ck + (size_t)j * 128 + kvh * 64 + c8; const float* vr = cv + (size_t)j * 128 + kvh * 64 + c8;
        const f32x4 k0 = *(const f32x4*)kr, k1 = *(const f32x4*)(kr + 4), v0 = *(const f32x4*)vr, v1 = *(const f32x4*)(vr + 4);
        u32x4 w; w.x = cvt_pk_bf16(k0[0], k0[1]); w.y = cvt_pk_bf16(k0[2], k0[3]); w.z = cvt_pk_bf16(k1[0], k1[1]); w.w = cvt_pk_bf16(k1[2], k1[3]);
        *(LAS u32x4*)(Kl + j * KSTR + c8) = w;
        const float vf[8] = {v0[0], v0[1], v0[2], v0[3], v1[0], v1[1], v1[2], v1[3]};
#pragma unroll
        for (int e = 0; e < 8; ++e) Vt[(c8 + e) * VSTR + j] = (bf16_t)(cvt_pk_bf16(vf[e], 0.f) & 0xffffu);
        if (j >= 4) { float* ok = ssk + (size_t)(j - 4) * 128 + kvh * 64 + c8; float* ov = ssv + (size_t)(j - 4) * 128 + kvh * 64 + c8;
            *(f32x4*)ok = k0; *(f32x4*)(ok + 4) = k1; *(f32x4*)ov = v0; *(f32x4*)(ov + 4) = v1; }
    }
    if (tid < 16) {
        const int t = tid >> 2, g = tid & 3, j = 128 + t; const size_t m = (size_t)TP + 4 * b + t;
        float x1[8], x2[8];
        NORM_ROPE(z + m * INC + ZCK + kvh * 64, kn, TP + t, g, 1, 2, x1, x2);
        u32x4 w0, w1; w0.x = cvt_pk_bf16(x1[0], x1[1]); w0.y = cvt_pk_bf16(x1[2], x1[3]); w0.z = cvt_pk_bf16(x1[4], x1[5]); w0.w = cvt_pk_bf16(x1[6], x1[7]);
        w1.x = cvt_pk_bf16(x2[0], x2[1]); w1.y = cvt_pk_bf16(x2[2], x2[3]); w1.z = cvt_pk_bf16(x2[4], x2[5]); w1.w = cvt_pk_bf16(x2[6], x2[7]);
        *(LAS u32x4*)(Kl + j * KSTR + 8 * g) = w0; *(LAS u32x4*)(Kl + j * KSTR + 32 + 8 * g) = w1;
        float* o = ssk + (size_t)(j - 4) * 128 + kvh * 64;
        *(f32x4*)(o + 8 * g) = (f32x4){x1[0], x1[1], x1[2], x1[3]}; *(f32x4*)(o + 8 * g + 4) = (f32x4){x1[4], x1[5], x1[6], x1[7]};
        *(f32x4*)(o + 32 + 8 * g) = (f32x4){x2[0], x2[1], x2[2], x2[3]}; *(f32x4*)(o + 32 + 8 * g + 4) = (f32x4){x2[4], x2[5], x2[6], x2[7]};
    }
    if (tid >= 64 && tid < 64 + 32) {
        const int t = (tid - 64) >> 3, c8 = ((tid - 64) & 7) * 8, j = 128 + t; const size_t m = (size_t)TP + 4 * b + t;
        const u32x4 w = *(const u32x4*)(z + m * INC + ZCV + kvh * 64 + c8);
        Vt[(c8 + 0) * VSTR + j] = (bf16_t)(w.x & 0xffffu); Vt[(c8 + 1) * VSTR + j] = (bf16_t)(w.x >> 16);
        Vt[(c8 + 2) * VSTR + j] = (bf16_t)(w.y & 0xffffu); Vt[(c8 + 3) * VSTR + j] = (bf16_t)(w.y >> 16);
        Vt[(c8 + 4) * VSTR + j] = (bf16_t)(w.z & 0xffffu); Vt[(c8 + 5) * VSTR + j] = (bf16_t)(w.z >> 16);
        Vt[(c8 + 6) * VSTR + j] = (bf16_t)(w.w & 0xffffu); Vt[(c8 + 7) * VSTR + j] = (bf16_t)(w.w >> 16);
        float f[8]; UNPACK8(w, f); float* o = ssv + (size_t)(j - 4) * 128 + kvh * 64 + c8;
        *(f32x4*)o = (f32x4){f[0], f[1], f[2], f[3]}; *(f32x4*)(o + 4) = (f32x4){f[4], f[5], f[6], f[7]};
    }
    if (tid >= 128 && tid < 128 + 12 * 8) { const int j = 132 + ((tid - 128) >> 3), c8 = ((tid - 128) & 7) * 8; *(LAS u32x4*)(Kl + j * KSTR + c8) = (u32x4){0u, 0u, 0u, 0u}; }
    for (int idx = tid; idx < 64 * 28; idx += 512) Vt[(idx / 28) * VSTR + 132 + (idx % 28)] = 0;
    LSYNC();
    if (wave == 0) {
        const int q = lane & 15, hg = q >> 2, t = q & 3, hq = kvh * 4 + hg; const size_t m = (size_t)TP + 4 * b + t;
        bf16x8 q0, q1;
        LOAD_QFRAG(z + m * INC + ZCQ + hq * 64, TP + t, q0, q1);
        attn_qtile(Kl, Vt, q0, q1, t, 0, 0, sinks[hq], mix + m * DM + 512 + hq * 64, lane);
    }
}

#define PHASE_HEAD { unsigned z_ = 0; asm volatile("" : "+s"(z_)); lds += z_; } int wave_ = wv; asm volatile("" : "+s"(wave_)); const int wave = wave_, lane = lane_id_opaque(), tid = wave * 64 + lane; const int G = gridDim.x, bid = blockIdx.x; unsigned char* ws = WSP; (void)lane; (void)wave; (void)G; (void)bid; (void)ws;
#define SSP(k) ((float*)(ws + WS_SS) + (size_t)(k) * MT)
#define WL(off) ((const bf16_t*)(ws + WS_W + (size_t)l * W_LAYER + (off)))

struct G1Order {
    pg8::StaticOrder so; unsigned* cnt; int c;
    __device__ __forceinline__ bool next(int i, Unit& u) const {
        if (c >= 64 && c < 82) { if (i == 0) { const int s = c - 64; u.pm = 64 + s / 9; u.pn = s % 9; return true; } return so.next(i - 1, u); }
        return so.next(i, u);
    }
    __device__ __forceinline__ void a_ready(const Unit&) const {}
    __device__ __forceinline__ void done(const Unit& u) const {
        if (u.pm >= 64) {
            asm volatile("s_waitcnt vmcnt(0)" ::: "memory");
            __builtin_amdgcn_fence(__ATOMIC_RELEASE, "agent");
            asm volatile("s_waitcnt vmcnt(0)" ::: "memory");
            if (lane_id_opaque() == 0) __hip_atomic_fetch_add(cnt, 1u, __ATOMIC_RELAXED, __HIP_MEMORY_SCOPE_AGENT);
        }
    }
};
__device__ __forceinline__ void phase_g1(LAS unsigned char* lds, int l, int wv) {
    PHASE_HEAD
    unsigned* cnt = (unsigned*)(ws + WS_CTL) + 8192 + 64 * l;
    { pg8::Gemm g{(const bf16_t*)(ws + WS_BUFA), WL(W_IN), MT, INC, DM}; G1Order S; S.so.init(TP, INC, G, bid); S.cnt = cnt; S.c = bid;
      EpiZ E{(bf16_t*)(ws + WS_ZACT), INC, SSP(3 * l)}; pg8::gemm_phase<EpiZ, G1Order, true, true>(lds, g, S, E, wv); }
    if (bid >= 82) {
        if (tid == 0) { unsigned sp = 0; while (__hip_atomic_load(cnt, __ATOMIC_RELAXED, __HIP_MEMORY_SCOPE_AGENT) < 144u) { __builtin_amdgcn_s_sleep(4); if (++sp > (1u << 22)) break; }
            __builtin_amdgcn_fence(__ATOMIC_ACQUIRE, "agent"); asm volatile("s_waitcnt vmcnt(0)" ::: "memory"); }
        __syncthreads();
        const bf16_t* z = (const bf16_t*)(ws + WS_ZACT); bf16_t* bufB = (bf16_t*)(ws + WS_BUFB);
        const float* lbp = (const float*)(ws + WS_LB) + l * 256;
        const float* rope_c = (const float*)(ws + WS_ROPE); const float* rope_s = rope_c + (size_t)NPOS * 32;
        float* out = OUTP;
#pragma unroll 1
        for (int it = bid - 82; it < 640; it += G - 82) {
            int r = it;
            if (r < 256) { const int b = r >> 1, hp = r & 1; const size_t so = ((size_t)(l * 128 + b) * 4) * 4096;
                hgrn_sample_item(z, lbp, IN(2) + so, out + O_SSH + so, IN(10) + l * 64, bufB, lds, b, hp, tid, lane, wave); continue; } r -= 256;
            if (r < 128) { conv_sample_item(z, IN(3) + (size_t)l * 128 * 7680, IN(11) + l * 31 * 256, IN(12) + l * 256, IN(13) + l * 256, IN(14) + l * 256, bufB, out + O_SSC + (size_t)l * 128 * 7680, lds, r, tid, lane, wave); continue; } r -= 128;
            { const int b = r >> 1, kvh = r & 1; const size_t co = (size_t)(l * 128 + b) * 16384;
              attn_sample_item(z, IN(4) + co, IN(5) + co, IN(15) + l * 64, IN(16) + l * 64, IN(17) + l * 8, rope_c, rope_s, bufB, out + O_SSK + co, out + O_SSV + co, lds, b, kvh, tid, lane, wave); }
        }
    }
}
__device__ __forceinline__ void phase_mix_a(LAS unsigned char* lds, int l, int wv) {
    PHASE_HEAD
    const bf16_t* z = (const bf16_t*)(ws + WS_ZACT); bf16_t* bufB = (bf16_t*)(ws + WS_BUFB);
    const float* lbp = (const float*)(ws + WS_LB) + l * 256; float* dvec = (float*)(ws + WS_DVEC); float* dS = (float*)(ws + WS_DS);
    const float* rope_c = (const float*)(ws + WS_ROPE); const float* rope_s = rope_c + (size_t)NPOS * 32;
    float* out = OUTP;
#pragma unroll 1
    for (int it = bid; it < 1024; it += G) {
        unsigned czf[8], cvi[8];
        const bf16_t* zb = z + (size_t)(64 * (it >> 2) + 8 * wave) * INC + (it & 3) * 64 + lane;
#pragma unroll
        for (int i = 0; i < 8; ++i) { czf[i] = zb[(size_t)i * INC + ZF]; cvi[i] = zb[(size_t)i * INC + ZI]; }
        hgrn_ds_item(czf, cvi, lbp, dS, dvec, lds, it >> 2, it & 3, tid, lane, wave);
    }
#pragma unroll 1
    for (int it = bid; it < 512; it += G) {
        int r = it;
        if (r < 256) { attn_prompt_item(z, IN(15) + l * 64, IN(16) + l * 64, IN(17) + l * 8, rope_c, rope_s, bufB, out + O_SPK + (size_t)l * 16384, out + O_SPV + (size_t)l * 16384, lds, r >> 1, r & 1, tid, lane, wave); continue; } r -= 256;
        conv_prompt_item(z, IN(11) + l * 31 * 256, IN(12) + l * 256, IN(13) + l * 256, IN(14) + l * 256, bufB, out + O_SPC + (size_t)l * 7680, lds, r, tid, lane, wave);
    }
}
__device__ __forceinline__ void phase_scan(LAS unsigned char* lds, int l, int wv) {
    PHASE_HEAD
    if (bid < 256) {
        float* dS = (float*)(ws + WS_DS); const float* dvec = (const float*)(ws + WS_DVEC);
        const int e = 64 * bid + lane, h = e >> 12, k = (e >> 6) & 63;
        LAS float* X = (LAS float*)lds;
        float v[32], d[32];
#pragma unroll
        for (int j = 0; j < 32; ++j) { const int c = 32 * wave + j; v[j] = dS[(size_t)c * 16384 + e]; d[j] = dvec[(c * 4 + h) * 64 + k]; }
        float A = 0.f, P = 1.f;
#pragma unroll
        for (int j = 0; j < 32; ++j) { const float t = v[j]; v[j] = A; A = d[j] * A + t; const float pd = d[j]; d[j] = P; P *= pd; }
        LSYNC();
        X[(wave * 2 + 0) * 64 + lane] = P; X[(wave * 2 + 1) * 64 + lane] = A;
        LSYNC();
        float S = 0.f;
#pragma unroll
        for (int w2 = 0; w2 < 8; ++w2) { const float p2 = X[(w2 * 2 + 0) * 64 + lane], a2 = X[(w2 * 2 + 1) * 64 + lane]; if (w2 < wave) S = p2 * S + a2; }
#pragma unroll
        for (int j = 0; j < 32; ++j) dS[(size_t)(32 * wave + j) * 16384 + e] = d[j] * S + v[j];
        if (wave == 7) OUTP[O_SPH + (size_t)l * 16384 + e] = P * S + A;
    }
}
__device__ __forceinline__ void phase_mix_c(LAS unsigned char* lds, int l, int wv) {
    PHASE_HEAD
    const bf16_t* z = (const bf16_t*)(ws + WS_ZACT); bf16_t* bufB = (bf16_t*)(ws + WS_BUFB);
    const float* lbp = (const float*)(ws + WS_LB) + l * 256; const float* dS = (const float*)(ws + WS_DS);
    const float* onorm = IN(10) + l * 64;
#pragma unroll 1
    for (int it = bid; it < 512; it += G) hgrn_out_item(z, lbp, dS, onorm, bufB, lds, it >> 1, it & 1, tid, lane, wave);
}
__device__ __forceinline__ void phase_g2(LAS unsigned char* lds, int l, int wv) {
    PHASE_HEAD
    bf16_t* bufA = (bf16_t*)(ws + WS_BUFA);
    pg8::Gemm g{(const bf16_t*)(ws + WS_BUFB), WL(W_OUT), TP, DM, DM}; pg8::StaticOrder S; S.init(TP, DM, G, bid);
    EpiRes E{bufA, bufA, SSP(3 * l + 1)};
    pg8::gemm_phase<EpiRes, pg8::StaticOrder, true, true>(lds, g, S, E, wv);
    SEpiRes SE{bufA + (size_t)TP * DM, bufA + (size_t)TP * DM, SSP(3 * l + 1) + TP};
    small_gemm(lds, (const bf16_t*)(ws + WS_BUFB) + (size_t)TP * DM, WL(W_OUT), DM, SE, bid, tid, lane, wave);
}
__device__ __forceinline__ void phase_g3(LAS unsigned char* lds, int l, int wv) {
    PHASE_HEAD
    pg8::Gemm g{(const bf16_t*)(ws + WS_BUFA), WL(W_GU), MT, 2 * DFF, DM}; pg8::StaticOrder S; S.init(MT, 2 * DFF, G, bid);
    EpiGU E{(bf16_t*)(ws + WS_ZACT), SSP(3 * l + 1)}; pg8::gemm_phase<EpiGU, pg8::StaticOrder, true, true>(lds, g, S, E, wv);
    if (bid >= 172) {
        bf16_t* pbl = (bf16_t*)(ws + WS_PB) + (size_t)l * MT * PLE;
        const float* pP = IN(6) + (size_t)l * TP * PLE; const float* pS = IN(7) + (size_t)l * NSM * PLE;
        const int gw2 = (bid - 172) * 8 + wave, NGW2 = (G - 172) * 8;
#pragma unroll 1
        for (int m0 = gw2; m0 < MT; m0 += 8 * NGW2) {
            f32x4 v[8];
#pragma unroll
            for (int q = 0; q < 8; ++q) { const int m = (m0 + q * NGW2 < MT) ? m0 + q * NGW2 : m0;
                const float* src = (m < TP) ? pP + (size_t)m * PLE : pS + (size_t)(m - TP) * PLE; v[q] = ((const f32x4*)src)[lane]; }
#pragma unroll
            for (int q = 0; q < 8; ++q) { const int m = (m0 + q * NGW2 < MT) ? m0 + q * NGW2 : m0;
                u32x2 w; w.x = cvt_pk_bf16(v[q][0], v[q][1]); w.y = cvt_pk_bf16(v[q][2], v[q][3]); ((u32x2*)(pbl + (size_t)m * PLE))[lane] = w; }
        }
    }
}
__device__ __forceinline__ void phase_g4(LAS unsigned char* lds, int l, int wv) {
    PHASE_HEAD
    const bf16_t* bufA = (const bf16_t*)(ws + WS_BUFA); bf16_t* bufB = (bf16_t*)(ws + WS_BUFB);
    pg8::Gemm g{(const bf16_t*)(ws + WS_ZACT), WL(W_D), TP, DM, DFF}; pg8::StaticOrder S; S.init(TP, DM, G, bid);
    EpiRes E{bufA, bufB, SSP(3 * l + 2)}; pg8::gemm_phase<EpiRes, pg8::StaticOrder, true, true>(lds, g, S, E, wv);
    SEpiRes SE{bufA + (size_t)TP * DM, bufB + (size_t)TP * DM, SSP(3 * l + 2) + TP};
    small_gemm(lds, (const bf16_t*)(ws + WS_ZACT) + (size_t)TP * DFF, WL(W_D), DFF, SE, bid, tid, lane, wave);
}
__device__ __forceinline__ void phase_g5a(LAS unsigned char* lds, int l, int wv) {
    PHASE_HEAD
    pg8::Gemm g{(const bf16_t*)(ws + WS_BUFB), WL(W_PG), TP, DM, DM}; pg8::StaticOrder S; S.init(TP, DM, G, bid);
    EpiGate E{(bf16_t*)(ws + WS_ZACT), SSP(3 * l + 2)}; pg8::gemm_phase<EpiGate, pg8::StaticOrder, true, true>(lds, g, S, E, wv);
    SEpiGate SE{(bf16_t*)(ws + WS_ZACT) + (size_t)TP * DM, SSP(3 * l + 2) + TP};
    small_gemm(lds, (const bf16_t*)(ws + WS_BUFB) + (size_t)TP * DM, WL(W_PG), DM, SE, bid, tid, lane, wave);
}
__device__ __forceinline__ void phase_g5b(LAS unsigned char* lds, int l, int wv) {
    PHASE_HEAD
    const bf16_t* gt = (const bf16_t*)(ws + WS_ZACT); const bf16_t* bufB = (const bf16_t*)(ws + WS_BUFB); bf16_t* bufA = (bf16_t*)(ws + WS_BUFA); float* Y = OUTP + O_Y;
    pg8::Gemm g{(const bf16_t*)(ws + WS_PB) + (size_t)l * MT * PLE, WL(W_PP), TP, DM, PLE}; pg8::StaticOrder S; S.init(TP, DM, G, bid);
    EpiOut E{gt, bufB, Y, bufA, SSP(3), l}; pg8::gemm_phase<EpiOut, pg8::StaticOrder, true, true>(lds, g, S, E, wv);
    SEpiOut SE{gt + (size_t)TP * DM, bufB + (size_t)TP * DM, Y + (size_t)TP * DM, bufA + (size_t)TP * DM, SSP(3) + TP, l};
    small_gemm(lds, (const bf16_t*)(ws + WS_PB) + ((size_t)l * MT + TP) * PLE, WL(W_PP), PLE, SE, bid, tid, lane, wave);
}

__global__ void __launch_bounds__(512, 2) fwd_kernel(Args a) {
    extern __shared__ __attribute__((aligned(16))) unsigned char lds_raw[];
    LAS unsigned char* lds = (LAS unsigned char*)lds_raw;
    volatile LAS unsigned* MISC = (volatile LAS unsigned*)(lds + MISC_OFF);
    if (threadIdx.x < 32) MISC[threadIdx.x] = 0u;
    if (threadIdx.x == 0) {
        LAS unsigned long long* PT = (LAS unsigned long long*)(lds + PT_OFF);
#pragma unroll
        for (int i = 0; i < 27; ++i) PT[i] = (unsigned long long)a.in[i];
        PT[27] = (unsigned long long)a.out; PT[28] = (unsigned long long)a.ws;
    }
    __syncthreads();
    const int wv = __builtin_amdgcn_readfirstlane(threadIdx.x >> 6);
    XcdBarrier bar = xcd_barrier_post((unsigned*)(WSP + WS_CTL), MISC + 8); bar.wv = wv;
    prologue(lds, wv);
    if (gridDim.x == 0x7fffffffu) cg::this_grid().sync();
    xcd_barrier(bar);
#define LAYER(l) do { \
        phase_g1(lds, l, wv); xcd_barrier(bar); \
        phase_mix_a(lds, l, wv); xcd_barrier(bar); \
        phase_scan(lds, l, wv); xcd_barrier(bar); \
        phase_mix_c(lds, l, wv); xcd_barrier(bar); \
        phase_g2(lds, l, wv); xcd_barrier(bar); \
        phase_g3(lds, l, wv); xcd_barrier(bar); \
        phase_g4(lds, l, wv); xcd_barrier(bar); \
        phase_g5a(lds, l, wv); \
        phase_g5b(lds, l, wv); } while (0)
    LAYER(0);
    xcd_barrier(bar);
    LAYER(1);
}

extern "C" void kernel_launch(void* const* d_in, const int* in_sizes, int n_in, void* d_out, int out_size, void* d_ws, size_t ws_size, hipStream_t stream) {
    static int grid = 0;
    if (grid == 0) {
        if (n_in != 27 || ws_size < WS_END) { fprintf(stderr, "kernel_launch: unexpected n_in %d / ws %zu\n", n_in, ws_size); grid = -1; return; }
        int dev = 0, cus = 0, per_cu = 0;
        hipGetDevice(&dev); hipDeviceGetAttribute(&cus, hipDeviceAttributeMultiprocessorCount, dev);
        if (hipFuncSetAttribute((const void*)fwd_kernel, hipFuncAttributeMaxDynamicSharedMemorySize, LDS_BYTES) != hipSuccess) { fprintf(stderr, "kernel_launch: hipFuncSetAttribute failed\n"); grid = -1; return; }
        hipOccupancyMaxActiveBlocksPerMultiprocessor(&per_cu, (const void*)fwd_kernel, 512, LDS_BYTES);
        (void)hipGetLastError();
        if (per_cu < 1) { fprintf(stderr, "kernel_launch: occupancy query says %d blocks per CU\n", per_cu); }
        grid = cus;
    }
    if (grid < 0) return;
    hipMemsetAsync((char*)d_ws + WS_CTL, 0, CTL_BYTES, stream);
    Args a{};
    for (int i = 0; i < 27; ++i) a.in[i] = (const float*)d_in[i];
    a.out = (float*)d_out; a.ws = (unsigned char*)d_ws;
    void* args[] = {&a};
    hipError_t e = hipLaunchCooperativeKernel((const void*)fwd_kernel, dim3(grid), dim3(512), args, LDS_BYTES, stream);
    if (e != hipSuccess) fprintf(stderr, "cooperative launch failed: %s (grid %d)\n", hipGetErrorString(e), grid);
}
```

```cpp
#include <hip/hip_runtime.h>
#include <hip/hip_cooperative_groups.h>
#include <cstdio>
#include <cstdint>
namespace cg = cooperative_groups;
namespace pg8 {
#define PG8_LAS __attribute__((address_space(3)))
typedef unsigned short bf16_t;
typedef short bf16x8 __attribute__((ext_vector_type(8)));
typedef float f32x4 __attribute__((ext_vector_type(4)));
typedef unsigned u32x4 __attribute__((ext_vector_type(4)));
constexpr int BM = 256, BK = 64, HALF = 128, HTB = HALF * BK * 2  , STAGE_BYTES = 8 * HTB, NXCD = 8, WGM = 8;

__host__ __device__ __forceinline__ int lds_byte(int r, int c) { const int st = (r >> 4) * 2 + (c >> 5), rr = r & 15, cc = c & 31, ob = rr * 64 + cc * 2; return st * 1024 + (ob ^ (((ob >> 9) & 1) << 5)); }
__host__ __device__ __forceinline__ void stage_rc(int b, int& R, int& C) { const int st = b / 1024, sb = b % 1024, swz = sb ^ (((sb >> 9) & 1) << 5); R = (st >> 1) * 16 + swz / 64; C = (st & 1) * 32 + (swz % 64) / 2; }
__host__ __device__ __forceinline__ int perm32(int rho) { const int n = rho >> 4, i = rho & 15; return 8 * (i >> 2) + 4 * n + (i & 3); }

struct Unit { int pm, pn; };
struct Gemm { const bf16_t* A; const bf16_t* Bt; int M, N, K; };

struct StaticOrder {
    int nM, nN, nwg, G, c;
    __host__ __device__ void init(int M, int N, int G_, int c_) { nM = M / BM; nN = N / BM; nwg = nM * nN; G = G_; c = c_; }
    __host__ __device__ bool next(int i, Unit& u) const {
        const long L = (long)i * G + c; if (L >= nwg) return false;
        int wgid = (int)L; { const int q = nwg / NXCD, r = nwg % NXCD, xcd = wgid % NXCD, off = wgid / NXCD; wgid = (xcd < r ? xcd * (q + 1) : r * (q + 1) + (xcd - r) * q) + off; }
        const int nig = WGM * nN, gid = wgid / nig, fm = gid * WGM, gsz = (nM - fm) < WGM ? (nM - fm) : WGM;
        u.pm = fm + ((wgid % nig) % gsz); u.pn = (wgid % nig) / gsz; return true;
    }
    __device__ __forceinline__ void a_ready(const Unit&) const {}
    __device__ __forceinline__ void done(const Unit&) const {}
};
__device__ __forceinline__ unsigned cvt_pk_bf16(float lo, float hi) { unsigned r; asm volatile("v_cvt_pk_bf16_f32 %0, %1, %2" : "=v"(r) : "v"(lo), "v"(hi)); return r; }
template <class Epi, class Sched, bool ALIGN_EPI = false, bool SP2 = false>
__device__ __forceinline__ void gemm_phase(PG8_LAS unsigned char* lds, const Gemm g, const Sched& S, const Epi& E, int wv_) {
    unsigned m_ = ~0u; asm volatile("" : "+s"(m_)); asm volatile("" : "+s"(wv_)); int tid_ = wv_ * 64 + (int)__builtin_amdgcn_mbcnt_hi(m_, __builtin_amdgcn_mbcnt_lo(m_, 0u)); { unsigned z_ = 0; asm volatile("" : "+s"(z_)); lds += z_; } const int tid = tid_, wid = __builtin_amdgcn_readfirstlane(tid >> 6), lane = tid & 63, wr = wid >> 2, wc = wid & 3, fr = lane & 15, fq = lane >> 4;
    const int K = g.K, nt = K / BK;
    unsigned voffA[2], voffB[2];
#pragma unroll
    for (int i = 0; i < 2; ++i) { int R, C; stage_rc(tid * 16 + i * 8192, R, C); const int Rb = Epi::PERM ? ((R & ~31) + perm32(R & 31)) : R;
        voffA[i] = (unsigned)(R * K + C) * 2u; voffB[i] = (unsigned)(Rb * K + C) * 2u; }
    const size_t kstep = (size_t)(BK * 2);
    const size_t hstep = (size_t)HALF * K * 2;
    const size_t tstep = 2 * hstep;
    const unsigned ldsw = (unsigned)wid * 1024u;
    const int aoff = lds_byte(wr * 64 + fr, fq * 8), boff = lds_byte(wc * 32 + fr, fq * 8);
#define PG8_SA(b, h) (((b) * 2 + (h)) * HTB)
#define PG8_SB(b, h) ((4 + (b) * 2 + (h)) * HTB)
#define PG8_STAGE(bufoff, gbase, voff) do { _Pragma("unroll") for (int _i = 0; _i < 2; ++_i) \
        __builtin_amdgcn_global_load_lds((const unsigned*)((const char*)(gbase) + (voff)[_i]), (PG8_LAS unsigned*)(lds + (bufoff) + ldsw + _i * 8192), 16, 0, 0); } while (0)
#define PG8_LDA(dst, b, h) do { _Pragma("unroll") for (int m = 0; m < 4; ++m) _Pragma("unroll") for (int k = 0; k < 2; ++k) dst[m][k] = *(const PG8_LAS bf16x8*)(lds + PG8_SA(b, h) + aoff + m * 2048 + k * 1024); } while (0)
#define PG8_LDB(dst, b, h) do { _Pragma("unroll") for (int n = 0; n < 2; ++n) _Pragma("unroll") for (int k = 0; k < 2; ++k) dst[n][k] = *(const PG8_LAS bf16x8*)(lds + PG8_SB(b, h) + boff + n * 2048 + k * 1024); } while (0)
#define PG8_MMA(ai, bj, At, Bt) do { __builtin_amdgcn_s_setprio(1); _Pragma("unroll") for (int m = 0; m < 4; ++m) _Pragma("unroll") for (int n = 0; n < 2; ++n) _Pragma("unroll") for (int k = 0; k < 2; ++k) \
        acc[ai][bj][m][n] = __builtin_amdgcn_mfma_f32_16x16x32_bf16(Bt[n][k], At[m][k], acc[ai][bj][m][n], 0, 0, 0); __builtin_amdgcn_s_setprio(0); } while (0)
#define PG8_WAIT_V(n) asm volatile("s_waitcnt vmcnt(" #n ")" ::: "memory")
#define PG8_WAIT_L(n) asm volatile("s_waitcnt lgkmcnt(" #n ")" ::: "memory")
#define PG8_BAR __builtin_amdgcn_s_barrier()
#define PG8_SCHED __builtin_amdgcn_sched_barrier(0)
    Unit cur, nxt; int ui = 0;
    if (!S.next(0, cur)) return;
    f32x4 acc[2][2][4][2];
#pragma unroll
    for (int a = 0; a < 2; ++a)
#pragma unroll
        for (int b = 0; b < 2; ++b)
#pragma unroll
            for (int m = 0; m < 4; ++m)
#pragma unroll
                for (int n = 0; n < 2; ++n) acc[a][b][m][n] = (f32x4){0.f, 0.f, 0.f, 0.f};
    bf16x8 At[4][2], B0[2][2], B1[2][2];
    const char* cA = (const char*)g.A + (size_t)cur.pm * tstep; const char* cB = (const char*)g.Bt + (size_t)cur.pn * tstep;
    S.a_ready(cur);
    if constexpr (SP2) {
        PG8_STAGE(PG8_SB(0, 0), cB, voffB); PG8_STAGE(PG8_SB(0, 1), cB + hstep, voffB); PG8_STAGE(PG8_SA(0, 0), cA, voffA); PG8_STAGE(PG8_SA(0, 1), cA + hstep, voffA);
        if (wr == 1) PG8_BAR;
        PG8_WAIT_V(2); PG8_BAR;
        PG8_STAGE(PG8_SB(1, 0), cB + kstep, voffB); PG8_STAGE(PG8_SA(1, 0), cA + kstep, voffA); PG8_STAGE(PG8_SB(1, 1), cB + hstep + kstep, voffB);
        PG8_WAIT_V(6); PG8_BAR;
    } else {
        PG8_STAGE(PG8_SB(0, 0), cB, voffB); PG8_STAGE(PG8_SA(0, 0), cA, voffA); PG8_STAGE(PG8_SB(0, 1), cB + hstep, voffB); PG8_STAGE(PG8_SA(0, 1), cA + hstep, voffA);
        if (wr == 1) PG8_BAR;
        PG8_WAIT_V(4); PG8_BAR;
        PG8_STAGE(PG8_SB(1, 0), cB + kstep, voffB); PG8_STAGE(PG8_SA(1, 0), cA + kstep, voffA); PG8_STAGE(PG8_SB(1, 1), cB + hstep + kstep, voffB);
        PG8_WAIT_V(6); PG8_BAR;
    }
    for (;;) {
        const bool has_next = S.next(ui + 1, nxt);
        const char* nA = has_next ? (const char*)g.A + (size_t)nxt.pm * tstep : cA; const char* nB = has_next ? (const char*)g.Bt + (size_t)nxt.pn * tstep : cB;
        for (int t = 0; t < nt; t += 2) {
            const bool last = (t == nt - 2);
            const char* a1 = cA + (size_t)(t + 1) * kstep;
            const char* a2 = last ? nA : cA + (size_t)(t + 2) * kstep; const char* b2 = last ? nB : cB + (size_t)(t + 2) * kstep;
            const char* a3 = a2 + kstep; const char* b3 = b2 + kstep;
            if (last && has_next) S.a_ready(nxt);
            if constexpr (SP2) {
            PG8_LDB(B0, 0, 0); PG8_LDB(B1, 0, 1); PG8_SCHED; PG8_LDA(At, 0, 0); PG8_STAGE(PG8_SA(1, 1), a1 + hstep, voffA);
            PG8_WAIT_V(8); PG8_WAIT_L(0); PG8_BAR; PG8_MMA(0, 0, At, B0); PG8_MMA(0, 1, At, B1); PG8_BAR; PG8_SCHED;
            PG8_LDA(At, 0, 1); PG8_STAGE(PG8_SB(0, 0), b2, voffB); PG8_STAGE(PG8_SB(0, 1), b2 + hstep, voffB); PG8_STAGE(PG8_SA(0, 0), a2, voffA);
            PG8_WAIT_V(8); PG8_WAIT_L(0); PG8_BAR; PG8_MMA(1, 0, At, B0); PG8_MMA(1, 1, At, B1); PG8_BAR; PG8_SCHED;
            PG8_LDB(B0, 1, 0); PG8_LDB(B1, 1, 1); PG8_SCHED; PG8_LDA(At, 1, 0); PG8_STAGE(PG8_SA(0, 1), a2 + hstep, voffA);
            PG8_WAIT_V(8); PG8_WAIT_L(0); PG8_BAR; PG8_MMA(0, 0, At, B0); PG8_MMA(0, 1, At, B1); PG8_BAR; PG8_SCHED;
            PG8_LDA(At, 1, 1); PG8_STAGE(PG8_SB(1, 0), b3, voffB); PG8_STAGE(PG8_SB(1, 1), b3 + hstep, voffB); PG8_STAGE(PG8_SA(1, 0), a3, voffA);
            PG8_WAIT_V(8); PG8_WAIT_L(0); PG8_BAR; PG8_MMA(1, 0, At, B0); PG8_MMA(1, 1, At, B1); PG8_BAR; PG8_SCHED;
            } else {
            PG8_LDB(B0, 0, 0); PG8_SCHED; PG8_LDA(At, 0, 0); PG8_STAGE(PG8_SA(1, 1), a1 + hstep, voffA);
            PG8_WAIT_L(8); PG8_BAR; PG8_WAIT_L(0); PG8_MMA(0, 0, At, B0); PG8_BAR; PG8_SCHED;
            PG8_LDB(B1, 0, 1); PG8_STAGE(PG8_SB(0, 0), b2, voffB);
            PG8_BAR; PG8_WAIT_L(0); PG8_MMA(0, 1, At, B1); PG8_BAR;
            PG8_LDA(At, 0, 1); PG8_STAGE(PG8_SA(0, 0), a2, voffA);
            PG8_BAR; PG8_WAIT_L(0); PG8_MMA(1, 0, At, B0); PG8_BAR; PG8_SCHED;
            PG8_STAGE(PG8_SB(0, 1), b2 + hstep, voffB);
            PG8_WAIT_V(6); PG8_BAR; PG8_MMA(1, 1, At, B1); PG8_BAR;
            PG8_LDB(B0, 1, 0); PG8_SCHED; PG8_LDA(At, 1, 0); PG8_STAGE(PG8_SA(0, 1), a2 + hstep, voffA);
            PG8_WAIT_L(8); PG8_BAR; PG8_WAIT_L(0); PG8_MMA(0, 0, At, B0); PG8_BAR; PG8_SCHED;
            PG8_LDB(B1, 1, 1); PG8_STAGE(PG8_SB(1, 0), b3, voffB);
            PG8_BAR; PG8_WAIT_L(0); PG8_MMA(0, 1, At, B1); PG8_BAR;
            PG8_LDA(At, 1, 1); PG8_STAGE(PG8_SA(1, 0), a3, voffA);
            PG8_BAR; PG8_WAIT_L(0); PG8_MMA(1, 0, At, B0); PG8_BAR; PG8_SCHED;
            PG8_STAGE(PG8_SB(1, 1), b3 + hstep, voffB);
            PG8_WAIT_V(6); PG8_BAR; PG8_MMA(1, 1, At, B1); PG8_BAR;
            }
        }
        if constexpr (ALIGN_EPI) { if (wr == 0) PG8_BAR; }
        if constexpr (!Epi::AFTER_DRAIN) { E(acc, cur, wr, wc, fr, fq); S.done(cur); }
        if (!has_next) break;
#pragma unroll
        for (int a = 0; a < 2; ++a)
#pragma unroll
            for (int b = 0; b < 2; ++b)
#pragma unroll
                for (int m = 0; m < 4; ++m)
#pragma unroll
                    for (int n = 0; n < 2; ++n) acc[a][b][m][n] = (f32x4){0.f, 0.f, 0.f, 0.f};
        cur = nxt; cA = nA; cB = nB; ++ui;
        if constexpr (ALIGN_EPI) { if (wr == 1) PG8_BAR; }
    }
    PG8_WAIT_V(0);
    if constexpr (!ALIGN_EPI) { if (wr == 0) PG8_BAR; }
    PG8_BAR;
    if constexpr (Epi::AFTER_DRAIN) { E.fused(acc, cur, wr, wc, fr, fq, lds, wid, lane); S.done(cur); }
#undef PG8_SA
#undef PG8_SB
#undef PG8_STAGE
#undef PG8_LDA
#undef PG8_LDB
#undef PG8_MMA
#undef PG8_WAIT_V
#undef PG8_WAIT_L
#undef PG8_BAR
#undef PG8_SCHED
}
}

#define LAS __attribute__((address_space(3)))
using pg8::bf16_t; using pg8::bf16x8; using pg8::f32x4; using pg8::u32x4; using pg8::Unit; using pg8::cvt_pk_bf16;
typedef unsigned u32x2 __attribute__((ext_vector_type(2)));

constexpr int DM = 1024, TP = 16384, NSM = 512, MT = TP + NSM, INC = 2304, DFF = 2816, PLE = 256;
constexpr int ZQ = 0, ZF = 256, ZI = 512, ZG = 768, ZBU = 1024, ZBG = 1280, ZCQ = 1536, ZCK = 2048, ZCV = 2176;
constexpr float EPS = 1e-6f;
constexpr int NPOS = TP + 4;
constexpr size_t O_Y = 0, O_SPH = (size_t)MT * DM, O_SPC = O_SPH + 32768, O_SPK = O_SPC + 15360, O_SPV = O_SPK + 32768,
                 O_SSH = O_SPV + 32768, O_SSC = O_SSH + 4194304, O_SSK = O_SSC + 1966080, O_SSV = O_SSK + 4194304;
constexpr size_t MiB = 1u << 20;
constexpr size_t WS_CTL = 0, CTL_BYTES = 65536;
constexpr size_t WS_SS = 1 * MiB;
constexpr size_t WS_LB = WS_SS + 512 * 1024;
constexpr size_t WS_DVEC = WS_LB + 4096;
constexpr size_t WS_ROPE = 2 * MiB;
constexpr size_t WS_W = 7 * MiB;
constexpr size_t W_IN = 0, W_OUT = W_IN + (size_t)INC * DM * 2, W_GU = W_OUT + (size_t)DM * DM * 2, W_D = W_GU + (size_t)2 * DFF * DM * 2,
                 W_PG = W_D + (size_t)DM * DFF * 2, W_PP = W_PG + (size_t)DM * DM * 2, W_LAYER = W_PP + (size_t)DM * PLE * 2;
constexpr size_t WS_BUFA = 59 * MiB, WS_BUFB = 92 * MiB, WS_ZACT = 125 * MiB, WS_PB = 216 * MiB, WS_DS = 233 * MiB, WS_END = 249 * MiB;
static_assert(WS_W + 2 * W_LAYER <= WS_BUFA && WS_BUFA + (size_t)MT * DM * 2 <= WS_BUFB && WS_BUFB + (size_t)MT * DM * 2 <= WS_ZACT, "ws map");
static_assert(WS_ZACT + (size_t)MT * DFF * 2 <= WS_PB && WS_PB + (size_t)2 * MT * PLE * 2 <= WS_DS && WS_ROPE + (size_t)NPOS * 64 * 4 <= WS_W, "ws map");
constexpr int LDS_BYTES = 147456, MISC_OFF = 131072 + 320;

#define LSYNC() do { asm volatile("s_waitcnt lgkmcnt(0)" ::: "memory"); __builtin_amdgcn_s_barrier(); asm volatile("" ::: "memory"); } while (0)
#define LDS_WAIT() asm volatile("s_waitcnt lgkmcnt(0)" ::: "memory")
__device__ __forceinline__ float bf2f(unsigned short h) { return __uint_as_float(((unsigned)h) << 16); }
template <int CTRL> __device__ __forceinline__ float dppf(float v) { return __int_as_float(__builtin_amdgcn_update_dpp(0, __float_as_int(v), CTRL, 0xf, 0xf, true)); }
__device__ __forceinline__ float wave_sum(float v) {
    v += dppf<0xB1>(v);
    v += dppf<0x4E>(v);
    v += dppf<0x141>(v);
    v += dppf<0x140>(v);
    const float r0 = __int_as_float(__builtin_amdgcn_readlane(__float_as_int(v), 0)), r1 = __int_as_float(__builtin_amdgcn_readlane(__float_as_int(v), 16));
    const float r2 = __int_as_float(__builtin_amdgcn_readlane(__float_as_int(v), 32)), r3 = __int_as_float(__builtin_amdgcn_readlane(__float_as_int(v), 48));
    return (r0 + r1) + (r2 + r3);
}
__device__ __forceinline__ float quad_sum(float v) { v += dppf<0xB1>(v); v += dppf<0x4E>(v); return v; }
__device__ __forceinline__ float sigmoidf_(float x) { return __builtin_amdgcn_rcpf(1.0f + __expf(-x)); }
__device__ __forceinline__ float siluf_(float x) { return x * __builtin_amdgcn_rcpf(1.0f + __expf(-x)); }
#define UNPACK8(V_, o) do { (o)[0] = __uint_as_float((V_).x << 16); (o)[1] = __uint_as_float((V_).x & 0xffff0000u); (o)[2] = __uint_as_float((V_).y << 16); (o)[3] = __uint_as_float((V_).y & 0xffff0000u); \
    (o)[4] = __uint_as_float((V_).z << 16); (o)[5] = __uint_as_float((V_).z & 0xffff0000u); (o)[6] = __uint_as_float((V_).w << 16); (o)[7] = __uint_as_float((V_).w & 0xffff0000u); } while (0)

#define XB_TMO      128
#define XB_XCNT(j)  (256  + 64 * (j))
#define XB_XSUB(j)  (1280 + 64 * (j))
#define XB_XGEN(j)  (2304 + 64 * (j))
#define XB_TOP      3328
#define XB_TOPGEN   3392
#define XCD_BAR_WORDS 3456
#define XB_SPIN_CAP (1u << 18)

__device__ __forceinline__ unsigned xb_ld(unsigned* p)              { return __hip_atomic_load(p, __ATOMIC_RELAXED, __HIP_MEMORY_SCOPE_AGENT); }
__device__ __forceinline__ unsigned xb_add(unsigned* p, unsigned v) { return __hip_atomic_fetch_add(p, v, __ATOMIC_RELAXED, __HIP_MEMORY_SCOPE_AGENT); }
__device__ __forceinline__ unsigned xb_xcc_id() { return (unsigned)__builtin_amdgcn_s_getreg((3 << 11) | 20) & 0xFu; }
#define XB_SPIN(cond, bar) do { unsigned _sp = 0; while (cond) { __builtin_amdgcn_s_sleep(1); \
    if ((++_sp & 255u) == 0u) { if (xb_ld(&(bar)[XB_TMO])) break; if (_sp > XB_SPIN_CAP) { atomicAdd(&(bar)[XB_TMO], 1u); break; } } } } while (0)

struct XcdBarrier {
    unsigned* bar; unsigned x; int wv;
    volatile LAS unsigned* st;
};

__device__ __forceinline__ XcdBarrier xcd_barrier_post(unsigned* bar, volatile LAS unsigned* st) {
    XcdBarrier b; b.bar = bar; b.x = xb_xcc_id(); b.st = st;
    if (threadIdx.x == 0) (void)xb_add(&bar[XB_XCNT(b.x)], 1u);
    return b;
}
__device__ __forceinline__ void xcd_barrier_complete(unsigned* bar, unsigned x, unsigned& nloc, unsigned& nx) {
    const unsigned G = gridDim.x * gridDim.y * gridDim.z;
    unsigned sum, cnt, mine, sp = 0u;
    for (;;) {
        sum = 0u; cnt = 0u; mine = 0u;
#pragma unroll
        for (unsigned j = 0; j < 16; ++j) { const unsigned c = xb_ld(&bar[XB_XCNT(j)]); sum += c; cnt += (c > 0u) ? 1u : 0u; mine = (j == x) ? c : mine; }
        if (sum == G) break;
        __builtin_amdgcn_s_sleep(1);
        if ((++sp & 255u) == 0u) { if (xb_ld(&bar[XB_TMO])) break; if (sp > XB_SPIN_CAP) { atomicAdd(&bar[XB_TMO], 1u); break; } }
    }
    nloc = mine > 0u ? mine : 1u; nx = cnt > 0u ? cnt : 1u;
}

__device__ __forceinline__ void xcd_barrier(const XcdBarrier& b) {
    asm volatile("s_waitcnt vmcnt(0)" ::: "memory");
    __syncthreads();
    unsigned xm_ = ~0u; asm volatile("" : "+s"(xm_));
    int xw_ = b.wv; asm volatile("" : "+s"(xw_));
    if (xw_ == 0 && __builtin_amdgcn_mbcnt_hi(xm_, __builtin_amdgcn_mbcnt_lo(xm_, 0u)) == 0u) {
        unsigned* bar = b.bar;
        __builtin_amdgcn_s_waitcnt(0);
        unsigned nloc = b.st[0], nx = b.st[1];
        if (nloc == 0u) { xcd_barrier_complete(bar, b.x, nloc, nx); b.st[0] = nloc; b.st[1] = nx; }
        const unsigned old = xb_add(&bar[XB_XSUB(b.x)], 1u);
        const unsigned gen = old / nloc;
        if (old + 1u == (gen + 1u) * nloc) {
            __builtin_amdgcn_fence(__ATOMIC_RELEASE, "agent");
            asm volatile("s_waitcnt vmcnt(0)" ::: "memory");
            const unsigned og = xb_add(&bar[XB_TOP], 1u);
            const unsigned tg = og / nx;
            if (og + 1u == (tg + 1u) * nx) xb_add(&bar[XB_TOPGEN], 1u);
            else XB_SPIN(xb_ld(&bar[XB_TOPGEN]) == tg, bar);
            __builtin_amdgcn_fence(__ATOMIC_ACQUIRE, "agent");
            xb_add(&bar[XB_XGEN(b.x)], 1u);
            asm volatile("s_waitcnt vmcnt(0)" ::: "memory");
        } else {
            XB_SPIN(xb_ld(&bar[XB_XGEN(b.x)]) == gen, bar);
            __builtin_amdgcn_fence(__ATOMIC_ACQUIRE, "agent");
            asm volatile("s_waitcnt vmcnt(0)" ::: "memory");
        }
    }
    __syncthreads();
}

struct EpiZ {
    static constexpr bool PERM = true, AFTER_DRAIN = false;
    bf16_t* O; int ldc; const float* ss;
    __device__ __forceinline__ void operator()(const f32x4 (&acc)[2][2][4][2], const Unit& u, int wr, int wc, int fr, int fq) const {
        const int row0 = u.pm * 256 + wr * 64 + fr, col0 = u.pn * 256 + wc * 32 + 8 * fq;
#pragma unroll
        for (int ai = 0; ai < 2; ++ai)
#pragma unroll
            for (int m = 0; m < 4; ++m) {
                const int row = row0 + ai * 128 + m * 16; const float r = rsqrtf(ss[row] * (1.0f / DM) + EPS);
                bf16_t* rowp = O + (size_t)row * ldc + col0;
#pragma unroll
                for (int bj = 0; bj < 2; ++bj) { const f32x4 v0 = acc[ai][bj][m][0] * r, v1 = acc[ai][bj][m][1] * r;
                    u32x4 w; w.x = cvt_pk_bf16(v0[0], v0[1]); w.y = cvt_pk_bf16(v0[2], v0[3]); w.z = cvt_pk_bf16(v1[0], v1[1]); w.w = cvt_pk_bf16(v1[2], v1[3]);
                    *(u32x4*)(rowp + bj * 128) = w; }
            }
    }
};
typedef float f32x2 __attribute__((ext_vector_type(2)));
struct EpiGU {
    static constexpr bool PERM = true, AFTER_DRAIN = false;
    bf16_t* O; const float* ss;
    __device__ __forceinline__ void operator()(const f32x4 (&acc)[2][2][4][2], const Unit& u, int wr, int wc, int fr, int fq) const {
        const int row0 = u.pm * 256 + wr * 64 + fr, col0 = u.pn * 128 + wc * 32 + 8 * fq;
#pragma unroll
        for (int ai = 0; ai < 2; ++ai)
#pragma unroll
            for (int m = 0; m < 4; ++m) {
                const int row = row0 + ai * 128 + m * 16; const float r = rsqrtf(ss[row] * (1.0f / DM) + EPS);
                const float rn = r * -1.44269504f, r2 = r * r;
                unsigned w4[4];
#pragma unroll
                for (int n = 0; n < 2; ++n)
#pragma unroll
                    for (int e = 0; e < 4; e += 2) {
                        const f32x2 g2 = (f32x2){acc[ai][0][m][n][e], acc[ai][0][m][n][e + 1]}, u2 = (f32x2){acc[ai][1][m][n][e], acc[ai][1][m][n][e + 1]};
                        const f32x2 t = g2 * rn; f32x2 ex; ex.x = __builtin_amdgcn_exp2f(t.x); ex.y = __builtin_amdgcn_exp2f(t.y);
                        const f32x2 d = ex + 1.0f; f32x2 rc; rc.x = __builtin_amdgcn_rcpf(d.x); rc.y = __builtin_amdgcn_rcpf(d.y);
                        const f32x2 o = (g2 * u2) * (rc * r2);
                        w4[n * 2 + (e >> 1)] = cvt_pk_bf16(o.x, o.y);
                    }
                u32x4 w; w.x = w4[0]; w.y = w4[1]; w.z = w4[2]; w.w = w4[3];
                *(u32x4*)(O + (size_t)row * DFF + col0) = w;
            }
    }
};
struct EpiRes {
    static constexpr bool PERM = false, AFTER_DRAIN = false;
    const bf16_t* res; bf16_t* Ob; float* ss;
    __device__ __forceinline__ void operator()(const f32x4 (&acc)[2][2][4][2], const Unit& u, int wr, int wc, int fr, int fq) const {
        const int row0 = u.pm * 256 + wr * 64 + fr, col0 = u.pn * 256 + wc * 32 + 4 * fq;
#pragma unroll
        for (int ai = 0; ai < 2; ++ai)
#pragma unroll
            for (int m = 0; m < 4; ++m) {
                const int row = row0 + ai * 128 + m * 16; const size_t off = (size_t)row * DM + col0; float sq = 0.f;
#pragma unroll
                for (int bj = 0; bj < 2; ++bj)
#pragma unroll
                    for (int n = 0; n < 2; ++n) { const size_t o2 = off + bj * 128 + n * 16;
                        const u32x2 rw = *(const u32x2*)(res + o2);
                        f32x4 v = acc[ai][bj][m][n]; v[0] += __uint_as_float(rw.x << 16); v[1] += __uint_as_float(rw.x & 0xffff0000u); v[2] += __uint_as_float(rw.y << 16); v[3] += __uint_as_float(rw.y & 0xffff0000u);
                        u32x2 w; w.x = cvt_pk_bf16(v[0], v[1]); w.y = cvt_pk_bf16(v[2], v[3]); *(u32x2*)(Ob + o2) = w;
                        sq += (v[0] * v[0] + v[1] * v[1]) + (v[2] * v[2] + v[3] * v[3]); }
                sq += __shfl_xor(sq, 16); sq += __shfl_xor(sq, 32);
                if (fq == 0) unsafeAtomicAdd(ss + row, sq);
            }
    }
};
struct EpiGate {
    static constexpr bool PERM = false, AFTER_DRAIN = false;
    bf16_t* Gt; const float* ss;
    __device__ __forceinline__ void operator()(const f32x4 (&acc)[2][2][4][2], const Unit& u, int wr, int wc, int fr, int fq) const {
        const int row0 = u.pm * 256 + wr * 64 + fr, col0 = u.pn * 256 + wc * 32 + 4 * fq;
#pragma unroll
        for (int ai = 0; ai < 2; ++ai)
#pragma unroll
            for (int m = 0; m < 4; ++m) {
                const int row = row0 + ai * 128 + m * 16; const size_t off = (size_t)row * DM + col0; const float r = rsqrtf(ss[row] * (1.0f / DM) + EPS);
#pragma unroll
                for (int bj = 0; bj < 2; ++bj)
#pragma unroll
                    for (int n = 0; n < 2; ++n) { const f32x4 a = acc[ai][bj][m][n] * r;
                        u32x2 w; w.x = cvt_pk_bf16(sigmoidf_(a[0]), sigmoidf_(a[1])); w.y = cvt_pk_bf16(sigmoidf_(a[2]), sigmoidf_(a[3]));
                        *(u32x2*)(Gt + off + bj * 128 + n * 16) = w; }
            }
    }
};
struct EpiOut {
    static constexpr bool PERM = false, AFTER_DRAIN = false;
    const bf16_t* Gt; const bf16_t* res; float* Y; bf16_t* Ob; float* ss; int final_;
    __device__ __forceinline__ void operator()(const f32x4 (&acc)[2][2][4][2], const Unit& u, int wr, int wc, int fr, int fq) const {
        const int row0 = u.pm * 256 + wr * 64 + fr, col0 = u.pn * 256 + wc * 32 + 4 * fq;
#pragma unroll
        for (int ai = 0; ai < 2; ++ai)
#pragma unroll
            for (int m = 0; m < 4; ++m) {
                const int row = row0 + ai * 128 + m * 16; const size_t off = (size_t)row * DM + col0; float sq = 0.f;
#pragma unroll
                for (int bj = 0; bj < 2; ++bj)
#pragma unroll
                    for (int n = 0; n < 2; ++n) { const size_t o2 = off + bj * 128 + n * 16;
                        const u32x2 rw = *(const u32x2*)(res + o2), gw = *(const u32x2*)(Gt + o2);
                        const f32x4 a = acc[ai][bj][m][n]; f32x4 v;
                        v[0] = __uint_as_float(rw.x << 16) + __uint_as_float(gw.x << 16) * a[0]; v[1] = __uint_as_float(rw.x & 0xffff0000u) + __uint_as_float(gw.x & 0xffff0000u) * a[1];
                        v[2] = __uint_as_float(rw.y << 16) + __uint_as_float(gw.y << 16) * a[2]; v[3] = __uint_as_float(rw.y & 0xffff0000u) + __uint_as_float(gw.y & 0xffff0000u) * a[3];
                        if (final_) *(f32x4*)(Y + o2) = v;
                        else { u32x2 w; w.x = cvt_pk_bf16(v[0], v[1]); w.y = cvt_pk_bf16(v[2], v[3]); *(u32x2*)(Ob + o2) = w; }
                        sq += (v[0] * v[0] + v[1] * v[1]) + (v[2] * v[2] + v[3] * v[3]); }
                if (!final_) { sq += __shfl_xor(sq, 16); sq += __shfl_xor(sq, 32); if (fq == 0) unsafeAtomicAdd(ss + row, sq); }
            }
    }
};

template <class Epi>
__device__ __forceinline__ void small_gemm(LAS unsigned char* lds, const bf16_t* A, const bf16_t* Bt, int K, const Epi& E, int bid, int tid, int lane, int wave) {
    if (bid >= 256) return;
    const int r0 = 64 * (bid >> 5), c0 = 32 * (bid & 31), fr = lane & 15, g = lane >> 4, kw = K >> 3;
    f32x4 acc[4][2];
#pragma unroll
    for (int m = 0; m < 4; ++m) { acc[m][0] = (f32x4){0.f, 0.f, 0.f, 0.f}; acc[m][1] = (f32x4){0.f, 0.f, 0.f, 0.f}; }
    const bf16_t* ap = A + (size_t)(r0 + fr) * K + wave * kw + 8 * g;
    const bf16_t* bp = Bt + (size_t)(c0 + fr) * K + wave * kw + 8 * g;
#pragma unroll 4
    for (int ks = 0; ks < kw; ks += 32) {
        bf16x8 a[4], b[2];
#pragma unroll
        for (int m = 0; m < 4; ++m) a[m] = *(const bf16x8*)(ap + (size_t)m * 16 * K + ks);
#pragma unroll
        for (int n = 0; n < 2; ++n) b[n] = *(const bf16x8*)(bp + (size_t)n * 16 * K + ks);
#pragma unroll
        for (int m = 0; m < 4; ++m)
#pragma unroll
            for (int n = 0; n < 2; ++n) acc[m][n] = __builtin_amdgcn_mfma_f32_16x16x32_bf16(a[m], b[n], acc[m][n], 0, 0, 0);
    }
    LAS float* P = (LAS float*)lds + wave * (64 * 33);
    LSYNC();
#pragma unroll
    for (int m = 0; m < 4; ++m)
#pragma unroll
        for (int n = 0; n < 2; ++n)
#pragma unroll
            for (int r = 0; r < 4; ++r) P[(16 * m + 4 * g + r) * 33 + 16 * n + fr] = acc[m][n][r];
    LSYNC();
    const int row = tid >> 3, c4 = (tid & 7) * 4;
    f32x4 v = (f32x4){0.f, 0.f, 0.f, 0.f};
#pragma unroll
    for (int w2 = 0; w2 < 8; ++w2) { const LAS float* q = (const LAS float*)lds + w2 * (64 * 33) + row * 33 + c4; v[0] += q[0]; v[1] += q[1]; v[2] += q[2]; v[3] += q[3]; }
    LSYNC();
    E.apply(r0 + row, c0 + c4, v, tid);
}
struct SEpiRes {
    const bf16_t* res; bf16_t* Ob; float* ss;
    __device__ __forceinline__ void apply(int row, int col, f32x4 v, int tid) const {
        const size_t o = (size_t)row * DM + col; const u32x2 rw = *(const u32x2*)(res + o);
        v[0] += __uint_as_float(rw.x << 16); v[1] += __uint_as_float(rw.x & 0xffff0000u); v[2] += __uint_as_float(rw.y << 16); v[3] += __uint_as_float(rw.y & 0xffff0000u);
        u32x2 w; w.x = cvt_pk_bf16(v[0], v[1]); w.y = cvt_pk_bf16(v[2], v[3]); *(u32x2*)(Ob + o) = w;
        float sq = (v[0] * v[0] + v[1] * v[1]) + (v[2] * v[2] + v[3] * v[3]);
        sq += __shfl_xor(sq, 1); sq += __shfl_xor(sq, 2); sq += __shfl_xor(sq, 4);
        if ((tid & 7) == 0) unsafeAtomicAdd(ss + row, sq);
    }
};
struct SEpiGate {
    bf16_t* Gt; const float* ss;
    __device__ __forceinline__ void apply(int row, int col, f32x4 v, int tid) const {
        const float r = rsqrtf(ss[row] * (1.0f / DM) + EPS);
        u32x2 w; w.x = cvt_pk_bf16(sigmoidf_(v[0] * r), sigmoidf_(v[1] * r)); w.y = cvt_pk_bf16(sigmoidf_(v[2] * r), sigmoidf_(v[3] * r));
        *(u32x2*)(Gt + (size_t)row * DM + col) = w;
    }
};
struct SEpiOut {
    const bf16_t* Gt; const bf16_t* res; float* Y; bf16_t* Ob; float* ss; int final_;
    __device__ __forceinline__ void apply(int row, int col, f32x4 a, int tid) const {
        const size_t o = (size_t)row * DM + col; const u32x2 rw = *(const u32x2*)(res + o), gw = *(const u32x2*)(Gt + o); f32x4 v;
        v[0] = __uint_as_float(rw.x << 16) + __uint_as_float(gw.x << 16) * a[0]; v[1] = __uint_as_float(rw.x & 0xffff0000u) + __uint_as_float(gw.x & 0xffff0000u) * a[1];
        v[2] = __uint_as_float(rw.y << 16) + __uint_as_float(gw.y << 16) * a[2]; v[3] = __uint_as_float(rw.y & 0xffff0000u) + __uint_as_float(gw.y & 0xffff0000u) * a[3];
        if (final_) { *(f32x4*)(Y + o) = v; return; }
        u32x2 w; w.x = cvt_pk_bf16(v[0], v[1]); w.y = cvt_pk_bf16(v[2], v[3]); *(u32x2*)(Ob + o) = w;
        float sq = (v[0] * v[0] + v[1] * v[1]) + (v[2] * v[2] + v[3] * v[3]);
        sq += __shfl_xor(sq, 1); sq += __shfl_xor(sq, 2); sq += __shfl_xor(sq, 4);
        if ((tid & 7) == 0) unsafeAtomicAdd(ss + row, sq);
    }
};

__device__ __forceinline__ void transpose_item(const float* W, int K, int N, const float* gain, bf16_t* WT, int mode, LAS float* scr, int item, int lane) {
    const int nblk = N / 32, kb = item / nblk, nb = item % nblk, k0 = 64 * kb, n0 = 32 * nb;
    { const int kr = lane >> 3, nq = (lane & 7) * 4; f32x4 v[8]; float gv[8];
#pragma unroll
      for (int i = 0; i < 8; ++i) { v[i] = *(const f32x4*)(W + (size_t)(k0 + 8 * i + kr) * N + n0 + nq); gv[i] = gain ? gain[k0 + 8 * i + kr] : 1.0f; }
#pragma unroll
      for (int i = 0; i < 8; ++i) { LAS float* d = scr + (8 * i + kr) * 33 + nq; d[0] = v[i][0] * gv[i]; d[1] = v[i][1] * gv[i]; d[2] = v[i][2] * gv[i]; d[3] = v[i][3] * gv[i]; } }
    LDS_WAIT(); asm volatile("" ::: "memory");
    const int drow0 = (mode == 0) ? n0 : (256 * (n0 >> 7) + (n0 & 127) + (mode == 2 ? 128 : 0));
    const int c = lane & 7;
#pragma unroll
    for (int j = 0; j < 4; ++j) { const int n = (lane >> 3) + 8 * j; const LAS float* s = scr + (8 * c) * 33 + n;
        u32x4 o; o.x = cvt_pk_bf16(s[0 * 33], s[1 * 33]); o.y = cvt_pk_bf16(s[2 * 33], s[3 * 33]); o.z = cvt_pk_bf16(s[4 * 33], s[5 * 33]); o.w = cvt_pk_bf16(s[6 * 33], s[7 * 33]);
        *(u32x4*)(WT + (size_t)(drow0 + n) * K + k0 + 8 * c) = o; }
    LDS_WAIT(); asm volatile("" ::: "memory");
}

struct Args { const float* in[27]; float* out; unsigned char* ws; };
constexpr int PT_OFF = 131072 + 1024;
__device__ __forceinline__ int opaque(int x) { asm volatile("" : "+v"(x)); return x; }
__device__ __forceinline__ int lane_id_opaque() { unsigned m_ = ~0u; asm volatile("" : "+s"(m_)); return (int)__builtin_amdgcn_mbcnt_hi(m_, __builtin_amdgcn_mbcnt_lo(m_, 0u)); }
__device__ __forceinline__ const float* ptf(LAS unsigned char* lds, int i) {
    const unsigned long long v = ((LAS const unsigned long long*)(lds + PT_OFF))[i];
    const unsigned lo = __builtin_amdgcn_readfirstlane((unsigned)v), hi = __builtin_amdgcn_readfirstlane((unsigned)(v >> 32));
    return (const float*)(((unsigned long long)hi << 32) | lo);
}
#define IN(i) ptf(lds, (i))
#define OUTP ((float*)ptf(lds, 27))
#define WSP ((unsigned char*)ptf(lds, 28))

constexpr int CI_OUT = (DM / 64) * (INC / 32), CI_GG = CI_OUT + (DM / 64) * (DM / 32), CI_GU = CI_GG + (DM / 64) * (DFF / 32), CI_D = CI_GU + (DM / 64) * (DFF / 32),
              CI_PG = CI_D + (DFF / 64) * (DM / 32), CI_PP = CI_PG + (DM / 64) * (DM / 32), CI_LAYER = CI_PP + (PLE / 64) * (DM / 32);
__device__ __forceinline__ void convert_item(LAS unsigned char* lds, unsigned char* ws, LAS float* scr, int it, int lane) {
    const int l = it / CI_LAYER; int r = it - l * CI_LAYER;
    const float* W; const float* gain = nullptr; int K = DM, N = DM, mode = 0; size_t woff;
    if (r < CI_OUT) { W = IN(9) + (size_t)l * DM * INC; N = INC; gain = IN(19) + l * DM; woff = W_IN; }
    else if (r < CI_GG) { r -= CI_OUT; W = IN(18) + (size_t)l * DM * DM; woff = W_OUT; }
    else if (r < CI_GU) { r -= CI_GG; W = IN(21) + (size_t)l * DM * DFF; N = DFF; gain = IN(20) + l * DM; woff = W_GU; mode = 1; }
    else if (r < CI_D) { r -= CI_GU; W = IN(22) + (size_t)l * DM * DFF; N = DFF; gain = IN(20) + l * DM; woff = W_GU; mode = 2; }
    else if (r < CI_PG) { r -= CI_D; W = IN(23) + (size_t)l * DFF * DM; K = DFF; woff = W_D; }
    else if (r < CI_PP) { r -= CI_PG; W = IN(25) + (size_t)l * DM * DM; gain = IN(24) + l * DM; woff = W_PG; }
    else { r -= CI_PP; W = IN(26) + (size_t)l * PLE * DM; K = PLE; woff = W_PP; }
    transpose_item(W, K, N, gain, (bf16_t*)(ws + WS_W + (size_t)l * W_LAYER + woff), mode, scr, r, lane);
}
__device__ __forceinline__ void prologue(LAS unsigned char* lds, int wv) {
    { unsigned z_ = 0; asm volatile("" : "+s"(z_)); lds += z_; }
    int wave_ = wv; asm volatile("" : "+s"(wave_)); const int wave = wave_, lane = lane_id_opaque(), tid = wave * 64 + lane;
    const int G = gridDim.x, bid = blockIdx.x, gw = bid * 8 + wave, NGW = G * 8, gtid = bid * 512 + tid, NT = G * 512;
    unsigned char* ws = WSP;
    LAS float* scr = (LAS float*)(lds + wave * 16384);
#pragma unroll 1
    for (int k = gw; k < CI_D + (CI_D - CI_OUT); k += NGW) convert_item(lds, ws, scr, (k < CI_D) ? k : (CI_LAYER + CI_OUT + (k - CI_D)), lane);
    float* ss = (float*)(ws + WS_SS);
    bf16_t* bufA = (bf16_t*)(ws + WS_BUFA);
    const float* xP = IN(0); const float* xS = IN(1);
#pragma unroll 1
    for (int m0 = gw; m0 < MT; m0 += 2 * NGW) {
        f32x4 v[2][4];
#pragma unroll
        for (int q = 0; q < 2; ++q) { const int m = (m0 + q * NGW < MT) ? m0 + q * NGW : m0; const float* xr = (m < TP) ? xP + (size_t)m * DM : xS + (size_t)(m - TP) * DM;
#pragma unroll
            for (int j = 0; j < 4; ++j) v[q][j] = ((const f32x4*)xr)[lane + 64 * j]; }
#pragma unroll
        for (int q = 0; q < 2; ++q) { const int m = (m0 + q * NGW < MT) ? m0 + q * NGW : m0; float s = 0.f;
#pragma unroll
            for (int j = 0; j < 4; ++j) s += (v[q][j][0] * v[q][j][0] + v[q][j][1] * v[q][j][1]) + (v[q][j][2] * v[q][j][2] + v[q][j][3] * v[q][j][3]);
            s = wave_sum(s); if (lane == 0) ss[m] = s;
#pragma unroll
            for (int j = 0; j < 4; ++j) { u32x2 w; w.x = cvt_pk_bf16(v[q][j][0], v[q][j][1]); w.y = cvt_pk_bf16(v[q][j][2], v[q][j][3]); ((u32x2*)(bufA + (size_t)m * DM))[lane + 64 * j] = w; } }
    }
    float* rc = (float*)(ws + WS_ROPE); float* rs = rc + (size_t)NPOS * 32;
#pragma unroll 1
    for (int idx = gtid; idx < NPOS * 32; idx += NT) {
        const int pos = idx >> 5, d = idx & 31;
        const double inv = exp2(-(double)d * (13.287712379549449 / 32.0));
        double rev = (double)pos * inv * 0.15915494309189535; rev -= rint(rev);
        const float fr = (float)rev;
        rc[idx] = __builtin_amdgcn_cosf(fr); rs[idx] = __builtin_amdgcn_sinf(fr);
    }
    if (gtid < 256) { float* lb = (float*)(ws + WS_LB); const float* al = IN(8); const float a0 = al[gtid], a1 = al[256 + gtid]; lb[gtid] = 0.f; lb[256 + gtid] = 1.0f / (1.0f + expf(a0 - a1)); }
#pragma unroll 1
    for (int idx = gtid; idx < 5 * MT; idx += NT) ss[MT + idx] = 0.f;
}

__device__ __forceinline__ void hgrn_gates(float z, float lb, float& logf_, float& kin) {
    const float e = __expf(-fabsf(z));
    const float inv = __builtin_amdgcn_rcpf(1.0f + e);
    const float big = inv, small = e * inv;
    const float sp = (z >= 0.f) ? big : small;
    const float sn = (z >= 0.f) ? small : big;
    kin = (1.0f - lb) * sn;
    if (lb > 0.f) logf_ = __logf(lb + (1.0f - lb) * sp);
    else logf_ = fminf(z, 0.f) - __logf(1.0f + e);
}

#define HGRN_G(zbase, lbv, tot) \
    float Gl[8], kin[8]; float Gend = 0.f, Gref = 0.f; { float run = 0.f; \
    _Pragma("unroll") for (int i = 0; i < 8; ++i) { float g; hgrn_gates(bf2f((zbase)[(size_t)(8 * wave + i) * INC + ZF]), lbv, g, kin[i]); run += g; Gl[i] = run; } \
    (tot)[wave * 64 + lane] = run; LSYNC(); float off = 0.f; \
    _Pragma("unroll") for (int w2 = 0; w2 < 8; ++w2) { const float t = (tot)[w2 * 64 + lane]; if (w2 < wave) off += t; if (w2 < 4) Gref += t; Gend += t; } \
    _Pragma("unroll") for (int i = 0; i < 8; ++i) Gl[i] += off; }

#define HGRN_G2(zf, lbv, tot) \
    float Gl[8], kin[8]; float Gend = 0.f, Gref = 0.f; { float run = 0.f; \
    _Pragma("unroll") for (int i = 0; i < 8; ++i) { float g; hgrn_gates((zf)[i], lbv, g, kin[i]); run += g; Gl[i] = run; } \
    (tot)[wave * 64 + lane] = run; LSYNC(); float off = 0.f; \
    _Pragma("unroll") for (int w2 = 0; w2 < 8; ++w2) { const float t = (tot)[w2 * 64 + lane]; if (w2 < wave) off += t; if (w2 < 4) Gref += t; Gend += t; } \
    _Pragma("unroll") for (int i = 0; i < 8; ++i) Gl[i] += off; }
__device__ __forceinline__ void hgrn_ds_item(const unsigned (&zfu)[8], const unsigned (&vi)[8], const float* lbp, float* dS, float* dvec, LAS unsigned char* lds, int c, int h, int tid, int lane, int wave) {
    LAS bf16_t* KTt = (LAS bf16_t*)lds;
    LAS bf16_t* Vt = KTt + 64 * 72;
    LAS float* TOT = (LAS float*)(Vt + 64 * 72);
    float zf[8];
#pragma unroll
    for (int i = 0; i < 8; ++i) zf[i] = __uint_as_float(zfu[i] << 16);
    const float lbv = lbp[h * 64 + lane];
    LSYNC();
    HGRN_G2(zf, lbv, TOT)
    { float kt[8];
#pragma unroll
      for (int i = 0; i < 8; ++i) kt[i] = kin[i] * __expf(Gend - Gl[i]);
      u32x4 kw; kw.x = cvt_pk_bf16(kt[0], kt[1]); kw.y = cvt_pk_bf16(kt[2], kt[3]); kw.z = cvt_pk_bf16(kt[4], kt[5]); kw.w = cvt_pk_bf16(kt[6], kt[7]);
      u32x4 vw; vw.x = vi[0] | (vi[1] << 16); vw.y = vi[2] | (vi[3] << 16); vw.z = vi[4] | (vi[5] << 16); vw.w = vi[6] | (vi[7] << 16);
      *(LAS u32x4*)(KTt + lane * 72 + 8 * wave) = kw; *(LAS u32x4*)(Vt + lane * 72 + 8 * wave) = vw; }
    if (wave == 0) dvec[(c * 4 + h) * 64 + lane] = __expf(Gend);
    LSYNC();
    const int fr = lane & 15, g = lane >> 4, kt4 = wave >> 1, vt0 = 2 * (wave & 1);
    f32x4 acc[2] = {(f32x4){0.f, 0.f, 0.f, 0.f}, (f32x4){0.f, 0.f, 0.f, 0.f}};
#pragma unroll
    for (int ks = 0; ks < 2; ++ks) {
        const bf16x8 kb = *(const LAS bf16x8*)(KTt + (16 * kt4 + fr) * 72 + 32 * ks + 8 * g);
#pragma unroll
        for (int n = 0; n < 2; ++n) { const bf16x8 va = *(const LAS bf16x8*)(Vt + (16 * (vt0 + n) + fr) * 72 + 32 * ks + 8 * g);
            acc[n] = __builtin_amdgcn_mfma_f32_16x16x32_bf16(va, kb, acc[n], 0, 0, 0); }
    }
    float* dst = dS + (size_t)(c * 4 + h) * 4096 + (16 * kt4 + fr) * 64 + 4 * g;
#pragma unroll
    for (int n = 0; n < 2; ++n) *(f32x4*)(dst + 16 * (vt0 + n)) = acc[n];
}

__device__ __forceinline__ void hgrn_out_item(const bf16_t* z, const float* lbp, const float* dS, const float* onorm, bf16_t* mix, LAS unsigned char* lds, int c, int hp, int tid, int lane, int wave) {
    const int hh = wave >> 2, wq = wave & 3, h = 2 * hp + hh, fr = lane & 15, g = lane >> 4;
    LAS bf16_t* QT = (LAS bf16_t*)(lds + hh * 46080);
    LAS bf16_t* KT = QT + 4608;
    LAS bf16_t* QS = KT + 4608;
    LAS bf16_t* Vt = QS + 4608;
    LAS bf16_t* St = Vt + 4608;
    LAS float* TOT = (LAS float*)(lds + 92160) + hh * 256;
    const bf16_t* zb = z + (size_t)(64 * c + 16 * wq) * INC + h * 64 + lane;
    unsigned zfu[16], zqu[16], ziu[16];
#pragma unroll
    for (int i = 0; i < 16; ++i) { zfu[i] = zb[(size_t)i * INC + ZF]; zqu[i] = zb[(size_t)i * INC + ZQ]; ziu[i] = zb[(size_t)i * INC + ZI]; }
    f32x4 sv[4];
#pragma unroll
    for (int j4 = 0; j4 < 4; ++j4) sv[j4] = *(const f32x4*)(dS + (size_t)(c * 4 + h) * 4096 + j4 * 1024 + (wq * 64 + lane) * 4);
    const size_t mt = (size_t)(64 * c + 16 * wq + fr);
    u32x2 gz[4];
#pragma unroll
    for (int vt = 0; vt < 4; ++vt) gz[vt] = *(const u32x2*)(z + mt * INC + ZG + h * 64 + 16 * vt + 4 * g);
    const float lbv = lbp[h * 64 + lane];
    LSYNC();
    float Gl[16], kin[16];
    { float run = 0.f;
#pragma unroll
      for (int i = 0; i < 16; ++i) { float gg; hgrn_gates(__uint_as_float(zfu[i] << 16), lbv, gg, kin[i]); run += gg; Gl[i] = run; }
      TOT[wq * 64 + lane] = run; }
    LSYNC();
    float off = 0.f, Gref = 0.f;
#pragma unroll
    for (int w2 = 0; w2 < 4; ++w2) { const float t = TOT[w2 * 64 + lane]; if (w2 < wq) off += t; if (w2 < 2) Gref += t; }
#pragma unroll
    for (int i = 0; i < 16; ++i) { const float G = Gl[i] + off, q = __uint_as_float(zqu[i] << 16); const int s = 16 * wq + i;
        QT[s * 72 + lane] = (bf16_t)(cvt_pk_bf16(q * __expf(fminf(G - Gref, 80.f)), 0.f) & 0xffffu);
        KT[s * 72 + lane] = (bf16_t)(cvt_pk_bf16(kin[i] * __expf(fminf(Gref - G, 80.f)), 0.f) & 0xffffu);
        QS[s * 72 + lane] = (bf16_t)(cvt_pk_bf16(q * __expf(G), 0.f) & 0xffffu); }
    { u32x4 v0, v1; v0.x = ziu[0] | (ziu[1] << 16); v0.y = ziu[2] | (ziu[3] << 16); v0.z = ziu[4] | (ziu[5] << 16); v0.w = ziu[6] | (ziu[7] << 16);
      v1.x = ziu[8] | (ziu[9] << 16); v1.y = ziu[10] | (ziu[11] << 16); v1.z = ziu[12] | (ziu[13] << 16); v1.w = ziu[14] | (ziu[15] << 16);
      *(LAS u32x4*)(Vt + lane * 72 + 16 * wq) = v0; *(LAS u32x4*)(Vt + lane * 72 + 16 * wq + 8) = v1; }
#pragma unroll
    for (int j4 = 0; j4 < 4; ++j4) { const int e = j4 * 1024 + (wq * 64 + lane) * 4, k = e >> 6, v = e & 63;
#pragma unroll
        for (int i = 0; i < 4; ++i) St[(v + i) * 72 + k] = (bf16_t)(cvt_pk_bf16(sv[j4][i], 0.f) & 0xffffu); }
    LSYNC();
    const int tt = wq;
    bf16x8 qb0 = *(const LAS bf16x8*)(QT + (16 * tt + fr) * 72 + 8 * g), qb1 = *(const LAS bf16x8*)(QT + (16 * tt + fr) * 72 + 32 + 8 * g);
    f32x4 at[4];
#pragma unroll
    for (int st = 0; st < 4; ++st) {
        at[st] = (f32x4){0.f, 0.f, 0.f, 0.f};
        if (st <= tt) {
            const bf16x8 k0 = *(const LAS bf16x8*)(KT + (16 * st + fr) * 72 + 8 * g), k1 = *(const LAS bf16x8*)(KT + (16 * st + fr) * 72 + 32 + 8 * g);
            f32x4 acc = (f32x4){0.f, 0.f, 0.f, 0.f};
            acc = __builtin_amdgcn_mfma_f32_16x16x32_bf16(k0, qb0, acc, 0, 0, 0);
            acc = __builtin_amdgcn_mfma_f32_16x16x32_bf16(k1, qb1, acc, 0, 0, 0);
            if (st == tt) {
#pragma unroll
                for (int r = 0; r < 4; ++r) acc[r] = (4 * g + r <= fr) ? acc[r] : 0.f; }
            at[st] = acc;
        }
    }
    f32x4 o[4];
#pragma unroll
    for (int vt = 0; vt < 4; ++vt) o[vt] = (f32x4){0.f, 0.f, 0.f, 0.f};
#pragma unroll
    for (int u = 0; u < 2; ++u) {
        if (2 * u <= tt) {
            u32x4 pw; pw.x = cvt_pk_bf16(at[2 * u][0], at[2 * u][1]); pw.y = cvt_pk_bf16(at[2 * u][2], at[2 * u][3]);
            pw.z = cvt_pk_bf16(at[2 * u + 1][0], at[2 * u + 1][1]); pw.w = cvt_pk_bf16(at[2 * u + 1][2], at[2 * u + 1][3]);
            const bf16x8 pf = __builtin_bit_cast(bf16x8, pw);
#pragma unroll
            for (int vt = 0; vt < 4; ++vt) {
                const LAS bf16_t* vp = Vt + (16 * vt + fr) * 72 + 32 * u + 4 * g;
                u32x4 vw; const u32x2 lo = *(const LAS u32x2*)vp, hi = *(const LAS u32x2*)(vp + 16); vw.x = lo.x; vw.y = lo.y; vw.z = hi.x; vw.w = hi.y;
                o[vt] = __builtin_amdgcn_mfma_f32_16x16x32_bf16(__builtin_bit_cast(bf16x8, vw), pf, o[vt], 0, 0, 0);
            }
        }
    }
#pragma unroll
    for (int ks = 0; ks < 2; ++ks) {
        const bf16x8 qs = *(const LAS bf16x8*)(QS + (16 * tt + fr) * 72 + 32 * ks + 8 * g);
#pragma unroll
        for (int vt = 0; vt < 4; ++vt) { const bf16x8 sa = *(const LAS bf16x8*)(St + (16 * vt + fr) * 72 + 32 * ks + 8 * g);
            o[vt] = __builtin_amdgcn_mfma_f32_16x16x32_bf16(sa, qs, o[vt], 0, 0, 0); }
    }
    float sq = 0.f;
#pragma unroll
    for (int vt = 0; vt < 4; ++vt) sq += (o[vt][0] * o[vt][0] + o[vt][1] * o[vt][1]) + (o[vt][2] * o[vt][2] + o[vt][3] * o[vt][3]);
    sq += __shfl_xor(sq, 16); sq += __shfl_xor(sq, 32);
    const float rn = rsqrtf(sq * (1.0f / 64.0f) + EPS);
#pragma unroll
    for (int vt = 0; vt < 4; ++vt) {
        const f32x4 nv = *(const f32x4*)(onorm + 16 * vt + 4 * g);
        const float g0 = __uint_as_float(gz[vt].x << 16), g1 = __uint_as_float(gz[vt].x & 0xffff0000u), g2 = __uint_as_float(gz[vt].y << 16), g3 = __uint_as_float(gz[vt].y & 0xffff0000u);
        u32x2 w; w.x = cvt_pk_bf16(o[vt][0] * rn * nv[0] * siluf_(g0), o[vt][1] * rn * nv[1] * siluf_(g1)); w.y = cvt_pk_bf16(o[vt][2] * rn * nv[2] * siluf_(g2), o[vt][3] * rn * nv[3] * siluf_(g3));
        *(u32x2*)(mix + mt * DM + h * 64 + 16 * vt + 4 * g) = w;
    }
}

__device__ __forceinline__ void hgrn_sample_item(const bf16_t* z, const float* lbp, const float* S0, float* Sout, const float* onorm, bf16_t* mix, LAS unsigned char* lds, int b, int hp, int tid, int lane, int wave) {
    LAS float* F = (LAS float*)lds; LAS float* KI = F + 512; LAS float* Q = KI + 512; LAS float* V = Q + 512;
    LAS float* RED = V + 512;
    const int hh = wave >> 2, kq = wave & 3, h = 2 * hp + hh;
    float S[16];
    { const float* sp = S0 + (size_t)h * 4096 + (16 * kq) * 64 + lane;
#pragma unroll
      for (int i = 0; i < 16; ++i) S[i] = sp[i * 64]; }
    const int t0 = tid >> 7, hk = tid & 127;
    const bf16_t* zr = z + ((size_t)TP + 4 * b + t0) * INC + hp * 128 + hk;
    const float zf = bf2f(zr[ZF]), q0 = bf2f(zr[ZQ]), vi = bf2f(zr[ZI]); const float lb = lbp[hp * 128 + hk];
    LSYNC();
    { const float e = __expf(-fabsf(zf)); const float sp = (zf >= 0.f) ? 1.0f / (1.0f + e) : e / (1.0f + e); const float sn = (zf >= 0.f) ? e / (1.0f + e) : 1.0f / (1.0f + e);
      F[tid] = lb + (1.0f - lb) * sp; KI[tid] = (1.0f - lb) * sn; Q[tid] = q0; V[tid] = vi; }
    LSYNC();
#pragma unroll
    for (int t = 0; t < 4; ++t) {
        const float vt = V[t * 128 + hh * 64 + lane]; float part = 0.f;
#pragma unroll
        for (int i = 0; i < 16; ++i) { const int k = t * 128 + hh * 64 + 16 * kq + i; S[i] = F[k] * S[i] + KI[k] * vt; part += S[i] * Q[k]; }
        RED[((t * 2 + hh) * 4 + kq) * 64 + lane] = part;
    }
    { float* so = Sout + (size_t)h * 4096 + (16 * kq) * 64 + lane;
#pragma unroll
      for (int i = 0; i < 16; ++i) so[i * 64] = S[i]; }
    LSYNC();
    { const int t = wave >> 1, hh2 = wave & 1, h2 = 2 * hp + hh2; const size_t m = (size_t)TP + 4 * b + t;
      float o = 0.f;
#pragma unroll
      for (int k4 = 0; k4 < 4; ++k4) o += RED[((t * 2 + hh2) * 4 + k4) * 64 + lane];
      const float r = rsqrtf(wave_sum(o * o) * (1.0f / 64.0f) + EPS);
      const float res = o * r * onorm[lane] * siluf_(bf2f(z[m * INC + ZG + h2 * 64 + lane]));
      mix[m * DM + h2 * 64 + lane] = (bf16_t)(cvt_pk_bf16(res, 0.f) & 0xffffu); }
}

template <int NTOK>
__device__ __forceinline__ void conv_compute(const LAS float* U, int r0, size_t m0, const float* cw, const float* cb, const float* lng, const float* lnb, bf16_t* mix, int lane, int wave) {
    const int ch = 64 * (wave & 3) + lane;
    float w[31];
#pragma unroll
    for (int j = 0; j < 31; ++j) w[j] = cw[j * 256 + ch];
    const float bias = cb[ch], g = lng[ch], be = lnb[ch];
    constexpr int TG = (NTOK >= 4) ? 4 : NTOK;
#pragma unroll 1
    for (int tg = 0; tg < NTOK / TG; ++tg) {
        float y[TG];
#pragma unroll
        for (int t = 0; t < TG; ++t) y[t] = bias;
        const LAS float* up = U + (r0 + TG * tg) * 256 + ch;
#pragma unroll
        for (int j = 0; j < TG + 30; ++j) { const float u = up[j * 256];
#pragma unroll
            for (int t = 0; t < TG; ++t) { if (j - t >= 0 && j - t < 31) y[t] += w[j - t] * u; } }
#pragma unroll
        for (int t = 0; t < TG; ++t) {
            const float mu = wave_sum(y[t]) * (1.0f / 64.0f); const float d = y[t] - mu;
            const float var = wave_sum(d * d) * (1.0f / 64.0f);
            const float o = siluf_(d * rsqrtf(var + EPS) * g + be);
            mix[(m0 + TG * tg + t) * DM + 256 + ch] = (bf16_t)(cvt_pk_bf16(o, 0.f) & 0xffffu);
        }
    }
}
__device__ __forceinline__ void conv_prompt_item(const bf16_t* z, const float* cw, const float* cb, const float* lng, const float* lnb, bf16_t* mix, float* spc, LAS unsigned char* lds, int ct, int tid, int lane, int wave) {
    LAS float* U = (LAS float*)lds;
    const int t0 = 64 * ct;
    u32x4 ra[6], rb[6];
#pragma unroll
    for (int it = 0; it < 6; ++it) { const int r = it * 16 + (tid >> 5), cg8 = (tid & 31) * 8; int tok = t0 - 30 + r; tok = tok < 0 ? 0 : tok;
        const bf16_t* zr = z + (size_t)tok * INC; ra[it] = *(const u32x4*)(zr + ZBU + cg8); rb[it] = *(const u32x4*)(zr + ZBG + cg8); }
    LSYNC();
#pragma unroll
    for (int it = 0; it < 6; ++it) { const int r = it * 16 + (tid >> 5), cg8 = (tid & 31) * 8; const bool ok = (t0 - 30 + r) >= 0;
        float fa[8], fb[8], u[8]; UNPACK8(ra[it], fa); UNPACK8(rb[it], fb);
#pragma unroll
        for (int j = 0; j < 8; ++j) u[j] = ok ? fa[j] * sigmoidf_(fb[j]) : 0.f;
        *(LAS f32x4*)(U + r * 256 + cg8) = (f32x4){u[0], u[1], u[2], u[3]}; *(LAS f32x4*)(U + r * 256 + cg8 + 4) = (f32x4){u[4], u[5], u[6], u[7]}; }
    LSYNC();
    conv_compute<32>(U, 32 * (wave >> 2), (size_t)t0 + 32 * (wave >> 2), cw, cb, lng, lnb, mix, lane, wave);
    if (ct == 255) for (int idx = tid; idx < 30 * 256; idx += 512) spc[idx] = U[(64 + (idx >> 8)) * 256 + (idx & 255)];
}
__device__ __forceinline__ void conv_sample_item(const bf16_t* z, const float* sconv, const float* cw, const float* cb, const float* lng, const float* lnb, bf16_t* mix, float* ssc, LAS unsigned char* lds, int b, int tid, int lane, int wave) {
    LAS float* U = (LAS float*)lds;
    float hv[15];
#pragma unroll
    for (int it = 0; it < 15; ++it) hv[it] = sconv[(size_t)b * 30 * 256 + it * 512 + tid];
    float nu[2];
#pragma unroll
    for (int it = 0; it < 2; ++it) { const int idx = it * 512 + tid, t = idx >> 8, ch = idx & 255; const bf16_t* zr = z + ((size_t)TP + 4 * b + t) * INC;
        nu[it] = bf2f(zr[ZBU + ch]) * sigmoidf_(bf2f(zr[ZBG + ch])); }
    LSYNC();
#pragma unroll
    for (int it = 0; it < 15; ++it) U[it * 512 + tid] = hv[it];
#pragma unroll
    for (int it = 0; it < 2; ++it) U[30 * 256 + it * 512 + tid] = nu[it];
    LSYNC();
    conv_compute<2>(U, 2 * (wave >> 2), (size_t)TP + 4 * b + 2 * (wave >> 2), cw, cb, lng, lnb, mix, lane, wave);
#pragma unroll
    for (int it = 0; it < 15; ++it) ssc[(size_t)b * 30 * 256 + it * 512 + tid] = U[4 * 256 + it * 512 + tid];
}

constexpr int KSTR = 72, VSTR = 280;
#define NORM_ROPE(rowp, gain, pos, g, sh1, sh2, x1, x2) do { \
    const u32x4 _lo = *(const u32x4*)((rowp) + 8 * (g)), _hi = *(const u32x4*)((rowp) + 32 + 8 * (g)); float _a[8], _b[8]; UNPACK8(_lo, _a); UNPACK8(_hi, _b); \
    float _sq = 0.f; _Pragma("unroll") for (int _j = 0; _j < 8; ++_j) _sq += _a[_j] * _a[_j] + _b[_j] * _b[_j]; \
    _sq += __shfl_xor(_sq, sh1); _sq += __shfl_xor(_sq, sh2); const float _r = rsqrtf(_sq * (1.0f / 64.0f) + EPS); \
    const float* _cp = rope_c + (size_t)(pos) * 32 + 8 * (g); const float* _sp = rope_s + (size_t)(pos) * 32 + 8 * (g); \
    _Pragma("unroll") for (int _j = 0; _j < 8; ++_j) { const float _y1 = _a[_j] * _r * (gain)[8 * (g) + _j], _y2 = _b[_j] * _r * (gain)[32 + 8 * (g) + _j]; const float _c = _cp[_j], _s = _sp[_j]; \
        (x1)[_j] = _y1 * _c - _y2 * _s; (x2)[_j] = _y2 * _c + _y1 * _s; } } while (0)

__device__ __forceinline__ void attn_qtile(const LAS bf16_t* Kl, const LAS bf16_t* Vt, bf16x8 q0, bf16x8 q1, int i, int T0, int jmin, float sink, bf16_t* outp, int lane) {
    const int fr = lane & 15, g = lane >> 4;
    f32x4 s[9];
#pragma unroll
    for (int T = 0; T < 9; ++T) {
        const LAS bf16_t* kp = Kl + (16 * (T0 + T) + fr) * KSTR + 8 * g;
        const bf16x8 k0 = *(const LAS bf16x8*)kp, k1 = *(const LAS bf16x8*)(kp + 32);
        f32x4 acc = (f32x4){0.f, 0.f, 0.f, 0.f};
        acc = __builtin_amdgcn_mfma_f32_16x16x32_bf16(k0, q0, acc, 0, 0, 0);
        acc = __builtin_amdgcn_mfma_f32_16x16x32_bf16(k1, q1, acc, 0, 0, 0);
        s[T] = acc;
    }
    float mx = sink;
#pragma unroll
    for (int T = 0; T < 9; ++T)
#pragma unroll
        for (int r = 0; r < 4; ++r) { const int j = 16 * (T0 + T) + 4 * g + r; const bool valid = (j >= i) && (j <= i + 128) && (j >= jmin);
            s[T][r] = valid ? s[T][r] : -INFINITY; mx = fmaxf(mx, s[T][r]); }
    mx = fmaxf(mx, __shfl_xor(mx, 16)); mx = fmaxf(mx, __shfl_xor(mx, 32));
    float sum = 0.f;
#pragma unroll
    for (int T = 0; T < 9; ++T)
#pragma unroll
        for (int r = 0; r < 4; ++r) { const float p = __expf(s[T][r] - mx); s[T][r] = p; sum += p; }
    sum += __shfl_xor(sum, 16); sum += __shfl_xor(sum, 32);
    const float inv = 1.0f / (sum + __expf(sink - mx));
    f32x4 o[4];
#pragma unroll
    for (int dt = 0; dt < 4; ++dt) o[dt] = (f32x4){0.f, 0.f, 0.f, 0.f};
#pragma unroll
    for (int u = 0; u < 5; ++u) {
        u32x4 pw; pw.x = cvt_pk_bf16(s[2 * u][0], s[2 * u][1]); pw.y = cvt_pk_bf16(s[2 * u][2], s[2 * u][3]);
        if (u < 4) { pw.z = cvt_pk_bf16(s[2 * u + 1 > 8 ? 8 : 2 * u + 1][0], s[2 * u + 1 > 8 ? 8 : 2 * u + 1][1]); pw.w = cvt_pk_bf16(s[2 * u + 1 > 8 ? 8 : 2 * u + 1][2], s[2 * u + 1 > 8 ? 8 : 2 * u + 1][3]); }
        else { pw.z = 0u; pw.w = 0u; }
        const bf16x8 pf = __builtin_bit_cast(bf16x8, pw);
#pragma unroll
        for (int dt = 0; dt < 4; ++dt) {
            const LAS bf16_t* vp = Vt + (16 * dt + fr) * VSTR + 16 * (T0 + 2 * u) + 4 * g;
            u32x4 vw; const u32x2 lo = *(const LAS u32x2*)vp, hi = *(const LAS u32x2*)(vp + 16); vw.x = lo.x; vw.y = lo.y; vw.z = hi.x; vw.w = hi.y;
            o[dt] = __builtin_amdgcn_mfma_f32_16x16x32_bf16(__builtin_bit_cast(bf16x8, vw), pf, o[dt], 0, 0, 0);
        }
    }
#pragma unroll
    for (int dt = 0; dt < 4; ++dt) { u32x2 w; w.x = cvt_pk_bf16(o[dt][0] * inv, o[dt][1] * inv); w.y = cvt_pk_bf16(o[dt][2] * inv, o[dt][3] * inv); *(u32x2*)(outp + 16 * dt + 4 * g) = w; }
}

#define LOAD_QFRAG(zq, pos, q0, q1) do { float _x1[8], _x2[8]; const int _g = lane >> 4; NORM_ROPE(zq, qn, pos, _g, 16, 32, _x1, _x2); \
    u32x4 _w0, _w1; _w0.x = cvt_pk_bf16(_x1[0] * 0.125f, _x1[1] * 0.125f); _w0.y = cvt_pk_bf16(_x1[2] * 0.125f, _x1[3] * 0.125f); _w0.z = cvt_pk_bf16(_x1[4] * 0.125f, _x1[5] * 0.125f); _w0.w = cvt_pk_bf16(_x1[6] * 0.125f, _x1[7] * 0.125f); \
    _w1.x = cvt_pk_bf16(_x2[0] * 0.125f, _x2[1] * 0.125f); _w1.y = cvt_pk_bf16(_x2[2] * 0.125f, _x2[3] * 0.125f); _w1.z = cvt_pk_bf16(_x2[4] * 0.125f, _x2[5] * 0.125f); _w1.w = cvt_pk_bf16(_x2[6] * 0.125f, _x2[7] * 0.125f); \
    q0 = __builtin_bit_cast(bf16x8, _w0); q1 = __builtin_bit_cast(bf16x8, _w1); } while (0)

__device__ __forceinline__ void attn_prompt_item(const bf16_t* z, const float* qn, const float* kn, const float* sinks, const float* rope_c, const float* rope_s, bf16_t* mix, float* spk, float* spv,
                                                 LAS unsigned char* lds, int qb, int kvh, int tid, int lane, int wave) {
    LAS bf16_t* Kl = (LAS bf16_t*)lds;
    LAS bf16_t* Vt = Kl + 256 * KSTR;
    LSYNC();
    const int kbase = qb * 128 - 128;
#pragma unroll
    for (int it_ = 0; it_ < 2; ++it_) { const int task = tid + 512 * it_;
        const int j = task >> 2, g = task & 3, pos = kbase + j;
        u32x4 w0 = (u32x4){0u, 0u, 0u, 0u}, w1 = w0;
        float x1[8], x2[8];
        const int posc = pos < 0 ? 0 : pos;
        const bf16_t* zr = z + (size_t)posc * INC + ZCK + kvh * 64;
        NORM_ROPE(zr, kn, posc, g, 1, 2, x1, x2);
        if (pos >= 0) { w0.x = cvt_pk_bf16(x1[0], x1[1]); w0.y = cvt_pk_bf16(x1[2], x1[3]); w0.z = cvt_pk_bf16(x1[4], x1[5]); w0.w = cvt_pk_bf16(x1[6], x1[7]);
                        w1.x = cvt_pk_bf16(x2[0], x2[1]); w1.y = cvt_pk_bf16(x2[2], x2[3]); w1.z = cvt_pk_bf16(x2[4], x2[5]); w1.w = cvt_pk_bf16(x2[6], x2[7]); }
        *(LAS u32x4*)(Kl + j * KSTR + 8 * g) = w0; *(LAS u32x4*)(Kl + j * KSTR + 32 + 8 * g) = w1;
        if (qb == 127 && j >= 128) { float* o = spk + (size_t)(j - 128) * 128 + kvh * 64;
            *(f32x4*)(o + 8 * g) = (f32x4){x1[0], x1[1], x1[2], x1[3]}; *(f32x4*)(o + 8 * g + 4) = (f32x4){x1[4], x1[5], x1[6], x1[7]};
            *(f32x4*)(o + 32 + 8 * g) = (f32x4){x2[0], x2[1], x2[2], x2[3]}; *(f32x4*)(o + 32 + 8 * g + 4) = (f32x4){x2[4], x2[5], x2[6], x2[7]}; }
    }
#pragma unroll
    for (int it_ = 0; it_ < 4; ++it_) { const int task = tid + 512 * it_;
        const int j = task >> 3, c8 = (task & 7) * 8, pos = kbase + j;
        u32x4 w = (u32x4){0u, 0u, 0u, 0u};
        if (pos >= 0) w = *(const u32x4*)(z + (size_t)pos * INC + ZCV + kvh * 64 + c8);
        Vt[(c8 + 0) * VSTR + j] = (bf16_t)(w.x & 0xffffu); Vt[(c8 + 1) * VSTR + j] = (bf16_t)(w.x >> 16);
        Vt[(c8 + 2) * VSTR + j] = (bf16_t)(w.y & 0xffffu); Vt[(c8 + 3) * VSTR + j] = (bf16_t)(w.y >> 16);
        Vt[(c8 + 4) * VSTR + j] = (bf16_t)(w.z & 0xffffu); Vt[(c8 + 5) * VSTR + j] = (bf16_t)(w.z >> 16);
        Vt[(c8 + 6) * VSTR + j] = (bf16_t)(w.w & 0xffffu); Vt[(c8 + 7) * VSTR + j] = (bf16_t)(w.w >> 16);
        if (qb == 127 && j >= 128) { float f[8]; UNPACK8(w, f); float* o = spv + (size_t)(j - 128) * 128 + kvh * 64 + c8;
            *(f32x4*)o = (f32x4){f[0], f[1], f[2], f[3]}; *(f32x4*)(o + 4) = (f32x4){f[4], f[5], f[6], f[7]}; }
    }
    for (int idx = tid; idx < 64 * 24; idx += 512) Vt[(idx / 24) * VSTR + 256 + (idx % 24)] = 0;
    LSYNC();
    const int hq = kvh * 4 + (wave >> 1);
    const float sink = sinks[hq];
    const int g4 = lane >> 4;
    float gq1[8], gq2[8];
#pragma unroll
    for (int j = 0; j < 8; ++j) { gq1[j] = qn[8 * g4 + j] * 0.125f; gq2[j] = qn[32 + 8 * g4 + j] * 0.125f; }
    const int pos0 = qb * 128 + (wave & 1) * 64 + (lane & 15);
    const bf16_t* zq0 = z + (size_t)pos0 * INC + ZCQ + hq * 64 + 8 * g4;
    const float* rc0 = rope_c + (size_t)pos0 * 32 + 8 * g4; const float* rs0 = rope_s + (size_t)pos0 * 32 + 8 * g4;
    u32x4 nlo = *(const u32x4*)zq0, nhi = *(const u32x4*)(zq0 + 32);
    f32x4 nc0 = *(const f32x4*)rc0, nc1 = *(const f32x4*)(rc0 + 4), ns0 = *(const f32x4*)rs0, ns1 = *(const f32x4*)(rs0 + 4);
#pragma unroll 1
    for (int a4 = 0; a4 < 4; ++a4) {
        const u32x4 lo = nlo, hi = nhi; const f32x4 c0 = nc0, c1 = nc1, s0 = ns0, s1 = ns1;
        { const int an = a4 < 3 ? a4 + 1 : 3; const bf16_t* zqn = zq0 + (size_t)(16 * an) * INC; const float* rcn = rc0 + (size_t)(16 * an) * 32; const float* rsn = rs0 + (size_t)(16 * an) * 32;
          nlo = *(const u32x4*)zqn; nhi = *(const u32x4*)(zqn + 32); nc0 = *(const f32x4*)rcn; nc1 = *(const f32x4*)(rcn + 4); ns0 = *(const f32x4*)rsn; ns1 = *(const f32x4*)(rsn + 4); }
        float a[8], b[8]; UNPACK8(lo, a); UNPACK8(hi, b);
        float sq = 0.f;
#pragma unroll
        for (int j = 0; j < 8; ++j) sq += a[j] * a[j] + b[j] * b[j];
        sq += __shfl_xor(sq, 16); sq += __shfl_xor(sq, 32);
        const float r = rsqrtf(sq * (1.0f / 64.0f) + EPS);
        float x1[8], x2[8];
#pragma unroll
        for (int j = 0; j < 8; ++j) { const float y1 = a[j] * r * gq1[j], y2 = b[j] * r * gq2[j]; const float c = j < 4 ? c0[j & 3] : c1[j & 3], s = j < 4 ? s0[j & 3] : s1[j & 3];
            x1[j] = y1 * c - y2 * s; x2[j] = y2 * c + y1 * s; }
        u32x4 w0, w1; w0.x = cvt_pk_bf16(x1[0], x1[1]); w0.y = cvt_pk_bf16(x1[2], x1[3]); w0.z = cvt_pk_bf16(x1[4], x1[5]); w0.w = cvt_pk_bf16(x1[6], x1[7]);
        w1.x = cvt_pk_bf16(x2[0], x2[1]); w1.y = cvt_pk_bf16(x2[2], x2[3]); w1.z = cvt_pk_bf16(x2[4], x2[5]); w1.w = cvt_pk_bf16(x2[6], x2[7]);
        const int i0 = (wave & 1) * 64 + 16 * a4, i = i0 + (lane & 15);
        const size_t m = (size_t)qb * 128 + i;
        attn_qtile(Kl, Vt, __builtin_bit_cast(bf16x8, w0), __builtin_bit_cast(bf16x8, w1), i, i0 >> 4, qb == 0 ? 128 : 0, sink, mix + m * DM + 512 + hq * 64, lane);
    }
}

__device__ __forceinline__ void attn_sample_item(const bf16_t* z, const float* ck, const float* cv, const float* qn, const float* kn, const float* sinks, const float* rope_c, const float* rope_s, bf16_t* mix,
                                                 float* ssk, float* ssv, LAS unsigned char* lds, int b, int kvh, int tid, int lane, int wave) {
    LAS bf16_t* Kl = (LAS bf16_t*)lds;
    LAS bf16_t* Vt = Kl + 256 * KSTR;
    LSYNC();
#pragma unroll
    for (int it_ = 0; it_ < 2; ++it_) { const int task = tid + 512 * it_;
        const int j = task >> 3, c8 = (task & 7) * 8;
        const float* kr = ck + (size_t)j * 128 + kvh * 64 + c8; const float* vr = cv + (size_t)j * 128 + kvh * 64 + c8;
        const f32x4 k0 = *(const f32x4*)kr, k1 = *(const f32x4*)(kr + 4), v0 = *(const f32x4*)vr, v1 = *(const f32x4*)(vr + 4);
        u32x4 w; w.x = cvt_pk_bf16(k0[0], k0[1]); w.y = cvt_pk_bf16(k0[2], k0[3]); w.z = cvt_pk_bf16(k1[0], k1[1]); w.w = cvt_pk_bf16(k1[2], k1[3]);
        *(LAS u32x4*)(Kl + j * KSTR + c8) = w;
        const float vf[8] = {v0[0], v0[1], v0[2], v0[3], v1[0], v1[1], v1[2], v1[3]};
#pragma unroll
        for (int e = 0; e < 8; ++e) Vt[(c8 + e) * VSTR + j] = (bf16_t)(cvt_pk_bf16(vf[e], 0.f) & 0xffffu);
        if (j >= 4) { float* ok = ssk + (size_t)(j - 4) * 128 + kvh * 64 + c8; float* ov = ssv + (size_t)(j - 4) * 128 + kvh * 64 + c8;
            *(f32x4*)ok = k0; *(f32x4*)(ok + 4) = k1; *(f32x4*)ov = v0; *(f32x4*)(ov + 4) = v1; }
    }
    if (tid < 16) {
        const int t = tid >> 2, g = tid & 3, j = 128 + t; const size_t m = (size_t)TP + 4 * b + t;
        float x1[8], x2[8];
        NORM_ROPE(z + m * INC + ZCK + kvh * 64, kn, TP + t, g, 1, 2, x1, x2);
        u32x4 w0, w1; w0.x = cvt_pk_bf16(x1[0], x1[1]); w0.y = cvt_pk_bf16(x1[2], x1[3]); w0.z = cvt_pk_bf16(x1[4], x1[5]); w0.w = cvt_pk_bf16(x1[6], x1[7]);
        w1.x = cvt_pk_bf16(x2[0], x2[1]); w1.y = cvt_pk_bf16(x2[2], x2[3]); w1.z = cvt_pk_bf16(x2[4], x2[5]); w1.w = cvt_pk_bf16(x2[6], x2[7]);
        *(LAS u32x4*)(Kl + j * KSTR + 8 * g) = w0; *(LAS u32x4*)(Kl + j * KSTR + 32 + 8 * g) = w1;
        float* o = ssk + (size_t)(j - 4) * 128 + kvh * 64;
        *(f32x4*)(o + 8 * g) = (f32x4){x1[0], x1[1], x1[2], x1[3]}; *(f32x4*)(o + 8 * g + 4) = (f32x4){x1[4], x1[5], x1[6], x1[7]};
        *(f32x4*)(o + 32 + 8 * g) = (f32x4){x2[0], x2[1], x2[2], x2[3]}; *(f32x4*)(o + 32 + 8 * g + 4) = (f32x4){x2[4], x2[5], x2[6], x2[7]};
    }
    if (tid >= 64 && tid < 64 + 32) {
        const int t = (tid - 64) >> 3, c8 = ((tid - 64) & 7) * 8, j = 128 + t; const size_t m = (size_t)TP + 4 * b + t;
        const u32x4 w = *(const u32x4*)(z + m * INC + ZCV + kvh * 64 + c8);
        Vt[(c8 + 0) * VSTR + j] = (bf16_t)(w.x & 0xffffu); Vt[(c8 + 1) * VSTR + j] = (bf16_t)(w.x >> 16);
        Vt[(c8 + 2) * VSTR + j] = (bf16_t)(w.y & 0xffffu); Vt[(c8 + 3) * VSTR + j] = (bf16_t)(w.y >> 16);
        Vt[(c8 + 4) * VSTR + j] = (bf16_t)(w.z & 0xffffu); Vt[(c8 + 5) * VSTR + j] = (bf16_t)(w.z >> 16);
        Vt[(c8 + 6) * VSTR + j] = (bf16_t)(w.w & 0xffffu); Vt[(c8 + 7) * VSTR + j] = (bf16_t)(w.w >> 16);
        float f[8]; UNPACK8(w, f); float* o = ssv + (size_t)(j - 4) * 128 + kvh * 64 + c8;
        *(f32x4*)o = (f32x4){f[0], f[1], f[2], f[3]}; *(f32x4*)(o + 4) = (f32x4){f[4], f[5], f[6], f[7]};
    }
    if (tid >= 128 && tid < 128 + 12 * 8) { const int j = 132 + ((tid - 128) >> 3), c8 = ((tid - 128) & 7) * 8; *(LAS u32x4*)(Kl + j * KSTR + c8) = (u32x4){0u, 0u, 0u, 0u}; }
    for (int idx = tid; idx < 64 * 28; idx += 512) Vt[(idx / 28) * VSTR + 132 + (idx % 28)] = 0;
    LSYNC();
    if (wave == 0) {
        const int q = lane & 15, hg = q >> 2, t = q & 3, hq = kvh * 4 + hg; const size_t m = (size_t)TP + 4 * b + t;
        bf16x8 q0, q1;
        LOAD_QFRAG(z + m * INC + ZCQ + hq * 64, TP + t, q0, q1);
        attn_qtile(Kl, Vt, q0, q1, t, 0, 0, sinks[hq], mix + m * DM + 512 + hq * 64, lane);
    }
}

#define PHASE_HEAD { unsigned z_ = 0; asm volatile("" : "+s"(z_)); lds += z_; } int wave_ = wv; asm volatile("" : "+s"(wave_)); const int wave = wave_, lane = lane_id_opaque(), tid = wave * 64 + lane; const int G = gridDim.x, bid = blockIdx.x; unsigned char* ws = WSP; (void)lane; (void)wave; (void)G; (void)bid; (void)ws;
#define SSP(k) ((float*)(ws + WS_SS) + (size_t)(k) * MT)
#define WL(off) ((const bf16_t*)(ws + WS_W + (size_t)l * W_LAYER + (off)))

struct G1Order {
    pg8::StaticOrder so; unsigned* cnt; int c;
    __device__ __forceinline__ bool next(int i, Unit& u) const {
        if (c >= 64 && c < 82) { if (i == 0) { const int s = c - 64; u.pm = 64 + s / 9; u.pn = s % 9; return true; } return so.next(i - 1, u); }
        return so.next(i, u);
    }
    __device__ __forceinline__ void a_ready(const Unit&) const {}
    __device__ __forceinline__ void done(const Unit& u) const {
        if (u.pm >= 64) {
            asm volatile("s_waitcnt vmcnt(0)" ::: "memory");
            __builtin_amdgcn_fence(__ATOMIC_RELEASE, "agent");
            asm volatile("s_waitcnt vmcnt(0)" ::: "memory");
            if (lane_id_opaque() == 0) __hip_atomic_fetch_add(cnt, 1u, __ATOMIC_RELAXED, __HIP_MEMORY_SCOPE_AGENT);
        }
    }
};
__device__ __forceinline__ void phase_g1(LAS unsigned char* lds, int l, int wv) {
    PHASE_HEAD
    unsigned* cnt = (unsigned*)(ws + WS_CTL) + 8192 + 64 * l;
    { pg8::Gemm g{(const bf16_t*)(ws + WS_BUFA), WL(W_IN), MT, INC, DM}; G1Order S; S.so.init(TP, INC, G, bid); S.cnt = cnt; S.c = bid;
      EpiZ E{(bf16_t*)(ws + WS_ZACT), INC, SSP(3 * l)}; pg8::gemm_phase<EpiZ, G1Order, true, true>(lds, g, S, E, wv); }
    if (bid >= 82) {
        if (tid == 0) { unsigned sp = 0; while (__hip_atomic_load(cnt, __ATOMIC_RELAXED, __HIP_MEMORY_SCOPE_AGENT) < 144u) { __builtin_amdgcn_s_sleep(4); if (++sp > (1u << 22)) break; }
            __builtin_amdgcn_fence(__ATOMIC_ACQUIRE, "agent"); asm volatile("s_waitcnt vmcnt(0)" ::: "memory"); }
        __syncthreads();
        const bf16_t* z = (const bf16_t*)(ws + WS_ZACT); bf16_t* bufB = (bf16_t*)(ws + WS_BUFB);
        const float* lbp = (const float*)(ws + WS_LB) + l * 256;
        const float* rope_c = (const float*)(ws + WS_ROPE); const float* rope_s = rope_c + (size_t)NPOS * 32;
        float* out = OUTP;
#pragma unroll 1
        for (int it = bid - 82; it < 640; it += G - 82) {
            int r = it;
            if (r < 256) { const int b = r >> 1, hp = r & 1; const size_t so = ((size_t)(l * 128 + b) * 4) * 4096;
                hgrn_sample_item(z, lbp, IN(2) + so, out + O_SSH + so, IN(10) + l * 64, bufB, lds, b, hp, tid, lane, wave); continue; } r -= 256;
            if (r < 128) { conv_sample_item(z, IN(3) + (size_t)l * 128 * 7680, IN(11) + l * 31 * 256, IN(12) + l * 256, IN(13) + l * 256, IN(14) + l * 256, bufB, out + O_SSC + (size_t)l * 128 * 7680, lds, r, tid, lane, wave); continue; } r -= 128;
            { const int b = r >> 1, kvh = r & 1; const size_t co = (size_t)(l * 128 + b) * 16384;
              attn_sample_item(z, IN(4) + co, IN(5) + co, IN(15) + l * 64, IN(16) + l * 64, IN(17) + l * 8, rope_c, rope_s, bufB, out + O_SSK + co, out + O_SSV + co, lds, b, kvh, tid, lane, wave); }
        }
        LSYNC();
        { LAS float* scr = (LAS float*)(lds + wave * 16384);
#pragma unroll 1
          for (int k = (bid - 82) * 8 + wave; k < CI_LAYER - CI_D; k += (G - 82) * 8) convert_item(lds, ws, scr, l * CI_LAYER + CI_D + k, lane); }
    }
}
__device__ __forceinline__ void phase_mix_a(LAS unsigned char* lds, int l, int wv) {
    PHASE_HEAD
    const bf16_t* z = (const bf16_t*)(ws + WS_ZACT); bf16_t* bufB = (bf16_t*)(ws + WS_BUFB);
    const float* lbp = (const float*)(ws + WS_LB) + l * 256; float* dvec = (float*)(ws + WS_DVEC); float* dS = (float*)(ws + WS_DS);
    const float* rope_c = (const float*)(ws + WS_ROPE); const float* rope_s = rope_c + (size_t)NPOS * 32;
    float* out = OUTP;
#pragma unroll 1
    for (int it = bid; it < 1024; it += G) {
        unsigned czf[8], cvi[8];
        const bf16_t* zb = z + (size_t)(64 * (it >> 2) + 8 * wave) * INC + (it & 3) * 64 + lane;
#pragma unroll
        for (int i = 0; i < 8; ++i) { czf[i] = zb[(size_t)i * INC + ZF]; cvi[i] = zb[(size_t)i * INC + ZI]; }
        hgrn_ds_item(czf, cvi, lbp, dS, dvec, lds, it >> 2, it & 3, tid, lane, wave);
    }
#pragma unroll 1
    for (int it = bid; it < 512; it += G) {
        int r = it;
        if (r < 256) { attn_prompt_item(z, IN(15) + l * 64, IN(16) + l * 64, IN(17) + l * 8, rope_c, rope_s, bufB, out + O_SPK + (size_t)l * 16384, out + O_SPV + (size_t)l * 16384, lds, r >> 1, r & 1, tid, lane, wave); continue; } r -= 256;
        conv_prompt_item(z, IN(11) + l * 31 * 256, IN(12) + l * 256, IN(13) + l * 256, IN(14) + l * 256, bufB, out + O_SPC + (size_t)l * 7680, lds, r, tid, lane, wave);
    }
}
__device__ __forceinline__ void phase_scan(LAS unsigned char* lds, int l, int wv) {
    PHASE_HEAD
    if (bid < 256) {
        float* dS = (float*)(ws + WS_DS); const float* dvec = (const float*)(ws + WS_DVEC);
        const int e = 64 * bid + lane, h = e >> 12, k = (e >> 6) & 63;
        LAS float* X = (LAS float*)lds;
        float v[32], d[32];
#pragma unroll
        for (int j = 0; j < 32; ++j) { const int c = 32 * wave + j; v[j] = dS[(size_t)c * 16384 + e]; d[j] = dvec[(c * 4 + h) * 64 + k]; }
        float A = 0.f, P = 1.f;
#pragma unroll
        for (int j = 0; j < 32; ++j) { const float t = v[j]; v[j] = A; A = d[j] * A + t; const float pd = d[j]; d[j] = P; P *= pd; }
        LSYNC();
        X[(wave * 2 + 0) * 64 + lane] = P; X[(wave * 2 + 1) * 64 + lane] = A;
        LSYNC();
        float S = 0.f;
#pragma unroll
        for (int w2 = 0; w2 < 8; ++w2) { const float p2 = X[(w2 * 2 + 0) * 64 + lane], a2 = X[(w2 * 2 + 1) * 64 + lane]; if (w2 < wave) S = p2 * S + a2; }
#pragma unroll
        for (int j = 0; j < 32; ++j) dS[(size_t)(32 * wave + j) * 16384 + e] = d[j] * S + v[j];
        if (wave == 7) OUTP[O_SPH + (size_t)l * 16384 + e] = P * S + A;
    }
}
__device__ __forceinline__ void phase_mix_c(LAS unsigned char* lds, int l, int wv) {
    PHASE_HEAD
    const bf16_t* z = (const bf16_t*)(ws + WS_ZACT); bf16_t* bufB = (bf16_t*)(ws + WS_BUFB);
    const float* lbp = (const float*)(ws + WS_LB) + l * 256; const float* dS = (const float*)(ws + WS_DS);
    const float* onorm = IN(10) + l * 64;
#pragma unroll 1
    for (int it = bid; it < 512; it += G) hgrn_out_item(z, lbp, dS, onorm, bufB, lds, it >> 1, it & 1, tid, lane, wave);
}
__device__ __forceinline__ void phase_g2(LAS unsigned char* lds, int l, int wv) {
    PHASE_HEAD
    bf16_t* bufA = (bf16_t*)(ws + WS_BUFA);
    pg8::Gemm g{(const bf16_t*)(ws + WS_BUFB), WL(W_OUT), TP, DM, DM}; pg8::StaticOrder S; S.init(TP, DM, G, bid);
    EpiRes E{bufA, bufA, SSP(3 * l + 1)};
    pg8::gemm_phase<EpiRes, pg8::StaticOrder, true, true>(lds, g, S, E, wv);
    SEpiRes SE{bufA + (size_t)TP * DM, bufA + (size_t)TP * DM, SSP(3 * l + 1) + TP};
    small_gemm(lds, (const bf16_t*)(ws + WS_BUFB) + (size_t)TP * DM, WL(W_OUT), DM, SE, bid, tid, lane, wave);
}
__device__ __forceinline__ void phase_g3(LAS unsigned char* lds, int l, int wv) {
    PHASE_HEAD
    pg8::Gemm g{(const bf16_t*)(ws + WS_BUFA), WL(W_GU), MT, 2 * DFF, DM}; pg8::StaticOrder S; S.init(MT, 2 * DFF, G, bid);
    EpiGU E{(bf16_t*)(ws + WS_ZACT), SSP(3 * l + 1)}; pg8::gemm_phase<EpiGU, pg8::StaticOrder, true, true>(lds, g, S, E, wv);
    if (bid >= 172) {
        bf16_t* pbl = (bf16_t*)(ws + WS_PB) + (size_t)l * MT * PLE;
        const float* pP = IN(6) + (size_t)l * TP * PLE; const float* pS = IN(7) + (size_t)l * NSM * PLE;
        const int gw2 = (bid - 172) * 8 + wave, NGW2 = (G - 172) * 8;
#pragma unroll 1
        for (int m0 = gw2; m0 < MT; m0 += 8 * NGW2) {
            f32x4 v[8];
#pragma unroll
            for (int q = 0; q < 8; ++q) { const int m = (m0 + q * NGW2 < MT) ? m0 + q * NGW2 : m0;
                const float* src = (m < TP) ? pP + (size_t)m * PLE : pS + (size_t)(m - TP) * PLE; v[q] = ((const f32x4*)src)[lane]; }
#pragma unroll
            for (int q = 0; q < 8; ++q) { const int m = (m0 + q * NGW2 < MT) ? m0 + q * NGW2 : m0;
                u32x2 w; w.x = cvt_pk_bf16(v[q][0], v[q][1]); w.y = cvt_pk_bf16(v[q][2], v[q][3]); ((u32x2*)(pbl + (size_t)m * PLE))[lane] = w; }
        }
        if (l == 0) { LAS float* scr = (LAS float*)(lds + wave * 16384);
#pragma unroll 1
            for (int k = (bid - 172) * 8 + wave; k < CI_OUT; k += (G - 172) * 8) convert_item(lds, ws, scr, CI_LAYER + k, lane); }
    }
}
__device__ __forceinline__ void phase_g4(LAS unsigned char* lds, int l, int wv) {
    PHASE_HEAD
    const bf16_t* bufA = (const bf16_t*)(ws + WS_BUFA); bf16_t* bufB = (bf16_t*)(ws + WS_BUFB);
    pg8::Gemm g{(const bf16_t*)(ws + WS_ZACT), WL(W_D), TP, DM, DFF}; pg8::StaticOrder S; S.init(TP, DM, G, bid);
    EpiRes E{bufA, bufB, SSP(3 * l + 2)}; pg8::gemm_phase<EpiRes, pg8::StaticOrder, true, true>(lds, g, S, E, wv);
    SEpiRes SE{bufA + (size_t)TP * DM, bufB + (size_t)TP * DM, SSP(3 * l + 2) + TP};
    small_gemm(lds, (const bf16_t*)(ws + WS_ZACT) + (size_t)TP * DFF, WL(W_D), DFF, SE, bid, tid, lane, wave);
}
__device__ __forceinline__ void phase_g5a(LAS unsigned char* lds, int l, int wv) {
    PHASE_HEAD
    pg8::Gemm g{(const bf16_t*)(ws + WS_BUFB), WL(W_PG), TP, DM, DM}; pg8::StaticOrder S; S.init(TP, DM, G, bid);
    EpiGate E{(bf16_t*)(ws + WS_ZACT), SSP(3 * l + 2)}; pg8::gemm_phase<EpiGate, pg8::StaticOrder, true, true>(lds, g, S, E, wv);
    SEpiGate SE{(bf16_t*)(ws + WS_ZACT) + (size_t)TP * DM, SSP(3 * l + 2) + TP};
    small_gemm(lds, (const bf16_t*)(ws + WS_BUFB) + (size_t)TP * DM, WL(W_PG), DM, SE, bid, tid, lane, wave);
}
__device__ __forceinline__ void phase_g5b(LAS unsigned char* lds, int l, int wv) {
    PHASE_HEAD
    const bf16_t* gt = (const bf16_t*)(ws + WS_ZACT); const bf16_t* bufB = (const bf16_t*)(ws + WS_BUFB); bf16_t* bufA = (bf16_t*)(ws + WS_BUFA); float* Y = OUTP + O_Y;
    pg8::Gemm g{(const bf16_t*)(ws + WS_PB) + (size_t)l * MT * PLE, WL(W_PP), TP, DM, PLE}; pg8::StaticOrder S; S.init(TP, DM, G, bid);
    EpiOut E{gt, bufB, Y, bufA, SSP(3), l}; pg8::gemm_phase<EpiOut, pg8::StaticOrder, true, true>(lds, g, S, E, wv);
    SEpiOut SE{gt + (size_t)TP * DM, bufB + (size_t)TP * DM, Y + (size_t)TP * DM, bufA + (size_t)TP * DM, SSP(3) + TP, l};
    small_gemm(lds, (const bf16_t*)(ws + WS_PB) + ((size_t)l * MT + TP) * PLE, WL(W_PP), PLE, SE, bid, tid, lane, wave);
}

__global__ void __launch_bounds__(512, 2) fwd_kernel(Args a) {
    extern __shared__ __attribute__((aligned(16))) unsigned char lds_raw[];
    LAS unsigned char* lds = (LAS unsigned char*)lds_raw;
    volatile LAS unsigned* MISC = (volatile LAS unsigned*)(lds + MISC_OFF);
    if (threadIdx.x < 32) MISC[threadIdx.x] = 0u;
    if (threadIdx.x == 0) {
        LAS unsigned long long* PT = (LAS unsigned long long*)(lds + PT_OFF);
#pragma unroll
        for (int i = 0; i < 27; ++i) PT[i] = (unsigned long long)a.in[i];
        PT[27] = (unsigned long long)a.out; PT[28] = (unsigned long long)a.ws;
    }
    __syncthreads();
    const int wv = __builtin_amdgcn_readfirstlane(threadIdx.x >> 6);
    XcdBarrier bar = xcd_barrier_post((unsigned*)(WSP + WS_CTL), MISC + 8); bar.wv = wv;
    prologue(lds, wv);
    if (gridDim.x == 0x7fffffffu) cg::this_grid().sync();
    xcd_barrier(bar);
#define LAYER(l) do { \
        phase_g1(lds, l, wv); xcd_barrier(bar); \
        phase_mix_a(lds, l, wv); xcd_barrier(bar); \
        phase_scan(lds, l, wv); xcd_barrier(bar); \
        phase_mix_c(lds, l, wv); xcd_barrier(bar); \
        phase_g2(lds, l, wv); xcd_barrier(bar); \
        phase_g3(lds, l, wv); xcd_barrier(bar); \
        phase_g4(lds, l, wv); xcd_barrier(bar); \
        phase_g5a(lds, l, wv); \
        phase_g5b(lds, l, wv); } while (0)
    LAYER(0);
    xcd_barrier(bar);
    LAYER(1);
}

extern "C" void kernel_launch(void* const* d_in, const int* in_sizes, int n_in, void* d_out, int out_size, void* d_ws, size_t ws_size, hipStream_t stream) {
    static int grid = 0;
    if (grid == 0) {
        if (n_in != 27 || ws_size < WS_END) { fprintf(stderr, "kernel_launch: unexpected n_in %d / ws %zu\n", n_in, ws_size); grid = -1; return; }
        int dev = 0, cus = 0, per_cu = 0;
        hipGetDevice(&dev); hipDeviceGetAttribute(&cus, hipDeviceAttributeMultiprocessorCount, dev);
        if (hipFuncSetAttribute((const void*)fwd_kernel, hipFuncAttributeMaxDynamicSharedMemorySize, LDS_BYTES) != hipSuccess) { fprintf(stderr, "kernel_launch: hipFuncSetAttribute failed\n"); grid = -1; return; }
        hipOccupancyMaxActiveBlocksPerMultiprocessor(&per_cu, (const void*)fwd_kernel, 512, LDS_BYTES);
        (void)hipGetLastError();
        if (per_cu < 1) { fprintf(stderr, "kernel_launch: occupancy query says %d blocks per CU\n", per_cu); }
        grid = cus;
    }
    if (grid < 0) return;
    hipMemsetAsync((char*)d_ws + WS_CTL, 0, CTL_BYTES, stream);
    Args a{};
    for (int i = 0; i < 27; ++i) a.in[i] = (const float*)d_in[i];
    a.out = (float*)d_out; a.ws = (unsigned char*)d_ws;
    void* args[] = {&a};
    hipError_t e = hipLaunchCooperativeKernel((const void*)fwd_kernel, dim3(grid), dim3(512), args, LDS_BYTES, stream);
    if (e != hipSuccess) fprintf(stderr, "cooperative launch failed: %s (grid %d)\n", hipGetErrorString(e), grid);
}
```

```cpp
#include <hip/hip_runtime.h>
#include <hip/hip_cooperative_groups.h>
#include <cstdio>
#include <cstdint>
namespace cg = cooperative_groups;
namespace pg8 {
#define PG8_LAS __attribute__((address_space(3)))
typedef unsigned short bf16_t;
typedef short bf16x8 __attribute__((ext_vector_type(8)));
typedef float f32x4 __attribute__((ext_vector_type(4)));
typedef unsigned u32x4 __attribute__((ext_vector_type(4)));
constexpr int BM = 256, BK = 64, HALF = 128, HTB = HALF * BK * 2  , STAGE_BYTES = 8 * HTB, NXCD = 8, WGM = 8;

__host__ __device__ __forceinline__ int lds_byte(int r, int c) { const int st = (r >> 4) * 2 + (c >> 5), rr = r & 15, cc = c & 31, ob = rr * 64 + cc * 2; return st * 1024 + (ob ^ (((ob >> 9) & 1) << 5)); }
__host__ __device__ __forceinline__ void stage_rc(int b, int& R, int& C) { const int st = b / 1024, sb = b % 1024, swz = sb ^ (((sb >> 9) & 1) << 5); R = (st >> 1) * 16 + swz / 64; C = (st & 1) * 32 + (swz % 64) / 2; }
__host__ __device__ __forceinline__ int perm32(int rho) { const int n = rho >> 4, i = rho & 15; return 8 * (i >> 2) + 4 * n + (i & 3); }

struct Unit { int pm, pn; };
struct Gemm { const bf16_t* A; const bf16_t* Bt; int M, N, K; };

struct StaticOrder {
    int nM, nN, nwg, G, c;
    __host__ __device__ void init(int M, int N, int G_, int c_) { nM = M / BM; nN = N / BM; nwg = nM * nN; G = G_; c = c_; }
    __host__ __device__ bool next(int i, Unit& u) const {
        const long L = (long)i * G + c; if (L >= nwg) return false;
        int wgid = (int)L; { const int q = nwg / NXCD, r = nwg % NXCD, xcd = wgid % NXCD, off = wgid / NXCD; wgid = (xcd < r ? xcd * (q + 1) : r * (q + 1) + (xcd - r) * q) + off; }
        const int nig = WGM * nN, gid = wgid / nig, fm = gid * WGM, gsz = (nM - fm) < WGM ? (nM - fm) : WGM;
        u.pm = fm + ((wgid % nig) % gsz); u.pn = (wgid % nig) / gsz; return true;
    }
    __device__ __forceinline__ void a_ready(const Unit&) const {}
    __device__ __forceinline__ void done(const Unit&) const {}
};
__device__ __forceinline__ unsigned cvt_pk_bf16(float lo, float hi) { unsigned r; asm volatile("v_cvt_pk_bf16_f32 %0, %1, %2" : "=v"(r) : "v"(lo), "v"(hi)); return r; }
template <class Epi, class Sched, bool ALIGN_EPI = false, bool SP2 = false>
__device__ __forceinline__ void gemm_phase(PG8_LAS unsigned char* lds, const Gemm g, const Sched& S, const Epi& E, int wv_) {
    unsigned m_ = ~0u; asm volatile("" : "+s"(m_)); asm volatile("" : "+s"(wv_)); int tid_ = wv_ * 64 + (int)__builtin_amdgcn_mbcnt_hi(m_, __builtin_amdgcn_mbcnt_lo(m_, 0u)); { unsigned z_ = 0; asm volatile("" : "+s"(z_)); lds += z_; } const int tid = tid_, wid = __builtin_amdgcn_readfirstlane(tid >> 6), lane = tid & 63, wr = wid >> 2, wc = wid & 3, fr = lane & 15, fq = lane >> 4;
    const int K = g.K, nt = K / BK;
    unsigned voffA[2], voffB[2];
#pragma unroll
    for (int i = 0; i < 2; ++i) { int R, C; stage_rc(tid * 16 + i * 8192, R, C); const int Rb = Epi::PERM ? ((R & ~31) + perm32(R & 31)) : R;
        voffA[i] = (unsigned)(R * K + C) * 2u; voffB[i] = (unsigned)(Rb * K + C) * 2u; }
    const size_t kstep = (size_t)(BK * 2);
    const size_t hstep = (size_t)HALF * K * 2;
    const size_t tstep = 2 * hstep;
    const unsigned ldsw = (unsigned)wid * 1024u;
    const int aoff = lds_byte(wr * 64 + fr, fq * 8), boff = lds_byte(wc * 32 + fr, fq * 8);
#define PG8_SA(b, h) (((b) * 2 + (h)) * HTB)
#define PG8_SB(b, h) ((4 + (b) * 2 + (h)) * HTB)
#define PG8_STAGE(bufoff, gbase, voff) do { _Pragma("unroll") for (int _i = 0; _i < 2; ++_i) \
        __builtin_amdgcn_global_load_lds((const unsigned*)((const char*)(gbase) + (voff)[_i]), (PG8_LAS unsigned*)(lds + (bufoff) + ldsw + _i * 8192), 16, 0, 0); } while (0)
#define PG8_LDA(dst, b, h) do { _Pragma("unroll") for (int m = 0; m < 4; ++m) _Pragma("unroll") for (int k = 0; k < 2; ++k) dst[m][k] = *(const PG8_LAS bf16x8*)(lds + PG8_SA(b, h) + aoff + m * 2048 + k * 1024); } while (0)
#define PG8_LDB(dst, b, h) do { _Pragma("unroll") for (int n = 0; n < 2; ++n) _Pragma("unroll") for (int k = 0; k < 2; ++k) dst[n][k] = *(const PG8_LAS bf16x8*)(lds + PG8_SB(b, h) + boff + n * 2048 + k * 1024); } while (0)
#define PG8_MMA(ai, bj, At, Bt) do { __builtin_amdgcn_s_setprio(1); _Pragma("unroll") for (int m = 0; m < 4; ++m) _Pragma("unroll") for (int n = 0; n < 2; ++n) _Pragma("unroll") for (int k = 0; k < 2; ++k) \
        acc[ai][bj][m][n] = __builtin_amdgcn_mfma_f32_16x16x32_bf16(Bt[n][k], At[m][k], acc[ai][bj][m][n], 0, 0, 0); __builtin_amdgcn_s_setprio(0); } while (0)
#define PG8_WAIT_V(n) asm volatile("s_waitcnt vmcnt(" #n ")" ::: "memory")
#define PG8_WAIT_L(n) asm volatile("s_waitcnt lgkmcnt(" #n ")" ::: "memory")
#define PG8_BAR __builtin_amdgcn_s_barrier()
#define PG8_SCHED __builtin_amdgcn_sched_barrier(0)
    Unit cur, nxt; int ui = 0;
    if (!S.next(0, cur)) return;
    f32x4 acc[2][2][4][2];
#pragma unroll
    for (int a = 0; a < 2; ++a)
#pragma unroll
        for (int b = 0; b < 2; ++b)
#pragma unroll
            for (int m = 0; m < 4; ++m)
#pragma unroll
                for (int n = 0; n < 2; ++n) acc[a][b][m][n] = (f32x4){0.f, 0.f, 0.f, 0.f};
    bf16x8 At[4][2], B0[2][2], B1[2][2];
    const char* cA = (const char*)g.A + (size_t)cur.pm * tstep; const char* cB = (const char*)g.Bt + (size_t)cur.pn * tstep;
    S.a_ready(cur);
    if constexpr (SP2) {
        PG8_STAGE(PG8_SB(0, 0), cB, voffB); PG8_STAGE(PG8_SB(0, 1), cB + hstep, voffB); PG8_STAGE(PG8_SA(0, 0), cA, voffA); PG8_STAGE(PG8_SA(0, 1), cA + hstep, voffA);
        if (wr == 1) PG8_BAR;
        PG8_WAIT_V(2); PG8_BAR;
        PG8_STAGE(PG8_SB(1, 0), cB + kstep, voffB); PG8_STAGE(PG8_SA(1, 0), cA + kstep, voffA); PG8_STAGE(PG8_SB(1, 1), cB + hstep + kstep, voffB);
        PG8_WAIT_V(6); PG8_BAR;
    } else {
        PG8_STAGE(PG8_SB(0, 0), cB, voffB); PG8_STAGE(PG8_SA(0, 0), cA, voffA); PG8_STAGE(PG8_SB(0, 1), cB + hstep, voffB); PG8_STAGE(PG8_SA(0, 1), cA + hstep, voffA);
        if (wr == 1) PG8_BAR;
        PG8_WAIT_V(4); PG8_BAR;
        PG8_STAGE(PG8_SB(1, 0), cB + kstep, voffB); PG8_STAGE(PG8_SA(1, 0), cA + kstep, voffA); PG8_STAGE(PG8_SB(1, 1), cB + hstep + kstep, voffB);
        PG8_WAIT_V(6); PG8_BAR;
    }
    for (;;) {
        const bool has_next = S.next(ui + 1, nxt);
        const char* nA = has_next ? (const char*)g.A + (size_t)nxt.pm * tstep : cA; const char* nB = has_next ? (const char*)g.Bt + (size_t)nxt.pn * tstep : cB;
        for (int t = 0; t < nt; t += 2) {
            const bool last = (t == nt - 2);
            const char* a1 = cA + (size_t)(t + 1) * kstep;
            const char* a2 = last ? nA : cA + (size_t)(t + 2) * kstep; const char* b2 = last ? nB : cB + (size_t)(t + 2) * kstep;
            const char* a3 = a2 + kstep; const char* b3 = b2 + kstep;
            if (last && has_next) S.a_ready(nxt);
            if constexpr (SP2) {
            PG8_LDB(B0, 0, 0); PG8_LDB(B1, 0, 1); PG8_SCHED; PG8_LDA(At, 0, 0); PG8_STAGE(PG8_SA(1, 1), a1 + hstep, voffA);
            PG8_WAIT_V(8); PG8_WAIT_L(0); PG8_BAR; PG8_MMA(0, 0, At, B0); PG8_MMA(0, 1, At, B1); PG8_BAR; PG8_SCHED;
            PG8_LDA(At, 0, 1); PG8_STAGE(PG8_SB(0, 0), b2, voffB); PG8_STAGE(PG8_SB(0, 1), b2 + hstep, voffB); PG8_STAGE(PG8_SA(0, 0), a2, voffA);
            PG8_WAIT_V(8); PG8_WAIT_L(0); PG8_BAR; PG8_MMA(1, 0, At, B0); PG8_MMA(1, 1, At, B1); PG8_BAR; PG8_SCHED;
            PG8_LDB(B0, 1, 0); PG8_LDB(B1, 1, 1); PG8_SCHED; PG8_LDA(At, 1, 0); PG8_STAGE(PG8_SA(0, 1), a2 + hstep, voffA);
            PG8_WAIT_V(8); PG8_WAIT_L(0); PG8_BAR; PG8_MMA(0, 0, At, B0); PG8_MMA(0, 1, At, B1); PG8_BAR; PG8_SCHED;
            PG8_LDA(At, 1, 1); PG8_STAGE(PG8_SB(1, 0), b3, voffB); PG8_STAGE(PG8_SB(1, 1), b3 + hstep, voffB); PG8_STAGE(PG8_SA(1, 0), a3, voffA);
            PG8_WAIT_V(8); PG8_WAIT_L(0); PG8_BAR; PG8_MMA(1, 0, At, B0); PG8_MMA(1, 1, At, B1); PG8_BAR; PG8_SCHED;
            } else {
            PG8_LDB(B0, 0, 0); PG8_SCHED; PG8_LDA(At, 0, 0); PG8_STAGE(PG8_SA(1, 1), a1 + hstep, voffA);
            PG8_WAIT_L(8); PG8_BAR; PG8_WAIT_L(0); PG8_MMA(0, 0, At, B0); PG8_BAR; PG8_SCHED;
            PG8_LDB(B1, 0, 1); PG8_STAGE(PG8_SB(0, 0), b2, voffB);
            PG8_BAR; PG8_WAIT_L(0); PG8_MMA(0, 1, At, B1); PG8_BAR;
            PG8_LDA(At, 0, 1); PG8_STAGE(PG8_SA(0, 0), a2, voffA);
            PG8_BAR; PG8_WAIT_L(0); PG8_MMA(1, 0, At, B0); PG8_BAR; PG8_SCHED;
            PG8_STAGE(PG8_SB(0, 1), b2 + hstep, voffB);
            PG8_WAIT_V(6); PG8_BAR; PG8_MMA(1, 1, At, B1); PG8_BAR;
            PG8_LDB(B0, 1, 0); PG8_SCHED; PG8_LDA(At, 1, 0); PG8_STAGE(PG8_SA(0, 1), a2 + hstep, voffA);
            PG8_WAIT_L(8); PG8_BAR; PG8_WAIT_L(0); PG8_MMA(0, 0, At, B0); PG8_BAR; PG8_SCHED;
            PG8_LDB(B1, 1, 1); PG8_STAGE(PG8_SB(1, 0), b3, voffB);
            PG8_BAR; PG8_WAIT_L(0); PG8_MMA(0, 1, At, B1); PG8_BAR;
            PG8_LDA(At, 1, 1); PG8_STAGE(PG8_SA(1, 0), a3, voffA);
            PG8_BAR; PG8_WAIT_L(0); PG8_MMA(1, 0, At, B0); PG8_BAR; PG8_SCHED;
            PG8_STAGE(PG8_SB(1, 1), b3 + hstep, voffB);
            PG8_WAIT_V(6); PG8_BAR; PG8_MMA(1, 1, At, B1); PG8_BAR;
            }
        }
        if constexpr (ALIGN_EPI) { if (wr == 0) PG8_BAR; }
        if constexpr (!Epi::AFTER_DRAIN) { E(acc, cur, wr, wc, fr, fq); S.done(cur); }
        if (!has_next) break;
#pragma unroll
        for (int a = 0; a < 2; ++a)
#pragma unroll
            for (int b = 0; b < 2; ++b)
#pragma unroll
                for (int m = 0; m < 4; ++m)
#pragma unroll
                    for (int n = 0; n < 2; ++n) acc[a][b][m][n] = (f32x4){0.f, 0.f, 0.f, 0.f};
        cur = nxt; cA = nA; cB = nB; ++ui;
        if constexpr (ALIGN_EPI) { if (wr == 1) PG8_BAR; }
    }
    PG8_WAIT_V(0);
    if constexpr (!ALIGN_EPI) { if (wr == 0) PG8_BAR; }
    PG8_BAR;
    if constexpr (Epi::AFTER_DRAIN) { E.fused(acc, cur, wr, wc, fr, fq, lds, wid, lane); S.done(cur); }
#undef PG8_SA
#undef PG8_SB
#undef PG8_STAGE
#undef PG8_LDA
#undef PG8_LDB
#undef PG8_MMA
#undef PG8_WAIT_V
#undef PG8_WAIT_L
#undef PG8_BAR
#undef PG8_SCHED
}
}

#define LAS __attribute__((address_space(3)))
using pg8::bf16_t; using pg8::bf16x8; using pg8::f32x4; using pg8::u32x4; using pg8::Unit; using pg8::cvt_pk_bf16;
typedef unsigned u32x2 __attribute__((ext_vector_type(2)));

constexpr int DM = 1024, TP = 16384, NSM = 512, MT = TP + NSM, INC = 2304, DFF = 2816, PLE = 256;
constexpr int ZQ = 0, ZF = 256, ZI = 512, ZG = 768, ZBU = 1024, ZBG = 1280, ZCQ = 1536, ZCK = 2048, ZCV = 2176;
constexpr float EPS = 1e-6f;
constexpr int NPOS = TP + 4;
constexpr size_t O_Y = 0, O_SPH = (size_t)MT * DM, O_SPC = O_SPH + 32768, O_SPK = O_SPC + 15360, O_SPV = O_SPK + 32768,
                 O_SSH = O_SPV + 32768, O_SSC = O_SSH + 4194304, O_SSK = O_SSC + 1966080, O_SSV = O_SSK + 4194304;
constexpr size_t MiB = 1u << 20;
constexpr size_t WS_CTL = 0, CTL_BYTES = 65536;
constexpr size_t WS_SS = 1 * MiB;
constexpr size_t WS_LB = WS_SS + 512 * 1024;
constexpr size_t WS_DVEC = WS_LB + 4096;
constexpr size_t WS_ROPE = 2 * MiB;
constexpr size_t WS_W = 7 * MiB;
constexpr size_t W_IN = 0, W_OUT = W_IN + (size_t)INC * DM * 2, W_GU = W_OUT + (size_t)DM * DM * 2, W_D = W_GU + (size_t)2 * DFF * DM * 2,
                 W_PG = W_D + (size_t)DM * DFF * 2, W_PP = W_PG + (size_t)DM * DM * 2, W_LAYER = W_PP + (size_t)DM * PLE * 2;
constexpr size_t WS_BUFA = 59 * MiB, WS_BUFB = 92 * MiB, WS_ZACT = 125 * MiB, WS_PB = 216 * MiB, WS_DS = 233 * MiB, WS_END = 249 * MiB;
static_assert(WS_W + 2 * W_LAYER <= WS_BUFA && WS_BUFA + (size_t)MT * DM * 2 <= WS_BUFB && WS_BUFB + (size_t)MT * DM * 2 <= WS_ZACT, "ws map");
static_assert(WS_ZACT + (size_t)MT * DFF * 2 <= WS_PB && WS_PB + (size_t)2 * MT * PLE * 2 <= WS_DS && WS_ROPE + (size_t)NPOS * 64 * 4 <= WS_W, "ws map");
constexpr int LDS_BYTES = 147456, MISC_OFF = 131072 + 320;

#define LSYNC() do { asm volatile("s_waitcnt lgkmcnt(0)" ::: "memory"); __builtin_amdgcn_s_barrier(); asm volatile("" ::: "memory"); } while (0)
#define LDS_WAIT() asm volatile("s_waitcnt lgkmcnt(0)" ::: "memory")
__device__ __forceinline__ float bf2f(unsigned short h) { return __uint_as_float(((unsigned)h) << 16); }
template <int CTRL> __device__ __forceinline__ float dppf(float v) { return __int_as_float(__builtin_amdgcn_update_dpp(0, __float_as_int(v), CTRL, 0xf, 0xf, true)); }
__device__ __forceinline__ float wave_sum(float v) {
    v += dppf<0xB1>(v);
    v += dppf<0x4E>(v);
    v += dppf<0x141>(v);
    v += dppf<0x140>(v);
    const float r0 = __int_as_float(__builtin_amdgcn_readlane(__float_as_int(v), 0)), r1 = __int_as_float(__builtin_amdgcn_readlane(__float_as_int(v), 16));
    const float r2 = __int_as_float(__builtin_amdgcn_readlane(__float_as_int(v), 32)), r3 = __int_as_float(__builtin_amdgcn_readlane(__float_as_int(v), 48));
    return (r0 + r1) + (r2 + r3);
}
__device__ __forceinline__ float quad_sum(float v) { v += dppf<0xB1>(v); v += dppf<0x4E>(v); return v; }
__device__ __forceinline__ float sigmoidf_(float x) { return __builtin_amdgcn_rcpf(1.0f + __expf(-x)); }
__device__ __forceinline__ float siluf_(float x) { return x * __builtin_amdgcn_rcpf(1.0f + __expf(-x)); }
#define UNPACK8(V_, o) do { (o)[0] = __uint_as_float((V_).x << 16); (o)[1] = __uint_as_float((V_).x & 0xffff0000u); (o)[2] = __uint_as_float((V_).y << 16); (o)[3] = __uint_as_float((V_).y & 0xffff0000u); \
    (o)[4] = __uint_as_float((V_).z << 16); (o)[5] = __uint_as_float((V_).z & 0xffff0000u); (o)[6] = __uint_as_float((V_).w << 16); (o)[7] = __uint_as_float((V_).w & 0xffff0000u); } while (0)

#define XB_TMO      128
#define XB_XCNT(j)  (256  + 64 * (j))
#define XB_XSUB(j)  (1280 + 64 * (j))
#define XB_XGEN(j)  (2304 + 64 * (j))
#define XB_TOP      3328
#define XB_TOPGEN   3392
#define XCD_BAR_WORDS 3456
#define XB_SPIN_CAP (1u << 18)

__device__ __forceinline__ unsigned xb_ld(unsigned* p)              { return __hip_atomic_load(p, __ATOMIC_RELAXED, __HIP_MEMORY_SCOPE_AGENT); }
__device__ __forceinline__ unsigned xb_add(unsigned* p, unsigned v) { return __hip_atomic_fetch_add(p, v, __ATOMIC_RELAXED, __HIP_MEMORY_SCOPE_AGENT); }
__device__ __forceinline__ unsigned xb_xcc_id() { return (unsigned)__builtin_amdgcn_s_getreg((3 << 11) | 20) & 0xFu; }
#define XB_SPIN(cond, bar) do { unsigned _sp = 0; while (cond) { __builtin_amdgcn_s_sleep(1); \
    if ((++_sp & 255u) == 0u) { if (xb_ld(&(bar)[XB_TMO])) break; if (_sp > XB_SPIN_CAP) { atomicAdd(&(bar)[XB_TMO], 1u); break; } } } } while (0)

struct XcdBarrier {
    unsigned* bar; unsigned x; int wv;
    volatile LAS unsigned* st;
};

__device__ __forceinline__ XcdBarrier xcd_barrier_post(unsigned* bar, volatile LAS unsigned* st) {
    XcdBarrier b; b.bar = bar; b.x = xb_xcc_id(); b.st = st;
    if (threadIdx.x == 0) (void)xb_add(&bar[XB_XCNT(b.x)], 1u);
    return b;
}
__device__ __forceinline__ void xcd_barrier_complete(unsigned* bar, unsigned x, unsigned& nloc, unsigned& nx) {
    const unsigned G = gridDim.x * gridDim.y * gridDim.z;
    unsigned sum, cnt, mine, sp = 0u;
    for (;;) {
        sum = 0u; cnt = 0u; mine = 0u;
#pragma unroll
        for (unsigned j = 0; j < 16; ++j) { const unsigned c = xb_ld(&bar[XB_XCNT(j)]); sum += c; cnt += (c > 0u) ? 1u : 0u; mine = (j == x) ? c : mine; }
        if (sum == G) break;
        __builtin_amdgcn_s_sleep(1);
        if ((++sp & 255u) == 0u) { if (xb_ld(&bar[XB_TMO])) break; if (sp > XB_SPIN_CAP) { atomicAdd(&bar[XB_TMO], 1u); break; } }
    }
    nloc = mine > 0u ? mine : 1u; nx = cnt > 0u ? cnt : 1u;
}

__device__ __forceinline__ void xcd_barrier(const XcdBarrier& b) {
    asm volatile("s_waitcnt vmcnt(0)" ::: "memory");
    __syncthreads();
    unsigned xm_ = ~0u; asm volatile("" : "+s"(xm_));
    int xw_ = b.wv; asm volatile("" : "+s"(xw_));
    if (xw_ == 0 && __builtin_amdgcn_mbcnt_hi(xm_, __builtin_amdgcn_mbcnt_lo(xm_, 0u)) == 0u) {
        unsigned* bar = b.bar;
        __builtin_amdgcn_s_waitcnt(0);
        unsigned nloc = b.st[0], nx = b.st[1];
        if (nloc == 0u) { xcd_barrier_complete(bar, b.x, nloc, nx); b.st[0] = nloc; b.st[1] = nx; }
        const unsigned old = xb_add(&bar[XB_XSUB(b.x)], 1u);
        const unsigned gen = old / nloc;
        if (old + 1u == (gen + 1u) * nloc) {
            __builtin_amdgcn_fence(__ATOMIC_RELEASE, "agent");
            asm volatile("s_waitcnt vmcnt(0)" ::: "memory");
            const unsigned og = xb_add(&bar[XB_TOP], 1u);
            const unsigned tg = og / nx;
            if (og + 1u == (tg + 1u) * nx) xb_add(&bar[XB_TOPGEN], 1u);
            else XB_SPIN(xb_ld(&bar[XB_TOPGEN]) == tg, bar);
            __builtin_amdgcn_fence(__ATOMIC_ACQUIRE, "agent");
            xb_add(&bar[XB_XGEN(b.x)], 1u);
            asm volatile("s_waitcnt vmcnt(0)" ::: "memory");
        } else {
            XB_SPIN(xb_ld(&bar[XB_XGEN(b.x)]) == gen, bar);
            __builtin_amdgcn_fence(__ATOMIC_ACQUIRE, "agent");
            asm volatile("s_waitcnt vmcnt(0)" ::: "memory");
        }
    }
    __syncthreads();
}

struct EpiZ {
    static constexpr bool PERM = true, AFTER_DRAIN = false;
    bf16_t* O; int ldc; const float* ss;
    __device__ __forceinline__ void operator()(const f32x4 (&acc)[2][2][4][2], const Unit& u, int wr, int wc, int fr, int fq) const {
        const int row0 = u.pm * 256 + wr * 64 + fr, col0 = u.pn * 256 + wc * 32 + 8 * fq;
#pragma unroll
        for (int ai = 0; ai < 2; ++ai)
#pragma unroll
            for (int m = 0; m < 4; ++m) {
                const int row = row0 + ai * 128 + m * 16; const float r = rsqrtf(ss[row] * (1.0f / DM) + EPS);
                bf16_t* rowp = O + (size_t)row * ldc + col0;
#pragma unroll
                for (int bj = 0; bj < 2; ++bj) { const f32x4 v0 = acc[ai][bj][m][0] * r, v1 = acc[ai][bj][m][1] * r;
                    u32x4 w; w.x = cvt_pk_bf16(v0[0], v0[1]); w.y = cvt_pk_bf16(v0[2], v0[3]); w.z = cvt_pk_bf16(v1[0], v1[1]); w.w = cvt_pk_bf16(v1[2], v1[3]);
                    *(u32x4*)(rowp + bj * 128) = w; }
            }
    }
};
typedef float f32x2 __attribute__((ext_vector_type(2)));
struct EpiGU {
    static constexpr bool PERM = true, AFTER_DRAIN = false;
    bf16_t* O; const float* ss;
    __device__ __forceinline__ void operator()(const f32x4 (&acc)[2][2][4][2], const Unit& u, int wr, int wc, int fr, int fq) const {
        const int row0 = u.pm * 256 + wr * 64 + fr, col0 = u.pn * 128 + wc * 32 + 8 * fq;
#pragma unroll
        for (int ai = 0; ai < 2; ++ai)
#pragma unroll
            for (int m = 0; m < 4; ++m) {
                const int row = row0 + ai * 128 + m * 16; const float r = rsqrtf(ss[row] * (1.0f / DM) + EPS);
                const float rn = r * -1.44269504f, r2 = r * r;
                unsigned w4[4];
#pragma unroll
                for (int n = 0; n < 2; ++n)
#pragma unroll
                    for (int e = 0; e < 4; e += 2) {
                        const f32x2 g2 = (f32x2){acc[ai][0][m][n][e], acc[ai][0][m][n][e + 1]}, u2 = (f32x2){acc[ai][1][m][n][e], acc[ai][1][m][n][e + 1]};
                        const f32x2 t = g2 * rn; f32x2 ex; ex.x = __builtin_amdgcn_exp2f(t.x); ex.y = __builtin_amdgcn_exp2f(t.y);
                        const f32x2 d = ex + 1.0f; f32x2 rc; rc.x = __builtin_amdgcn_rcpf(d.x); rc.y = __builtin_amdgcn_rcpf(d.y);
                        const f32x2 o = (g2 * u2) * (rc * r2);
                        w4[n * 2 + (e >> 1)] = cvt_pk_bf16(o.x, o.y);
                    }
                u32x4 w; w.x = w4[0]; w.y = w4[1]; w.z = w4[2]; w.w = w4[3];
                *(u32x4*)(O + (size_t)row * DFF + col0) = w;
            }
    }
};
struct EpiRes {
    static constexpr bool PERM = false, AFTER_DRAIN = false;
    const bf16_t* res; bf16_t* Ob; float* ss;
    __device__ __forceinline__ void operator()(const f32x4 (&acc)[2][2][4][2], const Unit& u, int wr, int wc, int fr, int fq) const {
        const int row0 = u.pm * 256 + wr * 64 + fr, col0 = u.pn * 256 + wc * 32 + 4 * fq;
#pragma unroll
        for (int ai = 0; ai < 2; ++ai)
#pragma unroll
            for (int m = 0; m < 4; ++m) {
                const int row = row0 + ai * 128 + m * 16; const size_t off = (size_t)row * DM + col0; float sq = 0.f;
#pragma unroll
                for (int bj = 0; bj < 2; ++bj)
#pragma unroll
                    for (int n = 0; n < 2; ++n) { const size_t o2 = off + bj * 128 + n * 16;
                        const u32x2 rw = *(const u32x2*)(res + o2);
                        f32x4 v = acc[ai][bj][m][n]; v[0] += __uint_as_float(rw.x << 16); v[1] += __uint_as_float(rw.x & 0xffff0000u); v[2] += __uint_as_float(rw.y << 16); v[3] += __uint_as_float(rw.y & 0xffff0000u);
                        u32x2 w; w.x = cvt_pk_bf16(v[0], v[1]); w.y = cvt_pk_bf16(v[2], v[3]); *(u32x2*)(Ob + o2) = w;
                        sq += (v[0] * v[0] + v[1] * v[1]) + (v[2] * v[2] + v[3] * v[3]); }
                sq += __shfl_xor(sq, 16); sq += __shfl_xor(sq, 32);
                if (fq == 0) unsafeAtomicAdd(ss + row, sq);
            }
    }
};
struct EpiGate {
    static constexpr bool PERM = false, AFTER_DRAIN = false;
    bf16_t* Gt; const float* ss;
    __device__ __forceinline__ void operator()(const f32x4 (&acc)[2][2][4][2], const Unit& u, int wr, int wc, int fr, int fq) const {
        const int row0 = u.pm * 256 + wr * 64 + fr, col0 = u.pn * 256 + wc * 32 + 4 * fq;
#pragma unroll
        for (int ai = 0; ai < 2; ++ai)
#pragma unroll
            for (int m = 0; m < 4; ++m) {
                const int row = row0 + ai * 128 + m * 16; const size_t off = (size_t)row * DM + col0; const float r = rsqrtf(ss[row] * (1.0f / DM) + EPS);
#pragma unroll
                for (int bj = 0; bj < 2; ++bj)
#pragma unroll
                    for (int n = 0; n < 2; ++n) { const f32x4 a = acc[ai][bj][m][n] * r;
                        u32x2 w; w.x = cvt_pk_bf16(sigmoidf_(a[0]), sigmoidf_(a[1])); w.y = cvt_pk_bf16(sigmoidf_(a[2]), sigmoidf_(a[3]));
                        *(u32x2*)(Gt + off + bj * 128 + n * 16) = w; }
            }
    }
};
struct EpiOut {
    static constexpr bool PERM = false, AFTER_DRAIN = false;
    const bf16_t* Gt; const bf16_t* res; float* Y; bf16_t* Ob; float* ss; int final_;
    __device__ __forceinline__ void operator()(const f32x4 (&acc)[2][2][4][2], const Unit& u, int wr, int wc, int fr, int fq) const {
        const int row0 = u.pm * 256 + wr * 64 + fr, col0 = u.pn * 256 + wc * 32 + 4 * fq;
#pragma unroll
        for (int ai = 0; ai < 2; ++ai)
#pragma unroll
            for (int m = 0; m < 4; ++m) {
                const int row = row0 + ai * 128 + m * 16; const size_t off = (size_t)row * DM + col0; float sq = 0.f;
#pragma unroll
                for (int bj = 0; bj < 2; ++bj)
#pragma unroll
                    for (int n = 0; n < 2; ++n) { const size_t o2 = off + bj * 128 + n * 16;
                        const u32x2 rw = *(const u32x2*)(res + o2), gw = *(const u32x2*)(Gt + o2);
                        const f32x4 a = acc[ai][bj][m][n]; f32x4 v;
                        v[0] = __uint_as_float(rw.x << 16) + __uint_as_float(gw.x << 16) * a[0]; v[1] = __uint_as_float(rw.x & 0xffff0000u) + __uint_as_float(gw.x & 0xffff0000u) * a[1];
                        v[2] = __uint_as_float(rw.y << 16) + __uint_as_float(gw.y << 16) * a[2]; v[3] = __uint_as_float(rw.y & 0xffff0000u) + __uint_as_float(gw.y & 0xffff0000u) * a[3];
                        if (final_) *(f32x4*)(Y + o2) = v;
                        else { u32x2 w; w.x = cvt_pk_bf16(v[0], v[1]); w.y = cvt_pk_bf16(v[2], v[3]); *(u32x2*)(Ob + o2) = w; }
                        sq += (v[0] * v[0] + v[1] * v[1]) + (v[2] * v[2] + v[3] * v[3]); }
                if (!final_) { sq += __shfl_xor(sq, 16); sq += __shfl_xor(sq, 32); if (fq == 0) unsafeAtomicAdd(ss + row, sq); }
            }
    }
};

template <class Epi>
__device__ __forceinline__ void small_gemm(LAS unsigned char* lds, const bf16_t* A, const bf16_t* Bt, int K, const Epi& E, int bid, int tid, int lane, int wave) {
    if (bid >= 256) return;
    const int r0 = 64 * (bid >> 5), c0 = 32 * (bid & 31), fr = lane & 15, g = lane >> 4, kw = K >> 3;
    f32x4 acc[4][2];
#pragma unroll
    for (int m = 0; m < 4; ++m) { acc[m][0] = (f32x4){0.f, 0.f, 0.f, 0.f}; acc[m][1] = (f32x4){0.f, 0.f, 0.f, 0.f}; }
    const bf16_t* ap = A + (size_t)(r0 + fr) * K + wave * kw + 8 * g;
    const bf16_t* bp = Bt + (size_t)(c0 + fr) * K + wave * kw + 8 * g;
#pragma unroll 4
    for (int ks = 0; ks < kw; ks += 32) {
        bf16x8 a[4], b[2];
#pragma unroll
        for (int m = 0; m < 4; ++m) a[m] = *(const bf16x8*)(ap + (size_t)m * 16 * K + ks);
#pragma unroll
        for (int n = 0; n < 2; ++n) b[n] = *(const bf16x8*)(bp + (size_t)n * 16 * K + ks);
#pragma unroll
        for (int m = 0; m < 4; ++m)
#pragma unroll
            for (int n = 0; n < 2; ++n) acc[m][n] = __builtin_amdgcn_mfma_f32_16x16x32_bf16(a[m], b[n], acc[m][n], 0, 0, 0);
    }
    LAS float* P = (LAS float*)lds + wave * (64 * 33);
    LSYNC();
#pragma unroll
    for (int m = 0; m < 4; ++m)
#pragma unroll
        for (int n = 0; n < 2; ++n)
#pragma unroll
            for (int r = 0; r < 4; ++r) P[(16 * m + 4 * g + r) * 33 + 16 * n + fr] = acc[m][n][r];
    LSYNC();
    const int row = tid >> 3, c4 = (tid & 7) * 4;
    f32x4 v = (f32x4){0.f, 0.f, 0.f, 0.f};
#pragma unroll
    for (int w2 = 0; w2 < 8; ++w2) { const LAS float* q = (const LAS float*)lds + w2 * (64 * 33) + row * 33 + c4; v[0] += q[0]; v[1] += q[1]; v[2] += q[2]; v[3] += q[3]; }
    LSYNC();
    E.apply(r0 + row, c0 + c4, v, tid);
}
struct SEpiRes {
    const bf16_t* res; bf16_t* Ob; float* ss;
    __device__ __forceinline__ void apply(int row, int col, f32x4 v, int tid) const {
        const size_t o = (size_t)row * DM + col; const u32x2 rw = *(const u32x2*)(res + o);
        v[0] += __uint_as_float(rw.x << 16); v[1] += __uint_as_float(rw.x & 0xffff0000u); v[2] += __uint_as_float(rw.y << 16); v[3] += __uint_as_float(rw.y & 0xffff0000u);
        u32x2 w; w.x = cvt_pk_bf16(v[0], v[1]); w.y = cvt_pk_bf16(v[2], v[3]); *(u32x2*)(Ob + o) = w;
        float sq = (v[0] * v[0] + v[1] * v[1]) + (v[2] * v[2] + v[3] * v[3]);
        sq += __shfl_xor(sq, 1); sq += __shfl_xor(sq, 2); sq += __shfl_xor(sq, 4);
        if ((tid & 7) == 0) unsafeAtomicAdd(ss + row, sq);
    }
};
struct SEpiGate {
    bf16_t* Gt; const float* ss;
    __device__ __forceinline__ void apply(int row, int col, f32x4 v, int tid) const {
        const float r = rsqrtf(ss[row] * (1.0f / DM) + EPS);
        u32x2 w; w.x = cvt_pk_bf16(sigmoidf_(v[0] * r), sigmoidf_(v[1] * r)); w.y = cvt_pk_bf16(sigmoidf_(v[2] * r), sigmoidf_(v[3] * r));
        *(u32x2*)(Gt + (size_t)row * DM + col) = w;
    }
};
struct SEpiOut {
    const bf16_t* Gt; const bf16_t* res; float* Y; bf16_t* Ob; float* ss; int final_;
    __device__ __forceinline__ void apply(int row, int col, f32x4 a, int tid) const {
        const size_t o = (size_t)row * DM + col; const u32x2 rw = *(const u32x2*)(res + o), gw = *(const u32x2*)(Gt + o); f32x4 v;
        v[0] = __uint_as_float(rw.x << 16) + __uint_as_float(gw.x << 16) * a[0]; v[1] = __uint_as_float(rw.x & 0xffff0000u) + __uint_as_float(gw.x & 0xffff0000u) * a[1];
        v[2] = __uint_as_float(rw.y << 16) + __uint_as_float(gw.y << 16) * a[2]; v[3] = __uint_as_float(rw.y & 0xffff0000u) + __uint_as_float(gw.y & 0xffff0000u) * a[3];
        if (final_) { *(f32x4*)(Y + o) = v; return; }
        u32x2 w; w.x = cvt_pk_bf16(v[0], v[1]); w.y = cvt_pk_bf16(v[2], v[3]); *(u32x2*)(Ob + o) = w;
        float sq = (v[0] * v[0] + v[1] * v[1]) + (v[2] * v[2] + v[3] * v[3]);
        sq += __shfl_xor(sq, 1); sq += __shfl_xor(sq, 2); sq += __shfl_xor(sq, 4);
        if ((tid & 7) == 0) unsafeAtomicAdd(ss + row, sq);
    }
};

__device__ __forceinline__ void transpose_item(const float* W, int K, int N, const float* gain, bf16_t* WT, int mode, LAS float* scr, int item, int lane) {
    const int nblk = N / 32, kb = item / nblk, nb = item % nblk, k0 = 64 * kb, n0 = 32 * nb;
    { const int kr = lane >> 3, nq = (lane & 7) * 4; f32x4 v[8]; float gv[8];
#pragma unroll
      for (int i = 0; i < 8; ++i) { v[i] = *(const f32x4*)(W + (size_t)(k0 + 8 * i + kr) * N + n0 + nq); gv[i] = gain ? gain[k0 + 8 * i + kr] : 1.0f; }
#pragma unroll
      for (int i = 0; i < 8; ++i) { LAS float* d = scr + (8 * i + kr) * 33 + nq; d[0] = v[i][0] * gv[i]; d[1] = v[i][1] * gv[i]; d[2] = v[i][2] * gv[i]; d[3] = v[i][3] * gv[i]; } }
    LDS_WAIT(); asm volatile("" ::: "memory");
    const int drow0 = (mode == 0) ? n0 : (256 * (n0 >> 7) + (n0 & 127) + (mode == 2 ? 128 : 0));
    const int c = lane & 7;
#pragma unroll
    for (int j = 0; j < 4; ++j) { const int n = (lane >> 3) + 8 * j; const LAS float* s = scr + (8 * c) * 33 + n;
        u32x4 o; o.x = cvt_pk_bf16(s[0 * 33], s[1 * 33]); o.y = cvt_pk_bf16(s[2 * 33], s[3 * 33]); o.z = cvt_pk_bf16(s[4 * 33], s[5 * 33]); o.w = cvt_pk_bf16(s[6 * 33], s[7 * 33]);
        *(u32x4*)(WT + (size_t)(drow0 + n) * K + k0 + 8 * c) = o; }
    LDS_WAIT(); asm volatile("" ::: "memory");
}

struct Args { const float* in[27]; float* out; unsigned char* ws; };
constexpr int PT_OFF = 131072 + 1024;
__device__ __forceinline__ int opaque(int x) { asm volatile("" : "+v"(x)); return x; }
__device__ __forceinline__ int lane_id_opaque() { unsigned m_ = ~0u; asm volatile("" : "+s"(m_)); return (int)__builtin_amdgcn_mbcnt_hi(m_, __builtin_amdgcn_mbcnt_lo(m_, 0u)); }
__device__ __forceinline__ const float* ptf(LAS unsigned char* lds, int i) {
    const unsigned long long v = ((LAS const unsigned long long*)(lds + PT_OFF))[i];
    const unsigned lo = __builtin_amdgcn_readfirstlane((unsigned)v), hi = __builtin_amdgcn_readfirstlane((unsigned)(v >> 32));
    return (const float*)(((unsigned long long)hi << 32) | lo);
}
#define IN(i) ptf(lds, (i))
#define OUTP ((float*)ptf(lds, 27))
#define WSP ((unsigned char*)ptf(lds, 28))

constexpr int CI_OUT = (DM / 64) * (INC / 32), CI_GG = CI_OUT + (DM / 64) * (DM / 32), CI_GU = CI_GG + (DM / 64) * (DFF / 32), CI_D = CI_GU + (DM / 64) * (DFF / 32),
              CI_PG = CI_D + (DFF / 64) * (DM / 32), CI_PP = CI_PG + (DM / 64) * (DM / 32), CI_LAYER = CI_PP + (PLE / 64) * (DM / 32);
__device__ __forceinline__ void convert_item(LAS unsigned char* lds, unsigned char* ws, LAS float* scr, int it, int lane) {
    const int l = it / CI_LAYER; int r = it - l * CI_LAYER;
    const float* W; const float* gain = nullptr; int K = DM, N = DM, mode = 0; size_t woff;
    if (r < CI_OUT) { W = IN(9) + (size_t)l * DM * INC; N = INC; gain = IN(19) + l * DM; woff = W_IN; }
    else if (r < CI_GG) { r -= CI_OUT; W = IN(18) + (size_t)l * DM * DM; woff = W_OUT; }
    else if (r < CI_GU) { r -= CI_GG; W = IN(21) + (size_t)l * DM * DFF; N = DFF; gain = IN(20) + l * DM; woff = W_GU; mode = 1; }
    else if (r < CI_D) { r -= CI_GU; W = IN(22) + (size_t)l * DM * DFF; N = DFF; gain = IN(20) + l * DM; woff = W_GU; mode = 2; }
    else if (r < CI_PG) { r -= CI_D; W = IN(23) + (size_t)l * DFF * DM; K = DFF; woff = W_D; }
    else if (r < CI_PP) { r -= CI_PG; W = IN(25) + (size_t)l * DM * DM; gain = IN(24) + l * DM; woff = W_PG; }
    else { r -= CI_PP; W = IN(26) + (size_t)l * PLE * DM; K = PLE; woff = W_PP; }
    transpose_item(W, K, N, gain, (bf16_t*)(ws + WS_W + (size_t)l * W_LAYER + woff), mode, scr, r, lane);
}
__device__ __forceinline__ void prologue(LAS unsigned char* lds, int wv) {
    { unsigned z_ = 0; asm volatile("" : "+s"(z_)); lds += z_; }
    int wave_ = wv; asm volatile("" : "+s"(wave_)); const int wave = wave_, lane = lane_id_opaque(), tid = wave * 64 + lane;
    const int G = gridDim.x, bid = blockIdx.x, gw = bid * 8 + wave, NGW = G * 8, gtid = bid * 512 + tid, NT = G * 512;
    unsigned char* ws = WSP;
    LAS float* scr = (LAS float*)(lds + wave * 16384);
#pragma unroll 1
    for (int k = gw; k < CI_D + (CI_D - CI_GG); k += NGW) convert_item(lds, ws, scr, (k < CI_D) ? k : (CI_LAYER + CI_GG + (k - CI_D)), lane);
    float* ss = (float*)(ws + WS_SS);
    bf16_t* bufA = (bf16_t*)(ws + WS_BUFA);
    const float* xP = IN(0); const float* xS = IN(1);
#pragma unroll 1
    for (int m0 = gw; m0 < MT; m0 += 2 * NGW) {
        f32x4 v[2][4];
#pragma unroll
        for (int q = 0; q < 2; ++q) { const int m = (m0 + q * NGW < MT) ? m0 + q * NGW : m0; const float* xr = (m < TP) ? xP + (size_t)m * DM : xS + (size_t)(m - TP) * DM;
#pragma unroll
            for (int j = 0; j < 4; ++j) v[q][j] = ((const f32x4*)xr)[lane + 64 * j]; }
#pragma unroll
        for (int q = 0; q < 2; ++q) { const int m = (m0 + q * NGW < MT) ? m0 + q * NGW : m0; float s = 0.f;
#pragma unroll
            for (int j = 0; j < 4; ++j) s += (v[q][j][0] * v[q][j][0] + v[q][j][1] * v[q][j][1]) + (v[q][j][2] * v[q][j][2] + v[q][j][3] * v[q][j][3]);
            s = wave_sum(s); if (lane == 0) ss[m] = s;
#pragma unroll
            for (int j = 0; j < 4; ++j) { u32x2 w; w.x = cvt_pk_bf16(v[q][j][0], v[q][j][1]); w.y = cvt_pk_bf16(v[q][j][2], v[q][j][3]); ((u32x2*)(bufA + (size_t)m * DM))[lane + 64 * j] = w; } }
    }
    float* rc = (float*)(ws + WS_ROPE); float* rs = rc + (size_t)NPOS * 32;
#pragma unroll 1
    for (int idx = gtid; idx < NPOS * 32; idx += NT) {
        const int pos = idx >> 5, d = idx & 31;
        const double inv = exp2(-(double)d * (13.287712379549449 / 32.0));
        double rev = (double)pos * inv * 0.15915494309189535; rev -= rint(rev);
        const float fr = (float)rev;
        rc[idx] = __builtin_amdgcn_cosf(fr); rs[idx] = __builtin_amdgcn_sinf(fr);
    }
    if (gtid < 256) { float* lb = (float*)(ws + WS_LB); const float* al = IN(8); const float a0 = al[gtid], a1 = al[256 + gtid]; lb[gtid] = 0.f; lb[256 + gtid] = 1.0f / (1.0f + expf(a0 - a1)); }
#pragma unroll 1
    for (int idx = gtid; idx < 5 * MT; idx += NT) ss[MT + idx] = 0.f;
}

__device__ __forceinline__ void hgrn_gates(float z, float lb, float& logf_, float& kin) {
    const float e = __expf(-fabsf(z));
    const float inv = __builtin_amdgcn_rcpf(1.0f + e);
    const float big = inv, small = e * inv;
    const float sp = (z >= 0.f) ? big : small;
    const float sn = (z >= 0.f) ? small : big;
    kin = (1.0f - lb) * sn;
    if (lb > 0.f) logf_ = __logf(lb + (1.0f - lb) * sp);
    else logf_ = fminf(z, 0.f) - __logf(1.0f + e);
}

#define HGRN_G(zbase, lbv, tot) \
    float Gl[8], kin[8]; float Gend = 0.f, Gref = 0.f; { float run = 0.f; \
    _Pragma("unroll") for (int i = 0; i < 8; ++i) { float g; hgrn_gates(bf2f((zbase)[(size_t)(8 * wave + i) * INC + ZF]), lbv, g, kin[i]); run += g; Gl[i] = run; } \
    (tot)[wave * 64 + lane] = run; LSYNC(); float off = 0.f; \
    _Pragma("unroll") for (int w2 = 0; w2 < 8; ++w2) { const float t = (tot)[w2 * 64 + lane]; if (w2 < wave) off += t; if (w2 < 4) Gref += t; Gend += t; } \
    _Pragma("unroll") for (int i = 0; i < 8; ++i) Gl[i] += off; }

#define HGRN_G2(zf, lbv, tot) \
    float Gl[8], kin[8]; float Gend = 0.f, Gref = 0.f; { float run = 0.f; \
    _Pragma("unroll") for (int i = 0; i < 8; ++i) { float g; hgrn_gates((zf)[i], lbv, g, kin[i]); run += g; Gl[i] = run; } \
    (tot)[wave * 64 + lane] = run; LSYNC(); float off = 0.f; \
    _Pragma("unroll") for (int w2 = 0; w2 < 8; ++w2) { const float t = (tot)[w2 * 64 + lane]; if (w2 < wave) off += t; if (w2 < 4) Gref += t; Gend += t; } \
    _Pragma("unroll") for (int i = 0; i < 8; ++i) Gl[i] += off; }
__device__ __forceinline__ void hgrn_ds_item(const unsigned (&zfu)[8], const unsigned (&vi)[8], const float* lbp, float* dS, float* dvec, LAS unsigned char* lds, int c, int h, int tid, int lane, int wave) {
    LAS bf16_t* KTt = (LAS bf16_t*)lds;
    LAS bf16_t* Vt = KTt + 64 * 72;
    LAS float* TOT = (LAS float*)(Vt + 64 * 72);
    float zf[8];
#pragma unroll
    for (int i = 0; i < 8; ++i) zf[i] = __uint_as_float(zfu[i] << 16);
    const float lbv = lbp[h * 64 + lane];
    LSYNC();
    HGRN_G2(zf, lbv, TOT)
    { float kt[8];
#pragma unroll
      for (int i = 0; i < 8; ++i) kt[i] = kin[i] * __expf(Gend - Gl[i]);
      u32x4 kw; kw.x = cvt_pk_bf16(kt[0], kt[1]); kw.y = cvt_pk_bf16(kt[2], kt[3]); kw.z = cvt_pk_bf16(kt[4], kt[5]); kw.w = cvt_pk_bf16(kt[6], kt[7]);
      u32x4 vw; vw.x = vi[0] | (vi[1] << 16); vw.y = vi[2] | (vi[3] << 16); vw.z = vi[4] | (vi[5] << 16); vw.w = vi[6] | (vi[7] << 16);
      *(LAS u32x4*)(KTt + lane * 72 + 8 * wave) = kw; *(LAS u32x4*)(Vt + lane * 72 + 8 * wave) = vw; }
    if (wave == 0) dvec[(c * 4 + h) * 64 + lane] = __expf(Gend);
    LSYNC();
    const int fr = lane & 15, g = lane >> 4, kt4 = wave >> 1, vt0 = 2 * (wave & 1);
    f32x4 acc[2] = {(f32x4){0.f, 0.f, 0.f, 0.f}, (f32x4){0.f, 0.f, 0.f, 0.f}};
#pragma unroll
    for (int ks = 0; ks < 2; ++ks) {
        const bf16x8 kb = *(const LAS bf16x8*)(KTt + (16 * kt4 + fr) * 72 + 32 * ks + 8 * g);
#pragma unroll
        for (int n = 0; n < 2; ++n) { const bf16x8 va = *(const LAS bf16x8*)(Vt + (16 * (vt0 + n) + fr) * 72 + 32 * ks + 8 * g);
            acc[n] = __builtin_amdgcn_mfma_f32_16x16x32_bf16(va, kb, acc[n], 0, 0, 0); }
    }
    float* dst = dS + (size_t)(c * 4 + h) * 4096 + (16 * kt4 + fr) * 64 + 4 * g;
#pragma unroll
    for (int n = 0; n < 2; ++n) *(f32x4*)(dst + 16 * (vt0 + n)) = acc[n];
}

__device__ __forceinline__ void hgrn_out_item(const bf16_t* z, const float* lbp, const float* dS, const float* onorm, bf16_t* mix, LAS unsigned char* lds, int c, int hp, int tid, int lane, int wave) {
    const int hh = wave >> 2, wq = wave & 3, h = 2 * hp + hh, fr = lane & 15, g = lane >> 4;
    LAS bf16_t* QT = (LAS bf16_t*)(lds + hh * 46080);
    LAS bf16_t* KT = QT + 4608;
    LAS bf16_t* QS = KT + 4608;
    LAS bf16_t* Vt = QS + 4608;
    LAS bf16_t* St = Vt + 4608;
    LAS float* TOT = (LAS float*)(lds + 92160) + hh * 256;
    const bf16_t* zb = z + (size_t)(64 * c + 16 * wq) * INC + h * 64 + lane;
    unsigned zfu[16], zqu[16], ziu[16];
#pragma unroll
    for (int i = 0; i < 16; ++i) { zfu[i] = zb[(size_t)i * INC + ZF]; zqu[i] = zb[(size_t)i * INC + ZQ]; ziu[i] = zb[(size_t)i * INC + ZI]; }
    f32x4 sv[4];
#pragma unroll
    for (int j4 = 0; j4 < 4; ++j4) sv[j4] = *(const f32x4*)(dS + (size_t)(c * 4 + h) * 4096 + j4 * 1024 + (wq * 64 + lane) * 4);
    const size_t mt = (size_t)(64 * c + 16 * wq + fr);
    u32x2 gz[4];
#pragma unroll
    for (int vt = 0; vt < 4; ++vt) gz[vt] = *(const u32x2*)(z + mt * INC + ZG + h * 64 + 16 * vt + 4 * g);
    const float lbv = lbp[h * 64 + lane];
    LSYNC();
    float Gl[16], kin[16];
    { float run = 0.f;
#pragma unroll
      for (int i = 0; i < 16; ++i) { float gg; hgrn_gates(__uint_as_float(zfu[i] << 16), lbv, gg, kin[i]); run += gg; Gl[i] = run; }
      TOT[wq * 64 + lane] = run; }
    LSYNC();
    float off = 0.f, Gref = 0.f;
#pragma unroll
    for (int w2 = 0; w2 < 4; ++w2) { const float t = TOT[w2 * 64 + lane]; if (w2 < wq) off += t; if (w2 < 2) Gref += t; }
#pragma unroll
    for (int i = 0; i < 16; ++i) { const float G = Gl[i] + off, q = __uint_as_float(zqu[i] << 16); const int s = 16 * wq + i;
        QT[s * 72 + lane] = (bf16_t)(cvt_pk_bf16(q * __expf(fminf(G - Gref, 80.f)), 0.f) & 0xffffu);
        KT[s * 72 + lane] = (bf16_t)(cvt_pk_bf16(kin[i] * __expf(fminf(Gref - G, 80.f)), 0.f) & 0xffffu);
        QS[s * 72 + lane] = (bf16_t)(cvt_pk_bf16(q * __expf(G), 0.f) & 0xffffu); }
    { u32x4 v0, v1; v0.x = ziu[0] | (ziu[1] << 16); v0.y = ziu[2] | (ziu[3] << 16); v0.z = ziu[4] | (ziu[5] << 16); v0.w = ziu[6] | (ziu[7] << 16);
      v1.x = ziu[8] | (ziu[9] << 16); v1.y = ziu[10] | (ziu[11] << 16); v1.z = ziu[12] | (ziu[13] << 16); v1.w = ziu[14] | (ziu[15] << 16);
      *(LAS u32x4*)(Vt + lane * 72 + 16 * wq) = v0; *(LAS u32x4*)(Vt + lane * 72 + 16 * wq + 8) = v1; }
#pragma unroll
    for (int j4 = 0; j4 < 4; ++j4) { const int e = j4 * 1024 + (wq * 64 + lane) * 4, k = e >> 6, v = e & 63;
#pragma unroll
        for (int i = 0; i < 4; ++i) St[(v + i) * 72 + k] = (bf16_t)(cvt_pk_bf16(sv[j4][i], 0.f) & 0xffffu); }
    LSYNC();
    const int tt = wq;
    bf16x8 qb0 = *(const LAS bf16x8*)(QT + (16 * tt + fr) * 72 + 8 * g), qb1 = *(const LAS bf16x8*)(QT + (16 * tt + fr) * 72 + 32 + 8 * g);
    f32x4 at[4];
#pragma unroll
    for (int st = 0; st < 4; ++st) {
        at[st] = (f32x4){0.f, 0.f, 0.f, 0.f};
        if (st <= tt) {
            const bf16x8 k0 = *(const LAS bf16x8*)(KT + (16 * st + fr) * 72 + 8 * g), k1 = *(const LAS bf16x8*)(KT + (16 * st + fr) * 72 + 32 + 8 * g);
            f32x4 acc = (f32x4){0.f, 0.f, 0.f, 0.f};
            acc = __builtin_amdgcn_mfma_f32_16x16x32_bf16(k0, qb0, acc, 0, 0, 0);
            acc = __builtin_amdgcn_mfma_f32_16x16x32_bf16(k1, qb1, acc, 0, 0, 0);
            if (st == tt) {
#pragma unroll
                for (int r = 0; r < 4; ++r) acc[r] = (4 * g + r <= fr) ? acc[r] : 0.f; }
            at[st] = acc;
        }
    }
    f32x4 o[4];
#pragma unroll
    for (int vt = 0; vt < 4; ++vt) o[vt] = (f32x4){0.f, 0.f, 0.f, 0.f};
#pragma unroll
    for (int u = 0; u < 2; ++u) {
        if (2 * u <= tt) {
            u32x4 pw; pw.x = cvt_pk_bf16(at[2 * u][0], at[2 * u][1]); pw.y = cvt_pk_bf16(at[2 * u][2], at[2 * u][3]);
            pw.z = cvt_pk_bf16(at[2 * u + 1][0], at[2 * u + 1][1]); pw.w = cvt_pk_bf16(at[2 * u + 1][2], at[2 * u + 1][3]);
            const bf16x8 pf = __builtin_bit_cast(bf16x8, pw);
#pragma unroll
            for (int vt = 0; vt < 4; ++vt) {
                const LAS bf16_t* vp = Vt + (16 * vt + fr) * 72 + 32 * u + 4 * g;
                u32x4 vw; const u32x2 lo = *(const LAS u32x2*)vp, hi = *(const LAS u32x2*)(vp + 16); vw.x = lo.x; vw.y = lo.y; vw.z = hi.x; vw.w = hi.y;
                o[vt] = __builtin_amdgcn_mfma_f32_16x16x32_bf16(__builtin_bit_cast(bf16x8, vw), pf, o[vt], 0, 0, 0);
            }
        }
    }
#pragma unroll
    for (int ks = 0; ks < 2; ++ks) {
        const bf16x8 qs = *(const LAS bf16x8*)(QS + (16 * tt + fr) * 72 + 32 * ks + 8 * g);
#pragma unroll
        for (int vt = 0; vt < 4; ++vt) { const bf16x8 sa = *(const LAS bf16x8*)(St + (16 * vt + fr) * 72 + 32 * ks + 8 * g);
            o[vt] = __builtin_amdgcn_mfma_f32_16x16x32_bf16(sa, qs, o[vt], 0, 0, 0); }
    }
    float sq = 0.f;
#pragma unroll
    for (int vt = 0; vt < 4; ++vt) sq += (o[vt][0] * o[vt][0] + o[vt][1] * o[vt][1]) + (o[vt][2] * o[vt][2] + o[vt][3] * o[vt][3]);
    sq += __shfl_xor(sq, 16); sq += __shfl_xor(sq, 32);
    const float rn = rsqrtf(sq * (1.0f / 64.0f) + EPS);
#pragma unroll
    for (int vt = 0; vt < 4; ++vt) {
        const f32x4 nv = *(const f32x4*)(onorm + 16 * vt + 4 * g);
        const float g0 = __uint_as_float(gz[vt].x << 16), g1 = __uint_as_float(gz[vt].x & 0xffff0000u), g2 = __uint_as_float(gz[vt].y << 16), g3 = __uint_as_float(gz[vt].y & 0xffff0000u);
        u32x2 w; w.x = cvt_pk_bf16(o[vt][0] * rn * nv[0] * siluf_(g0), o[vt][1] * rn * nv[1] * siluf_(g1)); w.y = cvt_pk_bf16(o[vt][2] * rn * nv[2] * siluf_(g2), o[vt][3] * rn * nv[3] * siluf_(g3));
        *(u32x2*)(mix + mt * DM + h * 64 + 16 * vt + 4 * g) = w;
    }
}

__device__ __forceinline__ void hgrn_sample_item(const bf16_t* z, const float* lbp, const float* S0, float* Sout, const float* onorm, bf16_t* mix, LAS unsigned char* lds, int b, int hp, int tid, int lane, int wave) {
    LAS float* F = (LAS float*)lds; LAS float* KI = F + 512; LAS float* Q = KI + 512; LAS float* V = Q + 512;
    LAS float* RED = V + 512;
    const int hh = wave >> 2, kq = wave & 3, h = 2 * hp + hh;
    float S[16];
    { const float* sp = S0 + (size_t)h * 4096 + (16 * kq) * 64 + lane;
#pragma unroll
      for (int i = 0; i < 16; ++i) S[i] = sp[i * 64]; }
    const int t0 = tid >> 7, hk = tid & 127;
    const bf16_t* zr = z + ((size_t)TP + 4 * b + t0) * INC + hp * 128 + hk;
    const float zf = bf2f(zr[ZF]), q0 = bf2f(zr[ZQ]), vi = bf2f(zr[ZI]); const float lb = lbp[hp * 128 + hk];
    LSYNC();
    { const float e = __expf(-fabsf(zf)); const float sp = (zf >= 0.f) ? 1.0f / (1.0f + e) : e / (1.0f + e); const float sn = (zf >= 0.f) ? e / (1.0f + e) : 1.0f / (1.0f + e);
      F[tid] = lb + (1.0f - lb) * sp; KI[tid] = (1.0f - lb) * sn; Q[tid] = q0; V[tid] = vi; }
    LSYNC();
#pragma unroll
    for (int t = 0; t < 4; ++t) {
        const float vt = V[t * 128 + hh * 64 + lane]; float part = 0.f;
#pragma unroll
        for (int i = 0; i < 16; ++i) { const int k = t * 128 + hh * 64 + 16 * kq + i; S[i] = F[k] * S[i] + KI[k] * vt; part += S[i] * Q[k]; }
        RED[((t * 2 + hh) * 4 + kq) * 64 + lane] = part;
    }
    { float* so = Sout + (size_t)h * 4096 + (16 * kq) * 64 + lane;
#pragma unroll
      for (int i = 0; i < 16; ++i) so[i * 64] = S[i]; }
    LSYNC();
    { const int t = wave >> 1, hh2 = wave & 1, h2 = 2 * hp + hh2; const size_t m = (size_t)TP + 4 * b + t;
      float o = 0.f;
#pragma unroll
      for (int k4 = 0; k4 < 4; ++k4) o += RED[((t * 2 + hh2) * 4 + k4) * 64 + lane];
      const float r = rsqrtf(wave_sum(o * o) * (1.0f / 64.0f) + EPS);
      const float res = o * r * onorm[lane] * siluf_(bf2f(z[m * INC + ZG + h2 * 64 + lane]));
      mix[m * DM + h2 * 64 + lane] = (bf16_t)(cvt_pk_bf16(res, 0.f) & 0xffffu); }
}

template <int NTOK>
__device__ __forceinline__ void conv_compute(const LAS float* U, int r0, size_t m0, const float* cw, const float* cb, const float* lng, const float* lnb, bf16_t* mix, int lane, int wave) {
    const int ch = 64 * (wave & 3) + lane;
    float w[31];
#pragma unroll
    for (int j = 0; j < 31; ++j) w[j] = cw[j * 256 + ch];
    const float bias = cb[ch], g = lng[ch], be = lnb[ch];
    constexpr int TG = (NTOK >= 4) ? 4 : NTOK;
#pragma unroll 1
    for (int tg = 0; tg < NTOK / TG; ++tg) {
        float y[TG];
#pragma unroll
        for (int t = 0; t < TG; ++t) y[t] = bias;
        const LAS float* up = U + (r0 + TG * tg) * 256 + ch;
#pragma unroll
        for (int j = 0; j < TG + 30; ++j) { const float u = up[j * 256];
#pragma unroll
            for (int t = 0; t < TG; ++t) { if (j - t >= 0 && j - t < 31) y[t] += w[j - t] * u; } }
#pragma unroll
        for (int t = 0; t < TG; ++t) {
            const float mu = wave_sum(y[t]) * (1.0f / 64.0f); const float d = y[t] - mu;
            const float var = wave_sum(d * d) * (1.0f / 64.0f);
            const float o = siluf_(d * rsqrtf(var + EPS) * g + be);
            mix[(m0 + TG * tg + t) * DM + 256 + ch] = (bf16_t)(cvt_pk_bf16(o, 0.f) & 0xffffu);
        }
    }
}
__device__ __forceinline__ void conv_prompt_item(const bf16_t* z, const float* cw, const float* cb, const float* lng, const float* lnb, bf16_t* mix, float* spc, LAS unsigned char* lds, int ct, int tid, int lane, int wave) {
    LAS float* U = (LAS float*)lds;
    const int t0 = 64 * ct;
    u32x4 ra[6], rb[6];
#pragma unroll
    for (int it = 0; it < 6; ++it) { const int r = it * 16 + (tid >> 5), cg8 = (tid & 31) * 8; int tok = t0 - 30 + r; tok = tok < 0 ? 0 : tok;
        const bf16_t* zr = z + (size_t)tok * INC; ra[it] = *(const u32x4*)(zr + ZBU + cg8); rb[it] = *(const u32x4*)(zr + ZBG + cg8); }
    LSYNC();
#pragma unroll
    for (int it = 0; it < 6; ++it) { const int r = it * 16 + (tid >> 5), cg8 = (tid & 31) * 8; const bool ok = (t0 - 30 + r) >= 0;
        float fa[8], fb[8], u[8]; UNPACK8(ra[it], fa); UNPACK8(rb[it], fb);
#pragma unroll
        for (int j = 0; j < 8; ++j) u[j] = ok ? fa[j] * sigmoidf_(fb[j]) : 0.f;
        *(LAS f32x4*)(U + r * 256 + cg8) = (f32x4){u[0], u[1], u[2], u[3]}; *(LAS f32x4*)(U + r * 256 + cg8 + 4) = (f32x4){u[4], u[5], u[6], u[7]}; }
    LSYNC();
    conv_compute<32>(U, 32 * (wave >> 2), (size_t)t0 + 32 * (wave >> 2), cw, cb, lng, lnb, mix, lane, wave);
    if (ct == 255) for (int idx = tid; idx < 30 * 256; idx += 512) spc[idx] = U[(64 + (idx >> 8)) * 256 + (idx & 255)];
}
__device__ __forceinline__ void conv_sample_item(const bf16_t* z, const float* sconv, const float* cw, const float* cb, const float* lng, const float* lnb, bf16_t* mix, float* ssc, LAS unsigned char* lds, int b, int tid, int lane, int wave) {
    LAS float* U = (LAS float*)lds;
    float hv[15];
#pragma unroll
    for (int it = 0; it < 15; ++it) hv[it] = sconv[(size_t)b * 30 * 256 + it * 512 + tid];
    float nu[2];
#pragma unroll
    for (int it = 0; it < 2; ++it) { const int idx = it * 512 + tid, t = idx >> 8, ch = idx & 255; const bf16_t* zr = z + ((size_t)TP + 4 * b + t) * INC;
        nu[it] = bf2f(zr[ZBU + ch]) * sigmoidf_(bf2f(zr[ZBG + ch])); }
    LSYNC();
#pragma unroll
    for (int it = 0; it < 15; ++it) U[it * 512 + tid] = hv[it];
#pragma unroll
    for (int it = 0; it < 2; ++it) U[30 * 256 + it * 512 + tid] = nu[it];
    LSYNC();
    conv_compute<2>(U, 2 * (wave >> 2), (size_t)TP + 4 * b + 2 * (wave >> 2), cw, cb, lng, lnb, mix, lane, wave);
#pragma unroll
    for (int it = 0; it < 15; ++it) ssc[(size_t)b * 30 * 256 + it * 512 + tid] = U[4 * 256 + it * 512 + tid];
}

constexpr int KSTR = 72, VSTR = 280;
#define NORM_ROPE(rowp, gain, pos, g, sh1, sh2, x1, x2) do { \
    const u32x4 _lo = *(const u32x4*)((rowp) + 8 * (g)), _hi = *(const u32x4*)((rowp) + 32 + 8 * (g)); float _a[8], _b[8]; UNPACK8(_lo, _a); UNPACK8(_hi, _b); \
    float _sq = 0.f; _Pragma("unroll") for (int _j = 0; _j < 8; ++_j) _sq += _a[_j] * _a[_j] + _b[_j] * _b[_j]; \
    _sq += __shfl_xor(_sq, sh1); _sq += __shfl_xor(_sq, sh2); const float _r = rsqrtf(_sq * (1.0f / 64.0f) + EPS); \
    const float* _cp = rope_c + (size_t)(pos) * 32 + 8 * (g); const float* _sp = rope_s + (size_t)(pos) * 32 + 8 * (g); \
    _Pragma("unroll") for (int _j = 0; _j < 8; ++_j) { const float _y1 = _a[_j] * _r * (gain)[8 * (g) + _j], _y2 = _b[_j] * _r * (gain)[32 + 8 * (g) + _j]; const float _c = _cp[_j], _s = _sp[_j]; \
        (x1)[_j] = _y1 * _c - _y2 * _s; (x2)[_j] = _y2 * _c + _y1 * _s; } } while (0)

__device__ __forceinline__ void attn_qtile(const LAS bf16_t* Kl, const LAS bf16_t* Vt, bf16x8 q0, bf16x8 q1, int i, int T0, int jmin, float sink, bf16_t* outp, int lane) {
    const int fr = lane & 15, g = lane >> 4;
    f32x4 s[9];
#pragma unroll
    for (int T = 0; T < 9; ++T) {
        const LAS bf16_t* kp = Kl + (16 * (T0 + T) + fr) * KSTR + 8 * g;
        const bf16x8 k0 = *(const LAS bf16x8*)kp, k1 = *(const LAS bf16x8*)(kp + 32);
        f32x4 acc = (f32x4){0.f, 0.f, 0.f, 0.f};
        acc = __builtin_amdgcn_mfma_f32_16x16x32_bf16(k0, q0, acc, 0, 0, 0);
        acc = __builtin_amdgcn_mfma_f32_16x16x32_bf16(k1, q1, acc, 0, 0, 0);
        s[T] = acc;
    }
    float mx = sink;
#pragma unroll
    for (int T = 0; T < 9; ++T)
#pragma unroll
        for (int r = 0; r < 4; ++r) { const int j = 16 * (T0 + T) + 4 * g + r; const bool valid = (j >= i) && (j <= i + 128) && (j >= jmin);
            s[T][r] = valid ? s[T][r] : -INFINITY; mx = fmaxf(mx, s[T][r]); }
    mx = fmaxf(mx, __shfl_xor(mx, 16)); mx = fmaxf(mx, __shfl_xor(mx, 32));
    float sum = 0.f;
#pragma unroll
    for (int T = 0; T < 9; ++T)
#pragma unroll
        for (int r = 0; r < 4; ++r) { const float p = __expf(s[T][r] - mx); s[T][r] = p; sum += p; }
    sum += __shfl_xor(sum, 16); sum += __shfl_xor(sum, 32);
    const float inv = 1.0f / (sum + __expf(sink - mx));
    f32x4 o[4];
#pragma unroll
    for (int dt = 0; dt < 4; ++dt) o[dt] = (f32x4){0.f, 0.f, 0.f, 0.f};
#pragma unroll
    for (int u = 0; u < 5; ++u) {
        u32x4 pw; pw.x = cvt_pk_bf16(s[2 * u][0], s[2 * u][1]); pw.y = cvt_pk_bf16(s[2 * u][2], s[2 * u][3]);
        if (u < 4) { pw.z = cvt_pk_bf16(s[2 * u + 1 > 8 ? 8 : 2 * u + 1][0], s[2 * u + 1 > 8 ? 8 : 2 * u + 1][1]); pw.w = cvt_pk_bf16(s[2 * u + 1 > 8 ? 8 : 2 * u + 1][2], s[2 * u + 1 > 8 ? 8 : 2 * u + 1][3]); }
        else { pw.z = 0u; pw.w = 0u; }
        const bf16x8 pf = __builtin_bit_cast(bf16x8, pw);
#pragma unroll
        for (int dt = 0; dt < 4; ++dt) {
            const LAS bf16_t* vp = Vt + (16 * dt + fr) * VSTR + 16 * (T0 + 2 * u) + 4 * g;
            u32x4 vw; const u32x2 lo = *(const LAS u32x2*)vp, hi = *(const LAS u32x2*)(vp + 16); vw.x = lo.x; vw.y = lo.y; vw.z = hi.x; vw.w = hi.y;
            o[dt] = __builtin_amdgcn_mfma_f32_16x16x32_bf16(__builtin_bit_cast(bf16x8, vw), pf, o[dt], 0, 0, 0);
        }
    }
#pragma unroll
    for (int dt = 0; dt < 4; ++dt) { u32x2 w; w.x = cvt_pk_bf16(o[dt][0] * inv, o[dt][1] * inv); w.y = cvt_pk_bf16(o[dt][2] * inv, o[dt][3] * inv); *(u32x2*)(outp + 16 * dt + 4 * g) = w; }
}

#define LOAD_QFRAG(zq, pos, q0, q1) do { float _x1[8], _x2[8]; const int _g = lane >> 4; NORM_ROPE(zq, qn, pos, _g, 16, 32, _x1, _x2); \
    u32x4 _w0, _w1; _w0.x = cvt_pk_bf16(_x1[0] * 0.125f, _x1[1] * 0.125f); _w0.y = cvt_pk_bf16(_x1[2] * 0.125f, _x1[3] * 0.125f); _w0.z = cvt_pk_bf16(_x1[4] * 0.125f, _x1[5] * 0.125f); _w0.w = cvt_pk_bf16(_x1[6] * 0.125f, _x1[7] * 0.125f); \
    _w1.x = cvt_pk_bf16(_x2[0] * 0.125f, _x2[1] * 0.125f); _w1.y = cvt_pk_bf16(_x2[2] * 0.125f, _x2[3] * 0.125f); _w1.z = cvt_pk_bf16(_x2[4] * 0.125f, _x2[5] * 0.125f); _w1.w = cvt_pk_bf16(_x2[6] * 0.125f, _x2[7] * 0.125f); \
    q0 = __builtin_bit_cast(bf16x8, _w0); q1 = __builtin_bit_cast(bf16x8, _w1); } while (0)

__device__ __forceinline__ void attn_prompt_item(const bf16_t* z, const float* qn, const float* kn, const float* sinks, const float* rope_c, const float* rope_s, bf16_t* mix, float* spk, float* spv,
                                                 LAS unsigned char* lds, int qb, int kvh, int tid, int lane, int wave) {
    LAS bf16_t* Kl = (LAS bf16_t*)lds;
    LAS bf16_t* Vt = Kl + 256 * KSTR;
    LSYNC();
    const int kbase = qb * 128 - 128;
#pragma unroll
    for (int it_ = 0; it_ < 2; ++it_) { const int task = tid + 512 * it_;
        const int j = task >> 2, g = task & 3, pos = kbase + j;
        u32x4 w0 = (u32x4){0u, 0u, 0u, 0u}, w1 = w0;
        float x1[8], x2[8];
        const int posc = pos < 0 ? 0 : pos;
        const bf16_t* zr = z + (size_t)posc * INC + ZCK + kvh * 64;
        NORM_ROPE(zr, kn, posc, g, 1, 2, x1, x2);
        if (pos >= 0) { w0.x = cvt_pk_bf16(x1[0], x1[1]); w0.y = cvt_pk_bf16(x1[2], x1[3]); w0.z = cvt_pk_bf16(x1[4], x1[5]); w0.w = cvt_pk_bf16(x1[6], x1[7]);
                        w1.x = cvt_pk_bf16(x2[0], x2[1]); w1.y = cvt_pk_bf16(x2[2], x2[3]); w1.z = cvt_pk_bf16(x2[4], x2[5]); w1.w = cvt_pk_bf16(x2[6], x2[7]); }
        *(LAS u32x4*)(Kl + j * KSTR + 8 * g) = w0; *(LAS u32x4*)(Kl + j * KSTR + 32 + 8 * g) = w1;
        if (qb == 127 && j >= 128) { float* o = spk + (size_t)(j - 128) * 128 + kvh * 64;
            *(f32x4*)(o + 8 * g) = (f32x4){x1[0], x1[1], x1[2], x1[3]}; *(f32x4*)(o + 8 * g + 4) = (f32x4){x1[4], x1[5], x1[6], x1[7]};
            *(f32x4*)(o + 32 + 8 * g) = (f32x4){x2[0], x2[1], x2[2], x2[3]}; *(f32x4*)(o + 32 + 8 * g + 4) = (f32x4){x2[4], x2[5], x2[6], x2[7]}; }
    }
#pragma unroll
    for (int it_ = 0; it_ < 4; ++it_) { const int task = tid + 512 * it_;
        const int j = task >> 3, c8 = (task & 7) * 8, pos = kbase + j;
        u32x4 w = (u32x4){0u, 0u, 0u, 0u};
        if (pos >= 0) w = *(const u32x4*)(z + (size_t)pos * INC + ZCV + kvh * 64 + c8);
        Vt[(c8 + 0) * VSTR + j] = (bf16_t)(w.x & 0xffffu); Vt[(c8 + 1) * VSTR + j] = (bf16_t)(w.x >> 16);
        Vt[(c8 + 2) * VSTR + j] = (bf16_t)(w.y & 0xffffu); Vt[(c8 + 3) * VSTR + j] = (bf16_t)(w.y >> 16);
        Vt[(c8 + 4) * VSTR + j] = (bf16_t)(w.z & 0xffffu); Vt[(c8 + 5) * VSTR + j] = (bf16_t)(w.z >> 16);
        Vt[(c8 + 6) * VSTR + j] = (bf16_t)(w.w & 0xffffu); Vt[(c8 + 7) * VSTR + j] = (bf16_t)(w.w >> 16);
        if (qb == 127 && j >= 128) { float f[8]; UNPACK8(w, f); float* o = spv + (size_t)(j - 128) * 128 + kvh * 64 + c8;
            *(f32x4*)o = (f32x4){f[0], f[1], f[2], f[3]}; *(f32x4*)(o + 4) = (f32x4){f[4], f[5], f[6], f[7]}; }
    }
    for (int idx = tid; idx < 64 * 24; idx += 512) Vt[(idx / 24) * VSTR + 256 + (idx % 24)] = 0;
    LSYNC();
    const int hq = kvh * 4 + (wave >> 1);
    const float sink = sinks[hq];
    const int g4 = lane >> 4;
    float gq1[8], gq2[8];
#pragma unroll
    for (int j = 0; j < 8; ++j) { gq1[j] = qn[8 * g4 + j] * 0.125f; gq2[j] = qn[32 + 8 * g4 + j] * 0.125f; }
    const int pos0 = qb * 128 + (wave & 1) * 64 + (lane & 15);
    const bf16_t* zq0 = z + (size_t)pos0 * INC + ZCQ + hq * 64 + 8 * g4;
    const float* rc0 = rope_c + (size_t)pos0 * 32 + 8 * g4; const float* rs0 = rope_s + (size_t)pos0 * 32 + 8 * g4;
    u32x4 nlo = *(const u32x4*)zq0, nhi = *(const u32x4*)(zq0 + 32);
    f32x4 nc0 = *(const f32x4*)rc0, nc1 = *(const f32x4*)(rc0 + 4), ns0 = *(const f32x4*)rs0, ns1 = *(const f32x4*)(rs0 + 4);
#pragma unroll 1
    for (int a4 = 0; a4 < 4; ++a4) {
        const u32x4 lo = nlo, hi = nhi; const f32x4 c0 = nc0, c1 = nc1, s0 = ns0, s1 = ns1;
        { const int an = a4 < 3 ? a4 + 1 : 3; const bf16_t* zqn = zq0 + (size_t)(16 * an) * INC; const float* rcn = rc0 + (size_t)(16 * an) * 32; const float* rsn = rs0 + (size_t)(16 * an) * 32;
          nlo = *(const u32x4*)zqn; nhi = *(const u32x4*)(zqn + 32); nc0 = *(const f32x4*)rcn; nc1 = *(const f32x4*)(rcn + 4); ns0 = *(const f32x4*)rsn; ns1 = *(const f32x4*)(rsn + 4); }
        float a[8], b[8]; UNPACK8(lo, a); UNPACK8(hi, b);
        float sq = 0.f;
#pragma unroll
        for (int j = 0; j < 8; ++j) sq += a[j] * a[j] + b[j] * b[j];
        sq += __shfl_xor(sq, 16); sq += __shfl_xor(sq, 32);
        const float r = rsqrtf(sq * (1.0f / 64.0f) + EPS);
        float x1[8], x2[8];
#pragma unroll
        for (int j = 0; j < 8; ++j) { const float y1 = a[j] * r * gq1[j], y2 = b[j] * r * gq2[j]; const float c = j < 4 ? c0[j & 3] : c1[j & 3], s = j < 4 ? s0[j & 3] : s1[j & 3];
            x1[j] = y1 * c - y2 * s; x2[j] = y2 * c + y1 * s; }
        u32x4 w0, w1; w0.x = cvt_pk_bf16(x1[0], x1[1]); w0.y = cvt_pk_bf16(x1[2], x1[3]); w0.z = cvt_pk_bf16(x1[4], x1[5]); w0.w = cvt_pk_bf16(x1[6], x1[7]);
        w1.x = cvt_pk_bf16(x2[0], x2[1]); w1.y = cvt_pk_bf16(x2[2], x2[3]); w1.z = cvt_pk_bf16(x2[4], x2[5]); w1.w = cvt_pk_bf16(x2[6], x2[7]);
        const int i0 = (wave & 1) * 64 + 16 * a4, i = i0 + (lane & 15);
        const size_t m = (size_t)qb * 128 + i;
        attn_qtile(Kl, Vt, __builtin_bit_cast(bf16x8, w0), __builtin_bit_cast(bf16x8, w1), i, i0 >> 4, qb == 0 ? 128 : 0, sink, mix + m * DM + 512 + hq * 64, lane);
    }
}

__device__ __forceinline__ void attn_sample_item(const bf16_t* z, const float* ck, const float* cv, const float* qn, const float* kn, const float* sinks, const float* rope_c, const float* rope_s, bf16_t* mix,
                                                 float* ssk, float* ssv, LAS unsigned char* lds, int b, int kvh, int tid, int lane, int wave) {
    LAS bf16_t* Kl = (LAS bf16_t*)lds;
    LAS bf16_t* Vt = Kl + 256 * KSTR;
    LSYNC();
#pragma unroll
    for (int it_ = 0; it_ < 2; ++it_) { const int task = tid + 512 * it_;
        const int j = task >> 3, c8 = (task & 7) * 8;
        const float* kr = ck + (size_t)j * 128 + kvh * 64 + c8; const float* vr = cv + (size_t)j * 128 + kvh * 64 + c8;
        const f32x4 k0 = *(const f32x4*)kr, k1 = *(const f32x4*)(kr + 4), v0 = *(const f32x4*)vr, v1 = *(const f32x4*)(vr + 4);
        u32x4 w; w.x = cvt_pk_bf16(k0[0], k0[1]); w.y = cvt_pk_bf16(k0[2], k0[3]); w.z = cvt_pk_bf16(k1[0], k1[1]); w.w = cvt_pk_bf16(k1[2], k1[3]);
        *(LAS u32x4*)(Kl + j * KSTR + c8) = w;
        const float vf[8] = {v0[0], v0[1], v0[2], v0[3], v1[0], v1[1], v1[2], v1[3]};
#pragma unroll
        for (int e = 0; e < 8; ++e) Vt[(c8 + e) * VSTR + j] = (bf16_t)(cvt_pk_bf16(vf[e], 0.f) & 0xffffu);
        if (j >= 4) { float* ok = ssk + (size_t)(j - 4) * 128 + kvh * 64 + c8; float* ov = ssv + (size_t)(j - 4) * 128 + kvh * 64 + c8;
            *(f32x4*)ok = k0; *(f32x4*)(ok + 4) = k1; *(f32x4*)ov = v0; *(f32x4*)(ov + 4) = v1; }
    }
    if (tid < 16) {
        const int t = tid >> 2, g = tid & 3, j = 128 + t; const size_t m = (size_t)TP + 4 * b + t;
        float x1[8], x2[8];
        NORM_ROPE(z + m * INC + ZCK + kvh * 64, kn, TP + t, g, 1, 2, x1, x2);
        u32x4 w0, w1; w0.x = cvt_pk_bf16(x1[0], x1[1]); w0.y = cvt_pk_bf16(x1[2], x1[3]); w0.z = cvt_pk_bf16(x1[4], x1[5]); w0.w = cvt_pk_bf16(x1[6], x1[7]);
        w1.x = cvt_pk_bf16(x2[0], x2[1]); w1.y = cvt_pk_bf16(x2[2], x2[3]); w1.z = cvt_pk_bf16(x2[4], x2[5]); w1.w = cvt_pk_bf16(x2[6], x2[7]);
        *(LAS u32x4*)(Kl + j * KSTR + 8 * g) = w0; *(LAS u32x4*)(Kl + j * KSTR + 32 + 8 * g) = w1;
        float* o = ssk + (size_t)(j - 4) * 128 + kvh * 64;
        *(f32x4*)(o + 8 * g) = (f32x4){x1[0], x1[1], x1[2], x1[3]}; *(f32x4*)(o + 8 * g + 4) = (f32x4){x1[4], x1[5], x1[6], x1[7]};
        *(f32x4*)(o + 32 + 8 * g) = (f32x4){x2[0], x2[1], x2[2], x2[3]}; *(f32x4*)(o + 32 + 8 * g + 4) = (f32x4){x2[4], x2[5], x2[6], x2[7]};
    }
    if (tid >= 64 && tid < 64 + 32) {
        const int t = (tid - 64) >> 3, c8 = ((tid - 64) & 7) * 8, j = 128 + t; const size_t m = (size_t)TP + 4 * b + t;
        const u32x4 w = *(const u32x4*)(z + m * INC + ZCV + kvh * 64 + c8);
        Vt[(c8 + 0) * VSTR + j] = (bf16_t)(w.x & 0xffffu); Vt[(c8 + 1) * VSTR + j] = (bf16_t)(w.x >> 16);
        Vt[(c8 + 2) * VSTR + j] = (bf16_t)(w.y & 0xffffu); Vt[(c8 + 3) * VSTR + j] = (bf16_t)(w.y >> 16);
        Vt[(c8 + 4) * VSTR + j] = (bf16_t)(w.z & 0xffffu); Vt[(c8 + 5) * VSTR + j] = (bf16_t)(w.z >> 16);
        Vt[(c8 + 6) * VSTR + j] = (bf16_t)(w.w & 0xffffu); Vt[(c8 + 7) * VSTR + j] = (bf16_t)(w.w >> 16);
        float f[8]; UNPACK8(w, f); float* o = ssv + (size_t)(j - 4) * 128 + kvh * 64 + c8;
        *(f32x4*)o = (f32x4){f[0], f[1], f[2], f[3]}; *(f32x4*)(o + 4) = (f32x4){f[4], f[5], f[6], f[7]};
    }
    if (tid >= 128 && tid < 128 + 12 * 8) { const int j = 132 + ((tid - 128) >> 3), c8 = ((tid - 128) & 7) * 8; *(LAS u32x4*)(Kl + j * KSTR + c8) = (u32x4){0u, 0u, 0u, 0u}; }
    for (int idx = tid; idx < 64 * 28; idx += 512) Vt[(idx / 28) * VSTR + 132 + (idx % 28)] = 0;
    LSYNC();
    if (wave == 0) {
        const int q = lane & 15, hg = q >> 2, t = q & 3, hq = kvh * 4 + hg; const size_t m = (size_t)TP + 4 * b + t;
        bf16x8 q0, q1;
        LOAD_QFRAG(z + m * INC + ZCQ + hq * 64, TP + t, q0, q1);
        attn_qtile(Kl, Vt, q0, q1, t, 0, 0, sinks[hq], mix + m * DM + 512 + hq * 64, lane);
    }
}

#define PHASE_HEAD { unsigned z_ = 0; asm volatile("" : "+s"(z_)); lds += z_; } int wave_ = wv; asm volatile("" : "+s"(wave_)); const int wave = wave_, lane = lane_id_opaque(), tid = wave * 64 + lane; const int G = gridDim.x, bid = blockIdx.x; unsigned char* ws = WSP; (void)lane; (void)wave; (void)G; (void)bid; (void)ws;
#define SSP(k) ((float*)(ws + WS_SS) + (size_t)(k) * MT)
#define WL(off) ((const bf16_t*)(ws + WS_W + (size_t)l * W_LAYER + (off)))

struct G1Order {
    pg8::StaticOrder so; unsigned* cnt; int c;
    __device__ __forceinline__ bool next(int i, Unit& u) const {
        if (c >= 64 && c < 82) { if (i == 0) { const int s = c - 64; u.pm = 64 + s / 9; u.pn = s % 9; return true; } return so.next(i - 1, u); }
        return so.next(i, u);
    }
    __device__ __forceinline__ void a_ready(const Unit&) const {}
    __device__ __forceinline__ void done(const Unit& u) const {
        if (u.pm >= 64) {
            asm volatile("s_waitcnt vmcnt(0)" ::: "memory");
            __builtin_amdgcn_fence(__ATOMIC_RELEASE, "agent");
            asm volatile("s_waitcnt vmcnt(0)" ::: "memory");
            if (lane_id_opaque() == 0) __hip_atomic_fetch_add(cnt, 1u, __ATOMIC_RELAXED, __HIP_MEMORY_SCOPE_AGENT);
        }
    }
};
__device__ __forceinline__ void phase_g1(LAS unsigned char* lds, int l, int wv) {
    PHASE_HEAD
    unsigned* cnt = (unsigned*)(ws + WS_CTL) + 8192 + 64 * l;
    { pg8::Gemm g{(const bf16_t*)(ws + WS_BUFA), WL(W_IN), MT, INC, DM}; G1Order S; S.so.init(TP, INC, G, bid); S.cnt = cnt; S.c = bid;
      EpiZ E{(bf16_t*)(ws + WS_ZACT), INC, SSP(3 * l)}; pg8::gemm_phase<EpiZ, G1Order, true, true>(lds, g, S, E, wv); }
    if (bid >= 82) {
        if (tid == 0) { unsigned sp = 0; while (__hip_atomic_load(cnt, __ATOMIC_RELAXED, __HIP_MEMORY_SCOPE_AGENT) < 144u) { __builtin_amdgcn_s_sleep(4); if (++sp > (1u << 22)) break; }
            __builtin_amdgcn_fence(__ATOMIC_ACQUIRE, "agent"); asm volatile("s_waitcnt vmcnt(0)" ::: "memory"); }
        __syncthreads();
        const bf16_t* z = (const bf16_t*)(ws + WS_ZACT); bf16_t* bufB = (bf16_t*)(ws + WS_BUFB);
        const float* lbp = (const float*)(ws + WS_LB) + l * 256;
        const float* rope_c = (const float*)(ws + WS_ROPE); const float* rope_s = rope_c + (size_t)NPOS * 32;
        float* out = OUTP;
#pragma unroll 1
        for (int it = bid - 82; it < 640; it += G - 82) {
            int r = it;
            if (r < 256) { const int b = r >> 1, hp = r & 1; const size_t so = ((size_t)(l * 128 + b) * 4) * 4096;
                hgrn_sample_item(z, lbp, IN(2) + so, out + O_SSH + so, IN(10) + l * 64, bufB, lds, b, hp, tid, lane, wave); continue; } r -= 256;
            if (r < 128) { conv_sample_item(z, IN(3) + (size_t)l * 128 * 7680, IN(11) + l * 31 * 256, IN(12) + l * 256, IN(13) + l * 256, IN(14) + l * 256, bufB, out + O_SSC + (size_t)l * 128 * 7680, lds, r, tid, lane, wave); continue; } r -= 128;
            { const int b = r >> 1, kvh = r & 1; const size_t co = (size_t)(l * 128 + b) * 16384;
              attn_sample_item(z, IN(4) + co, IN(5) + co, IN(15) + l * 64, IN(16) + l * 64, IN(17) + l * 8, rope_c, rope_s, bufB, out + O_SSK + co, out + O_SSV + co, lds, b, kvh, tid, lane, wave); }
        }
        LSYNC();
        { LAS float* scr = (LAS float*)(lds + wave * 16384);
          const int first = (l == 0) ? CI_D : (CI_LAYER + CI_OUT), cnt_ = (l == 0) ? (CI_LAYER - CI_D) : (CI_GG - CI_OUT);
#pragma unroll 1
          for (int k = (bid - 82) * 8 + wave; k < cnt_; k += (G - 82) * 8) convert_item(lds, ws, scr, first + k, lane); }
    }
}
__device__ __forceinline__ void phase_mix_a(LAS unsigned char* lds, int l, int wv) {
    PHASE_HEAD
    const bf16_t* z = (const bf16_t*)(ws + WS_ZACT); bf16_t* bufB = (bf16_t*)(ws + WS_BUFB);
    const float* lbp = (const float*)(ws + WS_LB) + l * 256; float* dvec = (float*)(ws + WS_DVEC); float* dS = (float*)(ws + WS_DS);
    const float* rope_c = (const float*)(ws + WS_ROPE); const float* rope_s = rope_c + (size_t)NPOS * 32;
    float* out = OUTP;
#pragma unroll 1
    for (int it = bid; it < 1024; it += G) {
        unsigned czf[8], cvi[8];
        const bf16_t* zb = z + (size_t)(64 * (it >> 2) + 8 * wave) * INC + (it & 3) * 64 + lane;
#pragma unroll
        for (int i = 0; i < 8; ++i) { czf[i] = zb[(size_t)i * INC + ZF]; cvi[i] = zb[(size_t)i * INC + ZI]; }
        hgrn_ds_item(czf, cvi, lbp, dS, dvec, lds, it >> 2, it & 3, tid, lane, wave);
    }
#pragma unroll 1
    for (int it = bid; it < 512; it += G) {
        int r = it;
        if (r < 256) { attn_prompt_item(z, IN(15) + l * 64, IN(16) + l * 64, IN(17) + l * 8, rope_c, rope_s, bufB, out + O_SPK + (size_t)l * 16384, out + O_SPV + (size_t)l * 16384, lds, r >> 1, r & 1, tid, lane, wave); continue; } r -= 256;
        conv_prompt_item(z, IN(11) + l * 31 * 256, IN(12) + l * 256, IN(13) + l * 256, IN(14) + l * 256, bufB, out + O_SPC + (size_t)l * 7680, lds, r, tid, lane, wave);
    }
}
__device__ __forceinline__ void phase_scan(LAS unsigned char* lds, int l, int wv) {
    PHASE_HEAD
    if (bid < 256) {
        float* dS = (float*)(ws + WS_DS); const float* dvec = (const float*)(ws + WS_DVEC);
        const int e = 64 * bid + lane, h = e >> 12, k = (e >> 6) & 63;
        LAS float* X = (LAS float*)lds;
        float v[32], d[32];
#pragma unroll
        for (int j = 0; j < 32; ++j) { const int c = 32 * wave + j; v[j] = dS[(size_t)c * 16384 + e]; d[j] = dvec[(c * 4 + h) * 64 + k]; }
        float A = 0.f, P = 1.f;
#pragma unroll
        for (int j = 0; j < 32; ++j) { const float t = v[j]; v[j] = A; A = d[j] * A + t; const float pd = d[j]; d[j] = P; P *= pd; }
        LSYNC();
        X[(wave * 2 + 0) * 64 + lane] = P; X[(wave * 2 + 1) * 64 + lane] = A;
        LSYNC();
        float S = 0.f;
#pragma unroll
        for (int w2 = 0; w2 < 8; ++w2) { const float p2 = X[(w2 * 2 + 0) * 64 + lane], a2 = X[(w2 * 2 + 1) * 64 + lane]; if (w2 < wave) S = p2 * S + a2; }
#pragma unroll
        for (int j = 0; j < 32; ++j) dS[(size_t)(32 * wave + j) * 16384 + e] = d[j] * S + v[j];
        if (wave == 7) OUTP[O_SPH + (size_t)l * 16384 + e] = P * S + A;
    }
}
__device__ __forceinline__ void phase_mix_c(LAS unsigned char* lds, int l, int wv) {
    PHASE_HEAD
    const bf16_t* z = (const bf16_t*)(ws + WS_ZACT); bf16_t* bufB = (bf16_t*)(ws + WS_BUFB);
    const float* lbp = (const float*)(ws + WS_LB) + l * 256; const float* dS = (const float*)(ws + WS_DS);
    const float* onorm = IN(10) + l * 64;
#pragma unroll 1
    for (int it = bid; it < 512; it += G) hgrn_out_item(z, lbp, dS, onorm, bufB, lds, it >> 1, it & 1, tid, lane, wave);
}
__device__ __forceinline__ void phase_g2(LAS unsigned char* lds, int l, int wv) {
    PHASE_HEAD
    bf16_t* bufA = (bf16_t*)(ws + WS_BUFA);
    pg8::Gemm g{(const bf16_t*)(ws + WS_BUFB), WL(W_OUT), TP, DM, DM}; pg8::StaticOrder S; S.init(TP, DM, G, bid);
    EpiRes E{bufA, bufA, SSP(3 * l + 1)};
    pg8::gemm_phase<EpiRes, pg8::StaticOrder, true, true>(lds, g, S, E, wv);
    SEpiRes SE{bufA + (size_t)TP * DM, bufA + (size_t)TP * DM, SSP(3 * l + 1) + TP};
    small_gemm(lds, (const bf16_t*)(ws + WS_BUFB) + (size_t)TP * DM, WL(W_OUT), DM, SE, bid, tid, lane, wave);
}
__device__ __forceinline__ void phase_g3(LAS unsigned char* lds, int l, int wv) {
    PHASE_HEAD
    pg8::Gemm g{(const bf16_t*)(ws + WS_BUFA), WL(W_GU), MT, 2 * DFF, DM}; pg8::StaticOrder S; S.init(MT, 2 * DFF, G, bid);
    EpiGU E{(bf16_t*)(ws + WS_ZACT), SSP(3 * l + 1)}; pg8::gemm_phase<EpiGU, pg8::StaticOrder, true, true>(lds, g, S, E, wv);
    if (bid >= 172) {
        bf16_t* pbl = (bf16_t*)(ws + WS_PB) + (size_t)l * MT * PLE;
        const float* pP = IN(6) + (size_t)l * TP * PLE; const float* pS = IN(7) + (size_t)l * NSM * PLE;
        const int gw2 = (bid - 172) * 8 + wave, NGW2 = (G - 172) * 8;
#pragma unroll 1
        for (int m0 = gw2; m0 < MT; m0 += 8 * NGW2) {
            f32x4 v[8];
#pragma unroll
            for (int q = 0; q < 8; ++q) { const int m = (m0 + q * NGW2 < MT) ? m0 + q * NGW2 : m0;
                const float* src = (m < TP) ? pP + (size_t)m * PLE : pS + (size_t)(m - TP) * PLE; v[q] = ((const f32x4*)src)[lane]; }
#pragma unroll
            for (int q = 0; q < 8; ++q) { const int m = (m0 + q * NGW2 < MT) ? m0 + q * NGW2 : m0;
                u32x2 w; w.x = cvt_pk_bf16(v[q][0], v[q][1]); w.y = cvt_pk_bf16(v[q][2], v[q][3]); ((u32x2*)(pbl + (size_t)m * PLE))[lane] = w; }
        }
        { LAS float* scr = (LAS float*)(lds + wave * 16384);
          const int first = (l == 0) ? CI_LAYER : (CI_LAYER + CI_D), cnt_ = (l == 0) ? CI_OUT : (CI_LAYER - CI_D);
#pragma unroll 1
          for (int k = (bid - 172) * 8 + wave; k < cnt_; k += (G - 172) * 8) convert_item(lds, ws, scr, first + k, lane); }
    }
}
__device__ __forceinline__ void phase_g4(LAS unsigned char* lds, int l, int wv) {
    PHASE_HEAD
    const bf16_t* bufA = (const bf16_t*)(ws + WS_BUFA); bf16_t* bufB = (bf16_t*)(ws + WS_BUFB);
    pg8::Gemm g{(const bf16_t*)(ws + WS_ZACT), WL(W_D), TP, DM, DFF}; pg8::StaticOrder S; S.init(TP, DM, G, bid);
    EpiRes E{bufA, bufB, SSP(3 * l + 2)}; pg8::gemm_phase<EpiRes, pg8::StaticOrder, true, true>(lds, g, S, E, wv);
    SEpiRes SE{bufA + (size_t)TP * DM, bufB + (size_t)TP * DM, SSP(3 * l + 2) + TP};
    small_gemm(lds, (const bf16_t*)(ws + WS_ZACT) + (size_t)TP * DFF, WL(W_D), DFF, SE, bid, tid, lane, wave);
}
__device__ __forceinline__ void phase_g5a(LAS unsigned char* lds, int l, int wv) {
    PHASE_HEAD
    pg8::Gemm g{(const bf16_t*)(ws + WS_BUFB), WL(W_PG), TP, DM, DM}; pg8::StaticOrder S; S.init(TP, DM, G, bid);
    EpiGate E{(bf16_t*)(ws + WS_ZACT), SSP(3 * l + 2)}; pg8::gemm_phase<EpiGate, pg8::StaticOrder, true, true>(lds, g, S, E, wv);
    SEpiGate SE{(bf16_t*)(ws + WS_ZACT) + (size_t)TP * DM, SSP(3 * l + 2) + TP};
    small_gemm(lds, (const bf16_t*)(ws + WS_BUFB) + (size_t)TP * DM, WL(W_PG), DM, SE, bid, tid, lane, wave);
}
__device__ __forceinline__ void phase_g5b(LAS unsigned char* lds, int l, int wv) {
    PHASE_HEAD
    const bf16_t* gt = (const bf16_t*)(ws + WS_ZACT); const bf16_t* bufB = (const bf16_t*)(ws + WS_BUFB); bf16_t* bufA = (bf16_t*)(ws + WS_BUFA); float* Y = OUTP + O_Y;
    pg8::Gemm g{(const bf16_t*)(ws + WS_PB) + (size_t)l * MT * PLE, WL(W_PP), TP, DM, PLE}; pg8::StaticOrder S; S.init(TP, DM, G, bid);
    EpiOut E{gt, bufB, Y, bufA, SSP(3), l}; pg8::gemm_phase<EpiOut, pg8::StaticOrder, true, true>(lds, g, S, E, wv);
    SEpiOut SE{gt + (size_t)TP * DM, bufB + (size_t)TP * DM, Y + (size_t)TP * DM, bufA + (size_t)TP * DM, SSP(3) + TP, l};
    small_gemm(lds, (const bf16_t*)(ws + WS_PB) + ((size_t)l * MT + TP) * PLE, WL(W_PP), PLE, SE, bid, tid, lane, wave);
}

__global__ void __launch_bounds__(512, 2) fwd_kernel(Args a) {
    extern __shared__ __attribute__((aligned(16))) unsigned char lds_raw[];
    LAS unsigned char* lds = (LAS unsigned char*)lds_raw;
    volatile LAS unsigned* MISC = (volatile LAS unsigned*)(lds + MISC_OFF);
    if (threadIdx.x < 32) MISC[threadIdx.x] = 0u;
    if (threadIdx.x == 0) {
        LAS unsigned long long* PT = (LAS unsigned long long*)(lds + PT_OFF);
#pragma unroll
        for (int i = 0; i < 27; ++i) PT[i] = (unsigned long long)a.in[i];
        PT[27] = (unsigned long long)a.out; PT[28] = (unsigned long long)a.ws;
    }
    __syncthreads();
    const int wv = __builtin_amdgcn_readfirstlane(threadIdx.x >> 6);
    XcdBarrier bar = xcd_barrier_post((unsigned*)(WSP + WS_CTL), MISC + 8); bar.wv = wv;
    prologue(lds, wv);
    if (gridDim.x == 0x7fffffffu) cg::this_grid().sync();
    xcd_barrier(bar);
#define LAYER(l) do { \
        phase_g1(lds, l, wv); xcd_barrier(bar); \
        phase_mix_a(lds, l, wv); xcd_barrier(bar); \
        phase_scan(lds, l, wv); xcd_barrier(bar); \
        phase_mix_c(lds, l, wv); xcd_barrier(bar); \
        phase_g2(lds, l, wv); xcd_barrier(bar); \
        phase_g3(lds, l, wv); xcd_barrier(bar); \
        phase_g4(lds, l, wv); xcd_barrier(bar); \
        phase_g5a(lds, l, wv); \
        phase_g5b(lds, l, wv); } while (0)
    LAYER(0);
    xcd_barrier(bar);
    LAYER(1);
}

extern "C" void kernel_launch(void* const* d_in, const int* in_sizes, int n_in, void* d_out, int out_size, void* d_ws, size_t ws_size, hipStream_t stream) {
    static int grid = 0;
    if (grid == 0) {
        if (n_in != 27 || ws_size < WS_END) { fprintf(stderr, "kernel_launch: unexpected n_in %d / ws %zu\n", n_in, ws_size); grid = -1; return; }
        int dev = 0, cus = 0, per_cu = 0;
        hipGetDevice(&dev); hipDeviceGetAttribute(&cus, hipDeviceAttributeMultiprocessorCount, dev);
        if (hipFuncSetAttribute((const void*)fwd_kernel, hipFuncAttributeMaxDynamicSharedMemorySize, LDS_BYTES) != hipSuccess) { fprintf(stderr, "kernel_launch: hipFuncSetAttribute failed\n"); grid = -1; return; }
        hipOccupancyMaxActiveBlocksPerMultiprocessor(&per_cu, (const void*)fwd_kernel, 512, LDS_BYTES);
        (void)hipGetLastError();
        if (per_cu < 1) { fprintf(stderr, "kernel_launch: occupancy query says %d blocks per CU\n", per_cu); }
        grid = cus;
    }
    if (grid < 0) return;
    hipMemsetAsync((char*)d_ws + WS_CTL, 0, CTL_BYTES, stream);
    Args a{};
    for (int i = 0; i < 27; ++i) a.in[i] = (const float*)d_in[i];
    a.out = (float*)d_out; a.ws = (unsigned char*)d_ws;
    void* args[] = {&a};
    hipError_t e = hipLaunchCooperativeKernel((const void*)fwd_kernel, dim3(grid), dim3(512), args, LDS_BYTES, stream);
    if (e != hipSuccess) fprintf(stderr, "cooperative launch failed: %s (grid %d)\n", hipGetErrorString(e), grid);
}
```

```cpp
#include <hip/hip_runtime.h>
#include <hip/hip_cooperative_groups.h>
#include <cstdio>
#include <cstdint>
namespace cg = cooperative_groups;
namespace pg8 {
#define PG8_LAS __attribute__((address_space(3)))
typedef unsigned short bf16_t;
typedef short bf16x8 __attribute__((ext_vector_type(8)));
typedef float f32x4 __attribute__((ext_vector_type(4)));
typedef unsigned u32x4 __attribute__((ext_vector_type(4)));
constexpr int BM = 256, BK = 64, HALF = 128, HTB = HALF * BK * 2  , STAGE_BYTES = 8 * HTB, NXCD = 8, WGM = 4;

__host__ __device__ __forceinline__ int lds_byte(int r, int c) { const int st = (r >> 4) * 2 + (c >> 5), rr = r & 15, cc = c & 31, ob = rr * 64 + cc * 2; return st * 1024 + (ob ^ (((ob >> 9) & 1) << 5)); }
__host__ __device__ __forceinline__ void stage_rc(int b, int& R, int& C) { const int st = b / 1024, sb = b % 1024, swz = sb ^ (((sb >> 9) & 1) << 5); R = (st >> 1) * 16 + swz / 64; C = (st & 1) * 32 + (swz % 64) / 2; }
__host__ __device__ __forceinline__ int perm32(int rho) { const int n = rho >> 4, i = rho & 15; return 8 * (i >> 2) + 4 * n + (i & 3); }

struct Unit { int pm, pn; };
struct Gemm { const bf16_t* A; const bf16_t* Bt; int M, N, K; };

struct StaticOrder {
    int nM, nN, nwg, G, c;
    __host__ __device__ void init(int M, int N, int G_, int c_) { nM = M / BM; nN = N / BM; nwg = nM * nN; G = G_; c = c_; }
    __host__ __device__ bool next(int i, Unit& u) const {
        const long L = (long)i * G + c; if (L >= nwg) return false;
        int wgid = (int)L; { const int q = nwg / NXCD, r = nwg % NXCD, xcd = wgid % NXCD, off = wgid / NXCD; wgid = (xcd < r ? xcd * (q + 1) : r * (q + 1) + (xcd - r) * q) + off; }
        const int nig = WGM * nN, gid = wgid / nig, fm = gid * WGM, gsz = (nM - fm) < WGM ? (nM - fm) : WGM;
        u.pm = fm + ((wgid % nig) % gsz); u.pn = (wgid % nig) / gsz; return true;
    }
    __device__ __forceinline__ void a_ready(const Unit&) const {}
    __device__ __forceinline__ void done(const Unit&) const {}
};
__device__ __forceinline__ unsigned cvt_pk_bf16(float lo, float hi) { unsigned r; asm volatile("v_cvt_pk_bf16_f32 %0, %1, %2" : "=v"(r) : "v"(lo), "v"(hi)); return r; }
template <class Epi, class Sched, bool ALIGN_EPI = false, bool SP2 = false>
__device__ __forceinline__ void gemm_phase(PG8_LAS unsigned char* lds, const Gemm g, const Sched& S, const Epi& E, int wv_) {
    unsigned m_ = ~0u; asm volatile("" : "+s"(m_)); asm volatile("" : "+s"(wv_)); int tid_ = wv_ * 64 + (int)__builtin_amdgcn_mbcnt_hi(m_, __builtin_amdgcn_mbcnt_lo(m_, 0u)); { unsigned z_ = 0; asm volatile("" : "+s"(z_)); lds += z_; } const int tid = tid_, wid = __builtin_amdgcn_readfirstlane(tid >> 6), lane = tid & 63, wr = wid >> 2, wc = wid & 3, fr = lane & 15, fq = lane >> 4;
    const int K = g.K, nt = K / BK;
    unsigned voffA[2], voffB[2];
#pragma unroll
    for (int i = 0; i < 2; ++i) { int R, C; stage_rc(tid * 16 + i * 8192, R, C); const int Rb = Epi::PERM ? ((R & ~31) + perm32(R & 31)) : R;
        voffA[i] = (unsigned)(R * K + C) * 2u; voffB[i] = (unsigned)(Rb * K + C) * 2u; }
    const size_t kstep = (size_t)(BK * 2);
    const size_t hstep = (size_t)HALF * K * 2;
    const size_t tstep = 2 * hstep;
    const unsigned ldsw = (unsigned)wid * 1024u;
    const int aoff = lds_byte(wr * 64 + fr, fq * 8), boff = lds_byte(wc * 32 + fr, fq * 8);
#define PG8_SA(b, h) (((b) * 2 + (h)) * HTB)
#define PG8_SB(b, h) ((4 + (b) * 2 + (h)) * HTB)
#define PG8_STAGE(bufoff, gbase, voff) do { _Pragma("unroll") for (int _i = 0; _i < 2; ++_i) \
        __builtin_amdgcn_global_load_lds((const unsigned*)((const char*)(gbase) + (voff)[_i]), (PG8_LAS unsigned*)(lds + (bufoff) + ldsw + _i * 8192), 16, 0, 0); } while (0)
#define PG8_LDA(dst, b, h) do { _Pragma("unroll") for (int m = 0; m < 4; ++m) _Pragma("unroll") for (int k = 0; k < 2; ++k) dst[m][k] = *(const PG8_LAS bf16x8*)(lds + PG8_SA(b, h) + aoff + m * 2048 + k * 1024); } while (0)
#define PG8_LDB(dst, b, h) do { _Pragma("unroll") for (int n = 0; n < 2; ++n) _Pragma("unroll") for (int k = 0; k < 2; ++k) dst[n][k] = *(const PG8_LAS bf16x8*)(lds + PG8_SB(b, h) + boff + n * 2048 + k * 1024); } while (0)
#define PG8_MMA(ai, bj, At, Bt) do { __builtin_amdgcn_s_setprio(1); _Pragma("unroll") for (int m = 0; m < 4; ++m) _Pragma("unroll") for (int n = 0; n < 2; ++n) _Pragma("unroll") for (int k = 0; k < 2; ++k) \
        acc[ai][bj][m][n] = __builtin_amdgcn_mfma_f32_16x16x32_bf16(Bt[n][k], At[m][k], acc[ai][bj][m][n], 0, 0, 0); __builtin_amdgcn_s_setprio(0); } while (0)
#define PG8_WAIT_V(n) asm volatile("s_waitcnt vmcnt(" #n ")" ::: "memory")
#define PG8_WAIT_L(n) asm volatile("s_waitcnt lgkmcnt(" #n ")" ::: "memory")
#define PG8_BAR __builtin_amdgcn_s_barrier()
#define PG8_SCHED __builtin_amdgcn_sched_barrier(0)
    Unit cur, nxt; int ui = 0;
    if (!S.next(0, cur)) return;
    f32x4 acc[2][2][4][2];
#pragma unroll
    for (int a = 0; a < 2; ++a)
#pragma unroll
        for (int b = 0; b < 2; ++b)
#pragma unroll
            for (int m = 0; m < 4; ++m)
#pragma unroll
                for (int n = 0; n < 2; ++n) acc[a][b][m][n] = (f32x4){0.f, 0.f, 0.f, 0.f};
    bf16x8 At[4][2], B0[2][2], B1[2][2];
    const char* cA = (const char*)g.A + (size_t)cur.pm * tstep; const char* cB = (const char*)g.Bt + (size_t)cur.pn * tstep;
    S.a_ready(cur);
    if constexpr (SP2) {
        PG8_STAGE(PG8_SB(0, 0), cB, voffB); PG8_STAGE(PG8_SB(0, 1), cB + hstep, voffB); PG8_STAGE(PG8_SA(0, 0), cA, voffA); PG8_STAGE(PG8_SA(0, 1), cA + hstep, voffA);
        if (wr == 1) PG8_BAR;
        PG8_WAIT_V(2); PG8_BAR;
        PG8_STAGE(PG8_SB(1, 0), cB + kstep, voffB); PG8_STAGE(PG8_SA(1, 0), cA + kstep, voffA); PG8_STAGE(PG8_SB(1, 1), cB + hstep + kstep, voffB);
        PG8_WAIT_V(6); PG8_BAR;
    } else {
        PG8_STAGE(PG8_SB(0, 0), cB, voffB); PG8_STAGE(PG8_SA(0, 0), cA, voffA); PG8_STAGE(PG8_SB(0, 1), cB + hstep, voffB); PG8_STAGE(PG8_SA(0, 1), cA + hstep, voffA);
        if (wr == 1) PG8_BAR;
        PG8_WAIT_V(4); PG8_BAR;
        PG8_STAGE(PG8_SB(1, 0), cB + kstep, voffB); PG8_STAGE(PG8_SA(1, 0), cA + kstep, voffA); PG8_STAGE(PG8_SB(1, 1), cB + hstep + kstep, voffB);
        PG8_WAIT_V(6); PG8_BAR;
    }
    for (;;) {
        const bool has_next = S.next(ui + 1, nxt);
        const char* nA = has_next ? (const char*)g.A + (size_t)nxt.pm * tstep : cA; const char* nB = has_next ? (const char*)g.Bt + (size_t)nxt.pn * tstep : cB;
        for (int t = 0; t < nt; t += 2) {
            const bool last = (t == nt - 2);
            const char* a1 = cA + (size_t)(t + 1) * kstep;
            const char* a2 = last ? nA : cA + (size_t)(t + 2) * kstep; const char* b2 = last ? nB : cB + (size_t)(t + 2) * kstep;
            const char* a3 = a2 + kstep; const char* b3 = b2 + kstep;
            if (last && has_next) S.a_ready(nxt);
            if constexpr (SP2) {
            PG8_LDB(B0, 0, 0); PG8_LDB(B1, 0, 1); PG8_SCHED; PG8_LDA(At, 0, 0); PG8_STAGE(PG8_SA(1, 1), a1 + hstep, voffA);
            PG8_WAIT_V(8); PG8_WAIT_L(0); PG8_BAR; PG8_MMA(0, 0, At, B0); PG8_MMA(0, 1, At, B1); PG8_BAR; PG8_SCHED;
            PG8_LDA(At, 0, 1); PG8_STAGE(PG8_SB(0, 0), b2, voffB); PG8_STAGE(PG8_SB(0, 1), b2 + hstep, voffB); PG8_STAGE(PG8_SA(0, 0), a2, voffA);
            PG8_WAIT_V(8); PG8_WAIT_L(0); PG8_BAR; PG8_MMA(1, 0, At, B0); PG8_MMA(1, 1, At, B1); PG8_BAR; PG8_SCHED;
            PG8_LDB(B0, 1, 0); PG8_LDB(B1, 1, 1); PG8_SCHED; PG8_LDA(At, 1, 0); PG8_STAGE(PG8_SA(0, 1), a2 + hstep, voffA);
            PG8_WAIT_V(8); PG8_WAIT_L(0); PG8_BAR; PG8_MMA(0, 0, At, B0); PG8_MMA(0, 1, At, B1); PG8_BAR; PG8_SCHED;
            PG8_LDA(At, 1, 1); PG8_STAGE(PG8_SB(1, 0), b3, voffB); PG8_STAGE(PG8_SB(1, 1), b3 + hstep, voffB); PG8_STAGE(PG8_SA(1, 0), a3, voffA);
            PG8_WAIT_V(8); PG8_WAIT_L(0); PG8_BAR; PG8_MMA(1, 0, At, B0); PG8_MMA(1, 1, At, B1); PG8_BAR; PG8_SCHED;
            } else {
            PG8_LDB(B0, 0, 0); PG8_SCHED; PG8_LDA(At, 0, 0); PG8_STAGE(PG8_SA(1, 1), a1 + hstep, voffA);
            PG8_WAIT_L(8); PG8_BAR; PG8_WAIT_L(0); PG8_MMA(0, 0, At, B0); PG8_BAR; PG8_SCHED;
            PG8_LDB(B1, 0, 1); PG8_STAGE(PG8_SB(0, 0), b2, voffB);
            PG8_BAR; PG8_WAIT_L(0); PG8_MMA(0, 1, At, B1); PG8_BAR;
            PG8_LDA(At, 0, 1); PG8_STAGE(PG8_SA(0, 0), a2, voffA);
            PG8_BAR; PG8_WAIT_L(0); PG8_MMA(1, 0, At, B0); PG8_BAR; PG8_SCHED;
            PG8_STAGE(PG8_SB(0, 1), b2 + hstep, voffB);
            PG8_WAIT_V(6); PG8_BAR; PG8_MMA(1, 1, At, B1); PG8_BAR;
            PG8_LDB(B0, 1, 0); PG8_SCHED; PG8_LDA(At, 1, 0); PG8_STAGE(PG8_SA(0, 1), a2 + hstep, voffA);
            PG8_WAIT_L(8); PG8_BAR; PG8_WAIT_L(0); PG8_MMA(0, 0, At, B0); PG8_BAR; PG8_SCHED;
            PG8_LDB(B1, 1, 1); PG8_STAGE(PG8_SB(1, 0), b3, voffB);
            PG8_BAR; PG8_WAIT_L(0); PG8_MMA(0, 1, At, B1); PG8_BAR;
            PG8_LDA(At, 1, 1); PG8_STAGE(PG8_SA(1, 0), a3, voffA);
            PG8_BAR; PG8_WAIT_L(0); PG8_MMA(1, 0, At, B0); PG8_BAR; PG8_SCHED;
            PG8_STAGE(PG8_SB(1, 1), b3 + hstep, voffB);
            PG8_WAIT_V(6); PG8_BAR; PG8_MMA(1, 1, At, B1); PG8_BAR;
            }
        }
        if constexpr (ALIGN_EPI) { if (wr == 0) PG8_BAR; }
        if constexpr (!Epi::AFTER_DRAIN) { E(acc, cur, wr, wc, fr, fq); S.done(cur); }
        if (!has_next) break;
#pragma unroll
        for (int a = 0; a < 2; ++a)
#pragma unroll
            for (int b = 0; b < 2; ++b)
#pragma unroll
                for (int m = 0; m < 4; ++m)
#pragma unroll
                    for (int n = 0; n < 2; ++n) acc[a][b][m][n] = (f32x4){0.f, 0.f, 0.f, 0.f};
        cur = nxt; cA = nA; cB = nB; ++ui;
        if constexpr (ALIGN_EPI) { if (wr == 1) PG8_BAR; }
    }
    PG8_WAIT_V(0);
    if constexpr (!ALIGN_EPI) { if (wr == 0) PG8_BAR; }
    PG8_BAR;
    if constexpr (Epi::AFTER_DRAIN) { E.fused(acc, cur, wr, wc, fr, fq, lds, wid, lane); S.done(cur); }
#undef PG8_SA
#undef PG8_SB
#undef PG8_STAGE
#undef PG8_LDA
#undef PG8_LDB
#undef PG8_MMA
#undef PG8_WAIT_V
#undef PG8_WAIT_L
#undef PG8_BAR
#undef PG8_SCHED
}
}

#define LAS __attribute__((address_space(3)))
using pg8::bf16_t; using pg8::bf16x8; using pg8::f32x4; using pg8::u32x4; using pg8::Unit; using pg8::cvt_pk_bf16;
typedef unsigned u32x2 __attribute__((ext_vector_type(2)));

constexpr int DM = 1024, TP = 16384, NSM = 512, MT = TP + NSM, INC = 2304, DFF = 2816, PLE = 256;
constexpr int ZQ = 0, ZF = 256, ZI = 512, ZG = 768, ZBU = 1024, ZBG = 1280, ZCQ = 1536, ZCK = 2048, ZCV = 2176;
constexpr float EPS = 1e-6f;
constexpr int NPOS = TP + 4;
constexpr size_t O_Y = 0, O_SPH = (size_t)MT * DM, O_SPC = O_SPH + 32768, O_SPK = O_SPC + 15360, O_SPV = O_SPK + 32768,
                 O_SSH = O_SPV + 32768, O_SSC = O_SSH + 4194304, O_SSK = O_SSC + 1966080, O_SSV = O_SSK + 4194304;
constexpr size_t MiB = 1u << 20;
constexpr size_t WS_CTL = 0, CTL_BYTES = 65536;
constexpr size_t WS_SS = 1 * MiB;
constexpr size_t WS_LB = WS_SS + 512 * 1024;
constexpr size_t WS_DVEC = WS_LB + 4096;
constexpr size_t WS_ROPE = 2 * MiB;
constexpr size_t WS_W = 7 * MiB;
constexpr size_t W_IN = 0, W_OUT = W_IN + (size_t)INC * DM * 2, W_GU = W_OUT + (size_t)DM * DM * 2, W_D = W_GU + (size_t)2 * DFF * DM * 2,
                 W_PG = W_D + (size_t)DM * DFF * 2, W_PP = W_PG + (size_t)DM * DM * 2, W_LAYER = W_PP + (size_t)DM * PLE * 2;
constexpr size_t WS_BUFA = 59 * MiB, WS_BUFB = 92 * MiB, WS_ZACT = 125 * MiB, WS_PB = 216 * MiB, WS_DS = 233 * MiB, WS_END = 249 * MiB;
static_assert(WS_W + 2 * W_LAYER <= WS_BUFA && WS_BUFA + (size_t)MT * DM * 2 <= WS_BUFB && WS_BUFB + (size_t)MT * DM * 2 <= WS_ZACT, "ws map");
static_assert(WS_ZACT + (size_t)MT * DFF * 2 <= WS_PB && WS_PB + (size_t)2 * MT * PLE * 2 <= WS_DS && WS_ROPE + (size_t)NPOS * 64 * 4 <= WS_W, "ws map");
constexpr int LDS_BYTES = 147456, MISC_OFF = 131072 + 320;

#define LSYNC() do { asm volatile("s_waitcnt lgkmcnt(0)" ::: "memory"); __builtin_amdgcn_s_barrier(); asm volatile("" ::: "memory"); } while (0)
#define LDS_WAIT() asm volatile("s_waitcnt lgkmcnt(0)" ::: "memory")
__device__ __forceinline__ float bf2f(unsigned short h) { return __uint_as_float(((unsigned)h) << 16); }
template <int CTRL> __device__ __forceinline__ float dppf(float v) { return __int_as_float(__builtin_amdgcn_update_dpp(0, __float_as_int(v), CTRL, 0xf, 0xf, true)); }
__device__ __forceinline__ float wave_sum(float v) {
    v += dppf<0xB1>(v);
    v += dppf<0x4E>(v);
    v += dppf<0x141>(v);
    v += dppf<0x140>(v);
    const float r0 = __int_as_float(__builtin_amdgcn_readlane(__float_as_int(v), 0)), r1 = __int_as_float(__builtin_amdgcn_readlane(__float_as_int(v), 16));
    const float r2 = __int_as_float(__builtin_amdgcn_readlane(__float_as_int(v), 32)), r3 = __int_as_float(__builtin_amdgcn_readlane(__float_as_int(v), 48));
    return (r0 + r1) + (r2 + r3);
}
__device__ __forceinline__ float quad_sum(float v) { v += dppf<0xB1>(v); v += dppf<0x4E>(v); return v; }
__device__ __forceinline__ float sigmoidf_(float x) { return __builtin_amdgcn_rcpf(1.0f + __expf(-x)); }
__device__ __forceinline__ float siluf_(float x) { return x * __builtin_amdgcn_rcpf(1.0f + __expf(-x)); }
#define UNPACK8(V_, o) do { (o)[0] = __uint_as_float((V_).x << 16); (o)[1] = __uint_as_float((V_).x & 0xffff0000u); (o)[2] = __uint_as_float((V_).y << 16); (o)[3] = __uint_as_float((V_).y & 0xffff0000u); \
    (o)[4] = __uint_as_float((V_).z << 16); (o)[5] = __uint_as_float((V_).z & 0xffff0000u); (o)[6] = __uint_as_float((V_).w << 16); (o)[7] = __uint_as_float((V_).w & 0xffff0000u); } while (0)

#define XB_TMO      128
#define XB_XCNT(j)  (256  + 64 * (j))
#define XB_XSUB(j)  (1280 + 64 * (j))
#define XB_XGEN(j)  (2304 + 64 * (j))
#define XB_TOP      3328
#define XB_TOPGEN   3392
#define XCD_BAR_WORDS 3456
#define XB_SPIN_CAP (1u << 18)

__device__ __forceinline__ unsigned xb_ld(unsigned* p)              { return __hip_atomic_load(p, __ATOMIC_RELAXED, __HIP_MEMORY_SCOPE_AGENT); }
__device__ __forceinline__ unsigned xb_add(unsigned* p, unsigned v) { return __hip_atomic_fetch_add(p, v, __ATOMIC_RELAXED, __HIP_MEMORY_SCOPE_AGENT); }
__device__ __forceinline__ unsigned xb_xcc_id() { return (unsigned)__builtin_amdgcn_s_getreg((3 << 11) | 20) & 0xFu; }
#define XB_SPIN(cond, bar) do { unsigned _sp = 0; while (cond) { __builtin_amdgcn_s_sleep(1); \
    if ((++_sp & 255u) == 0u) { if (xb_ld(&(bar)[XB_TMO])) break; if (_sp > XB_SPIN_CAP) { atomicAdd(&(bar)[XB_TMO], 1u); break; } } } } while (0)

struct XcdBarrier {
    unsigned* bar; unsigned x; int wv;
    volatile LAS unsigned* st;
};

__device__ __forceinline__ XcdBarrier xcd_barrier_post(unsigned* bar, volatile LAS unsigned* st) {
    XcdBarrier b; b.bar = bar; b.x = xb_xcc_id(); b.st = st;
    if (threadIdx.x == 0) (void)xb_add(&bar[XB_XCNT(b.x)], 1u);
    return b;
}
__device__ __forceinline__ void xcd_barrier_complete(unsigned* bar, unsigned x, unsigned& nloc, unsigned& nx) {
    const unsigned G = gridDim.x * gridDim.y * gridDim.z;
    unsigned sum, cnt, mine, sp = 0u;
    for (;;) {
        sum = 0u; cnt = 0u; mine = 0u;
#pragma unroll
        for (unsigned j = 0; j < 16; ++j) { const unsigned c = xb_ld(&bar[XB_XCNT(j)]); sum += c; cnt += (c > 0u) ? 1u : 0u; mine = (j == x) ? c : mine; }
        if (sum == G) break;
        __builtin_amdgcn_s_sleep(1);
        if ((++sp & 255u) == 0u) { if (xb_ld(&bar[XB_TMO])) break; if (sp > XB_SPIN_CAP) { atomicAdd(&bar[XB_TMO], 1u); break; } }
    }
    nloc = mine > 0u ? mine : 1u; nx = cnt > 0u ? cnt : 1u;
}

__device__ __forceinline__ void xcd_barrier(const XcdBarrier& b) {
    asm volatile("s_waitcnt vmcnt(0)" ::: "memory");
    __syncthreads();
    unsigned xm_ = ~0u; asm volatile("" : "+s"(xm_));
    int xw_ = b.wv; asm volatile("" : "+s"(xw_));
    if (xw_ == 0 && __builtin_amdgcn_mbcnt_hi(xm_, __builtin_amdgcn_mbcnt_lo(xm_, 0u)) == 0u) {
        unsigned* bar = b.bar;
        __builtin_amdgcn_s_waitcnt(0);
        unsigned nloc = b.st[0], nx = b.st[1];
        if (nloc == 0u) { xcd_barrier_complete(bar, b.x, nloc, nx); b.st[0] = nloc; b.st[1] = nx; }
        const unsigned old = xb_add(&bar[XB_XSUB(b.x)], 1u);
        const unsigned gen = old / nloc;
        if (old + 1u == (gen + 1u) * nloc) {
            __builtin_amdgcn_fence(__ATOMIC_RELEASE, "agent");
            asm volatile("s_waitcnt vmcnt(0)" ::: "memory");
            const unsigned og = xb_add(&bar[XB_TOP], 1u);
            const unsigned tg = og / nx;
            if (og + 1u == (tg + 1u) * nx) xb_add(&bar[XB_TOPGEN], 1u);
            else XB_SPIN(xb_ld(&bar[XB_TOPGEN]) == tg, bar);
            __builtin_amdgcn_fence(__ATOMIC_ACQUIRE, "agent");
            xb_add(&bar[XB_XGEN(b.x)], 1u);
            asm volatile("s_waitcnt vmcnt(0)" ::: "memory");
        } else {
            XB_SPIN(xb_ld(&bar[XB_XGEN(b.x)]) == gen, bar);
            __builtin_amdgcn_fence(__ATOMIC_ACQUIRE, "agent");
            asm volatile("s_waitcnt vmcnt(0)" ::: "memory");
        }
    }
    __syncthreads();
}

struct EpiZ {
    static constexpr bool PERM = true, AFTER_DRAIN = false;
    bf16_t* O; int ldc; const float* ss;
    __device__ __forceinline__ void operator()(const f32x4 (&acc)[2][2][4][2], const Unit& u, int wr, int wc, int fr, int fq) const {
        const int row0 = u.pm * 256 + wr * 64 + fr, col0 = u.pn * 256 + wc * 32 + 8 * fq;
#pragma unroll
        for (int ai = 0; ai < 2; ++ai)
#pragma unroll
            for (int m = 0; m < 4; ++m) {
                const int row = row0 + ai * 128 + m * 16; const float r = rsqrtf(ss[row] * (1.0f / DM) + EPS);
                bf16_t* rowp = O + (size_t)row * ldc + col0;
#pragma unroll
                for (int bj = 0; bj < 2; ++bj) { const f32x4 v0 = acc[ai][bj][m][0] * r, v1 = acc[ai][bj][m][1] * r;
                    u32x4 w; w.x = cvt_pk_bf16(v0[0], v0[1]); w.y = cvt_pk_bf16(v0[2], v0[3]); w.z = cvt_pk_bf16(v1[0], v1[1]); w.w = cvt_pk_bf16(v1[2], v1[3]);
                    *(u32x4*)(rowp + bj * 128) = w; }
            }
    }
};
typedef float f32x2 __attribute__((ext_vector_type(2)));
struct EpiGU {
    static constexpr bool PERM = true, AFTER_DRAIN = false;
    bf16_t* O; const float* ss;
    __device__ __forceinline__ void operator()(const f32x4 (&acc)[2][2][4][2], const Unit& u, int wr, int wc, int fr, int fq) const {
        const int row0 = u.pm * 256 + wr * 64 + fr, col0 = u.pn * 128 + wc * 32 + 8 * fq;
#pragma unroll
        for (int ai = 0; ai < 2; ++ai)
#pragma unroll
            for (int m = 0; m < 4; ++m) {
                const int row = row0 + ai * 128 + m * 16; const float r = rsqrtf(ss[row] * (1.0f / DM) + EPS);
                const float rn = r * -1.44269504f, r2 = r * r;
                unsigned w4[4];
#pragma unroll
                for (int n = 0; n < 2; ++n)
#pragma unroll
                    for (int e = 0; e < 4; e += 2) {
                        const f32x2 g2 = (f32x2){acc[ai][0][m][n][e], acc[ai][0][m][n][e + 1]}, u2 = (f32x2){acc[ai][1][m][n][e], acc[ai][1][m][n][e + 1]};
                        const f32x2 t = g2 * rn; f32x2 ex; ex.x = __builtin_amdgcn_exp2f(t.x); ex.y = __builtin_amdgcn_exp2f(t.y);
                        const f32x2 d = ex + 1.0f; f32x2 rc; rc.x = __builtin_amdgcn_rcpf(d.x); rc.y = __builtin_amdgcn_rcpf(d.y);
                        const f32x2 o = (g2 * u2) * (rc * r2);
                        w4[n * 2 + (e >> 1)] = cvt_pk_bf16(o.x, o.y);
                    }
                u32x4 w; w.x = w4[0]; w.y = w4[1]; w.z = w4[2]; w.w = w4[3];
                *(u32x4*)(O + (size_t)row * DFF + col0) = w;
            }
    }
};
struct EpiRes {
    static constexpr bool PERM = false, AFTER_DRAIN = false;
    const bf16_t* res; bf16_t* Ob; float* ss;
    __device__ __forceinline__ void operator()(const f32x4 (&acc)[2][2][4][2], const Unit& u, int wr, int wc, int fr, int fq) const {
        const int row0 = u.pm * 256 + wr * 64 + fr, col0 = u.pn * 256 + wc * 32 + 4 * fq;
#pragma unroll
        for (int ai = 0; ai < 2; ++ai)
#pragma unroll
            for (int m = 0; m < 4; ++m) {
                const int row = row0 + ai * 128 + m * 16; const size_t off = (size_t)row * DM + col0; float sq = 0.f;
#pragma unroll
                for (int bj = 0; bj < 2; ++bj)
#pragma unroll
                    for (int n = 0; n < 2; ++n) { const size_t o2 = off + bj * 128 + n * 16;
                        const u32x2 rw = *(const u32x2*)(res + o2);
                        f32x4 v = acc[ai][bj][m][n]; v[0] += __uint_as_float(rw.x << 16); v[1] += __uint_as_float(rw.x & 0xffff0000u); v[2] += __uint_as_float(rw.y << 16); v[3] += __uint_as_float(rw.y & 0xffff0000u);
                        u32x2 w; w.x = cvt_pk_bf16(v[0], v[1]); w.y = cvt_pk_bf16(v[2], v[3]); *(u32x2*)(Ob + o2) = w;
                        sq += (v[0] * v[0] + v[1] * v[1]) + (v[2] * v[2] + v[3] * v[3]); }
                sq += __shfl_xor(sq, 16); sq += __shfl_xor(sq, 32);
                if (fq == 0) unsafeAtomicAdd(ss + row, sq);
            }
    }
};
struct EpiGate {
    static constexpr bool PERM = false, AFTER_DRAIN = false;
    bf16_t* Gt; const float* ss;
    __device__ __forceinline__ void operator()(const f32x4 (&acc)[2][2][4][2], const Unit& u, int wr, int wc, int fr, int fq) const {
        const int row0 = u.pm * 256 + wr * 64 + fr, col0 = u.pn * 256 + wc * 32 + 4 * fq;
#pragma unroll
        for (int ai = 0; ai < 2; ++ai)
#pragma unroll
            for (int m = 0; m < 4; ++m) {
                const int row = row0 + ai * 128 + m * 16; const size_t off = (size_t)row * DM + col0; const float r = rsqrtf(ss[row] * (1.0f / DM) + EPS);
#pragma unroll
                for (int bj = 0; bj < 2; ++bj)
#pragma unroll
                    for (int n = 0; n < 2; ++n) { const f32x4 a = acc[ai][bj][m][n] * r;
                        u32x2 w; w.x = cvt_pk_bf16(sigmoidf_(a[0]), sigmoidf_(a[1])); w.y = cvt_pk_bf16(sigmoidf_(a[2]), sigmoidf_(a[3]));
                        *(u32x2*)(Gt + off + bj * 128 + n * 16) = w; }
            }
    }
};
struct EpiOut {
    static constexpr bool PERM = false, AFTER_DRAIN = false;
    const bf16_t* Gt; const bf16_t* res; float* Y; bf16_t* Ob; float* ss; int final_;
    __device__ __forceinline__ void operator()(const f32x4 (&acc)[2][2][4][2], const Unit& u, int wr, int wc, int fr, int fq) const {
        const int row0 = u.pm * 256 + wr * 64 + fr, col0 = u.pn * 256 + wc * 32 + 4 * fq;
#pragma unroll
        for (int ai = 0; ai < 2; ++ai)
#pragma unroll
            for (int m = 0; m < 4; ++m) {
                const int row = row0 + ai * 128 + m * 16; const size_t off = (size_t)row * DM + col0; float sq = 0.f;
#pragma unroll
                for (int bj = 0; bj < 2; ++bj)
#pragma unroll
                    for (int n = 0; n < 2; ++n) { const size_t o2 = off + bj * 128 + n * 16;
                        const u32x2 rw = *(const u32x2*)(res + o2), gw = *(const u32x2*)(Gt + o2);
                        const f32x4 a = acc[ai][bj][m][n]; f32x4 v;
                        v[0] = __uint_as_float(rw.x << 16) + __uint_as_float(gw.x << 16) * a[0]; v[1] = __uint_as_float(rw.x & 0xffff0000u) + __uint_as_float(gw.x & 0xffff0000u) * a[1];
                        v[2] = __uint_as_float(rw.y << 16) + __uint_as_float(gw.y << 16) * a[2]; v[3] = __uint_as_float(rw.y & 0xffff0000u) + __uint_as_float(gw.y & 0xffff0000u) * a[3];
                        if (final_) *(f32x4*)(Y + o2) = v;
                        else { u32x2 w; w.x = cvt_pk_bf16(v[0], v[1]); w.y = cvt_pk_bf16(v[2], v[3]); *(u32x2*)(Ob + o2) = w; }
                        sq += (v[0] * v[0] + v[1] * v[1]) + (v[2] * v[2] + v[3] * v[3]); }
                if (!final_) { sq += __shfl_xor(sq, 16); sq += __shfl_xor(sq, 32); if (fq == 0) unsafeAtomicAdd(ss + row, sq); }
            }
    }
};

template <class Epi>
__device__ __forceinline__ void small_gemm(LAS unsigned char* lds, const bf16_t* A, const bf16_t* Bt, int K, const Epi& E, int bid, int tid, int lane, int wave) {
    if (bid >= 256) return;
    const int r0 = 64 * (bid >> 5), c0 = 32 * (bid & 31), fr = lane & 15, g = lane >> 4, kw = K >> 3;
    f32x4 acc[4][2];
#pragma unroll
    for (int m = 0; m < 4; ++m) { acc[m][0] = (f32x4){0.f, 0.f, 0.f, 0.f}; acc[m][1] = (f32x4){0.f, 0.f, 0.f, 0.f}; }
    const bf16_t* ap = A + (size_t)(r0 + fr) * K + wave * kw + 8 * g;
    const bf16_t* bp = Bt + (size_t)(c0 + fr) * K + wave * kw + 8 * g;
#pragma unroll 4
    for (int ks = 0; ks < kw; ks += 32) {
        bf16x8 a[4], b[2];
#pragma unroll
        for (int m = 0; m < 4; ++m) a[m] = *(const bf16x8*)(ap + (size_t)m * 16 * K + ks);
#pragma unroll
        for (int n = 0; n < 2; ++n) b[n] = *(const bf16x8*)(bp + (size_t)n * 16 * K + ks);
#pragma unroll
        for (int m = 0; m < 4; ++m)
#pragma unroll
            for (int n = 0; n < 2; ++n) acc[m][n] = __builtin_amdgcn_mfma_f32_16x16x32_bf16(a[m], b[n], acc[m][n], 0, 0, 0);
    }
    LAS float* P = (LAS float*)lds + wave * (64 * 33);
    LSYNC();
#pragma unroll
    for (int m = 0; m < 4; ++m)
#pragma unroll
        for (int n = 0; n < 2; ++n)
#pragma unroll
            for (int r = 0; r < 4; ++r) P[(16 * m + 4 * g + r) * 33 + 16 * n + fr] = acc[m][n][r];
    LSYNC();
    const int row = tid >> 3, c4 = (tid & 7) * 4;
    f32x4 v = (f32x4){0.f, 0.f, 0.f, 0.f};
#pragma unroll
    for (int w2 = 0; w2 < 8; ++w2) { const LAS float* q = (const LAS float*)lds + w2 * (64 * 33) + row * 33 + c4; v[0] += q[0]; v[1] += q[1]; v[2] += q[2]; v[3] += q[3]; }
    LSYNC();
    E.apply(r0 + row, c0 + c4, v, tid);
}
struct SEpiRes {
    const bf16_t* res; bf16_t* Ob; float* ss;
    __device__ __forceinline__ void apply(int row, int col, f32x4 v, int tid) const {
        const size_t o = (size_t)row * DM + col; const u32x2 rw = *(const u32x2*)(res + o);
        v[0] += __uint_as_float(rw.x << 16); v[1] += __uint_as_float(rw.x & 0xffff0000u); v[2] += __uint_as_float(rw.y << 16); v[3] += __uint_as_float(rw.y & 0xffff0000u);
        u32x2 w; w.x = cvt_pk_bf16(v[0], v[1]); w.y = cvt_pk_bf16(v[2], v[3]); *(u32x2*)(Ob + o) = w;
        float sq = (v[0] * v[0] + v[1] * v[1]) + (v[2] * v[2] + v[3] * v[3]);
        sq += __shfl_xor(sq, 1); sq += __shfl_xor(sq, 2); sq += __shfl_xor(sq, 4);
        if ((tid & 7) == 0) unsafeAtomicAdd(ss + row, sq);
    }
};
struct SEpiGate {
    bf16_t* Gt; const float* ss;
    __device__ __forceinline__ void apply(int row, int col, f32x4 v, int tid) const {
        const float r = rsqrtf(ss[row] * (1.0f / DM) + EPS);
        u32x2 w; w.x = cvt_pk_bf16(sigmoidf_(v[0] * r), sigmoidf_(v[1] * r)); w.y = cvt_pk_bf16(sigmoidf_(v[2] * r), sigmoidf_(v[3] * r));
        *(u32x2*)(Gt + (size_t)row * DM + col) = w;
    }
};
struct SEpiOut {
    const bf16_t* Gt; const bf16_t* res; float* Y; bf16_t* Ob; float* ss; int final_;
    __device__ __forceinline__ void apply(int row, int col, f32x4 a, int tid) const {
        const size_t o = (size_t)row * DM + col; const u32x2 rw = *(const u32x2*)(res + o), gw = *(const u32x2*)(Gt + o); f32x4 v;
        v[0] = __uint_as_float(rw.x << 16) + __uint_as_float(gw.x << 16) * a[0]; v[1] = __uint_as_float(rw.x & 0xffff0000u) + __uint_as_float(gw.x & 0xffff0000u) * a[1];
        v[2] = __uint_as_float(rw.y << 16) + __uint_as_float(gw.y << 16) * a[2]; v[3] = __uint_as_float(rw.y & 0xffff0000u) + __uint_as_float(gw.y & 0xffff0000u) * a[3];
        if (final_) { *(f32x4*)(Y + o) = v; return; }
        u32x2 w; w.x = cvt_pk_bf16(v[0], v[1]); w.y = cvt_pk_bf16(v[2], v[3]); *(u32x2*)(Ob + o) = w;
        float sq = (v[0] * v[0] + v[1] * v[1]) + (v[2] * v[2] + v[3] * v[3]);
        sq += __shfl_xor(sq, 1); sq += __shfl_xor(sq, 2); sq += __shfl_xor(sq, 4);
        if ((tid & 7) == 0) unsafeAtomicAdd(ss + row, sq);
    }
};

__device__ __forceinline__ void transpose_item(const float* W, int K, int N, const float* gain, bf16_t* WT, int mode, LAS float* scr, int item, int lane) {
    const int nblk = N / 32, kb = item / nblk, nb = item % nblk, k0 = 64 * kb, n0 = 32 * nb;
    { const int kr = lane >> 3, nq = (lane & 7) * 4; f32x4 v[8]; float gv[8];
#pragma unroll
      for (int i = 0; i < 8; ++i) { v[i] = *(const f32x4*)(W + (size_t)(k0 + 8 * i + kr) * N + n0 + nq); gv[i] = gain ? gain[k0 + 8 * i + kr] : 1.0f; }
#pragma unroll
      for (int i = 0; i < 8; ++i) { LAS float* d = scr + (8 * i + kr) * 33 + nq; d[0] = v[i][0] * gv[i]; d[1] = v[i][1] * gv[i]; d[2] = v[i][2] * gv[i]; d[3] = v[i][3] * gv[i]; } }
    LDS_WAIT(); asm volatile("" ::: "memory");
    const int drow0 = (mode == 0) ? n0 : (256 * (n0 >> 7) + (n0 & 127) + (mode == 2 ? 128 : 0));
    const int c = lane & 7;
#pragma unroll
    for (int j = 0; j < 4; ++j) { const int n = (lane >> 3) + 8 * j; const LAS float* s = scr + (8 * c) * 33 + n;
        u32x4 o; o.x = cvt_pk_bf16(s[0 * 33], s[1 * 33]); o.y = cvt_pk_bf16(s[2 * 33], s[3 * 33]); o.z = cvt_pk_bf16(s[4 * 33], s[5 * 33]); o.w = cvt_pk_bf16(s[6 * 33], s[7 * 33]);
        *(u32x4*)(WT + (size_t)(drow0 + n) * K + k0 + 8 * c) = o; }
    LDS_WAIT(); asm volatile("" ::: "memory");
}

struct Args { const float* in[27]; float* out; unsigned char* ws; };
constexpr int PT_OFF = 131072 + 1024;
__device__ __forceinline__ int opaque(int x) { asm volatile("" : "+v"(x)); return x; }
__device__ __forceinline__ int lane_id_opaque() { unsigned m_ = ~0u; asm volatile("" : "+s"(m_)); return (int)__builtin_amdgcn_mbcnt_hi(m_, __builtin_amdgcn_mbcnt_lo(m_, 0u)); }
__device__ __forceinline__ const float* ptf(LAS unsigned char* lds, int i) {
    const unsigned long long v = ((LAS const unsigned long long*)(lds + PT_OFF))[i];
    const unsigned lo = __builtin_amdgcn_readfirstlane((unsigned)v), hi = __builtin_amdgcn_readfirstlane((unsigned)(v >> 32));
    return (const float*)(((unsigned long long)hi << 32) | lo);
}
#define IN(i) ptf(lds, (i))
#define OUTP ((float*)ptf(lds, 27))
#define WSP ((unsigned char*)ptf(lds, 28))

constexpr int CI_OUT = (DM / 64) * (INC / 32), CI_GG = CI_OUT + (DM / 64) * (DM / 32), CI_GU = CI_GG + (DM / 64) * (DFF / 32), CI_D = CI_GU + (DM / 64) * (DFF / 32),
              CI_PG = CI_D + (DFF / 64) * (DM / 32), CI_PP = CI_PG + (DM / 64) * (DM / 32), CI_LAYER = CI_PP + (PLE / 64) * (DM / 32);
__device__ __forceinline__ void convert_item(LAS unsigned char* lds, unsigned char* ws, LAS float* scr, int it, int lane) {
    const int l = it / CI_LAYER; int r = it - l * CI_LAYER;
    const float* W; const float* gain = nullptr; int K = DM, N = DM, mode = 0; size_t woff;
    if (r < CI_OUT) { W = IN(9) + (size_t)l * DM * INC; N = INC; gain = IN(19) + l * DM; woff = W_IN; }
    else if (r < CI_GG) { r -= CI_OUT; W = IN(18) + (size_t)l * DM * DM; woff = W_OUT; }
    else if (r < CI_GU) { r -= CI_GG; W = IN(21) + (size_t)l * DM * DFF; N = DFF; gain = IN(20) + l * DM; woff = W_GU; mode = 1; }
    else if (r < CI_D) { r -= CI_GU; W = IN(22) + (size_t)l * DM * DFF; N = DFF; gain = IN(20) + l * DM; woff = W_GU; mode = 2; }
    else if (r < CI_PG) { r -= CI_D; W = IN(23) + (size_t)l * DFF * DM; K = DFF; woff = W_D; }
    else if (r < CI_PP) { r -= CI_PG; W = IN(25) + (size_t)l * DM * DM; gain = IN(24) + l * DM; woff = W_PG; }
    else { r -= CI_PP; W = IN(26) + (size_t)l * PLE * DM; K = PLE; woff = W_PP; }
    transpose_item(W, K, N, gain, (bf16_t*)(ws + WS_W + (size_t)l * W_LAYER + woff), mode, scr, r, lane);
}
__device__ __forceinline__ void prologue(LAS unsigned char* lds, int wv) {
    { unsigned z_ = 0; asm volatile("" : "+s"(z_)); lds += z_; }
    int wave_ = wv; asm volatile("" : "+s"(wave_)); const int wave = wave_, lane = lane_id_opaque(), tid = wave * 64 + lane;
    const int G = gridDim.x, bid = blockIdx.x, gw = bid * 8 + wave, NGW = G * 8, gtid = bid * 512 + tid, NT = G * 512;
    unsigned char* ws = WSP;
    LAS float* scr = (LAS float*)(lds + wave * 16384);
#pragma unroll 1
    for (int k = gw; k < CI_D + (CI_D - CI_GG); k += NGW) convert_item(lds, ws, scr, (k < CI_D) ? k : (CI_LAYER + CI_GG + (k - CI_D)), lane);
    float* ss = (float*)(ws + WS_SS);
    bf16_t* bufA = (bf16_t*)(ws + WS_BUFA);
    const float* xP = IN(0); const float* xS = IN(1);
#pragma unroll 1
    for (int m0 = gw; m0 < MT; m0 += 2 * NGW) {
        f32x4 v[2][4];
#pragma unroll
        for (int q = 0; q < 2; ++q) { const int m = (m0 + q * NGW < MT) ? m0 + q * NGW : m0; const float* xr = (m < TP) ? xP + (size_t)m * DM : xS + (size_t)(m - TP) * DM;
#pragma unroll
            for (int j = 0; j < 4; ++j) v[q][j] = ((const f32x4*)xr)[lane + 64 * j]; }
#pragma unroll
        for (int q = 0; q < 2; ++q) { const int m = (m0 + q * NGW < MT) ? m0 + q * NGW : m0; float s = 0.f;
#pragma unroll
            for (int j = 0; j < 4; ++j) s += (v[q][j][0] * v[q][j][0] + v[q][j][1] * v[q][j][1]) + (v[q][j][2] * v[q][j][2] + v[q][j][3] * v[q][j][3]);
            s = wave_sum(s); if (lane == 0) ss[m] = s;
#pragma unroll
            for (int j = 0; j < 4; ++j) { u32x2 w; w.x = cvt_pk_bf16(v[q][j][0], v[q][j][1]); w.y = cvt_pk_bf16(v[q][j][2], v[q][j][3]); ((u32x2*)(bufA + (size_t)m * DM))[lane + 64 * j] = w; } }
    }
    float* rc = (float*)(ws + WS_ROPE); float* rs = rc + (size_t)NPOS * 32;
#pragma unroll 1
    for (int idx = gtid; idx < NPOS * 32; idx += NT) {
        const int pos = idx >> 5, d = idx & 31;
        const double inv = exp2(-(double)d * (13.287712379549449 / 32.0));
        double rev = (double)pos * inv * 0.15915494309189535; rev -= rint(rev);
        const float fr = (float)rev;
        rc[idx] = __builtin_amdgcn_cosf(fr); rs[idx] = __builtin_amdgcn_sinf(fr);
    }
    if (gtid < 256) { float* lb = (float*)(ws + WS_LB); const float* al = IN(8); const float a0 = al[gtid], a1 = al[256 + gtid]; lb[gtid] = 0.f; lb[256 + gtid] = 1.0f / (1.0f + expf(a0 - a1)); }
#pragma unroll 1
    for (int idx = gtid; idx < 5 * MT; idx += NT) ss[MT + idx] = 0.f;
}

__device__ __forceinline__ void hgrn_gates(float z, float lb, float& logf_, float& kin) {
    const float e = __expf(-fabsf(z));
    const float inv = __builtin_amdgcn_rcpf(1.0f + e);
    const float big = inv, small = e * inv;
    const float sp = (z >= 0.f) ? big : small;
    const float sn = (z >= 0.f) ? small : big;
    kin = (1.0f - lb) * sn;
    if (lb > 0.f) logf_ = __logf(lb + (1.0f - lb) * sp);
    else logf_ = fminf(z, 0.f) - __logf(1.0f + e);
}

#define HGRN_G(zbase, lbv, tot) \
    float Gl[8], kin[8]; float Gend = 0.f, Gref = 0.f; { float run = 0.f; \
    _Pragma("unroll") for (int i = 0; i < 8; ++i) { float g; hgrn_gates(bf2f((zbase)[(size_t)(8 * wave + i) * INC + ZF]), lbv, g, kin[i]); run += g; Gl[i] = run; } \
    (tot)[wave * 64 + lane] = run; LSYNC(); float off = 0.f; \
    _Pragma("unroll") for (int w2 = 0; w2 < 8; ++w2) { const float t = (tot)[w2 * 64 + lane]; if (w2 < wave) off += t; if (w2 < 4) Gref += t; Gend += t; } \
    _Pragma("unroll") for (int i = 0; i < 8; ++i) Gl[i] += off; }

#define HGRN_G2(zf, lbv, tot) \
    float Gl[8], kin[8]; float Gend = 0.f, Gref = 0.f; { float run = 0.f; \
    _Pragma("unroll") for (int i = 0; i < 8; ++i) { float g; hgrn_gates((zf)[i], lbv, g, kin[i]); run += g; Gl[i] = run; } \
    (tot)[wave * 64 + lane] = run; LSYNC(); float off = 0.f; \
    _Pragma("unroll") for (int w2 = 0; w2 < 8; ++w2) { const float t = (tot)[w2 * 64 + lane]; if (w2 < wave) off += t; if (w2 < 4) Gref += t; Gend += t; } \
    _Pragma("unroll") for (int i = 0; i < 8; ++i) Gl[i] += off; }
__device__ __forceinline__ void hgrn_ds_item(const unsigned (&zfu)[8], const unsigned (&vi)[8], const float* lbp, float* dS, float* dvec, LAS unsigned char* lds, int c, int h, int tid, int lane, int wave) {
    LAS bf16_t* KTt = (LAS bf16_t*)lds;
    LAS bf16_t* Vt = KTt + 64 * 72;
    LAS float* TOT = (LAS float*)(Vt + 64 * 72);
    float zf[8];
#pragma unroll
    for (int i = 0; i < 8; ++i) zf[i] = __uint_as_float(zfu[i] << 16);
    const float lbv = lbp[h * 64 + lane];
    LSYNC();
    HGRN_G2(zf, lbv, TOT)
    { float kt[8];
#pragma unroll
      for (int i = 0; i < 8; ++i) kt[i] = kin[i] * __expf(Gend - Gl[i]);
      u32x4 kw; kw.x = cvt_pk_bf16(kt[0], kt[1]); kw.y = cvt_pk_bf16(kt[2], kt[3]); kw.z = cvt_pk_bf16(kt[4], kt[5]); kw.w = cvt_pk_bf16(kt[6], kt[7]);
      u32x4 vw; vw.x = vi[0] | (vi[1] << 16); vw.y = vi[2] | (vi[3] << 16); vw.z = vi[4] | (vi[5] << 16); vw.w = vi[6] | (vi[7] << 16);
      *(LAS u32x4*)(KTt + lane * 72 + 8 * wave) = kw; *(LAS u32x4*)(Vt + lane * 72 + 8 * wave) = vw; }
    if (wave == 0) dvec[(c * 4 + h) * 64 + lane] = __expf(Gend);
    LSYNC();
    const int fr = lane & 15, g = lane >> 4, kt4 = wave >> 1, vt0 = 2 * (wave & 1);
    f32x4 acc[2] = {(f32x4){0.f, 0.f, 0.f, 0.f}, (f32x4){0.f, 0.f, 0.f, 0.f}};
#pragma unroll
    for (int ks = 0; ks < 2; ++ks) {
        const bf16x8 kb = *(const LAS bf16x8*)(KTt + (16 * kt4 + fr) * 72 + 32 * ks + 8 * g);
#pragma unroll
        for (int n = 0; n < 2; ++n) { const bf16x8 va = *(const LAS bf16x8*)(Vt + (16 * (vt0 + n) + fr) * 72 + 32 * ks + 8 * g);
            acc[n] = __builtin_amdgcn_mfma_f32_16x16x32_bf16(va, kb, acc[n], 0, 0, 0); }
    }
    float* dst = dS + (size_t)(c * 4 + h) * 4096 + (16 * kt4 + fr) * 64 + 4 * g;
#pragma unroll
    for (int n = 0; n < 2; ++n) *(f32x4*)(dst + 16 * (vt0 + n)) = acc[n];
}

__device__ __forceinline__ void hgrn_out_item(const bf16_t* z, const float* lbp, const float* dS, const float* onorm, bf16_t* mix, LAS unsigned char* lds, int c, int hp, int tid, int lane, int wave) {
    const int hh = wave >> 2, wq = wave & 3, h = 2 * hp + hh, fr = lane & 15, g = lane >> 4;
    LAS bf16_t* QT = (LAS bf16_t*)(lds + hh * 46080);
    LAS bf16_t* KT = QT + 4608;
    LAS bf16_t* QS = KT + 4608;
    LAS bf16_t* Vt = QS + 4608;
    LAS bf16_t* St = Vt + 4608;
    LAS float* TOT = (LAS float*)(lds + 92160) + hh * 256;
    const bf16_t* zb = z + (size_t)(64 * c + 16 * wq) * INC + h * 64 + lane;
    unsigned zfu[16], zqu[16], ziu[16];
#pragma unroll
    for (int i = 0; i < 16; ++i) { zfu[i] = zb[(size_t)i * INC + ZF]; zqu[i] = zb[(size_t)i * INC + ZQ]; ziu[i] = zb[(size_t)i * INC + ZI]; }
    f32x4 sv[4];
#pragma unroll
    for (int j4 = 0; j4 < 4; ++j4) sv[j4] = *(const f32x4*)(dS + (size_t)(c * 4 + h) * 4096 + j4 * 1024 + (wq * 64 + lane) * 4);
    const size_t mt = (size_t)(64 * c + 16 * wq + fr);
    u32x2 gz[4];
#pragma unroll
    for (int vt = 0; vt < 4; ++vt) gz[vt] = *(const u32x2*)(z + mt * INC + ZG + h * 64 + 16 * vt + 4 * g);
    const float lbv = lbp[h * 64 + lane];
    LSYNC();
    float Gl[16], kin[16];
    { float run = 0.f;
#pragma unroll
      for (int i = 0; i < 16; ++i) { float gg; hgrn_gates(__uint_as_float(zfu[i] << 16), lbv, gg, kin[i]); run += gg; Gl[i] = run; }
      TOT[wq * 64 + lane] = run; }
    LSYNC();
    float off = 0.f, Gref = 0.f;
#pragma unroll
    for (int w2 = 0; w2 < 4; ++w2) { const float t = TOT[w2 * 64 + lane]; if (w2 < wq) off += t; if (w2 < 2) Gref += t; }
#pragma unroll
    for (int i = 0; i < 16; ++i) { const float G = Gl[i] + off, q = __uint_as_float(zqu[i] << 16); const int s = 16 * wq + i;
        QT[s * 72 + lane] = (bf16_t)(cvt_pk_bf16(q * __expf(fminf(G - Gref, 80.f)), 0.f) & 0xffffu);
        KT[s * 72 + lane] = (bf16_t)(cvt_pk_bf16(kin[i] * __expf(fminf(Gref - G, 80.f)), 0.f) & 0xffffu);
        QS[s * 72 + lane] = (bf16_t)(cvt_pk_bf16(q * __expf(G), 0.f) & 0xffffu); }
    { u32x4 v0, v1; v0.x = ziu[0] | (ziu[1] << 16); v0.y = ziu[2] | (ziu[3] << 16); v0.z = ziu[4] | (ziu[5] << 16); v0.w = ziu[6] | (ziu[7] << 16);
      v1.x = ziu[8] | (ziu[9] << 16); v1.y = ziu[10] | (ziu[11] << 16); v1.z = ziu[12] | (ziu[13] << 16); v1.w = ziu[14] | (ziu[15] << 16);
      *(LAS u32x4*)(Vt + lane * 72 + 16 * wq) = v0; *(LAS u32x4*)(Vt + lane * 72 + 16 * wq + 8) = v1; }
#pragma unroll
    for (int j4 = 0; j4 < 4; ++j4) { const int e = j4 * 1024 + (wq * 64 + lane) * 4, k = e >> 6, v = e & 63;
#pragma unroll
        for (int i = 0; i < 4; ++i) St[(v + i) * 72 + k] = (bf16_t)(cvt_pk_bf16(sv[j4][i], 0.f) & 0xffffu); }
    LSYNC();
    const int tt = wq;
    bf16x8 qb0 = *(const LAS bf16x8*)(QT + (16 * tt + fr) * 72 + 8 * g), qb1 = *(const LAS bf16x8*)(QT + (16 * tt + fr) * 72 + 32 + 8 * g);
    f32x4 at[4];
#pragma unroll
    for (int st = 0; st < 4; ++st) {
        at[st] = (f32x4){0.f, 0.f, 0.f, 0.f};
        if (st <= tt) {
            const bf16x8 k0 = *(const LAS bf16x8*)(KT + (16 * st + fr) * 72 + 8 * g), k1 = *(const LAS bf16x8*)(KT + (16 * st + fr) * 72 + 32 + 8 * g);
            f32x4 acc = (f32x4){0.f, 0.f, 0.f, 0.f};
            acc = __builtin_amdgcn_mfma_f32_16x16x32_bf16(k0, qb0, acc, 0, 0, 0);
            acc = __builtin_amdgcn_mfma_f32_16x16x32_bf16(k1, qb1, acc, 0, 0, 0);
            if (st == tt) {
#pragma unroll
                for (int r = 0; r < 4; ++r) acc[r] = (4 * g + r <= fr) ? acc[r] : 0.f; }
            at[st] = acc;
        }
    }
    f32x4 o[4];
#pragma unroll
    for (int vt = 0; vt < 4; ++vt) o[vt] = (f32x4){0.f, 0.f, 0.f, 0.f};
#pragma unroll
    for (int u = 0; u < 2; ++u) {
        if (2 * u <= tt) {
            u32x4 pw; pw.x = cvt_pk_bf16(at[2 * u][0], at[2 * u][1]); pw.y = cvt_pk_bf16(at[2 * u][2], at[2 * u][3]);
            pw.z = cvt_pk_bf16(at[2 * u + 1][0], at[2 * u + 1][1]); pw.w = cvt_pk_bf16(at[2 * u + 1][2], at[2 * u + 1][3]);
            const bf16x8 pf = __builtin_bit_cast(bf16x8, pw);
#pragma unroll
            for (int vt = 0; vt < 4; ++vt) {
                const LAS bf16_t* vp = Vt + (16 * vt + fr) * 72 + 32 * u + 4 * g;
                u32x4 vw; const u32x2 lo = *(const LAS u32x2*)vp, hi = *(const LAS u32x2*)(vp + 16); vw.x = lo.x; vw.y = lo.y; vw.z = hi.x; vw.w = hi.y;
                o[vt] = __builtin_amdgcn_mfma_f32_16x16x32_bf16(__builtin_bit_cast(bf16x8, vw), pf, o[vt], 0, 0, 0);
            }
        }
    }
#pragma unroll
    for (int ks = 0; ks < 2; ++ks) {
        const bf16x8 qs = *(const LAS bf16x8*)(QS + (16 * tt + fr) * 72 + 32 * ks + 8 * g);
#pragma unroll
        for (int vt = 0; vt < 4; ++vt) { const bf16x8 sa = *(const LAS bf16x8*)(St + (16 * vt + fr) * 72 + 32 * ks + 8 * g);
            o[vt] = __builtin_amdgcn_mfma_f32_16x16x32_bf16(sa, qs, o[vt], 0, 0, 0); }
    }
    float sq = 0.f;
#pragma unroll
    for (int vt = 0; vt < 4; ++vt) sq += (o[vt][0] * o[vt][0] + o[vt][1] * o[vt][1]) + (o[vt][2] * o[vt][2] + o[vt][3] * o[vt][3]);
    sq += __shfl_xor(sq, 16); sq += __shfl_xor(sq, 32);
    const float rn = rsqrtf(sq * (1.0f / 64.0f) + EPS);
#pragma unroll
    for (int vt = 0; vt < 4; ++vt) {
        const f32x4 nv = *(const f32x4*)(onorm + 16 * vt + 4 * g);
        const float g0 = __uint_as_float(gz[vt].x << 16), g1 = __uint_as_float(gz[vt].x & 0xffff0000u), g2 = __uint_as_float(gz[vt].y << 16), g3 = __uint_as_float(gz[vt].y & 0xffff0000u);
        u32x2 w; w.x = cvt_pk_bf16(o[vt][0] * rn * nv[0] * siluf_(g0), o[vt][1] * rn * nv[1] * siluf_(g1)); w.y = cvt_pk_bf16(o[vt][2] * rn * nv[2] * siluf_(g2), o[vt][3] * rn * nv[3] * siluf_(g3));
        *(u32x2*)(mix + mt * DM + h * 64 + 16 * vt + 4 * g) = w;
    }
}

__device__ __forceinline__ void hgrn_sample_item(const bf16_t* z, const float* lbp, const float* S0, float* Sout, const float* onorm, bf16_t* mix, LAS unsigned char* lds, int b, int hp, int tid, int lane, int wave) {
    LAS float* F = (LAS float*)lds; LAS float* KI = F + 512; LAS float* Q = KI + 512; LAS float* V = Q + 512;
    LAS float* RED = V + 512;
    const int hh = wave >> 2, kq = wave & 3, h = 2 * hp + hh;
    float S[16];
    { const float* sp = S0 + (size_t)h * 4096 + (16 * kq) * 64 + lane;
#pragma unroll
      for (int i = 0; i < 16; ++i) S[i] = sp[i * 64]; }
    const int t0 = tid >> 7, hk = tid & 127;
    const bf16_t* zr = z + ((size_t)TP + 4 * b + t0) * INC + hp * 128 + hk;
    const float zf = bf2f(zr[ZF]), q0 = bf2f(zr[ZQ]), vi = bf2f(zr[ZI]); const float lb = lbp[hp * 128 + hk];
    LSYNC();
    { const float e = __expf(-fabsf(zf)); const float sp = (zf >= 0.f) ? 1.0f / (1.0f + e) : e / (1.0f + e); const float sn = (zf >= 0.f) ? e / (1.0f + e) : 1.0f / (1.0f + e);
      F[tid] = lb + (1.0f - lb) * sp; KI[tid] = (1.0f - lb) * sn; Q[tid] = q0; V[tid] = vi; }
    LSYNC();
#pragma unroll
    for (int t = 0; t < 4; ++t) {
        const float vt = V[t * 128 + hh * 64 + lane]; float part = 0.f;
#pragma unroll
        for (int i = 0; i < 16; ++i) { const int k = t * 128 + hh * 64 + 16 * kq + i; S[i] = F[k] * S[i] + KI[k] * vt; part += S[i] * Q[k]; }
        RED[((t * 2 + hh) * 4 + kq) * 64 + lane] = part;
    }
    { float* so = Sout + (size_t)h * 4096 + (16 * kq) * 64 + lane;
#pragma unroll
      for (int i = 0; i < 16; ++i) so[i * 64] = S[i]; }
    LSYNC();
    { const int t = wave >> 1, hh2 = wave & 1, h2 = 2 * hp + hh2; const size_t m = (size_t)TP + 4 * b + t;
      float o = 0.f;
#pragma unroll
      for (int k4 = 0; k4 < 4; ++k4) o += RED[((t * 2 + hh2) * 4 + k4) * 64 + lane];
      const float r = rsqrtf(wave_sum(o * o) * (1.0f / 64.0f) + EPS);
      const float res = o * r * onorm[lane] * siluf_(bf2f(z[m * INC + ZG + h2 * 64 + lane]));
      mix[m * DM + h2 * 64 + lane] = (bf16_t)(cvt_pk_bf16(res, 0.f) & 0xffffu); }
}

template <int NTOK>
__device__ __forceinline__ void conv_compute(const LAS float* U, int r0, size_t m0, const float* cw, const float* cb, const float* lng, const float* lnb, bf16_t* mix, int lane, int wave) {
    const int ch = 64 * (wave & 3) + lane;
    float w[31];
#pragma unroll
    for (int j = 0; j < 31; ++j) w[j] = cw[j * 256 + ch];
    const float bias = cb[ch], g = lng[ch], be = lnb[ch];
    constexpr int TG = (NTOK >= 4) ? 4 : NTOK;
#pragma unroll 1
    for (int tg = 0; tg < NTOK / TG; ++tg) {
        float y[TG];
#pragma unroll
        for (int t = 0; t < TG; ++t) y[t] = bias;
        const LAS float* up = U + (r0 + TG * tg) * 256 + ch;
#pragma unroll
        for (int j = 0; j < TG + 30; ++j) { const float u = up[j * 256];
#pragma unroll
            for (int t = 0; t < TG; ++t) { if (j - t >= 0 && j - t < 31) y[t] += w[j - t] * u; } }
#pragma unroll
        for (int t = 0; t < TG; ++t) {
            const float mu = wave_sum(y[t]) * (1.0f / 64.0f); const float d = y[t] - mu;
            const float var = wave_sum(d * d) * (1.0f / 64.0f);
            const float o = siluf_(d * rsqrtf(var + EPS) * g + be);
            mix[(m0 + TG * tg + t) * DM + 256 + ch] = (bf16_t)(cvt_pk_bf16(o, 0.f) & 0xffffu);
        }
    }
}
__device__ __forceinline__ void conv_prompt_item(const bf16_t* z, const float* cw, const float* cb, const float* lng, const float* lnb, bf16_t* mix, float* spc, LAS unsigned char* lds, int ct, int tid, int lane, int wave) {
    LAS float* U = (LAS float*)lds;
    const int t0 = 64 * ct;
    u32x4 ra[6], rb[6];
#pragma unroll
    for (int it = 0; it < 6; ++it) { const int r = it * 16 + (tid >> 5), cg8 = (tid & 31) * 8; int tok = t0 - 30 + r; tok = tok < 0 ? 0 : tok;
        const bf16_t* zr = z + (size_t)tok * INC; ra[it] = *(const u32x4*)(zr + ZBU + cg8); rb[it] = *(const u32x4*)(zr + ZBG + cg8); }
    LSYNC();
#pragma unroll
    for (int it = 0; it < 6; ++it) { const int r = it * 16 + (tid >> 5), cg8 = (tid & 31) * 8; const bool ok = (t0 - 30 + r) >= 0;
        float fa[8], fb[8], u[8]; UNPACK8(ra[it], fa); UNPACK8(rb[it], fb);
#pragma unroll
        for (int j = 0; j < 8; ++j) u[j] = ok ? fa[j] * sigmoidf_(fb[j]) : 0.f;
        *(LAS f32x4*)(U + r * 256 + cg8) = (f32x4){u[0], u[1], u[2], u[3]}; *(LAS f32x4*)(U + r * 256 + cg8 + 4) = (f32x4){u[4], u[5], u[6], u[7]}; }
    LSYNC();
    conv_compute<32>(U, 32 * (wave >> 2), (size_t)t0 + 32 * (wave >> 2), cw, cb, lng, lnb, mix, lane, wave);
    if (ct == 255) for (int idx = tid; idx < 30 * 256; idx += 512) spc[idx] = U[(64 + (idx >> 8)) * 256 + (idx & 255)];
}
__device__ __forceinline__ void conv_sample_item(const bf16_t* z, const float* sconv, const float* cw, const float* cb, const float* lng, const float* lnb, bf16_t* mix, float* ssc, LAS unsigned char* lds, int b, int tid, int lane, int wave) {
    LAS float* U = (LAS float*)lds;
    float hv[15];
#pragma unroll
    for (int it = 0; it < 15; ++it) hv[it] = sconv[(size_t)b * 30 * 256 + it * 512 + tid];
    float nu[2];
#pragma unroll
    for (int it = 0; it < 2; ++it) { const int idx = it * 512 + tid, t = idx >> 8, ch = idx & 255; const bf16_t* zr = z + ((size_t)TP + 4 * b + t) * INC;
        nu[it] = bf2f(zr[ZBU + ch]) * sigmoidf_(bf2f(zr[ZBG + ch])); }
    LSYNC();
#pragma unroll
    for (int it = 0; it < 15; ++it) U[it * 512 + tid] = hv[it];
#pragma unroll
    for (int it = 0; it < 2; ++it) U[30 * 256 + it * 512 + tid] = nu[it];
    LSYNC();
    conv_compute<2>(U, 2 * (wave >> 2), (size_t)TP + 4 * b + 2 * (wave >> 2), cw, cb, lng, lnb, mix, lane, wave);
#pragma unroll
    for (int it = 0; it < 15; ++it) ssc[(size_t)b * 30 * 256 + it * 512 + tid] = U[4 * 256 + it * 512 + tid];
}

constexpr int KSTR = 72, VSTR = 280;
#define NORM_ROPE(rowp, gain, pos, g, sh1, sh2, x1, x2) do { \
    const u32x4 _lo = *(const u32x4*)((rowp) + 8 * (g)), _hi = *(const u32x4*)((rowp) + 32 + 8 * (g)); float _a[8], _b[8]; UNPACK8(_lo, _a); UNPACK8(_hi, _b); \
    float _sq = 0.f; _Pragma("unroll") for (int _j = 0; _j < 8; ++_j) _sq += _a[_j] * _a[_j] + _b[_j] * _b[_j]; \
    _sq += __shfl_xor(_sq, sh1); _sq += __shfl_xor(_sq, sh2); const float _r = rsqrtf(_sq * (1.0f / 64.0f) + EPS); \
    const float* _cp = rope_c + (size_t)(pos) * 32 + 8 * (g); const float* _sp = rope_s + (size_t)(pos) * 32 + 8 * (g); \
    _Pragma("unroll") for (int _j = 0; _j < 8; ++_j) { const float _y1 = _a[_j] * _r * (gain)[8 * (g) + _j], _y2 = _b[_j] * _r * (gain)[32 + 8 * (g) + _j]; const float _c = _cp[_j], _s = _sp[_j]; \
        (x1)[_j] = _y1 * _c - _y2 * _s; (x2)[_j] = _y2 * _c + _y1 * _s; } } while (0)

__device__ __forceinline__ void attn_qtile(const LAS bf16_t* Kl, const LAS bf16_t* Vt, bf16x8 q0, bf16x8 q1, int i, int T0, int jmin, float sink, bf16_t* outp, int lane) {
    const int fr = lane & 15, g = lane >> 4;
    f32x4 s[9];
#pragma unroll
    for (int T = 0; T < 9; ++T) {
        const LAS bf16_t* kp = Kl + (16 * (T0 + T) + fr) * KSTR + 8 * g;
        const bf16x8 k0 = *(const LAS bf16x8*)kp, k1 = *(const LAS bf16x8*)(kp + 32);
        f32x4 acc = (f32x4){0.f, 0.f, 0.f, 0.f};
        acc = __builtin_amdgcn_mfma_f32_16x16x32_bf16(k0, q0, acc, 0, 0, 0);
        acc = __builtin_amdgcn_mfma_f32_16x16x32_bf16(k1, q1, acc, 0, 0, 0);
        s[T] = acc;
    }
    float mx = sink;
#pragma unroll
    for (int T = 0; T < 9; ++T)
#pragma unroll
        for (int r = 0; r < 4; ++r) { const int j = 16 * (T0 + T) + 4 * g + r; const bool valid = (j >= i) && (j <= i + 128) && (j >= jmin);
            s[T][r] = valid ? s[T][r] : -INFINITY; mx = fmaxf(mx, s[T][r]); }
    mx = fmaxf(mx, __shfl_xor(mx, 16)); mx = fmaxf(mx, __shfl_xor(mx, 32));
    float sum = 0.f;
#pragma unroll
    for (int T = 0; T < 9; ++T)
#pragma unroll
        for (int r = 0; r < 4; ++r) { const float p = __expf(s[T][r] - mx); s[T][r] = p; sum += p; }
    sum += __shfl_xor(sum, 16); sum += __shfl_xor(sum, 32);
    const float inv = 1.0f / (sum + __expf(sink - mx));
    f32x4 o[4];
#pragma unroll
    for (int dt = 0; dt < 4; ++dt) o[dt] = (f32x4){0.f, 0.f, 0.f, 0.f};
#pragma unroll
    for (int u = 0; u < 5; ++u) {
        u32x4 pw; pw.x = cvt_pk_bf16(s[2 * u][0], s[2 * u][1]); pw.y = cvt_pk_bf16(s[2 * u][2], s[2 * u][3]);
        if (u < 4) { pw.z = cvt_pk_bf16(s[2 * u + 1 > 8 ? 8 : 2 * u + 1][0], s[2 * u + 1 > 8 ? 8 : 2 * u + 1][1]); pw.w = cvt_pk_bf16(s[2 * u + 1 > 8 ? 8 : 2 * u + 1][2], s[2 * u + 1 > 8 ? 8 : 2 * u + 1][3]); }
        else { pw.z = 0u; pw.w = 0u; }
        const bf16x8 pf = __builtin_bit_cast(bf16x8, pw);
#pragma unroll
        for (int dt = 0; dt < 4; ++dt) {
            const LAS bf16_t* vp = Vt + (16 * dt + fr) * VSTR + 16 * (T0 + 2 * u) + 4 * g;
            u32x4 vw; const u32x2 lo = *(const LAS u32x2*)vp, hi = *(const LAS u32x2*)(vp + 16); vw.x = lo.x; vw.y = lo.y; vw.z = hi.x; vw.w = hi.y;
            o[dt] = __builtin_amdgcn_mfma_f32_16x16x32_bf16(__builtin_bit_cast(bf16x8, vw), pf, o[dt], 0, 0, 0);
        }
    }
#pragma unroll
    for (int dt = 0; dt < 4; ++dt) { u32x2 w; w.x = cvt_pk_bf16(o[dt][0] * inv, o[dt][1] * inv); w.y = cvt_pk_bf16(o[dt][2] * inv, o[dt][3] * inv); *(u32x2*)(outp + 16 * dt + 4 * g) = w; }
}

#define LOAD_QFRAG(zq, pos, q0, q1) do { float _x1[8], _x2[8]; const int _g = lane >> 4; NORM_ROPE(zq, qn, pos, _g, 16, 32, _x1, _x2); \
    u32x4 _w0, _w1; _w0.x = cvt_pk_bf16(_x1[0] * 0.125f, _x1[1] * 0.125f); _w0.y = cvt_pk_bf16(_x1[2] * 0.125f, _x1[3] * 0.125f); _w0.z = cvt_pk_bf16(_x1[4] * 0.125f, _x1[5] * 0.125f); _w0.w = cvt_pk_bf16(_x1[6] * 0.125f, _x1[7] * 0.125f); \
    _w1.x = cvt_pk_bf16(_x2[0] * 0.125f, _x2[1] * 0.125f); _w1.y = cvt_pk_bf16(_x2[2] * 0.125f, _x2[3] * 0.125f); _w1.z = cvt_pk_bf16(_x2[4] * 0.125f, _x2[5] * 0.125f); _w1.w = cvt_pk_bf16(_x2[6] * 0.125f, _x2[7] * 0.125f); \
    q0 = __builtin_bit_cast(bf16x8, _w0); q1 = __builtin_bit_cast(bf16x8, _w1); } while (0)

__device__ __forceinline__ void attn_prompt_item(const bf16_t* z, const float* qn, const float* kn, const float* sinks, const float* rope_c, const float* rope_s, bf16_t* mix, float* spk, float* spv,
                                                 LAS unsigned char* lds, int qb, int kvh, int tid, int lane, int wave) {
    LAS bf16_t* Kl = (LAS bf16_t*)lds;
    LAS bf16_t* Vt = Kl + 256 * KSTR;
    LSYNC();
    const int kbase = qb * 128 - 128;
#pragma unroll
    for (int it_ = 0; it_ < 2; ++it_) { const int task = tid + 512 * it_;
        const int j = task >> 2, g = task & 3, pos = kbase + j;
        u32x4 w0 = (u32x4){0u, 0u, 0u, 0u}, w1 = w0;
        float x1[8], x2[8];
        const int posc = pos < 0 ? 0 : pos;
        const bf16_t* zr = z + (size_t)posc * INC + ZCK + kvh * 64;
        NORM_ROPE(zr, kn, posc, g, 1, 2, x1, x2);
        if (pos >= 0) { w0.x = cvt_pk_bf16(x1[0], x1[1]); w0.y = cvt_pk_bf16(x1[2], x1[3]); w0.z = cvt_pk_bf16(x1[4], x1[5]); w0.w = cvt_pk_bf16(x1[6], x1[7]);
                        w1.x = cvt_pk_bf16(x2[0], x2[1]); w1.y = cvt_pk_bf16(x2[2], x2[3]); w1.z = cvt_pk_bf16(x2[4], x2[5]); w1.w = cvt_pk_bf16(x2[6], x2[7]); }
        *(LAS u32x4*)(Kl + j * KSTR + 8 * g) = w0; *(LAS u32x4*)(Kl + j * KSTR + 32 + 8 * g) = w1;
        if (qb == 127 && j >= 128) { float* o = spk + (size_t)(j - 128) * 128 + kvh * 64;
            *(f32x4*)(o + 8 * g) = (f32x4){x1[0], x1[1], x1[2], x1[3]}; *(f32x4*)(o + 8 * g + 4) = (f32x4){x1[4], x1[5], x1[6], x1[7]};
            *(f32x4*)(o + 32 + 8 * g) = (f32x4){x2[0], x2[1], x2[2], x2[3]}; *(f32x4*)(o + 32 + 8 * g + 4) = (f32x4){x2[4], x2[5], x2[6], x2[7]}; }
    }
#pragma unroll
    for (int it_ = 0; it_ < 4; ++it_) { const int task = tid + 512 * it_;
        const int j = task >> 3, c8 = (task & 7) * 8, pos = kbase + j;
        u32x4 w = (u32x4){0u, 0u, 0u, 0u};
        if (pos >= 0) w = *(const u32x4*)(z + (size_t)pos * INC + ZCV + kvh * 64 + c8);
        Vt[(c8 + 0) * VSTR + j] = (bf16_t)(w.x & 0xffffu); Vt[(c8 + 1) * VSTR + j] = (bf16_t)(w.x >> 16);
        Vt[(c8 + 2) * VSTR + j] = (bf16_t)(w.y & 0xffffu); Vt[(c8 + 3) * VSTR + j] = (bf16_t)(w.y >> 16);
        Vt[(c8 + 4) * VSTR + j] = (bf16_t)(w.z & 0xffffu); Vt[(c8 + 5) * VSTR + j] = (bf16_t)(w.z >> 16);
        Vt[(c8 + 6) * VSTR + j] = (bf16_t)(w.w & 0xffffu); Vt[(c8 + 7) * VSTR + j] = (bf16_t)(w.w >> 16);
        if (qb == 127 && j >= 128) { float f[8]; UNPACK8(w, f); float* o = spv + (size_t)(j - 128) * 128 + kvh * 64 + c8;
            *(f32x4*)o = (f32x4){f[0], f[1], f[2], f[3]}; *(f32x4*)(o + 4) = (f32x4){f[4], f[5], f[6], f[7]}; }
    }
    for (int idx = tid; idx < 64 * 24; idx += 512) Vt[(idx / 24) * VSTR + 256 + (idx % 24)] = 0;
    LSYNC();
    const int hq = kvh * 4 + (wave >> 1);
    const float sink = sinks[hq];
    const int g4 = lane >> 4;
    float gq1[8], gq2[8];
#pragma unroll
    for (int j = 0; j < 8; ++j) { gq1[j] = qn[8 * g4 + j] * 0.125f; gq2[j] = qn[32 + 8 * g4 + j] * 0.125f; }
    const int pos0 = qb * 128 + (wave & 1) * 64 + (lane & 15);
    const bf16_t* zq0 = z + (size_t)pos0 * INC + ZCQ + hq * 64 + 8 * g4;
    const float* rc0 = rope_c + (size_t)pos0 * 32 + 8 * g4; const float* rs0 = rope_s + (size_t)pos0 * 32 + 8 * g4;
    u32x4 nlo = *(const u32x4*)zq0, nhi = *(const u32x4*)(zq0 + 32);
    f32x4 nc0 = *(const f32x4*)rc0, nc1 = *(const f32x4*)(rc0 + 4), ns0 = *(const f32x4*)rs0, ns1 = *(const f32x4*)(rs0 + 4);
#pragma unroll 1
    for (int a4 = 0; a4 < 4; ++a4) {
        const u32x4 lo = nlo, hi = nhi; const f32x4 c0 = nc0, c1 = nc1, s0 = ns0, s1 = ns1;
        { const int an = a4 < 3 ? a4 + 1 : 3; const bf16_t* zqn = zq0 + (size_t)(16 * an) * INC; const float* rcn = rc0 + (size_t)(16 * an) * 32; const float* rsn = rs0 + (size_t)(16 * an) * 32;
          nlo = *(const u32x4*)zqn; nhi = *(const u32x4*)(zqn + 32); nc0 = *(const f32x4*)rcn; nc1 = *(const f32x4*)(rcn + 4); ns0 = *(const f32x4*)rsn; ns1 = *(const f32x4*)(rsn + 4); }
        float a[8], b[8]; UNPACK8(lo, a); UNPACK8(hi, b);
        float sq = 0.f;
#pragma unroll
        for (int j = 0; j < 8; ++j) sq += a[j] * a[j] + b[j] * b[j];
        sq += __shfl_xor(sq, 16); sq += __shfl_xor(sq, 32);
        const float r = rsqrtf(sq * (1.0f / 64.0f) + EPS);
        float x1[8], x2[8];
#pragma unroll
        for (int j = 0; j < 8; ++j) { const float y1 = a[j] * r * gq1[j], y2 = b[j] * r * gq2[j]; const float c = j < 4 ? c0[j & 3] : c1[j & 3], s = j < 4 ? s0[j & 3] : s1[j & 3];
            x1[j] = y1 * c - y2 * s; x2[j] = y2 * c + y1 * s; }
        u32x4 w0, w1; w0.x = cvt_pk_bf16(x1[0], x1[1]); w0.y = cvt_pk_bf16(x1[2], x1[3]); w0.z = cvt_pk_bf16(x1[4], x1[5]); w0.w = cvt_pk_bf16(x1[6], x1[7]);
        w1.x = cvt_pk_bf16(x2[0], x2[1]); w1.y = cvt_pk_bf16(x2[2], x2[3]); w1.z = cvt_pk_bf16(x2[4], x2[5]); w1.w = cvt_pk_bf16(x2[6], x2[7]);
        const int i0 = (wave & 1) * 64 + 16 * a4, i = i0 + (lane & 15);
        const size_t m = (size_t)qb * 128 + i;
        attn_qtile(Kl, Vt, __builtin_bit_cast(bf16x8, w0), __builtin_bit_cast(bf16x8, w1), i, i0 >> 4, qb == 0 ? 128 : 0, sink, mix + m * DM + 512 + hq * 64, lane);
    }
}

__device__ __forceinline__ void attn_sample_item(const bf16_t* z, const float* ck, const float* cv, const float* qn, const float* kn, const float* sinks, const float* rope_c, const float* rope_s, bf16_t* mix,
                                                 float* ssk, float* ssv, LAS unsigned char* lds, int b, int kvh, int tid, int lane, int wave) {
    LAS bf16_t* Kl = (LAS bf16_t*)lds;
    LAS bf16_t* Vt = Kl + 256 * KSTR;
    LSYNC();
#pragma unroll
    for (int it_ = 0; it_ < 2; ++it_) { const int task = tid + 512 * it_;
        const int j = task >> 3, c8 = (task & 7) * 8;
        const float* kr = ck + (size_t)j * 128 + kvh * 64 + c8; const float* vr = cv + (size_t)j * 128 + kvh * 64 + c8;
        const f32x4 k0 = *(const f32x4*)kr, k1 = *(const f32x4*)(kr + 4), v0 = *(const f32x4*)vr, v1 = *(const f32x4*)(vr + 4);
        u32x4 w; w.x = cvt_pk_bf16(k0[0], k0[1]); w.y = cvt_pk_bf16(k0[2], k0[3]); w.z = cvt_pk_bf16(k1[0], k1[1]); w.w = cvt_pk_bf16(k1[2], k1[3]);
        *(LAS u32x4*)(Kl + j * KSTR + c8) = w;
        const float vf[8] = {v0[0], v0[1], v0[2], v0[3], v1[0], v1[1], v1[2], v1[3]};
#pragma unroll
        for (int e = 0; e < 8; ++e) Vt[(c8 + e) * VSTR + j] = (bf16_t)(cvt_pk_bf16(vf[e], 0.f) & 0xffffu);
        if (j >= 4) { float* ok = ssk + (size_t)(j - 4) * 128 + kvh * 64 + c8; float* ov = ssv + (size_t)(j - 4) * 128 + kvh * 64 + c8;
            *(f32x4*)ok = k0; *(f32x4*)(ok + 4) = k1; *(f32x4*)ov = v0; *(f32x4*)(ov + 4) = v1; }
    }
    if (tid < 16) {
        const int t = tid >> 2, g = tid & 3, j = 128 + t; const size_t m = (size_t)TP + 4 * b + t;
        float x1[8], x2[8];
        NORM_ROPE(z + m * INC + ZCK + kvh * 64, kn, TP + t, g, 1, 2, x1, x2);
        u32x4 w0, w1; w0.x = cvt_pk_bf16(x1[0], x1[1]); w0.y = cvt_pk_bf16(x1[2], x1[3]); w0.z = cvt_pk_bf16(x1[4], x1[5]); w0.w = cvt_pk_bf16(x1[6], x1[7]);
        w1.x = cvt_pk_bf16(x2[0], x2[1]); w1.y = cvt_pk_bf16(x2[2], x2[3]); w1.z = cvt_pk_bf16(x2[4], x2[5]); w1.w = cvt_pk_bf16(x2[6], x2[7]);
        *(LAS u32x4*)(Kl + j * KSTR + 8 * g) = w0; *(LAS u32x4*)(Kl + j * KSTR + 32 + 8 * g) = w1;
        float* o = ssk + (size_t)(j - 4) * 128 + kvh * 64;
        *(f32x4*)(o + 8 * g) = (f32x4){x1[0], x1[1], x1[2], x1[3]}; *(f32x4*)(o + 8 * g + 4) = (f32x4){x1[4], x1[5], x1[6], x1[7]};
        *(f32x4*)(o + 32 + 8 * g) = (f32x4){x2[0], x2[1], x2[2], x2[3]}; *(f32x4*)(o + 32 + 8 * g + 4) = (f32x4){x2[4], x2[5], x2[6], x2[7]};
    }
    if (tid >= 64 && tid < 64 + 32) {
        const int t = (tid - 64) >> 3, c8 = ((tid - 64) & 7) * 8, j = 128 + t; const size_t m = (size_t)TP + 4 * b + t;
        const u32x4 w = *(const u32x4*)(z + m * INC + ZCV + kvh * 64 + c8);
        Vt[(c8 + 0) * VSTR + j] = (bf16_t)(w.x & 0xffffu); Vt[(c8 + 1) * VSTR + j] = (bf16_t)(w.x >> 16);
        Vt[(c8 + 2) * VSTR + j] = (bf16_t)(w.y & 0xffffu); Vt[(c8 + 3) * VSTR + j] = (bf16_t)(w.y >> 16);
        Vt[(c8 + 4) * VSTR + j] = (bf16_t)(w.z & 0xffffu); Vt[(c8 + 5) * VSTR + j] = (bf16_t)(w.z >> 16);
        Vt[(c8 + 6) * VSTR + j] = (bf16_t)(w.w & 0xffffu); Vt[(c8 + 7) * VSTR + j] = (bf16_t)(w.w >> 16);
        float f[8]; UNPACK8(w, f); float* o = ssv + (size_t)(j - 4) * 128 + kvh * 64 + c8;
        *(f32x4*)o = (f32x4){f[0], f[1], f[2], f[3]}; *(f32x4*)(o + 4) = (f32x4){f[4], f[5], f[6], f[7]};
    }
    if (tid >= 128 && tid < 128 + 12 * 8) { const int j = 132 + ((tid - 128) >> 3), c8 = ((tid - 128) & 7) * 8; *(LAS u32x4*)(Kl + j * KSTR + c8) = (u32x4){0u, 0u, 0u, 0u}; }
    for (int idx = tid; idx < 64 * 28; idx += 512) Vt[(idx / 28) * VSTR + 132 + (idx % 28)] = 0;
    LSYNC();
    if (wave == 0) {
        const int q = lane & 15, hg = q >> 2, t = q & 3, hq = kvh * 4 + hg; const size_t m = (size_t)TP + 4 * b + t;
        bf16x8 q0, q1;
        LOAD_QFRAG(z + m * INC + ZCQ + hq * 64, TP + t, q0, q1);
        attn_qtile(Kl, Vt, q0, q1, t, 0, 0, sinks[hq], mix + m * DM + 512 + hq * 64, lane);
    }
}

#define PHASE_HEAD { unsigned z_ = 0; asm volatile("" : "+s"(z_)); lds += z_; } int wave_ = wv; asm volatile("" : "+s"(wave_)); const int wave = wave_, lane = lane_id_opaque(), tid = wave * 64 + lane; const int G = gridDim.x, bid = blockIdx.x; unsigned char* ws = WSP; (void)lane; (void)wave; (void)G; (void)bid; (void)ws;
#define SSP(k) ((float*)(ws + WS_SS) + (size_t)(k) * MT)
#define WL(off) ((const bf16_t*)(ws + WS_W + (size_t)l * W_LAYER + (off)))

struct G1Order {
    pg8::StaticOrder so; unsigned* cnt; int c;
    __device__ __forceinline__ bool next(int i, Unit& u) const {
        if (c >= 64 && c < 82) { if (i == 0) { const int s = c - 64; u.pm = 64 + s / 9; u.pn = s % 9; return true; } return so.next(i - 1, u); }
        return so.next(i, u);
    }
    __device__ __forceinline__ void a_ready(const Unit&) const {}
    __device__ __forceinline__ void done(const Unit& u) const {
        if (u.pm >= 64) {
            asm volatile("s_waitcnt vmcnt(0)" ::: "memory");
            __builtin_amdgcn_fence(__ATOMIC_RELEASE, "agent");
            asm volatile("s_waitcnt vmcnt(0)" ::: "memory");
            if (lane_id_opaque() == 0) __hip_atomic_fetch_add(cnt, 1u, __ATOMIC_RELAXED, __HIP_MEMORY_SCOPE_AGENT);
        }
    }
};
__device__ __forceinline__ void phase_g1(LAS unsigned char* lds, int l, int wv) {
    PHASE_HEAD
    unsigned* cnt = (unsigned*)(ws + WS_CTL) + 8192 + 64 * l;
    { pg8::Gemm g{(const bf16_t*)(ws + WS_BUFA), WL(W_IN), MT, INC, DM}; G1Order S; S.so.init(TP, INC, G, bid); S.cnt = cnt; S.c = bid;
      EpiZ E{(bf16_t*)(ws + WS_ZACT), INC, SSP(3 * l)}; pg8::gemm_phase<EpiZ, G1Order, true, true>(lds, g, S, E, wv); }
    if (bid >= 82) {
        if (tid == 0) { unsigned sp = 0; while (__hip_atomic_load(cnt, __ATOMIC_RELAXED, __HIP_MEMORY_SCOPE_AGENT) < 144u) { __builtin_amdgcn_s_sleep(4); if (++sp > (1u << 22)) break; }
            __builtin_amdgcn_fence(__ATOMIC_ACQUIRE, "agent"); asm volatile("s_waitcnt vmcnt(0)" ::: "memory"); }
        __syncthreads();
        const bf16_t* z = (const bf16_t*)(ws + WS_ZACT); bf16_t* bufB = (bf16_t*)(ws + WS_BUFB);
        const float* lbp = (const float*)(ws + WS_LB) + l * 256;
        const float* rope_c = (const float*)(ws + WS_ROPE); const float* rope_s = rope_c + (size_t)NPOS * 32;
        float* out = OUTP;
#pragma unroll 1
        for (int it = bid - 82; it < 640; it += G - 82) {
            int r = it;
            if (r < 256) { const int b = r >> 1, hp = r & 1; const size_t so = ((size_t)(l * 128 + b) * 4) * 4096;
                hgrn_sample_item(z, lbp, IN(2) + so, out + O_SSH + so, IN(10) + l * 64, bufB, lds, b, hp, tid, lane, wave); continue; } r -= 256;
            if (r < 128) { conv_sample_item(z, IN(3) + (size_t)l * 128 * 7680, IN(11) + l * 31 * 256, IN(12) + l * 256, IN(13) + l * 256, IN(14) + l * 256, bufB, out + O_SSC + (size_t)l * 128 * 7680, lds, r, tid, lane, wave); continue; } r -= 128;
            { const int b = r >> 1, kvh = r & 1; const size_t co = (size_t)(l * 128 + b) * 16384;
              attn_sample_item(z, IN(4) + co, IN(5) + co, IN(15) + l * 64, IN(16) + l * 64, IN(17) + l * 8, rope_c, rope_s, bufB, out + O_SSK + co, out + O_SSV + co, lds, b, kvh, tid, lane, wave); }
        }
        LSYNC();
        { LAS float* scr = (LAS float*)(lds + wave * 16384);
          const int first = (l == 0) ? CI_D : (CI_LAYER + CI_OUT), cnt_ = (l == 0) ? (CI_LAYER - CI_D) : (CI_GG - CI_OUT);
#pragma unroll 1
          for (int k = (bid - 82) * 8 + wave; k < cnt_; k += (G - 82) * 8) convert_item(lds, ws, scr, first + k, lane); }
    }
}
__device__ __forceinline__ void phase_mix_a(LAS unsigned char* lds, int l, int wv) {
    PHASE_HEAD
    const bf16_t* z = (const bf16_t*)(ws + WS_ZACT); bf16_t* bufB = (bf16_t*)(ws + WS_BUFB);
    const float* lbp = (const float*)(ws + WS_LB) + l * 256; float* dvec = (float*)(ws + WS_DVEC); float* dS = (float*)(ws + WS_DS);
    const float* rope_c = (const float*)(ws + WS_ROPE); const float* rope_s = rope_c + (size_t)NPOS * 32;
    float* out = OUTP;
#pragma unroll 1
    for (int it = bid; it < 1024; it += G) {
        unsigned czf[8], cvi[8];
        const bf16_t* zb = z + (size_t)(64 * (it >> 2) + 8 * wave) * INC + (it & 3) * 64 + lane;
#pragma unroll
        for (int i = 0; i < 8; ++i) { czf[i] = zb[(size_t)i * INC + ZF]; cvi[i] = zb[(size_t)i * INC + ZI]; }
        hgrn_ds_item(czf, cvi, lbp, dS, dvec, lds, it >> 2, it & 3, tid, lane, wave);
    }
#pragma unroll 1
    for (int it = bid; it < 512; it += G) {
        int r = it;
        if (r < 256) { attn_prompt_item(z, IN(15) + l * 64, IN(16) + l * 64, IN(17) + l * 8, rope_c, rope_s, bufB, out + O_SPK + (size_t)l * 16384, out + O_SPV + (size_t)l * 16384, lds, r >> 1, r & 1, tid, lane, wave); continue; } r -= 256;
        conv_prompt_item(z, IN(11) + l * 31 * 256, IN(12) + l * 256, IN(13) + l * 256, IN(14) + l * 256, bufB, out + O_SPC + (size_t)l * 7680, lds, r, tid, lane, wave);
    }
}
__device__ __forceinline__ void phase_scan(LAS unsigned char* lds, int l, int wv) {
    PHASE_HEAD
    if (bid < 256) {
        float* dS = (float*)(ws + WS_DS); const float* dvec = (const float*)(ws + WS_DVEC);
        const int e = 64 * bid + lane, h = e >> 12, k = (e >> 6) & 63;
        LAS float* X = (LAS float*)lds;
        float v[32], d[32];
#pragma unroll
        for (int j = 0; j < 32; ++j) { const int c = 32 * wave + j; v[j] = dS[(size_t)c * 16384 + e]; d[j] = dvec[(c * 4 + h) * 64 + k]; }
        float A = 0.f, P = 1.f;
#pragma unroll
        for (int j = 0; j < 32; ++j) { const float t = v[j]; v[j] = A; A = d[j] * A + t; const float pd = d[j]; d[j] = P; P *= pd; }
        LSYNC();
        X[(wave * 2 + 0) * 64 + lane] = P; X[(wave * 2 + 1) * 64 + lane] = A;
        LSYNC();
        float S = 0.f;
#pragma unroll
        for (int w2 = 0; w2 < 8; ++w2) { const float p2 = X[(w2 * 2 + 0) * 64 + lane], a2 = X[(w2 * 2 + 1) * 64 + lane]; if (w2 < wave) S = p2 * S + a2; }
#pragma unroll
        for (int j = 0; j < 32; ++j) dS[(size_t)(32 * wave + j) * 16384 + e] = d[j] * S + v[j];
        if (wave == 7) OUTP[O_SPH + (size_t)l * 16384 + e] = P * S + A;
    }
}
__device__ __forceinline__ void phase_mix_c(LAS unsigned char* lds, int l, int wv) {
    PHASE_HEAD
    const bf16_t* z = (const bf16_t*)(ws + WS_ZACT); bf16_t* bufB = (bf16_t*)(ws + WS_BUFB);
    const float* lbp = (const float*)(ws + WS_LB) + l * 256; const float* dS = (const float*)(ws + WS_DS);
    const float* onorm = IN(10) + l * 64;
#pragma unroll 1
    for (int it = bid; it < 512; it += G) hgrn_out_item(z, lbp, dS, onorm, bufB, lds, it >> 1, it & 1, tid, lane, wave);
}
__device__ __forceinline__ void phase_g2(LAS unsigned char* lds, int l, int wv) {
    PHASE_HEAD
    bf16_t* bufA = (bf16_t*)(ws + WS_BUFA);
    pg8::Gemm g{(const bf16_t*)(ws + WS_BUFB), WL(W_OUT), TP, DM, DM}; pg8::StaticOrder S; S.init(TP, DM, G, bid);
    EpiRes E{bufA, bufA, SSP(3 * l + 1)};
    pg8::gemm_phase<EpiRes, pg8::StaticOrder, true, true>(lds, g, S, E, wv);
    SEpiRes SE{bufA + (size_t)TP * DM, bufA + (size_t)TP * DM, SSP(3 * l + 1) + TP};
    small_gemm(lds, (const bf16_t*)(ws + WS_BUFB) + (size_t)TP * DM, WL(W_OUT), DM, SE, bid, tid, lane, wave);
}
__device__ __forceinline__ void phase_g3(LAS unsigned char* lds, int l, int wv) {
    PHASE_HEAD
    pg8::Gemm g{(const bf16_t*)(ws + WS_BUFA), WL(W_GU), MT, 2 * DFF, DM}; pg8::StaticOrder S; S.init(MT, 2 * DFF, G, bid);
    EpiGU E{(bf16_t*)(ws + WS_ZACT), SSP(3 * l + 1)}; pg8::gemm_phase<EpiGU, pg8::StaticOrder, true, true>(lds, g, S, E, wv);
    if (bid >= 172) {
        bf16_t* pbl = (bf16_t*)(ws + WS_PB) + (size_t)l * MT * PLE;
        const float* pP = IN(6) + (size_t)l * TP * PLE; const float* pS = IN(7) + (size_t)l * NSM * PLE;
        const int gw2 = (bid - 172) * 8 + wave, NGW2 = (G - 172) * 8;
#pragma unroll 1
        for (int m0 = gw2; m0 < MT; m0 += 8 * NGW2) {
            f32x4 v[8];
#pragma unroll
            for (int q = 0; q < 8; ++q) { const int m = (m0 + q * NGW2 < MT) ? m0 + q * NGW2 : m0;
                const float* src = (m < TP) ? pP + (size_t)m * PLE : pS + (size_t)(m - TP) * PLE; v[q] = ((const f32x4*)src)[lane]; }
#pragma unroll
            for (int q = 0; q < 8; ++q) { const int m = (m0 + q * NGW2 < MT) ? m0 + q * NGW2 : m0;
                u32x2 w; w.x = cvt_pk_bf16(v[q][0], v[q][1]); w.y = cvt_pk_bf16(v[q][2], v[q][3]); ((u32x2*)(pbl + (size_t)m * PLE))[lane] = w; }
        }
        { LAS float* scr = (LAS float*)(lds + wave * 16384);
          const int first = (l == 0) ? CI_LAYER : (CI_LAYER + CI_D), cnt_ = (l == 0) ? CI_OUT : (CI_LAYER - CI_D);
#pragma unroll 1
          for (int k = (bid - 172) * 8 + wave; k < cnt_; k += (G - 172) * 8) convert_item(lds, ws, scr, first + k, lane); }
    }
}
__device__ __forceinline__ void phase_g4(LAS unsigned char* lds, int l, int wv) {
    PHASE_HEAD
    const bf16_t* bufA = (const bf16_t*)(ws + WS_BUFA); bf16_t* bufB = (bf16_t*)(ws + WS_BUFB);
    pg8::Gemm g{(const bf16_t*)(ws + WS_ZACT), WL(W_D), TP, DM, DFF}; pg8::StaticOrder S; S.init(TP, DM, G, bid);
    EpiRes E{bufA, bufB, SSP(3 * l + 2)}; pg8::gemm_phase<EpiRes, pg8::StaticOrder, true, true>(lds, g, S, E, wv);
    SEpiRes SE{bufA + (size_t)TP * DM, bufB + (size_t)TP * DM, SSP(3 * l + 2) + TP};
    small_gemm(lds, (const bf16_t*)(ws + WS_ZACT) + (size_t)TP * DFF, WL(W_D), DFF, SE, bid, tid, lane, wave);
}
__device__ __forceinline__ void phase_g5a(LAS unsigned char* lds, int l, int wv) {
    PHASE_HEAD
    pg8::Gemm g{(const bf16_t*)(ws + WS_BUFB), WL(W_PG), TP, DM, DM}; pg8::StaticOrder S; S.init(TP, DM, G, bid);
    EpiGate E{(bf16_t*)(ws + WS_ZACT), SSP(3 * l + 2)}; pg8::gemm_phase<EpiGate, pg8::StaticOrder, true, true>(lds, g, S, E, wv);
    SEpiGate SE{(bf16_t*)(ws + WS_ZACT) + (size_t)TP * DM, SSP(3 * l + 2) + TP};
    small_gemm(lds, (const bf16_t*)(ws + WS_BUFB) + (size_t)TP * DM, WL(W_PG), DM, SE, bid, tid, lane, wave);
}
__device__ __forceinline__ void phase_g5b(LAS unsigned char* lds, int l, int wv) {
    PHASE_HEAD
    const bf16_t* gt = (const bf16_t*)(ws + WS_ZACT); const bf16_t* bufB = (const bf16_t*)(ws + WS_BUFB); bf16_t* bufA = (bf16_t*)(ws + WS_BUFA); float* Y = OUTP + O_Y;
    pg8::Gemm g{(const bf16_t*)(ws + WS_PB) + (size_t)l * MT * PLE, WL(W_PP), TP, DM, PLE}; pg8::StaticOrder S; S.init(TP, DM, G, bid);
    EpiOut E{gt, bufB, Y, bufA, SSP(3), l}; pg8::gemm_phase<EpiOut, pg8::StaticOrder, true, true>(lds, g, S, E, wv);
    SEpiOut SE{gt + (size_t)TP * DM, bufB + (size_t)TP * DM, Y + (size_t)TP * DM, bufA + (size_t)TP * DM, SSP(3) + TP, l};
    small_gemm(lds, (const bf16_t*)(ws + WS_PB) + ((size_t)l * MT + TP) * PLE, WL(W_PP), PLE, SE, bid, tid, lane, wave);
}

__global__ void __launch_bounds__(512, 2) fwd_kernel(Args a) {
    extern __shared__ __attribute__((aligned(16))) unsigned char lds_raw[];
    LAS unsigned char* lds = (LAS unsigned char*)lds_raw;
    volatile LAS unsigned* MISC = (volatile LAS unsigned*)(lds + MISC_OFF);
    if (threadIdx.x < 32) MISC[threadIdx.x] = 0u;
    if (threadIdx.x == 0) {
        LAS unsigned long long* PT = (LAS unsigned long long*)(lds + PT_OFF);
#pragma unroll
        for (int i = 0; i < 27; ++i) PT[i] = (unsigned long long)a.in[i];
        PT[27] = (unsigned long long)a.out; PT[28] = (unsigned long long)a.ws;
    }
    __syncthreads();
    const int wv = __builtin_amdgcn_readfirstlane(threadIdx.x >> 6);
    XcdBarrier bar = xcd_barrier_post((unsigned*)(WSP + WS_CTL), MISC + 8); bar.wv = wv;
    prologue(lds, wv);
    if (gridDim.x == 0x7fffffffu) cg::this_grid().sync();
    xcd_barrier(bar);
#define LAYER(l) do { \
        phase_g1(lds, l, wv); xcd_barrier(bar); \
        phase_mix_a(lds, l, wv); xcd_barrier(bar); \
        phase_scan(lds, l, wv); xcd_barrier(bar); \
        phase_mix_c(lds, l, wv); xcd_barrier(bar); \
        phase_g2(lds, l, wv); xcd_barrier(bar); \
        phase_g3(lds, l, wv); xcd_barrier(bar); \
        phase_g4(lds, l, wv); xcd_barrier(bar); \
        phase_g5a(lds, l, wv); \
        phase_g5b(lds, l, wv); } while (0)
    LAYER(0);
    xcd_barrier(bar);
    LAYER(1);
}

extern "C" void kernel_launch(void* const* d_in, const int* in_sizes, int n_in, void* d_out, int out_size, void* d_ws, size_t ws_size, hipStream_t stream) {
    static int grid = 0;
    if (grid == 0) {
        if (n_in != 27 || ws_size < WS_END) { fprintf(stderr, "kernel_launch: unexpected n_in %d / ws %zu\n", n_in, ws_size); grid = -1; return; }
        int dev = 0, cus = 0, per_cu = 0;
        hipGetDevice(&dev); hipDeviceGetAttribute(&cus, hipDeviceAttributeMultiprocessorCount, dev);
        if (hipFuncSetAttribute((const void*)fwd_kernel, hipFuncAttributeMaxDynamicSharedMemorySize, LDS_BYTES) != hipSuccess) { fprintf(stderr, "kernel_launch: hipFuncSetAttribute failed\n"); grid = -1; return; }
        hipOccupancyMaxActiveBlocksPerMultiprocessor(&per_cu, (const void*)fwd_kernel, 512, LDS_BYTES);
        (void)hipGetLastError();
        if (per_cu < 1) { fprintf(stderr, "kernel_launch: occupancy query says %d blocks per CU\n", per_cu); }
        grid = cus;
    }
    if (grid < 0) return;
    hipMemsetAsync((char*)d_ws + WS_CTL, 0, CTL_BYTES, stream);
    Args a{};
    for (int i = 0; i < 27; ++i) a.in[i] = (const float*)d_in[i];
    a.out = (float*)d_out; a.ws = (unsigned char*)d_ws;
    void* args[] = {&a};
    hipError_t e = hipLaunchCooperativeKernel((const void*)fwd_kernel, dim3(grid), dim3(512), args, LDS_BYTES, stream);
    if (e != hipSuccess) fprintf(stderr, "cooperative launch failed: %s (grid %d)\n", hipGetErrorString(e), grid);
}
```

```cpp
#include <hip/hip_runtime.h>
#include <hip/hip_cooperative_groups.h>
#include <cstdio>
#include <cstdint>
namespace cg = cooperative_groups;
namespace pg8 {
#define PG8_LAS __attribute__((address_space(3)))
typedef unsigned short bf16_t;
typedef short bf16x8 __attribute__((ext_vector_type(8)));
typedef float f32x4 __attribute__((ext_vector_type(4)));
typedef unsigned u32x4 __attribute__((ext_vector_type(4)));
constexpr int BM = 256, BK = 64, HALF = 128, HTB = HALF * BK * 2  , STAGE_BYTES = 8 * HTB, NXCD = 8, WGM = 4;

__host__ __device__ __forceinline__ int lds_byte(int r, int c) { const int st = (r >> 4) * 2 + (c >> 5), rr = r & 15, cc = c & 31, ob = rr * 64 + cc * 2; return st * 1024 + (ob ^ (((ob >> 9) & 1) << 5)); }
__host__ __device__ __forceinline__ void stage_rc(int b, int& R, int& C) { const int st = b / 1024, sb = b % 1024, swz = sb ^ (((sb >> 9) & 1) << 5); R = (st >> 1) * 16 + swz / 64; C = (st & 1) * 32 + (swz % 64) / 2; }
__host__ __device__ __forceinline__ int perm32(int rho) { const int n = rho >> 4, i = rho & 15; return 8 * (i >> 2) + 4 * n + (i & 3); }

struct Unit { int pm, pn; };
struct Gemm { const bf16_t* A; const bf16_t* Bt; int M, N, K; };

struct StaticOrder {
    int nM, nN, nwg, G, c;
    __host__ __device__ void init(int M, int N, int G_, int c_) { nM = M / BM; nN = N / BM; nwg = nM * nN; G = G_; c = c_; }
    __host__ __device__ bool next(int i, Unit& u) const {
        const long L = (long)i * G + c; if (L >= nwg) return false;
        int wgid = (int)L; { const int q = nwg / NXCD, r = nwg % NXCD, xcd = wgid % NXCD, off = wgid / NXCD; wgid = (xcd < r ? xcd * (q + 1) : r * (q + 1) + (xcd - r) * q) + off; }
        const int nig = WGM * nN, gid = wgid / nig, fm = gid * WGM, gsz = (nM - fm) < WGM ? (nM - fm) : WGM;
        u.pm = fm + ((wgid % nig) % gsz); u.pn = (wgid % nig) / gsz; return true;
    }
    __device__ __forceinline__ void a_ready(const Unit&) const {}
    __device__ __forceinline__ void done(const Unit&) const {}
};
__device__ __forceinline__ unsigned cvt_pk_bf16(float lo, float hi) { unsigned r; asm volatile("v_cvt_pk_bf16_f32 %0, %1, %2" : "=v"(r) : "v"(lo), "v"(hi)); return r; }
template <class Epi, class Sched, bool ALIGN_EPI = false, bool SP2 = false>
__device__ __forceinline__ void gemm_phase(PG8_LAS unsigned char* lds, const Gemm g, const Sched& S, const Epi& E, int wv_) {
    unsigned m_ = ~0u; asm volatile("" : "+s"(m_)); asm volatile("" : "+s"(wv_)); int tid_ = wv_ * 64 + (int)__builtin_amdgcn_mbcnt_hi(m_, __builtin_amdgcn_mbcnt_lo(m_, 0u)); { unsigned z_ = 0; asm volatile("" : "+s"(z_)); lds += z_; } const int tid = tid_, wid = __builtin_amdgcn_readfirstlane(tid >> 6), lane = tid & 63, wr = wid >> 2, wc = wid & 3, fr = lane & 15, fq = lane >> 4;
    const int K = g.K, nt = K / BK;
    unsigned voffA[2], voffB[2];
#pragma unroll
    for (int i = 0; i < 2; ++i) { int R, C; stage_rc(tid * 16 + i * 8192, R, C); const int Rb = Epi::PERM ? ((R & ~31) + perm32(R & 31)) : R;
        voffA[i] = (unsigned)(R * K + C) * 2u; voffB[i] = (unsigned)(Rb * K + C) * 2u; }
    const size_t kstep = (size_t)(BK * 2);
    const size_t hstep = (size_t)HALF * K * 2;
    const size_t tstep = 2 * hstep;
    const unsigned ldsw = (unsigned)wid * 1024u;
    const int aoff = lds_byte(wr * 64 + fr, fq * 8), boff = lds_byte(wc * 32 + fr, fq * 8);
#define PG8_SA(b, h) (((b) * 2 + (h)) * HTB)
#define PG8_SB(b, h) ((4 + (b) * 2 + (h)) * HTB)
#define PG8_STAGE(bufoff, gbase, voff) do { _Pragma("unroll") for (int _i = 0; _i < 2; ++_i) \
        __builtin_amdgcn_global_load_lds((const unsigned*)((const char*)(gbase) + (voff)[_i]), (PG8_LAS unsigned*)(lds + (bufoff) + ldsw + _i * 8192), 16, 0, 0); } while (0)
#define PG8_LDA(dst, b, h) do { _Pragma("unroll") for (int m = 0; m < 4; ++m) _Pragma("unroll") for (int k = 0; k < 2; ++k) dst[m][k] = *(const PG8_LAS bf16x8*)(lds + PG8_SA(b, h) + aoff + m * 2048 + k * 1024); } while (0)
#define PG8_LDB(dst, b, h) do { _Pragma("unroll") for (int n = 0; n < 2; ++n) _Pragma("unroll") for (int k = 0; k < 2; ++k) dst[n][k] = *(const PG8_LAS bf16x8*)(lds + PG8_SB(b, h) + boff + n * 2048 + k * 1024); } while (0)
#define PG8_MMA(ai, bj, At, Bt) do { __builtin_amdgcn_s_setprio(1); _Pragma("unroll") for (int m = 0; m < 4; ++m) _Pragma("unroll") for (int n = 0; n < 2; ++n) _Pragma("unroll") for (int k = 0; k < 2; ++k) \
        acc[ai][bj][m][n] = __builtin_amdgcn_mfma_f32_16x16x32_bf16(Bt[n][k], At[m][k], acc[ai][bj][m][n], 0, 0, 0); __builtin_amdgcn_s_setprio(0); } while (0)
#define PG8_WAIT_V(n) asm volatile("s_waitcnt vmcnt(" #n ")" ::: "memory")
#define PG8_WAIT_L(n) asm volatile("s_waitcnt lgkmcnt(" #n ")" ::: "memory")
#define PG8_BAR __builtin_amdgcn_s_barrier()
#define PG8_SCHED __builtin_amdgcn_sched_barrier(0)
    Unit cur, nxt; int ui = 0;
    if (!S.next(0, cur)) return;
    f32x4 acc[2][2][4][2];
#pragma unroll
    for (int a = 0; a < 2; ++a)
#pragma unroll
        for (int b = 0; b < 2; ++b)
#pragma unroll
            for (int m = 0; m < 4; ++m)
#pragma unroll
                for (int n = 0; n < 2; ++n) acc[a][b][m][n] = (f32x4){0.f, 0.f, 0.f, 0.f};
    bf16x8 At[4][2], B0[2][2], B1[2][2];
    const char* cA = (const char*)g.A + (size_t)cur.pm * tstep; const char* cB = (const char*)g.Bt + (size_t)cur.pn * tstep;
    S.a_ready(cur);
    if constexpr (SP2) {
        PG8_STAGE(PG8_SB(0, 0), cB, voffB); PG8_STAGE(PG8_SB(0, 1), cB + hstep, voffB); PG8_STAGE(PG8_SA(0, 0), cA, voffA); PG8_STAGE(PG8_SA(0, 1), cA + hstep, voffA);
        if (wr == 1) PG8_BAR;
        PG8_WAIT_V(2); PG8_BAR;
        PG8_STAGE(PG8_SB(1, 0), cB + kstep, voffB); PG8_STAGE(PG8_SA(1, 0), cA + kstep, voffA); PG8_STAGE(PG8_SB(1, 1), cB + hstep + kstep, voffB);
        PG8_WAIT_V(6); PG8_BAR;
    } else {
        PG8_STAGE(PG8_SB(0, 0), cB, voffB); PG8_STAGE(PG8_SA(0, 0), cA, voffA); PG8_STAGE(PG8_SB(0, 1), cB + hstep, voffB); PG8_STAGE(PG8_SA(0, 1), cA + hstep, voffA);
        if (wr == 1) PG8_BAR;
        PG8_WAIT_V(4); PG8_BAR;
        PG8_STAGE(PG8_SB(1, 0), cB + kstep, voffB); PG8_STAGE(PG8_SA(1, 0), cA + kstep, voffA); PG8_STAGE(PG8_SB(1, 1), cB + hstep + kstep, voffB);
        PG8_WAIT_V(6); PG8_BAR;
    }
    for (;;) {
        const bool has_next = S.next(ui + 1, nxt);
        const char* nA = has_next ? (const char*)g.A + (size_t)nxt.pm * tstep : cA; const char* nB = has_next ? (const char*)g.Bt + (size_t)nxt.pn * tstep : cB;
        for (int t = 0; t < nt; t += 2) {
            const bool last = (t == nt - 2);
            const char* a1 = cA + (size_t)(t + 1) * kstep;
            const char* a2 = last ? nA : cA + (size_t)(t + 2) * kstep; const char* b2 = last ? nB : cB + (size_t)(t + 2) * kstep;
            const char* a3 = a2 + kstep; const char* b3 = b2 + kstep;
            if (last && has_next) S.a_ready(nxt);
            if constexpr (SP2) {
            PG8_LDB(B0, 0, 0); PG8_LDB(B1, 0, 1); PG8_SCHED; PG8_LDA(At, 0, 0); PG8_STAGE(PG8_SA(1, 1), a1 + hstep, voffA);
            PG8_WAIT_V(8); PG8_WAIT_L(0); PG8_BAR; PG8_MMA(0, 0, At, B0); PG8_MMA(0, 1, At, B1); PG8_BAR; PG8_SCHED;
            PG8_LDA(At, 0, 1); PG8_STAGE(PG8_SB(0, 0), b2, voffB); PG8_STAGE(PG8_SB(0, 1), b2 + hstep, voffB); PG8_STAGE(PG8_SA(0, 0), a2, voffA);
            PG8_WAIT_V(8); PG8_WAIT_L(0); PG8_BAR; PG8_MMA(1, 0, At, B0); PG8_MMA(1, 1, At, B1); PG8_BAR; PG8_SCHED;
            PG8_LDB(B0, 1, 0); PG8_LDB(B1, 1, 1); PG8_SCHED; PG8_LDA(At, 1, 0); PG8_STAGE(PG8_SA(0, 1), a2 + hstep, voffA);
            PG8_WAIT_V(8); PG8_WAIT_L(0); PG8_BAR; PG8_MMA(0, 0, At, B0); PG8_MMA(0, 1, At, B1); PG8_BAR; PG8_SCHED;
            PG8_LDA(At, 1, 1); PG8_STAGE(PG8_SB(1, 0), b3, voffB); PG8_STAGE(PG8_SB(1, 1), b3 + hstep, voffB); PG8_STAGE(PG8_SA(1, 0), a3, voffA);
            PG8_WAIT_V(8); PG8_WAIT_L(0); PG8_BAR; PG8_MMA(1, 0, At, B0); PG8_MMA(1, 1, At, B1); PG8_BAR; PG8_SCHED;
            } else {
            PG8_LDB(B0, 0, 0); PG8_SCHED; PG8_LDA(At, 0, 0); PG8_STAGE(PG8_SA(1, 1), a1 + hstep, voffA);
            PG8_WAIT_L(8); PG8_BAR; PG8_WAIT_L(0); PG8_MMA(0, 0, At, B0); PG8_BAR; PG8_SCHED;
            PG8_LDB(B1, 0, 1); PG8_STAGE(PG8_SB(0, 0), b2, voffB);
            PG8_BAR; PG8_WAIT_L(0); PG8_MMA(0, 1, At, B1); PG8_BAR;
            PG8_LDA(At, 0, 1); PG8_STAGE(PG8_SA(0, 0), a2, voffA);
            PG8_BAR; PG8_WAIT_L(0); PG8_MMA(1, 0, At, B0); PG8_BAR; PG8_SCHED;
            PG8_STAGE(PG8_SB(0, 1), b2 + hstep, voffB);
            PG8_WAIT_V(6); PG8_BAR; PG8_MMA(1, 1, At, B1); PG8_BAR;
            PG8_LDB(B0, 1, 0); PG8_SCHED; PG8_LDA(At, 1, 0); PG8_STAGE(PG8_SA(0, 1), a2 + hstep, voffA);
            PG8_WAIT_L(8); PG8_BAR; PG8_WAIT_L(0); PG8_MMA(0, 0, At, B0); PG8_BAR; PG8_SCHED;
            PG8_LDB(B1, 1, 1); PG8_STAGE(PG8_SB(1, 0), b3, voffB);
            PG8_BAR; PG8_WAIT_L(0); PG8_MMA(0, 1, At, B1); PG8_BAR;
            PG8_LDA(At, 1, 1); PG8_STAGE(PG8_SA(1, 0), a3, voffA);
            PG8_BAR; PG8_WAIT_L(0); PG8_MMA(1, 0, At, B0); PG8_BAR; PG8_SCHED;
            PG8_STAGE(PG8_SB(1, 1), b3 + hstep, voffB);
            PG8_WAIT_V(6); PG8_BAR; PG8_MMA(1, 1, At, B1); PG8_BAR;
            }
        }
        if constexpr (ALIGN_EPI) { if (wr == 0) PG8_BAR; }
        if constexpr (!Epi::AFTER_DRAIN) { E(acc, cur, wr, wc, fr, fq); S.done(cur); }
        if (!has_next) break;
#pragma unroll
        for (int a = 0; a < 2; ++a)
#pragma unroll
            for (int b = 0; b < 2; ++b)
#pragma unroll
                for (int m = 0; m < 4; ++m)
#pragma unroll
                    for (int n = 0; n < 2; ++n) acc[a][b][m][n] = (f32x4){0.f, 0.f, 0.f, 0.f};
        cur = nxt; cA = nA; cB = nB; ++ui;
        if constexpr (ALIGN_EPI) { if (wr == 1) PG8_BAR; }
    }
    PG8_WAIT_V(0);
    if constexpr (!ALIGN_EPI) { if (wr == 0) PG8_BAR; }
    PG8_BAR;
    if constexpr (Epi::AFTER_DRAIN) { E.fused(acc, cur, wr, wc, fr, fq, lds, wid, lane); S.done(cur); }
#undef PG8_SA
#undef PG8_SB
#undef PG8_STAGE
#undef PG8_LDA
#undef PG8_LDB
#undef PG8_MMA
#undef PG8_WAIT_V
#undef PG8_WAIT_L
#undef PG8_BAR
#undef PG8_SCHED
}
}

#define LAS __attribute__((address_space(3)))
using pg8::bf16_t; using pg8::bf16x8; using pg8::f32x4; using pg8::u32x4; using pg8::Unit; using pg8::cvt_pk_bf16;
typedef unsigned u32x2 __attribute__((ext_vector_type(2)));

constexpr int DM = 1024, TP = 16384, NSM = 512, MT = TP + NSM, INC = 2304, DFF = 2816, PLE = 256;
constexpr int ZQ = 0, ZF = 256, ZI = 512, ZG = 768, ZBU = 1024, ZBG = 1280, ZCQ = 1536, ZCK = 2048, ZCV = 2176;
constexpr float EPS = 1e-6f;
constexpr int NPOS = TP + 4;
constexpr size_t O_Y = 0, O_SPH = (size_t)MT * DM, O_SPC = O_SPH + 32768, O_SPK = O_SPC + 15360, O_SPV = O_SPK + 32768,
                 O_SSH = O_SPV + 32768, O_SSC = O_SSH + 4194304, O_SSK = O_SSC + 1966080, O_SSV = O_SSK + 4194304;
constexpr size_t MiB = 1u << 20;
constexpr size_t WS_CTL = 0, CTL_BYTES = 65536;
constexpr size_t WS_SS = 1 * MiB;
constexpr size_t WS_LB = WS_SS + 512 * 1024;
constexpr size_t WS_DVEC = WS_LB + 4096;
constexpr size_t WS_ROPE = 2 * MiB;
constexpr size_t WS_W = 7 * MiB;
constexpr size_t W_IN = 0, W_OUT = W_IN + (size_t)INC * DM * 2, W_GU = W_OUT + (size_t)DM * DM * 2, W_D = W_GU + (size_t)2 * DFF * DM * 2,
                 W_PG = W_D + (size_t)DM * DFF * 2, W_PP = W_PG + (size_t)DM * DM * 2, W_LAYER = W_PP + (size_t)DM * PLE * 2;
constexpr size_t WS_BUFA = 59 * MiB, WS_BUFB = 92 * MiB, WS_ZACT = 125 * MiB, WS_PB = 216 * MiB, WS_DS = 233 * MiB, WS_END = 249 * MiB;
static_assert(WS_W + 2 * W_LAYER <= WS_BUFA && WS_BUFA + (size_t)MT * DM * 2 <= WS_BUFB && WS_BUFB + (size_t)MT * DM * 2 <= WS_ZACT, "ws map");
static_assert(WS_ZACT + (size_t)MT * DFF * 2 <= WS_PB && WS_PB + (size_t)2 * MT * PLE * 2 <= WS_DS && WS_ROPE + (size_t)NPOS * 64 * 4 <= WS_W, "ws map");
constexpr int LDS_BYTES = 147456, MISC_OFF = 131072 + 320;

#define LSYNC() do { asm volatile("s_waitcnt lgkmcnt(0)" ::: "memory"); __builtin_amdgcn_s_barrier(); asm volatile("" ::: "memory"); } while (0)
#define LDS_WAIT() asm volatile("s_waitcnt lgkmcnt(0)" ::: "memory")
__device__ __forceinline__ float bf2f(unsigned short h) { return __uint_as_float(((unsigned)h) << 16); }
template <int CTRL> __device__ __forceinline__ float dppf(float v) { return __int_as_float(__builtin_amdgcn_update_dpp(0, __float_as_int(v), CTRL, 0xf, 0xf, true)); }
__device__ __forceinline__ float wave_sum(float v) {
    v += dppf<0xB1>(v);
    v += dppf<0x4E>(v);
    v += dppf<0x141>(v);
    v += dppf<0x140>(v);
    const float r0 = __int_as_float(__builtin_amdgcn_readlane(__float_as_int(v), 0)), r1 = __int_as_float(__builtin_amdgcn_readlane(__float_as_int(v), 16));
    const float r2 = __int_as_float(__builtin_amdgcn_readlane(__float_as_int(v), 32)), r3 = __int_as_float(__builtin_amdgcn_readlane(__float_as_int(v), 48));
    return (r0 + r1) + (r2 + r3);
}
__device__ __forceinline__ float quad_sum(float v) { v += dppf<0xB1>(v); v += dppf<0x4E>(v); return v; }
__device__ __forceinline__ float sigmoidf_(float x) { return __builtin_amdgcn_rcpf(1.0f + __expf(-x)); }
__device__ __forceinline__ float siluf_(float x) { return x * __builtin_amdgcn_rcpf(1.0f + __expf(-x)); }
#define UNPACK8(V_, o) do { (o)[0] = __uint_as_float((V_).x << 16); (o)[1] = __uint_as_float((V_).x & 0xffff0000u); (o)[2] = __uint_as_float((V_).y << 16); (o)[3] = __uint_as_float((V_).y & 0xffff0000u); \
    (o)[4] = __uint_as_float((V_).z << 16); (o)[5] = __uint_as_float((V_).z & 0xffff0000u); (o)[6] = __uint_as_float((V_).w << 16); (o)[7] = __uint_as_float((V_).w & 0xffff0000u); } while (0)

#define XB_TMO      128
#define XB_XCNT(j)  (256  + 64 * (j))
#define XB_XSUB(j)  (1280 + 64 * (j))
#define XB_XGEN(j)  (2304 + 64 * (j))
#define XB_TOP      3328
#define XB_TOPGEN   3392
#define XCD_BAR_WORDS 3456
#define XB_SPIN_CAP (1u << 18)

__device__ __forceinline__ unsigned xb_ld(unsigned* p)              { return __hip_atomic_load(p, __ATOMIC_RELAXED, __HIP_MEMORY_SCOPE_AGENT); }
__device__ __forceinline__ unsigned xb_add(unsigned* p, unsigned v) { return __hip_atomic_fetch_add(p, v, __ATOMIC_RELAXED, __HIP_MEMORY_SCOPE_AGENT); }
__device__ __forceinline__ unsigned xb_xcc_id() { return (unsigned)__builtin_amdgcn_s_getreg((3 << 11) | 20) & 0xFu; }
#define XB_SPIN(cond, bar) do { unsigned _sp = 0; while (cond) { __builtin_amdgcn_s_sleep(1); \
    if ((++_sp & 255u) == 0u) { if (xb_ld(&(bar)[XB_TMO])) break; if (_sp > XB_SPIN_CAP) { atomicAdd(&(bar)[XB_TMO], 1u); break; } } } } while (0)

struct XcdBarrier {
    unsigned* bar; unsigned x; int wv;
    volatile LAS unsigned* st;
};

__device__ __forceinline__ XcdBarrier xcd_barrier_post(unsigned* bar, volatile LAS unsigned* st) {
    XcdBarrier b; b.bar = bar; b.x = xb_xcc_id(); b.st = st;
    if (threadIdx.x == 0) (void)xb_add(&bar[XB_XCNT(b.x)], 1u);
    return b;
}
__device__ __forceinline__ void xcd_barrier_complete(unsigned* bar, unsigned x, unsigned& nloc, unsigned& nx) {
    const unsigned G = gridDim.x * gridDim.y * gridDim.z;
    unsigned sum, cnt, mine, sp = 0u;
    for (;;) {
        sum = 0u; cnt = 0u; mine = 0u;
#pragma unroll
        for (unsigned j = 0; j < 16; ++j) { const unsigned c = xb_ld(&bar[XB_XCNT(j)]); sum += c; cnt += (c > 0u) ? 1u : 0u; mine = (j == x) ? c : mine; }
        if (sum == G) break;
        __builtin_amdgcn_s_sleep(1);
        if ((++sp & 255u) == 0u) { if (xb_ld(&bar[XB_TMO])) break; if (sp > XB_SPIN_CAP) { atomicAdd(&bar[XB_TMO], 1u); break; } }
    }
    nloc = mine > 0u ? mine : 1u; nx = cnt > 0u ? cnt : 1u;
}

__device__ __forceinline__ void xcd_barrier(const XcdBarrier& b) {
    asm volatile("s_waitcnt vmcnt(0)" ::: "memory");
    __syncthreads();
    unsigned xm_ = ~0u; asm volatile("" : "+s"(xm_));
    int xw_ = b.wv; asm volatile("" : "+s"(xw_));
    if (xw_ == 0 && __builtin_amdgcn_mbcnt_hi(xm_, __builtin_amdgcn_mbcnt_lo(xm_, 0u)) == 0u) {
        unsigned* bar = b.bar;
        __builtin_amdgcn_s_waitcnt(0);
        unsigned nloc = b.st[0], nx = b.st[1];
        if (nloc == 0u) { xcd_barrier_complete(bar, b.x, nloc, nx); b.st[0] = nloc; b.st[1] = nx; }
        const unsigned old = xb_add(&bar[XB_XSUB(b.x)], 1u);
        const unsigned gen = old / nloc;
        if (old + 1u == (gen + 1u) * nloc) {
            __builtin_amdgcn_fence(__ATOMIC_RELEASE, "agent");
            asm volatile("s_waitcnt vmcnt(0)" ::: "memory");
            const unsigned og = xb_add(&bar[XB_TOP], 1u);
            const unsigned tg = og / nx;
            if (og + 1u == (tg + 1u) * nx) xb_add(&bar[XB_TOPGEN], 1u);
            else XB_SPIN(xb_ld(&bar[XB_TOPGEN]) == tg, bar);
            __builtin_amdgcn_fence(__ATOMIC_ACQUIRE, "agent");
            xb_add(&bar[XB_XGEN(b.x)], 1u);
            asm volatile("s_waitcnt vmcnt(0)" ::: "memory");
        } else {
            XB_SPIN(xb_ld(&bar[XB_XGEN(b.x)]) == gen, bar);
            __builtin_amdgcn_fence(__ATOMIC_ACQUIRE, "agent");
            asm volatile("s_waitcnt vmcnt(0)" ::: "memory");
        }
    }
    __syncthreads();
}

struct EpiZ {
    static constexpr bool PERM = true, AFTER_DRAIN = false;
    bf16_t* O; int ldc; const float* ss;
    __device__ __forceinline__ void operator()(const f32x4 (&acc)[2][2][4][2], const Unit& u, int wr, int wc, int fr, int fq) const {
        const int row0 = u.pm * 256 + wr * 64 + fr, col0 = u.pn * 256 + wc * 32 + 8 * fq;
#pragma unroll
        for (int ai = 0; ai < 2; ++ai)
#pragma unroll
            for (int m = 0; m < 4; ++m) {
                const int row = row0 + ai * 128 + m * 16; const float r = rsqrtf(ss[row] * (1.0f / DM) + EPS);
                bf16_t* rowp = O + (size_t)row * ldc + col0;
#pragma unroll
                for (int bj = 0; bj < 2; ++bj) { const f32x4 v0 = acc[ai][bj][m][0] * r, v1 = acc[ai][bj][m][1] * r;
                    u32x4 w; w.x = cvt_pk_bf16(v0[0], v0[1]); w.y = cvt_pk_bf16(v0[2], v0[3]); w.z = cvt_pk_bf16(v1[0], v1[1]); w.w = cvt_pk_bf16(v1[2], v1[3]);
                    *(u32x4*)(rowp + bj * 128) = w; }
            }
    }
};
typedef float f32x2 __attribute__((ext_vector_type(2)));
struct EpiGU {
    static constexpr bool PERM = true, AFTER_DRAIN = false;
    bf16_t* O; const float* ss;
    __device__ __forceinline__ void operator()(const f32x4 (&acc)[2][2][4][2], const Unit& u, int wr, int wc, int fr, int fq) const {
        const int row0 = u.pm * 256 + wr * 64 + fr, col0 = u.pn * 128 + wc * 32 + 8 * fq;
#pragma unroll
        for (int ai = 0; ai < 2; ++ai)
#pragma unroll
            for (int m = 0; m < 4; ++m) {
                const int row = row0 + ai * 128 + m * 16; const float r = rsqrtf(ss[row] * (1.0f / DM) + EPS);
                const float rn = r * -1.44269504f, r2 = r * r;
                unsigned w4[4];
#pragma unroll
                for (int n = 0; n < 2; ++n)
#pragma unroll
                    for (int e = 0; e < 4; e += 2) {
                        const f32x2 g2 = (f32x2){acc[ai][0][m][n][e], acc[ai][0][m][n][e + 1]}, u2 = (f32x2){acc[ai][1][m][n][e], acc[ai][1][m][n][e + 1]};
                        const f32x2 t = g2 * rn; f32x2 ex; ex.x = __builtin_amdgcn_exp2f(t.x); ex.y = __builtin_amdgcn_exp2f(t.y);
                        const f32x2 d = ex + 1.0f; f32x2 rc; rc.x = __builtin_amdgcn_rcpf(d.x); rc.y = __builtin_amdgcn_rcpf(d.y);
                        const f32x2 o = (g2 * u2) * (rc * r2);
                        w4[n * 2 + (e >> 1)] = cvt_pk_bf16(o.x, o.y);
                    }
                u32x4 w; w.x = w4[0]; w.y = w4[1]; w.z = w4[2]; w.w = w4[3];
                *(u32x4*)(O + (size_t)row * DFF + col0) = w;
            }
    }
};
struct EpiRes {
    static constexpr bool PERM = false, AFTER_DRAIN = false;
    const bf16_t* res; bf16_t* Ob; float* ss;
    __device__ __forceinline__ void operator()(const f32x4 (&acc)[2][2][4][2], const Unit& u, int wr, int wc, int fr, int fq) const {
        const int row0 = u.pm * 256 + wr * 64 + fr, col0 = u.pn * 256 + wc * 32 + 4 * fq;
#pragma unroll
        for (int ai = 0; ai < 2; ++ai)
#pragma unroll
            for (int m = 0; m < 4; ++m) {
                const int row = row0 + ai * 128 + m * 16; const size_t off = (size_t)row * DM + col0; float sq = 0.f;
#pragma unroll
                for (int bj = 0; bj < 2; ++bj)
#pragma unroll
                    for (int n = 0; n < 2; ++n) { const size_t o2 = off + bj * 128 + n * 16;
                        const u32x2 rw = *(const u32x2*)(res + o2);
                        f32x4 v = acc[ai][bj][m][n]; v[0] += __uint_as_float(rw.x << 16); v[1] += __uint_as_float(rw.x & 0xffff0000u); v[2] += __uint_as_float(rw.y << 16); v[3] += __uint_as_float(rw.y & 0xffff0000u);
                        u32x2 w; w.x = cvt_pk_bf16(v[0], v[1]); w.y = cvt_pk_bf16(v[2], v[3]); *(u32x2*)(Ob + o2) = w;
                        sq += (v[0] * v[0] + v[1] * v[1]) + (v[2] * v[2] + v[3] * v[3]); }
                sq += __shfl_xor(sq, 16); sq += __shfl_xor(sq, 32);
                if (fq == 0) unsafeAtomicAdd(ss + row, sq);
            }
    }
};
struct EpiGate {
    static constexpr bool PERM = false, AFTER_DRAIN = false;
    bf16_t* Gt; const float* ss;
    __device__ __forceinline__ void operator()(const f32x4 (&acc)[2][2][4][2], const Unit& u, int wr, int wc, int fr, int fq) const {
        const int row0 = u.pm * 256 + wr * 64 + fr, col0 = u.pn * 256 + wc * 32 + 4 * fq;
#pragma unroll
        for (int ai = 0; ai < 2; ++ai)
#pragma unroll
            for (int m = 0; m < 4; ++m) {
                const int row = row0 + ai * 128 + m * 16; const size_t off = (size_t)row * DM + col0; const float r = rsqrtf(ss[row] * (1.0f / DM) + EPS);
#pragma unroll
                for (int bj = 0; bj < 2; ++bj)
#pragma unroll
                    for (int n = 0; n < 2; ++n) { const f32x4 a = acc[ai][bj][m][n] * r;
                        u32x2 w; w.x = cvt_pk_bf16(sigmoidf_(a[0]), sigmoidf_(a[1])); w.y = cvt_pk_bf16(sigmoidf_(a[2]), sigmoidf_(a[3]));
                        *(u32x2*)(Gt + off + bj * 128 + n * 16) = w; }
            }
    }
};
struct EpiOut {
    static constexpr bool PERM = false, AFTER_DRAIN = false;
    const bf16_t* Gt; const bf16_t* res; float* Y; bf16_t* Ob; float* ss; int final_;
    __device__ __forceinline__ void operator()(const f32x4 (&acc)[2][2][4][2], const Unit& u, int wr, int wc, int fr, int fq) const {
        const int row0 = u.pm * 256 + wr * 64 + fr, col0 = u.pn * 256 + wc * 32 + 4 * fq;
#pragma unroll
        for (int ai = 0; ai < 2; ++ai)
#pragma unroll
            for (int m = 0; m < 4; ++m) {
                const int row = row0 + ai * 128 + m * 16; const size_t off = (size_t)row * DM + col0; float sq = 0.f;
#pragma unroll
                for (int bj = 0; bj < 2; ++bj)
#pragma unroll
                    for (int n = 0; n < 2; ++n) { const size_t o2 = off + bj * 128 + n * 16;
                        const u32x2 rw = *(const u32x2*)(res + o2), gw = *(const u32x2*)(Gt + o2);
                        const f32x4 a = acc[ai][bj][m][n]; f32x4 v;
                        v[0] = __uint_as_float(rw.x << 16) + __uint_as_float(gw.x << 16) * a[0]; v[1] = __uint_as_float(rw.x & 0xffff0000u) + __uint_as_float(gw.x & 0xffff0000u) * a[1];
                        v[2] = __uint_as_float(rw.y << 16) + __uint_as_float(gw.y << 16) * a[2]; v[3] = __uint_as_float(rw.y & 0xffff0000u) + __uint_as_float(gw.y & 0xffff0000u) * a[3];
                        if (final_) *(f32x4*)(Y + o2) = v;
                        else { u32x2 w; w.x = cvt_pk_bf16(v[0], v[1]); w.y = cvt_pk_bf16(v[2], v[3]); *(u32x2*)(Ob + o2) = w; }
                        sq += (v[0] * v[0] + v[1] * v[1]) + (v[2] * v[2] + v[3] * v[3]); }
                if (!final_) { sq += __shfl_xor(sq, 16); sq += __shfl_xor(sq, 32); if (fq == 0) unsafeAtomicAdd(ss + row, sq); }
            }
    }
};

template <class Epi>
__device__ __forceinline__ void small_gemm(LAS unsigned char* lds, const bf16_t* A, const bf16_t* Bt, int K, const Epi& E, int bid, int tid, int lane, int wave) {
    if (bid >= 256) return;
    const int r0 = 64 * (bid >> 5), c0 = 32 * (bid & 31), fr = lane & 15, g = lane >> 4, kw = K >> 3;
    f32x4 acc[4][2];
#pragma unroll
    for (int m = 0; m < 4; ++m) { acc[m][0] = (f32x4){0.f, 0.f, 0.f, 0.f}; acc[m][1] = (f32x4){0.f, 0.f, 0.f, 0.f}; }
    const bf16_t* ap = A + (size_t)(r0 + fr) * K + wave * kw + 8 * g;
    const bf16_t* bp = Bt + (size_t)(c0 + fr) * K + wave * kw + 8 * g;
#pragma unroll 4
    for (int ks = 0; ks < kw; ks += 32) {
        bf16x8 a[4], b[2];
#pragma unroll
        for (int m = 0; m < 4; ++m) a[m] = *(const bf16x8*)(ap + (size_t)m * 16 * K + ks);
#pragma unroll
        for (int n = 0; n < 2; ++n) b[n] = *(const bf16x8*)(bp + (size_t)n * 16 * K + ks);
#pragma unroll
        for (int m = 0; m < 4; ++m)
#pragma unroll
            for (int n = 0; n < 2; ++n) acc[m][n] = __builtin_amdgcn_mfma_f32_16x16x32_bf16(a[m], b[n], acc[m][n], 0, 0, 0);
    }
    LAS float* P = (LAS float*)lds + wave * (64 * 33);
    LSYNC();
#pragma unroll
    for (int m = 0; m < 4; ++m)
#pragma unroll
        for (int n = 0; n < 2; ++n)
#pragma unroll
            for (int r = 0; r < 4; ++r) P[(16 * m + 4 * g + r) * 33 + 16 * n + fr] = acc[m][n][r];
    LSYNC();
    const int row = tid >> 3, c4 = (tid & 7) * 4;
    f32x4 v = (f32x4){0.f, 0.f, 0.f, 0.f};
#pragma unroll
    for (int w2 = 0; w2 < 8; ++w2) { const LAS float* q = (const LAS float*)lds + w2 * (64 * 33) + row * 33 + c4; v[0] += q[0]; v[1] += q[1]; v[2] += q[2]; v[3] += q[3]; }
    LSYNC();
    E.apply(r0 + row, c0 + c4, v, tid);
}
struct SEpiRes {
    const bf16_t* res; bf16_t* Ob; float* ss;
    __device__ __forceinline__ void apply(int row, int col, f32x4 v, int tid) const {
        const size_t o = (size_t)row * DM + col; const u32x2 rw = *(const u32x2*)(res + o);
        v[0] += __uint_as_float(rw.x << 16); v[1] += __uint_as_float(rw.x & 0xffff0000u); v[2] += __uint_as_float(rw.y << 16); v[3] += __uint_as_float(rw.y & 0xffff0000u);
        u32x2 w; w.x = cvt_pk_bf16(v[0], v[1]); w.y = cvt_pk_bf16(v[2], v[3]); *(u32x2*)(Ob + o) = w;
        float sq = (v[0] * v[0] + v[1] * v[1]) + (v[2] * v[2] + v[3] * v[3]);
        sq += __shfl_xor(sq, 1); sq += __shfl_xor(sq, 2); sq += __shfl_xor(sq, 4);
        if ((tid & 7) == 0) unsafeAtomicAdd(ss + row, sq);
    }
};
struct SEpiGate {
    bf16_t* Gt; const float* ss;
    __device__ __forceinline__ void apply(int row, int col, f32x4 v, int tid) const {
        const float r = rsqrtf(ss[row] * (1.0f / DM) + EPS);
        u32x2 w; w.x = cvt_pk_bf16(sigmoidf_(v[0] * r), sigmoidf_(v[1] * r)); w.y = cvt_pk_bf16(sigmoidf_(v[2] * r), sigmoidf_(v[3] * r));
        *(u32x2*)(Gt + (size_t)row * DM + col) = w;
    }
};
struct SEpiOut {
    const bf16_t* Gt; const bf16_t* res; float* Y; bf16_t* Ob; float* ss; int final_;
    __device__ __forceinline__ void apply(int row, int col, f32x4 a, int tid) const {
        const size_t o = (size_t)row * DM + col; const u32x2 rw = *(const u32x2*)(res + o), gw = *(const u32x2*)(Gt + o); f32x4 v;
        v[0] = __uint_as_float(rw.x << 16) + __uint_as_float(gw.x << 16) * a[0]; v[1] = __uint_as_float(rw.x & 0xffff0000u) + __uint_as_float(gw.x & 0xffff0000u) * a[1];
        v[2] = __uint_as_float(rw.y << 16) + __uint_as_float(gw.y << 16) * a[2]; v[3] = __uint_as_float(rw.y & 0xffff0000u) + __uint_as_float(gw.y & 0xffff0000u) * a[3];
        if (final_) { *(f32x4*)(Y + o) = v; return; }
        u32x2 w; w.x = cvt_pk_bf16(v[0], v[1]); w.y = cvt_pk_bf16(v[2], v[3]); *(u32x2*)(Ob + o) = w;
        float sq = (v[0] * v[0] + v[1] * v[1]) + (v[2] * v[2] + v[3] * v[3]);
        sq += __shfl_xor(sq, 1); sq += __shfl_xor(sq, 2); sq += __shfl_xor(sq, 4);
        if ((tid & 7) == 0) unsafeAtomicAdd(ss + row, sq);
    }
};

__device__ __forceinline__ void transpose_item(const float* W, int K, int N, const float* gain, bf16_t* WT, int mode, LAS float* scr, int item, int lane) {
    const int nblk = N / 32, kb = item / nblk, nb = item % nblk, k0 = 64 * kb, n0 = 32 * nb;
    { const int kr = lane >> 3, nq = (lane & 7) * 4; f32x4 v[8]; float gv[8];
#pragma unroll
      for (int i = 0; i < 8; ++i) { v[i] = *(const f32x4*)(W + (size_t)(k0 + 8 * i + kr) * N + n0 + nq); gv[i] = gain ? gain[k0 + 8 * i + kr] : 1.0f; }
#pragma unroll
      for (int i = 0; i < 8; ++i) { LAS float* d = scr + (8 * i + kr) * 33 + nq; d[0] = v[i][0] * gv[i]; d[1] = v[i][1] * gv[i]; d[2] = v[i][2] * gv[i]; d[3] = v[i][3] * gv[i]; } }
    LDS_WAIT(); asm volatile("" ::: "memory");
    const int drow0 = (mode == 0) ? n0 : (256 * (n0 >> 7) + (n0 & 127) + (mode == 2 ? 128 : 0));
    const int c = lane & 7;
#pragma unroll
    for (int j = 0; j < 4; ++j) { const int n = (lane >> 3) + 8 * j; const LAS float* s = scr + (8 * c) * 33 + n;
        u32x4 o; o.x = cvt_pk_bf16(s[0 * 33], s[1 * 33]); o.y = cvt_pk_bf16(s[2 * 33], s[3 * 33]); o.z = cvt_pk_bf16(s[4 * 33], s[5 * 33]); o.w = cvt_pk_bf16(s[6 * 33], s[7 * 33]);
        *(u32x4*)(WT + (size_t)(drow0 + n) * K + k0 + 8 * c) = o; }
    LDS_WAIT(); asm volatile("" ::: "memory");
}

struct Args { const float* in[27]; float* out; unsigned char* ws; };
constexpr int PT_OFF = 131072 + 1024;
__device__ __forceinline__ int opaque(int x) { asm volatile("" : "+v"(x)); return x; }
__device__ __forceinline__ int lane_id_opaque() { unsigned m_ = ~0u; asm volatile("" : "+s"(m_)); return (int)__builtin_amdgcn_mbcnt_hi(m_, __builtin_amdgcn_mbcnt_lo(m_, 0u)); }
__device__ __forceinline__ const float* ptf(LAS unsigned char* lds, int i) {
    const unsigned long long v = ((LAS const unsigned long long*)(lds + PT_OFF))[i];
    const unsigned lo = __builtin_amdgcn_readfirstlane((unsigned)v), hi = __builtin_amdgcn_readfirstlane((unsigned)(v >> 32));
    return (const float*)(((unsigned long long)hi << 32) | lo);
}
#define IN(i) ptf(lds, (i))
#define OUTP ((float*)ptf(lds, 27))
#define WSP ((unsigned char*)ptf(lds, 28))

constexpr int CI_OUT = (DM / 64) * (INC / 32), CI_GG = CI_OUT + (DM / 64) * (DM / 32), CI_GU = CI_GG + (DM / 64) * (DFF / 32), CI_D = CI_GU + (DM / 64) * (DFF / 32),
              CI_PG = CI_D + (DFF / 64) * (DM / 32), CI_PP = CI_PG + (DM / 64) * (DM / 32), CI_LAYER = CI_PP + (PLE / 64) * (DM / 32);
__device__ __forceinline__ void convert_item(LAS unsigned char* lds, unsigned char* ws, LAS float* scr, int it, int lane) {
    const int l = it / CI_LAYER; int r = it - l * CI_LAYER;
    const float* W; const float* gain = nullptr; int K = DM, N = DM, mode = 0; size_t woff;
    if (r < CI_OUT) { W = IN(9) + (size_t)l * DM * INC; N = INC; gain = IN(19) + l * DM; woff = W_IN; }
    else if (r < CI_GG) { r -= CI_OUT; W = IN(18) + (size_t)l * DM * DM; woff = W_OUT; }
    else if (r < CI_GU) { r -= CI_GG; W = IN(21) + (size_t)l * DM * DFF; N = DFF; gain = IN(20) + l * DM; woff = W_GU; mode = 1; }
    else if (r < CI_D) { r -= CI_GU; W = IN(22) + (size_t)l * DM * DFF; N = DFF; gain = IN(20) + l * DM; woff = W_GU; mode = 2; }
    else if (r < CI_PG) { r -= CI_D; W = IN(23) + (size_t)l * DFF * DM; K = DFF; woff = W_D; }
    else if (r < CI_PP) { r -= CI_PG; W = IN(25) + (size_t)l * DM * DM; gain = IN(24) + l * DM; woff = W_PG; }
    else { r -= CI_PP; W = IN(26) + (size_t)l * PLE * DM; K = PLE; woff = W_PP; }
    transpose_item(W, K, N, gain, (bf16_t*)(ws + WS_W + (size_t)l * W_LAYER + woff), mode, scr, r, lane);
}
__device__ __forceinline__ void prologue(LAS unsigned char* lds, int wv) {
    { unsigned z_ = 0; asm volatile("" : "+s"(z_)); lds += z_; }
    int wave_ = wv; asm volatile("" : "+s"(wave_)); const int wave = wave_, lane = lane_id_opaque(), tid = wave * 64 + lane;
    const int G = gridDim.x, bid = blockIdx.x, gw = bid * 8 + wave, NGW = G * 8, gtid = bid * 512 + tid, NT = G * 512;
    unsigned char* ws = WSP;
    LAS float* scr = (LAS float*)(lds + wave * 16384);
#pragma unroll 1
    for (int k = gw; k < CI_D + (CI_D - CI_GG); k += NGW) convert_item(lds, ws, scr, (k < CI_D) ? k : (CI_LAYER + CI_GG + (k - CI_D)), lane);
    float* ss = (float*)(ws + WS_SS);
    bf16_t* bufA = (bf16_t*)(ws + WS_BUFA);
    const float* xP = IN(0); const float* xS = IN(1);
#pragma unroll 1
    for (int m0 = gw; m0 < MT; m0 += 2 * NGW) {
        f32x4 v[2][4];
#pragma unroll
        for (int q = 0; q < 2; ++q) { const int m = (m0 + q * NGW < MT) ? m0 + q * NGW : m0; const float* xr = (m < TP) ? xP + (size_t)m * DM : xS + (size_t)(m - TP) * DM;
#pragma unroll
            for (int j = 0; j < 4; ++j) v[q][j] = ((const f32x4*)xr)[lane + 64 * j]; }
#pragma unroll
        for (int q = 0; q < 2; ++q) { const int m = (m0 + q * NGW < MT) ? m0 + q * NGW : m0; float s = 0.f;
#pragma unroll
            for (int j = 0; j < 4; ++j) s += (v[q][j][0] * v[q][j][0] + v[q][j][1] * v[q][j][1]) + (v[q][j][2] * v[q][j][2] + v[q][j][3] * v[q][j][3]);
            s = wave_sum(s); if (lane == 0) ss[m] = s;
#pragma unroll
            for (int j = 0; j < 4; ++j) { u32x2 w; w.x = cvt_pk_bf16(v[q][j][0], v[q][j][1]); w.y = cvt_pk_bf16(v[q][j][2], v[q][j][3]); ((u32x2*)(bufA + (size_t)m * DM))[lane + 64 * j] = w; } }
    }
    float* rc = (float*)(ws + WS_ROPE); float* rs = rc + (size_t)NPOS * 32;
#pragma unroll 1
    for (int idx = gtid; idx < NPOS * 32; idx += NT) {
        const int pos = idx >> 5, d = idx & 31;
        const double inv = exp2(-(double)d * (13.287712379549449 / 32.0));
        double rev = (double)pos * inv * 0.15915494309189535; rev -= rint(rev);
        const float fr = (float)rev;
        rc[idx] = __builtin_amdgcn_cosf(fr); rs[idx] = __builtin_amdgcn_sinf(fr);
    }
    if (gtid < 256) { float* lb = (float*)(ws + WS_LB); const float* al = IN(8); const float a0 = al[gtid], a1 = al[256 + gtid]; lb[gtid] = 0.f; lb[256 + gtid] = 1.0f / (1.0f + expf(a0 - a1)); }
#pragma unroll 1
    for (int idx = gtid; idx < 5 * MT; idx += NT) ss[MT + idx] = 0.f;
}

__device__ __forceinline__ void hgrn_gates(float z, float lb, float& logf_, float& kin) {
    const float e = __expf(-fabsf(z));
    const float inv = __builtin_amdgcn_rcpf(1.0f + e);
    const float big = inv, small = e * inv;
    const float sp = (z >= 0.f) ? big : small;
    const float sn = (z >= 0.f) ? small : big;
    kin = (1.0f - lb) * sn;
    if (lb > 0.f) logf_ = __logf(lb + (1.0f - lb) * sp);
    else logf_ = fminf(z, 0.f) - __logf(1.0f + e);
}

#define HGRN_G(zbase, lbv, tot) \
    float Gl[8], kin[8]; float Gend = 0.f, Gref = 0.f; { float run = 0.f; \
    _Pragma("unroll") for (int i = 0; i < 8; ++i) { float g; hgrn_gates(bf2f((zbase)[(size_t)(8 * wave + i) * INC + ZF]), lbv, g, kin[i]); run += g; Gl[i] = run; } \
    (tot)[wave * 64 + lane] = run; LSYNC(); float off = 0.f; \
    _Pragma("unroll") for (int w2 = 0; w2 < 8; ++w2) { const float t = (tot)[w2 * 64 + lane]; if (w2 < wave) off += t; if (w2 < 4) Gref += t; Gend += t; } \
    _Pragma("unroll") for (int i = 0; i < 8; ++i) Gl[i] += off; }

#define HGRN_G2(zf, lbv, tot) \
    float Gl[8], kin[8]; float Gend = 0.f, Gref = 0.f; { float run = 0.f; \
    _Pragma("unroll") for (int i = 0; i < 8; ++i) { float g; hgrn_gates((zf)[i], lbv, g, kin[i]); run += g; Gl[i] = run; } \
    (tot)[wave * 64 + lane] = run; LSYNC(); float off = 0.f; \
    _Pragma("unroll") for (int w2 = 0; w2 < 8; ++w2) { const float t = (tot)[w2 * 64 + lane]; if (w2 < wave) off += t; if (w2 < 4) Gref += t; Gend += t; } \
    _Pragma("unroll") for (int i = 0; i < 8; ++i) Gl[i] += off; }
__device__ __forceinline__ void hgrn_ds_item(const unsigned (&zfu)[8], const unsigned (&vi)[8], const float* lbp, float* dS, float* dvec, LAS unsigned char* lds, int c, int h, int tid, int lane, int wave) {
    LAS bf16_t* KTt = (LAS bf16_t*)lds;
    LAS bf16_t* Vt = KTt + 64 * 72;
    LAS float* TOT = (LAS float*)(Vt + 64 * 72);
    float zf[8];
#pragma unroll
    for (int i = 0; i < 8; ++i) zf[i] = __uint_as_float(zfu[i] << 16);
    const float lbv = lbp[h * 64 + lane];
    LSYNC();
    HGRN_G2(zf, lbv, TOT)
    { float kt[8];
#pragma unroll
      for (int i = 0; i < 8; ++i) kt[i] = kin[i] * __expf(Gend - Gl[i]);
      u32x4 kw; kw.x = cvt_pk_bf16(kt[0], kt[1]); kw.y = cvt_pk_bf16(kt[2], kt[3]); kw.z = cvt_pk_bf16(kt[4], kt[5]); kw.w = cvt_pk_bf16(kt[6], kt[7]);
      u32x4 vw; vw.x = vi[0] | (vi[1] << 16); vw.y = vi[2] | (vi[3] << 16); vw.z = vi[4] | (vi[5] << 16); vw.w = vi[6] | (vi[7] << 16);
      *(LAS u32x4*)(KTt + lane * 72 + 8 * wave) = kw; *(LAS u32x4*)(Vt + lane * 72 + 8 * wave) = vw; }
    if (wave == 0) dvec[(c * 4 + h) * 64 + lane] = __expf(Gend);
    LSYNC();
    const int fr = lane & 15, g = lane >> 4, kt4 = wave >> 1, vt0 = 2 * (wave & 1);
    f32x4 acc[2] = {(f32x4){0.f, 0.f, 0.f, 0.f}, (f32x4){0.f, 0.f, 0.f, 0.f}};
#pragma unroll
    for (int ks = 0; ks < 2; ++ks) {
        const bf16x8 kb = *(const LAS bf16x8*)(KTt + (16 * kt4 + fr) * 72 + 32 * ks + 8 * g);
#pragma unroll
        for (int n = 0; n < 2; ++n) { const bf16x8 va = *(const LAS bf16x8*)(Vt + (16 * (vt0 + n) + fr) * 72 + 32 * ks + 8 * g);
            acc[n] = __builtin_amdgcn_mfma_f32_16x16x32_bf16(va, kb, acc[n], 0, 0, 0); }
    }
    float* dst = dS + (size_t)(c * 4 + h) * 4096 + (16 * kt4 + fr) * 64 + 4 * g;
#pragma unroll
    for (int n = 0; n < 2; ++n) *(f32x4*)(dst + 16 * (vt0 + n)) = acc[n];
}

__device__ __forceinline__ void hgrn_out_item(const bf16_t* z, const float* lbp, const float* dS, const float* onorm, bf16_t* mix, LAS unsigned char* lds, int c, int hp, int tid, int lane, int wave) {
    const int hh = wave >> 2, wq = wave & 3, h = 2 * hp + hh, fr = lane & 15, g = lane >> 4;
    LAS bf16_t* QT = (LAS bf16_t*)(lds + hh * 46080);
    LAS bf16_t* KT = QT + 4608;
    LAS bf16_t* QS = KT + 4608;
    LAS bf16_t* Vt = QS + 4608;
    LAS bf16_t* St = Vt + 4608;
    LAS float* TOT = (LAS float*)(lds + 92160) + hh * 256;
    const bf16_t* zb = z + (size_t)(64 * c + 16 * wq) * INC + h * 64 + lane;
    unsigned zfu[16], zqu[16], ziu[16];
#pragma unroll
    for (int i = 0; i < 16; ++i) { zfu[i] = zb[(size_t)i * INC + ZF]; zqu[i] = zb[(size_t)i * INC + ZQ]; ziu[i] = zb[(size_t)i * INC + ZI]; }
    f32x4 sv[4];
#pragma unroll
    for (int j4 = 0; j4 < 4; ++j4) sv[j4] = *(const f32x4*)(dS + (size_t)(c * 4 + h) * 4096 + j4 * 1024 + (wq * 64 + lane) * 4);
    const size_t mt = (size_t)(64 * c + 16 * wq + fr);
    u32x2 gz[4];
#pragma unroll
    for (int vt = 0; vt < 4; ++vt) gz[vt] = *(const u32x2*)(z + mt * INC + ZG + h * 64 + 16 * vt + 4 * g);
    const float lbv = lbp[h * 64 + lane];
    LSYNC();
    float Gl[16], kin[16];
    { float run = 0.f;
#pragma unroll
      for (int i = 0; i < 16; ++i) { float gg; hgrn_gates(__uint_as_float(zfu[i] << 16), lbv, gg, kin[i]); run += gg; Gl[i] = run; }
      TOT[wq * 64 + lane] = run; }
    LSYNC();
    float off = 0.f, Gref = 0.f;
#pragma unroll
    for (int w2 = 0; w2 < 4; ++w2) { const float t = TOT[w2 * 64 + lane]; if (w2 < wq) off += t; if (w2 < 2) Gref += t; }
#pragma unroll
    for (int i = 0; i < 16; ++i) { const float G = Gl[i] + off, q = __uint_as_float(zqu[i] << 16); const int s = 16 * wq + i;
        QT[s * 72 + lane] = (bf16_t)(cvt_pk_bf16(q * __expf(fminf(G - Gref, 80.f)), 0.f) & 0xffffu);
        KT[s * 72 + lane] = (bf16_t)(cvt_pk_bf16(kin[i] * __expf(fminf(Gref - G, 80.f)), 0.f) & 0xffffu);
        QS[s * 72 + lane] = (bf16_t)(cvt_pk_bf16(q * __expf(G), 0.f) & 0xffffu); }
    { u32x4 v0, v1; v0.x = ziu[0] | (ziu[1] << 16); v0.y = ziu[2] | (ziu[3] << 16); v0.z = ziu[4] | (ziu[5] << 16); v0.w = ziu[6] | (ziu[7] << 16);
      v1.x = ziu[8] | (ziu[9] << 16); v1.y = ziu[10] | (ziu[11] << 16); v1.z = ziu[12] | (ziu[13] << 16); v1.w = ziu[14] | (ziu[15] << 16);
      *(LAS u32x4*)(Vt + lane * 72 + 16 * wq) = v0; *(LAS u32x4*)(Vt + lane * 72 + 16 * wq + 8) = v1; }
#pragma unroll
    for (int j4 = 0; j4 < 4; ++j4) { const int e = j4 * 1024 + (wq * 64 + lane) * 4, k = e >> 6, v = e & 63;
#pragma unroll
        for (int i = 0; i < 4; ++i) St[(v + i) * 72 + k] = (bf16_t)(cvt_pk_bf16(sv[j4][i], 0.f) & 0xffffu); }
    LSYNC();
    const int tt = wq;
    bf16x8 qb0 = *(const LAS bf16x8*)(QT + (16 * tt + fr) * 72 + 8 * g), qb1 = *(const LAS bf16x8*)(QT + (16 * tt + fr) * 72 + 32 + 8 * g);
    f32x4 at[4];
#pragma unroll
    for (int st = 0; st < 4; ++st) {
        at[st] = (f32x4){0.f, 0.f, 0.f, 0.f};
        if (st <= tt) {
            const bf16x8 k0 = *(const LAS bf16x8*)(KT + (16 * st + fr) * 72 + 8 * g), k1 = *(const LAS bf16x8*)(KT + (16 * st + fr) * 72 + 32 + 8 * g);
            f32x4 acc = (f32x4){0.f, 0.f, 0.f, 0.f};
            acc = __builtin_amdgcn_mfma_f32_16x16x32_bf16(k0, qb0, acc, 0, 0, 0);
            acc = __builtin_amdgcn_mfma_f32_16x16x32_bf16(k1, qb1, acc, 0, 0, 0);
            if (st == tt) {
#pragma unroll
                for (int r = 0; r < 4; ++r) acc[r] = (4 * g + r <= fr) ? acc[r] : 0.f; }
            at[st] = acc;
        }
    }
    f32x4 o[4];
#pragma unroll
    for (int vt = 0; vt < 4; ++vt) o[vt] = (f32x4){0.f, 0.f, 0.f, 0.f};
#pragma unroll
    for (int u = 0; u < 2; ++u) {
        if (2 * u <= tt) {
            u32x4 pw; pw.x = cvt_pk_bf16(at[2 * u][0], at[2 * u][1]); pw.y = cvt_pk_bf16(at[2 * u][2], at[2 * u][3]);
            pw.z = cvt_pk_bf16(at[2 * u + 1][0], at[2 * u + 1][1]); pw.w = cvt_pk_bf16(at[2 * u + 1][2], at[2 * u + 1][3]);
            const bf16x8 pf = __builtin_bit_cast(bf16x8, pw);
#pragma unroll
            for (int vt = 0; vt < 4; ++vt) {
                const LAS bf16_t* vp = Vt + (16 * vt + fr) * 72 + 32 * u + 4 * g;
                u32x4 vw; const u32x2 lo = *(const LAS u32x2*)vp, hi = *(const LAS u32x2*)(vp + 16); vw.x = lo.x; vw.y = lo.y; vw.z = hi.x; vw.w = hi.y;
                o[vt] = __builtin_amdgcn_mfma_f32_16x16x32_bf16(__builtin_bit_cast(bf16x8, vw), pf, o[vt], 0, 0, 0);
            }
        }
    }
#pragma unroll
    for (int ks = 0; ks < 2; ++ks) {
        const bf16x8 qs = *(const LAS bf16x8*)(QS + (16 * tt + fr) * 72 + 32 * ks + 8 * g);
#pragma unroll
        for (int vt = 0; vt < 4; ++vt) { const bf16x8 sa = *(const LAS bf16x8*)(St + (16 * vt + fr) * 72 + 32 * ks + 8 * g);
            o[vt] = __builtin_amdgcn_mfma_f32_16x16x32_bf16(sa, qs, o[vt], 0, 0, 0); }
    }
    float sq = 0.f;
#pragma unroll
    for (int vt = 0; vt < 4; ++vt) sq += (o[vt][0] * o[vt][0] + o[vt][1] * o[vt][1]) + (o[vt][2] * o[vt][2] + o[vt][3] * o[vt][3]);
    sq += __shfl_xor(sq, 16); sq += __shfl_xor(sq, 32);
    const float rn = rsqrtf(sq * (1.0f / 64.0f) + EPS);
#pragma unroll
    for (int vt = 0; vt < 4; ++vt) {
        const f32x4 nv = *(const f32x4*)(onorm + 16 * vt + 4 * g);
        const float g0 = __uint_as_float(gz[vt].x << 16), g1 = __uint_as_float(gz[vt].x & 0xffff0000u), g2 = __uint_as_float(gz[vt].y << 16), g3 = __uint_as_float(gz[vt].y & 0xffff0000u);
        u32x2 w; w.x = cvt_pk_bf16(o[vt][0] * rn * nv[0] * siluf_(g0), o[vt][1] * rn * nv[1] * siluf_(g1)); w.y = cvt_pk_bf16(o[vt][2] * rn * nv[2] * siluf_(g2), o[vt][3] * rn * nv[3] * siluf_(g3));
        *(u32x2*)(mix + mt * DM + h * 64 + 16 * vt + 4 * g) = w;
    }
}

__device__ __forceinline__ void hgrn_sample_item(const bf16_t* z, const float* lbp, const float* S0, float* Sout, const float* onorm, bf16_t* mix, LAS unsigned char* lds, int b, int hp, int tid, int lane, int wave) {
    LAS float* F = (LAS float*)lds; LAS float* KI = F + 512; LAS float* Q = KI + 512; LAS float* V = Q + 512;
    LAS float* RED = V + 512;
    const int hh = wave >> 2, kq = wave & 3, h = 2 * hp + hh;
    float S[16];
    { const float* sp = S0 + (size_t)h * 4096 + (16 * kq) * 64 + lane;
#pragma unroll
      for (int i = 0; i < 16; ++i) S[i] = sp[i * 64]; }
    const int t0 = tid >> 7, hk = tid & 127;
    const bf16_t* zr = z + ((size_t)TP + 4 * b + t0) * INC + hp * 128 + hk;
    const float zf = bf2f(zr[ZF]), q0 = bf2f(zr[ZQ]), vi = bf2f(zr[ZI]); const float lb = lbp[hp * 128 + hk];
    LSYNC();
    { const float e = __expf(-fabsf(zf)); const float sp = (zf >= 0.f) ? 1.0f / (1.0f + e) : e / (1.0f + e); const float sn = (zf >= 0.f) ? e / (1.0f + e) : 1.0f / (1.0f + e);
      F[tid] = lb + (1.0f - lb) * sp; KI[tid] = (1.0f - lb) * sn; Q[tid] = q0; V[tid] = vi; }
    LSYNC();
#pragma unroll
    for (int t = 0; t < 4; ++t) {
        const float vt = V[t * 128 + hh * 64 + lane]; float part = 0.f;
#pragma unroll
        for (int i = 0; i < 16; ++i) { const int k = t * 128 + hh * 64 + 16 * kq + i; S[i] = F[k] * S[i] + KI[k] * vt; part += S[i] * Q[k]; }
        RED[((t * 2 + hh) * 4 + kq) * 64 + lane] = part;
    }
    { float* so = Sout + (size_t)h * 4096 + (16 * kq) * 64 + lane;
#pragma unroll
      for (int i = 0; i < 16; ++i) so[i * 64] = S[i]; }
    LSYNC();
    { const int t = wave >> 1, hh2 = wave & 1, h2 = 2 * hp + hh2; const size_t m = (size_t)TP + 4 * b + t;
      float o = 0.f;
#pragma unroll
      for (int k4 = 0; k4 < 4; ++k4) o += RED[((t * 2 + hh2) * 4 + k4) * 64 + lane];
      const float r = rsqrtf(wave_sum(o * o) * (1.0f / 64.0f) + EPS);
      const float res = o * r * onorm[lane] * siluf_(bf2f(z[m * INC + ZG + h2 * 64 + lane]));
      mix[m * DM + h2 * 64 + lane] = (bf16_t)(cvt_pk_bf16(res, 0.f) & 0xffffu); }
}

template <int NTOK>
__device__ __forceinline__ void conv_compute(const LAS float* U, int r0, size_t m0, const float* cw, const float* cb, const float* lng, const float* lnb, bf16_t* mix, int lane, int wave) {
    const int ch = 64 * (wave & 3) + lane;
    float w[31];
#pragma unroll
    for (int j = 0; j < 31; ++j) w[j] = cw[j * 256 + ch];
    const float bias = cb[ch], g = lng[ch], be = lnb[ch];
    constexpr int TG = (NTOK >= 4) ? 4 : NTOK;
#pragma unroll 1
    for (int tg = 0; tg < NTOK / TG; ++tg) {
        float y[TG];
#pragma unroll
        for (int t = 0; t < TG; ++t) y[t] = bias;
        const LAS float* up = U + (r0 + TG * tg) * 256 + ch;
#pragma unroll
        for (int j = 0; j < TG + 30; ++j) { const float u = up[j * 256];
#pragma unroll
            for (int t = 0; t < TG; ++t) { if (j - t >= 0 && j - t < 31) y[t] += w[j - t] * u; } }
#pragma unroll
        for (int t = 0; t < TG; ++t) {
            const float mu = wave_sum(y[t]) * (1.0f / 64.0f); const float d = y[t] - mu;
            const float var = wave_sum(d * d) * (1.0f / 64.0f);
            const float o = siluf_(d * rsqrtf(var + EPS) * g + be);
            mix[(m0 + TG * tg + t) * DM + 256 + ch] = (bf16_t)(cvt_pk_bf16(o, 0.f) & 0xffffu);
        }
    }
}
__device__ __forceinline__ void conv_prompt_item(const bf16_t* z, const float* cw, const float* cb, const float* lng, const float* lnb, bf16_t* mix, float* spc, LAS unsigned char* lds, int ct, int tid, int lane, int wave) {
    LAS float* U = (LAS float*)lds;
    const int t0 = 64 * ct;
    u32x4 ra[6], rb[6];
#pragma unroll
    for (int it = 0; it < 6; ++it) { const int r = it * 16 + (tid >> 5), cg8 = (tid & 31) * 8; int tok = t0 - 30 + r; tok = tok < 0 ? 0 : tok;
        const bf16_t* zr = z + (size_t)tok * INC; ra[it] = *(const u32x4*)(zr + ZBU + cg8); rb[it] = *(const u32x4*)(zr + ZBG + cg8); }
    LSYNC();
#pragma unroll
    for (int it = 0; it < 6; ++it) { const int r = it * 16 + (tid >> 5), cg8 = (tid & 31) * 8; const bool ok = (t0 - 30 + r) >= 0;
        float fa[8], fb[8], u[8]; UNPACK8(ra[it], fa); UNPACK8(rb[it], fb);
#pragma unroll
        for (int j = 0; j < 8; ++j) u[j] = ok ? fa[j] * sigmoidf_(fb[j]) : 0.f;
        *(LAS f32x4*)(U + r * 256 + cg8) = (f32x4){u[0], u[1], u[2], u[3]}; *(LAS f32x4*)(U + r * 256 + cg8 + 4) = (f32x4){u[4], u[5], u[6], u[7]}; }
    LSYNC();
    conv_compute<32>(U, 32 * (wave >> 2), (size_t)t0 + 32 * (wave >> 2), cw, cb, lng, lnb, mix, lane, wave);
    if (ct == 255) for (int idx = tid; idx < 30 * 256; idx += 512) spc[idx] = U[(64 + (idx >> 8)) * 256 + (idx & 255)];
}
__device__ __forceinline__ void conv_sample_item(const bf16_t* z, const float* sconv, const float* cw, const float* cb, const float* lng, const float* lnb, bf16_t* mix, float* ssc, LAS unsigned char* lds, int b, int tid, int lane, int wave) {
    LAS float* U = (LAS float*)lds;
    float hv[15];
#pragma unroll
    for (int it = 0; it < 15; ++it) hv[it] = sconv[(size_t)b * 30 * 256 + it * 512 + tid];
    float nu[2];
#pragma unroll
    for (int it = 0; it < 2; ++it) { const int idx = it * 512 + tid, t = idx >> 8, ch = idx & 255; const bf16_t* zr = z + ((size_t)TP + 4 * b + t) * INC;
        nu[it] = bf2f(zr[ZBU + ch]) * sigmoidf_(bf2f(zr[ZBG + ch])); }
    LSYNC();
#pragma unroll
    for (int it = 0; it < 15; ++it) U[it * 512 + tid] = hv[it];
#pragma unroll
    for (int it = 0; it < 2; ++it) U[30 * 256 + it * 512 + tid] = nu[it];
    LSYNC();
    conv_compute<2>(U, 2 * (wave >> 2), (size_t)TP + 4 * b + 2 * (wave >> 2), cw, cb, lng, lnb, mix, lane, wave);
#pragma unroll
    for (int it = 0; it < 15; ++it) ssc[(size_t)b * 30 * 256 + it * 512 + tid] = U[4 * 256 + it * 512 + tid];
}

constexpr float QSCALE = 0.125f * 1.44269504089f, LOG2E = 1.44269504089f;
constexpr int KSTR = 72, VSTR = 280;
#define NORM_ROPE(rowp, gain, pos, g, sh1, sh2, x1, x2) do { \
    const u32x4 _lo = *(const u32x4*)((rowp) + 8 * (g)), _hi = *(const u32x4*)((rowp) + 32 + 8 * (g)); float _a[8], _b[8]; UNPACK8(_lo, _a); UNPACK8(_hi, _b); \
    float _sq = 0.f; _Pragma("unroll") for (int _j = 0; _j < 8; ++_j) _sq += _a[_j] * _a[_j] + _b[_j] * _b[_j]; \
    _sq += __shfl_xor(_sq, sh1); _sq += __shfl_xor(_sq, sh2); const float _r = rsqrtf(_sq * (1.0f / 64.0f) + EPS); \
    const float* _cp = rope_c + (size_t)(pos) * 32 + 8 * (g); const float* _sp = rope_s + (size_t)(pos) * 32 + 8 * (g); \
    _Pragma("unroll") for (int _j = 0; _j < 8; ++_j) { const float _y1 = _a[_j] * _r * (gain)[8 * (g) + _j], _y2 = _b[_j] * _r * (gain)[32 + 8 * (g) + _j]; const float _c = _cp[_j], _s = _sp[_j]; \
        (x1)[_j] = _y1 * _c - _y2 * _s; (x2)[_j] = _y2 * _c + _y1 * _s; } } while (0)

__device__ __forceinline__ void attn_qtile(const LAS bf16_t* Kl, const LAS bf16_t* Vt, bf16x8 q0, bf16x8 q1, int i, int T0, int jmin, float sink, bf16_t* outp, int lane) {
    const int fr = lane & 15, g = lane >> 4;
    f32x4 s[9];
#pragma unroll
    for (int T = 0; T < 9; ++T) {
        const LAS bf16_t* kp = Kl + (16 * (T0 + T) + fr) * KSTR + 8 * g;
        const bf16x8 k0 = *(const LAS bf16x8*)kp, k1 = *(const LAS bf16x8*)(kp + 32);
        f32x4 acc = (f32x4){0.f, 0.f, 0.f, 0.f};
        acc = __builtin_amdgcn_mfma_f32_16x16x32_bf16(k0, q0, acc, 0, 0, 0);
        acc = __builtin_amdgcn_mfma_f32_16x16x32_bf16(k1, q1, acc, 0, 0, 0);
        s[T] = acc;
    }
    float mx = sink;
#pragma unroll
    for (int T = 0; T < 9; ++T)
#pragma unroll
        for (int r = 0; r < 4; ++r) { const int j = 16 * (T0 + T) + 4 * g + r;
            const bool valid = (T == 0) ? ((j >= i) && (j >= jmin)) : (T == 8) ? ((j <= i + 128) && (j >= jmin)) : (j >= jmin);
            s[T][r] = valid ? s[T][r] : -INFINITY; mx = fmaxf(mx, s[T][r]); }
    mx = fmaxf(mx, __shfl_xor(mx, 16)); mx = fmaxf(mx, __shfl_xor(mx, 32));
    float sum = 0.f;
#pragma unroll
    for (int T = 0; T < 9; ++T)
#pragma unroll
        for (int r = 0; r < 4; ++r) { const float p = __builtin_amdgcn_exp2f(s[T][r] - mx); s[T][r] = p; sum += p; }
    sum += __shfl_xor(sum, 16); sum += __shfl_xor(sum, 32);
    const float inv = 1.0f / (sum + __builtin_amdgcn_exp2f(sink - mx));
    f32x4 o[4];
#pragma unroll
    for (int dt = 0; dt < 4; ++dt) o[dt] = (f32x4){0.f, 0.f, 0.f, 0.f};
#pragma unroll
    for (int u = 0; u < 5; ++u) {
        u32x4 pw; pw.x = cvt_pk_bf16(s[2 * u][0], s[2 * u][1]); pw.y = cvt_pk_bf16(s[2 * u][2], s[2 * u][3]);
        if (u < 4) { pw.z = cvt_pk_bf16(s[2 * u + 1 > 8 ? 8 : 2 * u + 1][0], s[2 * u + 1 > 8 ? 8 : 2 * u + 1][1]); pw.w = cvt_pk_bf16(s[2 * u + 1 > 8 ? 8 : 2 * u + 1][2], s[2 * u + 1 > 8 ? 8 : 2 * u + 1][3]); }
        else { pw.z = 0u; pw.w = 0u; }
        const bf16x8 pf = __builtin_bit_cast(bf16x8, pw);
#pragma unroll
        for (int dt = 0; dt < 4; ++dt) {
            const LAS bf16_t* vp = Vt + (16 * dt + fr) * VSTR + 16 * (T0 + 2 * u) + 4 * g;
            u32x4 vw; const u32x2 lo = *(const LAS u32x2*)vp, hi = *(const LAS u32x2*)(vp + 16); vw.x = lo.x; vw.y = lo.y; vw.z = hi.x; vw.w = hi.y;
            o[dt] = __builtin_amdgcn_mfma_f32_16x16x32_bf16(__builtin_bit_cast(bf16x8, vw), pf, o[dt], 0, 0, 0);
        }
    }
#pragma unroll
    for (int dt = 0; dt < 4; ++dt) { u32x2 w; w.x = cvt_pk_bf16(o[dt][0] * inv, o[dt][1] * inv); w.y = cvt_pk_bf16(o[dt][2] * inv, o[dt][3] * inv); *(u32x2*)(outp + 16 * dt + 4 * g) = w; }
}

#define LOAD_QFRAG(zq, pos, q0, q1) do { float _x1[8], _x2[8]; const int _g = lane >> 4; NORM_ROPE(zq, qn, pos, _g, 16, 32, _x1, _x2); \
    u32x4 _w0, _w1; _w0.x = cvt_pk_bf16(_x1[0] * QSCALE, _x1[1] * QSCALE); _w0.y = cvt_pk_bf16(_x1[2] * QSCALE, _x1[3] * QSCALE); _w0.z = cvt_pk_bf16(_x1[4] * QSCALE, _x1[5] * QSCALE); _w0.w = cvt_pk_bf16(_x1[6] * QSCALE, _x1[7] * QSCALE); \
    _w1.x = cvt_pk_bf16(_x2[0] * QSCALE, _x2[1] * QSCALE); _w1.y = cvt_pk_bf16(_x2[2] * QSCALE, _x2[3] * QSCALE); _w1.z = cvt_pk_bf16(_x2[4] * QSCALE, _x2[5] * QSCALE); _w1.w = cvt_pk_bf16(_x2[6] * QSCALE, _x2[7] * QSCALE); \
    q0 = __builtin_bit_cast(bf16x8, _w0); q1 = __builtin_bit_cast(bf16x8, _w1); } while (0)

__device__ __forceinline__ void attn_prompt_item(const bf16_t* z, const float* qn, const float* kn, const float* sinks, const float* rope_c, const float* rope_s, bf16_t* mix, float* spk, float* spv,
                                                 LAS unsigned char* lds, int qb, int kvh, int tid, int lane, int wave) {
    LAS bf16_t* Kl = (LAS bf16_t*)lds;
    LAS bf16_t* Vt = Kl + 256 * KSTR;
    LSYNC();
    const int kbase = qb * 128 - 128;
#pragma unroll
    for (int it_ = 0; it_ < 2; ++it_) { const int task = tid + 512 * it_;
        const int j = task >> 2, g = task & 3, pos = kbase + j;
        u32x4 w0 = (u32x4){0u, 0u, 0u, 0u}, w1 = w0;
        float x1[8], x2[8];
        const int posc = pos < 0 ? 0 : pos;
        const bf16_t* zr = z + (size_t)posc * INC + ZCK + kvh * 64;
        NORM_ROPE(zr, kn, posc, g, 1, 2, x1, x2);
        if (pos >= 0) { w0.x = cvt_pk_bf16(x1[0], x1[1]); w0.y = cvt_pk_bf16(x1[2], x1[3]); w0.z = cvt_pk_bf16(x1[4], x1[5]); w0.w = cvt_pk_bf16(x1[6], x1[7]);
                        w1.x = cvt_pk_bf16(x2[0], x2[1]); w1.y = cvt_pk_bf16(x2[2], x2[3]); w1.z = cvt_pk_bf16(x2[4], x2[5]); w1.w = cvt_pk_bf16(x2[6], x2[7]); }
        *(LAS u32x4*)(Kl + j * KSTR + 8 * g) = w0; *(LAS u32x4*)(Kl + j * KSTR + 32 + 8 * g) = w1;
        if (qb == 127 && j >= 128) { float* o = spk + (size_t)(j - 128) * 128 + kvh * 64;
            *(f32x4*)(o + 8 * g) = (f32x4){x1[0], x1[1], x1[2], x1[3]}; *(f32x4*)(o + 8 * g + 4) = (f32x4){x1[4], x1[5], x1[6], x1[7]};
            *(f32x4*)(o + 32 + 8 * g) = (f32x4){x2[0], x2[1], x2[2], x2[3]}; *(f32x4*)(o + 32 + 8 * g + 4) = (f32x4){x2[4], x2[5], x2[6], x2[7]}; }
    }
#pragma unroll
    for (int it_ = 0; it_ < 4; ++it_) { const int task = tid + 512 * it_;
        const int j = task >> 3, c8 = (task & 7) * 8, pos = kbase + j;
        u32x4 w = (u32x4){0u, 0u, 0u, 0u};
        if (pos >= 0) w = *(const u32x4*)(z + (size_t)pos * INC + ZCV + kvh * 64 + c8);
        Vt[(c8 + 0) * VSTR + j] = (bf16_t)(w.x & 0xffffu); Vt[(c8 + 1) * VSTR + j] = (bf16_t)(w.x >> 16);
        Vt[(c8 + 2) * VSTR + j] = (bf16_t)(w.y & 0xffffu); Vt[(c8 + 3) * VSTR + j] = (bf16_t)(w.y >> 16);
        Vt[(c8 + 4) * VSTR + j] = (bf16_t)(w.z & 0xffffu); Vt[(c8 + 5) * VSTR + j] = (bf16_t)(w.z >> 16);
        Vt[(c8 + 6) * VSTR + j] = (bf16_t)(w.w & 0xffffu); Vt[(c8 + 7) * VSTR + j] = (bf16_t)(w.w >> 16);
        if (qb == 127 && j >= 128) { float f[8]; UNPACK8(w, f); float* o = spv + (size_t)(j - 128) * 128 + kvh * 64 + c8;
            *(f32x4*)o = (f32x4){f[0], f[1], f[2], f[3]}; *(f32x4*)(o + 4) = (f32x4){f[4], f[5], f[6], f[7]}; }
    }
    for (int idx = tid; idx < 64 * 24; idx += 512) Vt[(idx / 24) * VSTR + 256 + (idx % 24)] = 0;
    LSYNC();
    const int hq = kvh * 4 + (wave >> 1);
    const float sink = sinks[hq] * LOG2E;
    const int g4 = lane >> 4;
    float gq1[8], gq2[8];
#pragma unroll
    for (int j = 0; j < 8; ++j) { gq1[j] = qn[8 * g4 + j] * QSCALE; gq2[j] = qn[32 + 8 * g4 + j] * QSCALE; }
    const int pos0 = qb * 128 + (wave & 1) * 64 + (lane & 15);
    const bf16_t* zq0 = z + (size_t)pos0 * INC + ZCQ + hq * 64 + 8 * g4;
    const float* rc0 = rope_c + (size_t)pos0 * 32 + 8 * g4; const float* rs0 = rope_s + (size_t)pos0 * 32 + 8 * g4;
    u32x4 nlo = *(const u32x4*)zq0, nhi = *(const u32x4*)(zq0 + 32);
    f32x4 nc0 = *(const f32x4*)rc0, nc1 = *(const f32x4*)(rc0 + 4), ns0 = *(const f32x4*)rs0, ns1 = *(const f32x4*)(rs0 + 4);
#pragma unroll 1
    for (int a4 = 0; a4 < 4; ++a4) {
        const u32x4 lo = nlo, hi = nhi; const f32x4 c0 = nc0, c1 = nc1, s0 = ns0, s1 = ns1;
        { const int an = a4 < 3 ? a4 + 1 : 3; const bf16_t* zqn = zq0 + (size_t)(16 * an) * INC; const float* rcn = rc0 + (size_t)(16 * an) * 32; const float* rsn = rs0 + (size_t)(16 * an) * 32;
          nlo = *(const u32x4*)zqn; nhi = *(const u32x4*)(zqn + 32); nc0 = *(const f32x4*)rcn; nc1 = *(const f32x4*)(rcn + 4); ns0 = *(const f32x4*)rsn; ns1 = *(const f32x4*)(rsn + 4); }
        float a[8], b[8]; UNPACK8(lo, a); UNPACK8(hi, b);
        float sq = 0.f;
#pragma unroll
        for (int j = 0; j < 8; ++j) sq += a[j] * a[j] + b[j] * b[j];
        sq += __shfl_xor(sq, 16); sq += __shfl_xor(sq, 32);
        const float r = rsqrtf(sq * (1.0f / 64.0f) + EPS);
        float x1[8], x2[8];
#pragma unroll
        for (int j = 0; j < 8; ++j) { const float y1 = a[j] * r * gq1[j], y2 = b[j] * r * gq2[j]; const float c = j < 4 ? c0[j & 3] : c1[j & 3], s = j < 4 ? s0[j & 3] : s1[j & 3];
            x1[j] = y1 * c - y2 * s; x2[j] = y2 * c + y1 * s; }
        u32x4 w0, w1; w0.x = cvt_pk_bf16(x1[0], x1[1]); w0.y = cvt_pk_bf16(x1[2], x1[3]); w0.z = cvt_pk_bf16(x1[4], x1[5]); w0.w = cvt_pk_bf16(x1[6], x1[7]);
        w1.x = cvt_pk_bf16(x2[0], x2[1]); w1.y = cvt_pk_bf16(x2[2], x2[3]); w1.z = cvt_pk_bf16(x2[4], x2[5]); w1.w = cvt_pk_bf16(x2[6], x2[7]);
        const int i0 = (wave & 1) * 64 + 16 * a4, i = i0 + (lane & 15);
        const size_t m = (size_t)qb * 128 + i;
        attn_qtile(Kl, Vt, __builtin_bit_cast(bf16x8, w0), __builtin_bit_cast(bf16x8, w1), i, i0 >> 4, qb == 0 ? 128 : 0, sink, mix + m * DM + 512 + hq * 64, lane);
    }
}

__device__ __forceinline__ void attn_sample_item(const bf16_t* z, const float* ck, const float* cv, const float* qn, const float* kn, const float* sinks, const float* rope_c, const float* rope_s, bf16_t* mix,
                                                 float* ssk, float* ssv, LAS unsigned char* lds, int b, int kvh, int tid, int lane, int wave) {
    LAS bf16_t* Kl = (LAS bf16_t*)lds;
    LAS bf16_t* Vt = Kl + 256 * KSTR;
    LSYNC();
#pragma unroll
    for (int it_ = 0; it_ < 2; ++it_) { const int task = tid + 512 * it_;
        const int j = task >> 3, c8 = (task & 7) * 8;
        const float* kr = ck + (size_t)j * 128 + kvh * 64 + c8; const float* vr = cv + (size_t)j * 128 + kvh * 64 + c8;
        const f32x4 k0 = *(const f32x4*)kr, k1 = *(const f32x4*)(kr + 4), v0 = *(const f32x4*)vr, v1 = *(const f32x4*)(vr + 4);
        u32x4 w; w.x = cvt_pk_bf16(k0[0], k0[1]); w.y = cvt_pk_bf16(k0[2], k0[3]); w.z = cvt_pk_bf16(k1[0], k1[1]); w.w = cvt_pk_bf16(k1[2], k1[3]);
        *(LAS u32x4*)(Kl + j * KSTR + c8) = w;
        const float vf[8] = {v0[0], v0[1], v0[2], v0[3], v1[0], v1[1], v1[2], v1[3]};
#pragma unroll
        for (int e = 0; e < 8; ++e) Vt[(c8 + e) * VSTR + j] = (bf16_t)(cvt_pk_bf16(vf[e], 0.f) & 0xffffu);
        if (j >= 4) { float* ok = ssk + (size_t)(j - 4) * 128 + kvh * 64 + c8; float* ov = ssv + (size_t)(j - 4) * 128 + kvh * 64 + c8;
            *(f32x4*)ok = k0; *(f32x4*)(ok + 4) = k1; *(f32x4*)ov = v0; *(f32x4*)(ov + 4) = v1; }
    }
    if (tid < 16) {
        const int t = tid >> 2, g = tid & 3, j = 128 + t; const size_t m = (size_t)TP + 4 * b + t;
        float x1[8], x2[8];
        NORM_ROPE(z + m * INC + ZCK + kvh * 64, kn, TP + t, g, 1, 2, x1, x2);
        u32x4 w0, w1; w0.x = cvt_pk_bf16(x1[0], x1[1]); w0.y = cvt_pk_bf16(x1[2], x1[3]); w0.z = cvt_pk_bf16(x1[4], x1[5]); w0.w = cvt_pk_bf16(x1[6], x1[7]);
        w1.x = cvt_pk_bf16(x2[0], x2[1]); w1.y = cvt_pk_bf16(x2[2], x2[3]); w1.z = cvt_pk_bf16(x2[4], x2[5]); w1.w = cvt_pk_bf16(x2[6], x2[7]);
        *(LAS u32x4*)(Kl + j * KSTR + 8 * g) = w0; *(LAS u32x4*)(Kl + j * KSTR + 32 + 8 * g) = w1;
        float* o = ssk + (size_t)(j - 4) * 128 + kvh * 64;
        *(f32x4*)(o + 8 * g) = (f32x4){x1[0], x1[1], x1[2], x1[3]}; *(f32x4*)(o + 8 * g + 4) = (f32x4){x1[4], x1[5], x1[6], x1[7]};
        *(f32x4*)(o + 32 + 8 * g) = (f32x4){x2[0], x2[1], x2[2], x2[3]}; *(f32x4*)(o + 32 + 8 * g + 4) = (f32x4){x2[4], x2[5], x2[6], x2[7]};
    }
    if (tid >= 64 && tid < 64 + 32) {
        const int t = (tid - 64) >> 3, c8 = ((tid - 64) & 7) * 8, j = 128 + t; const size_t m = (size_t)TP + 4 * b + t;
        const u32x4 w = *(const u32x4*)(z + m * INC + ZCV + kvh * 64 + c8);
        Vt[(c8 + 0) * VSTR + j] = (bf16_t)(w.x & 0xffffu); Vt[(c8 + 1) * VSTR + j] = (bf16_t)(w.x >> 16);
        Vt[(c8 + 2) * VSTR + j] = (bf16_t)(w.y & 0xffffu); Vt[(c8 + 3) * VSTR + j] = (bf16_t)(w.y >> 16);
        Vt[(c8 + 4) * VSTR + j] = (bf16_t)(w.z & 0xffffu); Vt[(c8 + 5) * VSTR + j] = (bf16_t)(w.z >> 16);
        Vt[(c8 + 6) * VSTR + j] = (bf16_t)(w.w & 0xffffu); Vt[(c8 + 7) * VSTR + j] = (bf16_t)(w.w >> 16);
        float f[8]; UNPACK8(w, f); float* o = ssv + (size_t)(j - 4) * 128 + kvh * 64 + c8;
        *(f32x4*)o = (f32x4){f[0], f[1], f[2], f[3]}; *(f32x4*)(o + 4) = (f32x4){f[4], f[5], f[6], f[7]};
    }
    if (tid >= 128 && tid < 128 + 12 * 8) { const int j = 132 + ((tid - 128) >> 3), c8 = ((tid - 128) & 7) * 8; *(LAS u32x4*)(Kl + j * KSTR + c8) = (u32x4){0u, 0u, 0u, 0u}; }
    for (int idx = tid; idx < 64 * 28; idx += 512) Vt[(idx / 28) * VSTR + 132 + (idx % 28)] = 0;
    LSYNC();
    if (wave == 0) {
        const int q = lane & 15, hg = q >> 2, t = q & 3, hq = kvh * 4 + hg; const size_t m = (size_t)TP + 4 * b + t;
        bf16x8 q0, q1;
        LOAD_QFRAG(z + m * INC + ZCQ + hq * 64, TP + t, q0, q1);
        attn_qtile(Kl, Vt, q0, q1, t, 0, 0, sinks[hq] * LOG2E, mix + m * DM + 512 + hq * 64, lane);
    }
}

#define PHASE_HEAD { unsigned z_ = 0; asm volatile("" : "+s"(z_)); lds += z_; } int wave_ = wv; asm volatile("" : "+s"(wave_)); const int wave = wave_, lane = lane_id_opaque(), tid = wave * 64 + lane; const int G = gridDim.x, bid = blockIdx.x; unsigned char* ws = WSP; (void)lane; (void)wave; (void)G; (void)bid; (void)ws;
#define SSP(k) ((float*)(ws + WS_SS) + (size_t)(k) * MT)
#define WL(off) ((const bf16_t*)(ws + WS_W + (size_t)l * W_LAYER + (off)))

struct G1Order {
    pg8::StaticOrder so; unsigned* cnt; int c;
    __device__ __forceinline__ bool next(int i, Unit& u) const {
        if (c >= 64 && c < 82) { if (i == 0) { const int s = c - 64; u.pm = 64 + s / 9; u.pn = s % 9; return true; } return so.next(i - 1, u); }
        return so.next(i, u);
    }
    __device__ __forceinline__ void a_ready(const Unit&) const {}
    __device__ __forceinline__ void done(const Unit& u) const {
        if (u.pm >= 64) {
            asm volatile("s_waitcnt vmcnt(0)" ::: "memory");
            __builtin_amdgcn_fence(__ATOMIC_RELEASE, "agent");
            asm volatile("s_waitcnt vmcnt(0)" ::: "memory");
            if (lane_id_opaque() == 0) __hip_atomic_fetch_add(cnt, 1u, __ATOMIC_RELAXED, __HIP_MEMORY_SCOPE_AGENT);
        }
    }
};
__device__ __forceinline__ void phase_g1(LAS unsigned char* lds, int l, int wv) {
    PHASE_HEAD
    unsigned* cnt = (unsigned*)(ws + WS_CTL) + 8192 + 64 * l;
    { pg8::Gemm g{(const bf16_t*)(ws + WS_BUFA), WL(W_IN), MT, INC, DM}; G1Order S; S.so.init(TP, INC, G, bid); S.cnt = cnt; S.c = bid;
      EpiZ E{(bf16_t*)(ws + WS_ZACT), INC, SSP(3 * l)}; pg8::gemm_phase<EpiZ, G1Order, true, true>(lds, g, S, E, wv); }
    if (bid >= 82) {
        if (tid == 0) { unsigned sp = 0; while (__hip_atomic_load(cnt, __ATOMIC_RELAXED, __HIP_MEMORY_SCOPE_AGENT) < 144u) { __builtin_amdgcn_s_sleep(4); if (++sp > (1u << 22)) break; }
            __builtin_amdgcn_fence(__ATOMIC_ACQUIRE, "agent"); asm volatile("s_waitcnt vmcnt(0)" ::: "memory"); }
        __syncthreads();
        const bf16_t* z = (const bf16_t*)(ws + WS_ZACT); bf16_t* bufB = (bf16_t*)(ws + WS_BUFB);
        const float* lbp = (const float*)(ws + WS_LB) + l * 256;
        const float* rope_c = (const float*)(ws + WS_ROPE); const float* rope_s = rope_c + (size_t)NPOS * 32;
        float* out = OUTP;
#pragma unroll 1
        for (int it = bid - 82; it < 640; it += G - 82) {
            int r = it;
            if (r < 256) { const int b = r >> 1, hp = r & 1; const size_t so = ((size_t)(l * 128 + b) * 4) * 4096;
                hgrn_sample_item(z, lbp, IN(2) + so, out + O_SSH + so, IN(10) + l * 64, bufB, lds, b, hp, tid, lane, wave); continue; } r -= 256;
            if (r < 128) { conv_sample_item(z, IN(3) + (size_t)l * 128 * 7680, IN(11) + l * 31 * 256, IN(12) + l * 256, IN(13) + l * 256, IN(14) + l * 256, bufB, out + O_SSC + (size_t)l * 128 * 7680, lds, r, tid, lane, wave); continue; } r -= 128;
            { const int b = r >> 1, kvh = r & 1; const size_t co = (size_t)(l * 128 + b) * 16384;
              attn_sample_item(z, IN(4) + co, IN(5) + co, IN(15) + l * 64, IN(16) + l * 64, IN(17) + l * 8, rope_c, rope_s, bufB, out + O_SSK + co, out + O_SSV + co, lds, b, kvh, tid, lane, wave); }
        }
        LSYNC();
        { LAS float* scr = (LAS float*)(lds + wave * 16384);
          const int first = (l == 0) ? CI_D : (CI_LAYER + CI_OUT), cnt_ = (l == 0) ? (CI_LAYER - CI_D) : (CI_GG - CI_OUT);
#pragma unroll 1
          for (int k = (bid - 82) * 8 + wave; k < cnt_; k += (G - 82) * 8) convert_item(lds, ws, scr, first + k, lane); }
    }
}
__device__ __forceinline__ void phase_mix_a(LAS unsigned char* lds, int l, int wv) {
    PHASE_HEAD
    const bf16_t* z = (const bf16_t*)(ws + WS_ZACT); bf16_t* bufB = (bf16_t*)(ws + WS_BUFB);
    const float* lbp = (const float*)(ws + WS_LB) + l * 256; float* dvec = (float*)(ws + WS_DVEC); float* dS = (float*)(ws + WS_DS);
    const float* rope_c = (const float*)(ws + WS_ROPE); const float* rope_s = rope_c + (size_t)NPOS * 32;
    float* out = OUTP;
#pragma unroll 1
    for (int it = bid; it < 1024; it += G) {
        unsigned czf[8], cvi[8];
        const bf16_t* zb = z + (size_t)(64 * (it >> 2) + 8 * wave) * INC + (it & 3) * 64 + lane;
#pragma unroll
        for (int i = 0; i < 8; ++i) { czf[i] = zb[(size_t)i * INC + ZF]; cvi[i] = zb[(size_t)i * INC + ZI]; }
        hgrn_ds_item(czf, cvi, lbp, dS, dvec, lds, it >> 2, it & 3, tid, lane, wave);
    }
#pragma unroll 1
    for (int it = bid; it < 512; it += G) {
        int r = it;
        if (r < 256) { attn_prompt_item(z, IN(15) + l * 64, IN(16) + l * 64, IN(17) + l * 8, rope_c, rope_s, bufB, out + O_SPK + (size_t)l * 16384, out + O_SPV + (size_t)l * 16384, lds, r >> 1, r & 1, tid, lane, wave); continue; } r -= 256;
        conv_prompt_item(z, IN(11) + l * 31 * 256, IN(12) + l * 256, IN(13) + l * 256, IN(14) + l * 256, bufB, out + O_SPC + (size_t)l * 7680, lds, r, tid, lane, wave);
    }
}
__device__ __forceinline__ void phase_scan(LAS unsigned char* lds, int l, int wv) {
    PHASE_HEAD
    if (bid < 256) {
        float* dS = (float*)(ws + WS_DS); const float* dvec = (const float*)(ws + WS_DVEC);
        const int e = 64 * bid + lane, h = e >> 12, k = (e >> 6) & 63;
        LAS float* X = (LAS float*)lds;
        float v[32], d[32];
#pragma unroll
        for (int j = 0; j < 32; ++j) { const int c = 32 * wave + j; v[j] = dS[(size_t)c * 16384 + e]; d[j] = dvec[(c * 4 + h) * 64 + k]; }
        float A = 0.f, P = 1.f;
#pragma unroll
        for (int j = 0; j < 32; ++j) { const float t = v[j]; v[j] = A; A = d[j] * A + t; const float pd = d[j]; d[j] = P; P *= pd; }
        LSYNC();
        X[(wave * 2 + 0) * 64 + lane] = P; X[(wave * 2 + 1) * 64 + lane] = A;
        LSYNC();
        float S = 0.f;
#pragma unroll
        for (int w2 = 0; w2 < 8; ++w2) { const float p2 = X[(w2 * 2 + 0) * 64 + lane], a2 = X[(w2 * 2 + 1) * 64 + lane]; if (w2 < wave) S = p2 * S + a2; }
#pragma unroll
        for (int j = 0; j < 32; ++j) dS[(size_t)(32 * wave + j) * 16384 + e] = d[j] * S + v[j];
        if (wave == 7) OUTP[O_SPH + (size_t)l * 16384 + e] = P * S + A;
    }
}
__device__ __forceinline__ void phase_mix_c(LAS unsigned char* lds, int l, int wv) {
    PHASE_HEAD
    const bf16_t* z = (const bf16_t*)(ws + WS_ZACT); bf16_t* bufB = (bf16_t*)(ws + WS_BUFB);
    const float* lbp = (const float*)(ws + WS_LB) + l * 256; const float* dS = (const float*)(ws + WS_DS);
    const float* onorm = IN(10) + l * 64;
#pragma unroll 1
    for (int it = bid; it < 512; it += G) hgrn_out_item(z, lbp, dS, onorm, bufB, lds, it >> 1, it & 1, tid, lane, wave);
}
__device__ __forceinline__ void phase_g2(LAS unsigned char* lds, int l, int wv) {
    PHASE_HEAD
    bf16_t* bufA = (bf16_t*)(ws + WS_BUFA);
    pg8::Gemm g{(const bf16_t*)(ws + WS_BUFB), WL(W_OUT), TP, DM, DM}; pg8::StaticOrder S; S.init(TP, DM, G, bid);
    EpiRes E{bufA, bufA, SSP(3 * l + 1)};
    pg8::gemm_phase<EpiRes, pg8::StaticOrder, true, true>(lds, g, S, E, wv);
    SEpiRes SE{bufA + (size_t)TP * DM, bufA + (size_t)TP * DM, SSP(3 * l + 1) + TP};
    small_gemm(lds, (const bf16_t*)(ws + WS_BUFB) + (size_t)TP * DM, WL(W_OUT), DM, SE, bid, tid, lane, wave);
}
__device__ __forceinline__ void phase_g3(LAS unsigned char* lds, int l, int wv) {
    PHASE_HEAD
    pg8::Gemm g{(const bf16_t*)(ws + WS_BUFA), WL(W_GU), MT, 2 * DFF, DM}; pg8::StaticOrder S; S.init(MT, 2 * DFF, G, bid);
    EpiGU E{(bf16_t*)(ws + WS_ZACT), SSP(3 * l + 1)}; pg8::gemm_phase<EpiGU, pg8::StaticOrder, true, true>(lds, g, S, E, wv);
    if (bid >= 172) {
        bf16_t* pbl = (bf16_t*)(ws + WS_PB) + (size_t)l * MT * PLE;
        const float* pP = IN(6) + (size_t)l * TP * PLE; const float* pS = IN(7) + (size_t)l * NSM * PLE;
        const int gw2 = (bid - 172) * 8 + wave, NGW2 = (G - 172) * 8;
#pragma unroll 1
        for (int m0 = gw2; m0 < MT; m0 += 8 * NGW2) {
            f32x4 v[8];
#pragma unroll
            for (int q = 0; q < 8; ++q) { const int m = (m0 + q * NGW2 < MT) ? m0 + q * NGW2 : m0;
                const float* src = (m < TP) ? pP + (size_t)m * PLE : pS + (size_t)(m - TP) * PLE; v[q] = ((const f32x4*)src)[lane]; }
#pragma unroll
            for (int q = 0; q < 8; ++q) { const int m = (m0 + q * NGW2 < MT) ? m0 + q * NGW2 : m0;
                u32x2 w; w.x = cvt_pk_bf16(v[q][0], v[q][1]); w.y = cvt_pk_bf16(v[q][2], v[q][3]); ((u32x2*)(pbl + (size_t)m * PLE))[lane] = w; }
        }
        { LAS float* scr = (LAS float*)(lds + wave * 16384);
          const int first = (l == 0) ? CI_LAYER : (CI_LAYER + CI_D), cnt_ = (l == 0) ? CI_OUT : (CI_LAYER - CI_D);
#pragma unroll 1
          for (int k = (bid - 172) * 8 + wave; k < cnt_; k += (G - 172) * 8) convert_item(lds, ws, scr, first + k, lane); }
    }
}
__device__ __forceinline__ void phase_g4(LAS unsigned char* lds, int l, int wv) {
    PHASE_HEAD
    const bf16_t* bufA = (const bf16_t*)(ws + WS_BUFA); bf16_t* bufB = (bf16_t*)(ws + WS_BUFB);
    pg8::Gemm g{(const bf16_t*)(ws + WS_ZACT), WL(W_D), TP, DM, DFF}; pg8::StaticOrder S; S.init(TP, DM, G, bid);
    EpiRes E{bufA, bufB, SSP(3 * l + 2)}; pg8::gemm_phase<EpiRes, pg8::StaticOrder, true, true>(lds, g, S, E, wv);
    SEpiRes SE{bufA + (size_t)TP * DM, bufB + (size_t)TP * DM, SSP(3 * l + 2) + TP};
    small_gemm(lds, (const bf16_t*)(ws + WS_ZACT) + (size_t)TP * DFF, WL(W_D), DFF, SE, bid, tid, lane, wave);
}
__device__ __forceinline__ void phase_g5a(LAS unsigned char* lds, int l, int wv) {
    PHASE_HEAD
    pg8::Gemm g{(const bf16_t*)(ws + WS_BUFB), WL(W_PG), TP, DM, DM}; pg8::StaticOrder S; S.init(TP, DM, G, bid);
    EpiGate E{(bf16_t*)(ws + WS_ZACT), SSP(3 * l + 2)}; pg8::gemm_phase<EpiGate, pg8::StaticOrder, true, true>(lds, g, S, E, wv);
    SEpiGate SE{(bf16_t*)(ws + WS_ZACT) + (size_t)TP * DM, SSP(3 * l + 2) + TP};
    small_gemm(lds, (const bf16_t*)(ws + WS_BUFB) + (size_t)TP * DM, WL(W_PG), DM, SE, bid, tid, lane, wave);
}
__device__ __forceinline__ void phase_g5b(LAS unsigned char* lds, int l, int wv) {
    PHASE_HEAD
    const bf16_t* gt = (const bf16_t*)(ws + WS_ZACT); const bf16_t* bufB = (const bf16_t*)(ws + WS_BUFB); bf16_t* bufA = (bf16_t*)(ws + WS_BUFA); float* Y = OUTP + O_Y;
    pg8::Gemm g{(const bf16_t*)(ws + WS_PB) + (size_t)l * MT * PLE, WL(W_PP), TP, DM, PLE}; pg8::StaticOrder S; S.init(TP, DM, G, bid);
    EpiOut E{gt, bufB, Y, bufA, SSP(3), l}; pg8::gemm_phase<EpiOut, pg8::StaticOrder, true, true>(lds, g, S, E, wv);
    SEpiOut SE{gt + (size_t)TP * DM, bufB + (size_t)TP * DM, Y + (size_t)TP * DM, bufA + (size_t)TP * DM, SSP(3) + TP, l};
    small_gemm(lds, (const bf16_t*)(ws + WS_PB) + ((size_t)l * MT + TP) * PLE, WL(W_PP), PLE, SE, bid, tid, lane, wave);
}

__global__ void __launch_bounds__(512, 2) fwd_kernel(Args a) {
    extern __shared__ __attribute__((aligned(16))) unsigned char lds_raw[];
    LAS unsigned char* lds = (LAS unsigned char*)lds_raw;
    volatile LAS unsigned* MISC = (volatile LAS unsigned*)(lds + MISC_OFF);
    if (threadIdx.x < 32) MISC[threadIdx.x] = 0u;
    if (threadIdx.x == 0) {
        LAS unsigned long long* PT = (LAS unsigned long long*)(lds + PT_OFF);
#pragma unroll
        for (int i = 0; i < 27; ++i) PT[i] = (unsigned long long)a.in[i];
        PT[27] = (unsigned long long)a.out; PT[28] = (unsigned long long)a.ws;
    }
    __syncthreads();
    const int wv = __builtin_amdgcn_readfirstlane(threadIdx.x >> 6);
    XcdBarrier bar = xcd_barrier_post((unsigned*)(WSP + WS_CTL), MISC + 8); bar.wv = wv;
    prologue(lds, wv);
    if (gridDim.x == 0x7fffffffu) cg::this_grid().sync();
    xcd_barrier(bar);
#define LAYER(l) do { \
        phase_g1(lds, l, wv); xcd_barrier(bar); \
        phase_mix_a(lds, l, wv); xcd_barrier(bar); \
        phase_scan(lds, l, wv); xcd_barrier(bar); \
        phase_mix_c(lds, l, wv); xcd_barrier(bar); \
        phase_g2(lds, l, wv); xcd_barrier(bar); \
        phase_g3(lds, l, wv); xcd_barrier(bar); \
        phase_g4(lds, l, wv); xcd_barrier(bar); \
        phase_g5a(lds, l, wv); \
        phase_g5b(lds, l, wv); } while (0)
    LAYER(0);
    xcd_barrier(bar);
    LAYER(1);
}

extern "C" void kernel_launch(void* const* d_in, const int* in_sizes, int n_in, void* d_out, int out_size, void* d_ws, size_t ws_size, hipStream_t stream) {
    static int grid = 0;
    if (grid == 0) {
        if (n_in != 27 || ws_size < WS_END) { fprintf(stderr, "kernel_launch: unexpected n_in %d / ws %zu\n", n_in, ws_size); grid = -1; return; }
        int dev = 0, cus = 0, per_cu = 0;
        hipGetDevice(&dev); hipDeviceGetAttribute(&cus, hipDeviceAttributeMultiprocessorCount, dev);
        if (hipFuncSetAttribute((const void*)fwd_kernel, hipFuncAttributeMaxDynamicSharedMemorySize, LDS_BYTES) != hipSuccess) { fprintf(stderr, "kernel_launch: hipFuncSetAttribute failed\n"); grid = -1; return; }
        hipOccupancyMaxActiveBlocksPerMultiprocessor(&per_cu, (const void*)fwd_kernel, 512, LDS_BYTES);
        (void)hipGetLastError();
        if (per_cu < 1) { fprintf(stderr, "kernel_launch: occupancy query says %d blocks per CU\n", per_cu); }
        grid = cus;
    }
    if (grid < 0) return;
    hipMemsetAsync((char*)d_ws + WS_CTL, 0, CTL_BYTES, stream);
    Args a{};
    for (int i = 0; i < 27; ++i) a.in[i] = (const float*)d_in[i];
    a.out = (float*)d_out; a.ws = (unsigned char*)d_ws;
    void* args[] = {&a};
    hipError_t e = hipLaunchCooperativeKernel((const void*)fwd_kernel, dim3(grid), dim3(512), args, LDS_BYTES, stream);
    if (e != hipSuccess) fprintf(stderr, "cooperative launch failed: %s (grid %d)\n", hipGetErrorString(e), grid);
}
```

```cpp
#include <hip/hip_runtime.h>
#include <hip/hip_cooperative_groups.h>
#include <cstdio>
#include <cstdint>
namespace cg = cooperative_groups;
namespace pg8 {
#define PG8_LAS __attribute__((address_space(3)))
typedef unsigned short bf16_t;
typedef short bf16x8 __attribute__((ext_vector_type(8)));
typedef float f32x4 __attribute__((ext_vector_type(4)));
typedef unsigned u32x4 __attribute__((ext_vector_type(4)));
constexpr int BM = 256, BK = 64, HALF = 128, HTB = HALF * BK * 2  , STAGE_BYTES = 8 * HTB, NXCD = 8, WGM = 4;

__host__ __device__ __forceinline__ int lds_byte(int r, int c) { const int st = (r >> 4) * 2 + (c >> 5), rr = r & 15, cc = c & 31, ob = rr * 64 + cc * 2; return st * 1024 + (ob ^ (((ob >> 9) & 1) << 5)); }
__host__ __device__ __forceinline__ void stage_rc(int b, int& R, int& C) { const int st = b / 1024, sb = b % 1024, swz = sb ^ (((sb >> 9) & 1) << 5); R = (st >> 1) * 16 + swz / 64; C = (st & 1) * 32 + (swz % 64) / 2; }
__host__ __device__ __forceinline__ int perm32(int rho) { const int n = rho >> 4, i = rho & 15; return 8 * (i >> 2) + 4 * n + (i & 3); }

struct Unit { int pm, pn; };
struct Gemm { const bf16_t* A; const bf16_t* Bt; int M, N, K; };

struct StaticOrder {
    int nM, nN, nwg, G, c;
    __host__ __device__ void init(int M, int N, int G_, int c_) { nM = M / BM; nN = N / BM; nwg = nM * nN; G = G_; c = c_; }
    __host__ __device__ bool next(int i, Unit& u) const {
        const long L = (long)i * G + c; if (L >= nwg) return false;
        int wgid = (int)L; { const int q = nwg / NXCD, r = nwg % NXCD, xcd = wgid % NXCD, off = wgid / NXCD; wgid = (xcd < r ? xcd * (q + 1) : r * (q + 1) + (xcd - r) * q) + off; }
        const int nig = WGM * nN, gid = wgid / nig, fm = gid * WGM, gsz = (nM - fm) < WGM ? (nM - fm) : WGM;
        u.pm = fm + ((wgid % nig) % gsz); u.pn = (wgid % nig) / gsz; return true;
    }
    __device__ __forceinline__ void a_ready(const Unit&) const {}
    __device__ __forceinline__ void done(const Unit&) const {}
};
__device__ __forceinline__ unsigned cvt_pk_bf16(float lo, float hi) { unsigned r; asm volatile("v_cvt_pk_bf16_f32 %0, %1, %2" : "=v"(r) : "v"(lo), "v"(hi)); return r; }
template <class Epi, class Sched, bool ALIGN_EPI = false, bool SP2 = false>
__device__ __forceinline__ void gemm_phase(PG8_LAS unsigned char* lds, const Gemm g, const Sched& S, const Epi& E, int wv_) {
    unsigned m_ = ~0u; asm volatile("" : "+s"(m_)); asm volatile("" : "+s"(wv_)); int tid_ = wv_ * 64 + (int)__builtin_amdgcn_mbcnt_hi(m_, __builtin_amdgcn_mbcnt_lo(m_, 0u)); { unsigned z_ = 0; asm volatile("" : "+s"(z_)); lds += z_; } const int tid = tid_, wid = __builtin_amdgcn_readfirstlane(tid >> 6), lane = tid & 63, wr = wid >> 2, wc = wid & 3, fr = lane & 15, fq = lane >> 4;
    const int K = g.K, nt = K / BK;
    unsigned voffA[2], voffB[2];
#pragma unroll
    for (int i = 0; i < 2; ++i) { int R, C; stage_rc(tid * 16 + i * 8192, R, C); const int Rb = Epi::PERM ? ((R & ~31) + perm32(R & 31)) : R;
        voffA[i] = (unsigned)(R * K + C) * 2u; voffB[i] = (unsigned)(Rb * K + C) * 2u; }
    const size_t kstep = (size_t)(BK * 2);
    const size_t hstep = (size_t)HALF * K * 2;
    const size_t tstep = 2 * hstep;
    const unsigned ldsw = (unsigned)wid * 1024u;
    const int aoff = lds_byte(wr * 64 + fr, fq * 8), boff = lds_byte(wc * 32 + fr, fq * 8);
#define PG8_SA(b, h) (((b) * 2 + (h)) * HTB)
#define PG8_SB(b, h) ((4 + (b) * 2 + (h)) * HTB)
#define PG8_STAGE(bufoff, gbase, voff) do { _Pragma("unroll") for (int _i = 0; _i < 2; ++_i) \
        __builtin_amdgcn_global_load_lds((const unsigned*)((const char*)(gbase) + (voff)[_i]), (PG8_LAS unsigned*)(lds + (bufoff) + ldsw + _i * 8192), 16, 0, 0); } while (0)
#define PG8_LDA(dst, b, h) do { _Pragma("unroll") for (int m = 0; m < 4; ++m) _Pragma("unroll") for (int k = 0; k < 2; ++k) dst[m][k] = *(const PG8_LAS bf16x8*)(lds + PG8_SA(b, h) + aoff + m * 2048 + k * 1024); } while (0)
#define PG8_LDB(dst, b, h) do { _Pragma("unroll") for (int n = 0; n < 2; ++n) _Pragma("unroll") for (int k = 0; k < 2; ++k) dst[n][k] = *(const PG8_LAS bf16x8*)(lds + PG8_SB(b, h) + boff + n * 2048 + k * 1024); } while (0)
#define PG8_MMA(ai, bj, At, Bt) do { __builtin_amdgcn_s_setprio(1); _Pragma("unroll") for (int m = 0; m < 4; ++m) _Pragma("unroll") for (int n = 0; n < 2; ++n) _Pragma("unroll") for (int k = 0; k < 2; ++k) \
        acc[ai][bj][m][n] = __builtin_amdgcn_mfma_f32_16x16x32_bf16(Bt[n][k], At[m][k], acc[ai][bj][m][n], 0, 0, 0); __builtin_amdgcn_s_setprio(0); } while (0)
#define PG8_WAIT_V(n) asm volatile("s_waitcnt vmcnt(" #n ")" ::: "memory")
#define PG8_WAIT_L(n) asm volatile("s_waitcnt lgkmcnt(" #n ")" ::: "memory")
#define PG8_BAR __builtin_amdgcn_s_barrier()
#define PG8_SCHED __builtin_amdgcn_sched_barrier(0)
    Unit cur, nxt; int ui = 0;
    if (!S.next(0, cur)) return;
    f32x4 acc[2][2][4][2];
#pragma unroll
    for (int a = 0; a < 2; ++a)
#pragma unroll
        for (int b = 0; b < 2; ++b)
#pragma unroll
            for (int m = 0; m < 4; ++m)
#pragma unroll
                for (int n = 0; n < 2; ++n) acc[a][b][m][n] = (f32x4){0.f, 0.f, 0.f, 0.f};
    bf16x8 At[4][2], B0[2][2], B1[2][2];
    const char* cA = (const char*)g.A + (size_t)cur.pm * tstep; const char* cB = (const char*)g.Bt + (size_t)cur.pn * tstep;
    S.a_ready(cur);
    if constexpr (SP2) {
        PG8_STAGE(PG8_SB(0, 0), cB, voffB); PG8_STAGE(PG8_SB(0, 1), cB + hstep, voffB); PG8_STAGE(PG8_SA(0, 0), cA, voffA); PG8_STAGE(PG8_SA(0, 1), cA + hstep, voffA);
        if (wr == 1) PG8_BAR;
        PG8_WAIT_V(2); PG8_BAR;
        PG8_STAGE(PG8_SB(1, 0), cB + kstep, voffB); PG8_STAGE(PG8_SA(1, 0), cA + kstep, voffA); PG8_STAGE(PG8_SB(1, 1), cB + hstep + kstep, voffB);
        PG8_WAIT_V(6); PG8_BAR;
    } else {
        PG8_STAGE(PG8_SB(0, 0), cB, voffB); PG8_STAGE(PG8_SA(0, 0), cA, voffA); PG8_STAGE(PG8_SB(0, 1), cB + hstep, voffB); PG8_STAGE(PG8_SA(0, 1), cA + hstep, voffA);
        if (wr == 1) PG8_BAR;
        PG8_WAIT_V(4); PG8_BAR;
        PG8_STAGE(PG8_SB(1, 0), cB + kstep, voffB); PG8_STAGE(PG8_SA(1, 0), cA + kstep, voffA); PG8_STAGE(PG8_SB(1, 1), cB + hstep + kstep, voffB);
        PG8_WAIT_V(6); PG8_BAR;
    }
    for (;;) {
        const bool has_next = S.next(ui + 1, nxt);
        const char* nA = has_next ? (const char*)g.A + (size_t)nxt.pm * tstep : cA; const char* nB = has_next ? (const char*)g.Bt + (size_t)nxt.pn * tstep : cB;
        for (int t = 0; t < nt; t += 2) {
            const bool last = (t == nt - 2);
            const char* a1 = cA + (size_t)(t + 1) * kstep;
            const char* a2 = last ? nA : cA + (size_t)(t + 2) * kstep; const char* b2 = last ? nB : cB + (size_t)(t + 2) * kstep;
            const char* a3 = a2 + kstep; const char* b3 = b2 + kstep;
            if (last && has_next) S.a_ready(nxt);
            if constexpr (SP2) {
            PG8_LDB(B0, 0, 0); PG8_LDB(B1, 0, 1); PG8_SCHED; PG8_LDA(At, 0, 0); PG8_STAGE(PG8_SA(1, 1), a1 + hstep, voffA);
            PG8_WAIT_V(8); PG8_WAIT_L(0); PG8_BAR; PG8_MMA(0, 0, At, B0); PG8_MMA(0, 1, At, B1); PG8_BAR; PG8_SCHED;
            PG8_LDA(At, 0, 1); PG8_STAGE(PG8_SB(0, 0), b2, voffB); PG8_STAGE(PG8_SB(0, 1), b2 + hstep, voffB); PG8_STAGE(PG8_SA(0, 0), a2, voffA);
            PG8_WAIT_V(8); PG8_WAIT_L(0); PG8_BAR; PG8_MMA(1, 0, At, B0); PG8_MMA(1, 1, At, B1); PG8_BAR; PG8_SCHED;
            PG8_LDB(B0, 1, 0); PG8_LDB(B1, 1, 1); PG8_SCHED; PG8_LDA(At, 1, 0); PG8_STAGE(PG8_SA(0, 1), a2 + hstep, voffA);
            PG8_WAIT_V(8); PG8_WAIT_L(0); PG8_BAR; PG8_MMA(0, 0, At, B0); PG8_MMA(0, 1, At, B1); PG8_BAR; PG8_SCHED;
            PG8_LDA(At, 1, 1); PG8_STAGE(PG8_SB(1, 0), b3, voffB); PG8_STAGE(PG8_SB(1, 1), b3 + hstep, voffB); PG8_STAGE(PG8_SA(1, 0), a3, voffA);
            PG8_WAIT_V(8); PG8_WAIT_L(0); PG8_BAR; PG8_MMA(1, 0, At, B0); PG8_MMA(1, 1, At, B1); PG8_BAR; PG8_SCHED;
            } else {
            PG8_LDB(B0, 0, 0); PG8_SCHED; PG8_LDA(At, 0, 0); PG8_STAGE(PG8_SA(1, 1), a1 + hstep, voffA);
            PG8_WAIT_L(8); PG8_BAR; PG8_WAIT_L(0); PG8_MMA(0, 0, At, B0); PG8_BAR; PG8_SCHED;
            PG8_LDB(B1, 0, 1); PG8_STAGE(PG8_SB(0, 0), b2, voffB);
            PG8_BAR; PG8_WAIT_L(0); PG8_MMA(0, 1, At, B1); PG8_BAR;
            PG8_LDA(At, 0, 1); PG8_STAGE(PG8_SA(0, 0), a2, voffA);
            PG8_BAR; PG8_WAIT_L(0); PG8_MMA(1, 0, At, B0); PG8_BAR; PG8_SCHED;
            PG8_STAGE(PG8_SB(0, 1), b2 + hstep, voffB);
            PG8_WAIT_V(6); PG8_BAR; PG8_MMA(1, 1, At, B1); PG8_BAR;
            PG8_LDB(B0, 1, 0); PG8_SCHED; PG8_LDA(At, 1, 0); PG8_STAGE(PG8_SA(0, 1), a2 + hstep, voffA);
            PG8_WAIT_L(8); PG8_BAR; PG8_WAIT_L(0); PG8_MMA(0, 0, At, B0); PG8_BAR; PG8_SCHED;
            PG8_LDB(B1, 1, 1); PG8_STAGE(PG8_SB(1, 0), b3, voffB);
            PG8_BAR; PG8_WAIT_L(0); PG8_MMA(0, 1, At, B1); PG8_BAR;
            PG8_LDA(At, 1, 1); PG8_STAGE(PG8_SA(1, 0), a3, voffA);
            PG8_BAR; PG8_WAIT_L(0); PG8_MMA(1, 0, At, B0); PG8_BAR; PG8_SCHED;
            PG8_STAGE(PG8_SB(1, 1), b3 + hstep, voffB);
            PG8_WAIT_V(6); PG8_BAR; PG8_MMA(1, 1, At, B1); PG8_BAR;
            }
        }
        if constexpr (ALIGN_EPI) { if (wr == 0) PG8_BAR; }
        if constexpr (!Epi::AFTER_DRAIN) { E(acc, cur, wr, wc, fr, fq); S.done(cur); }
        if (!has_next) break;
#pragma unroll
        for (int a = 0; a < 2; ++a)
#pragma unroll
            for (int b = 0; b < 2; ++b)
#pragma unroll
                for (int m = 0; m < 4; ++m)
#pragma unroll
                    for (int n = 0; n < 2; ++n) acc[a][b][m][n] = (f32x4){0.f, 0.f, 0.f, 0.f};
        cur = nxt; cA = nA; cB = nB; ++ui;
        if constexpr (ALIGN_EPI) { if (wr == 1) PG8_BAR; }
    }
    PG8_WAIT_V(0);
    if constexpr (!ALIGN_EPI) { if (wr == 0) PG8_BAR; }
    PG8_BAR;
    if constexpr (Epi::AFTER_DRAIN) { E.fused(acc, cur, wr, wc, fr, fq, lds, wid, lane); S.done(cur); }
#undef PG8_SA
#undef PG8_SB
#undef PG8_STAGE
#undef PG8_LDA
#undef PG8_LDB
#undef PG8_MMA
#undef PG8_WAIT_V
#undef PG8_WAIT_L
#undef PG8_BAR
#undef PG8_SCHED
}
}

#define LAS __attribute__((address_space(3)))
using pg8::bf16_t; using pg8::bf16x8; using pg8::f32x4; using pg8::u32x4; using pg8::Unit; using pg8::cvt_pk_bf16;
typedef unsigned u32x2 __attribute__((ext_vector_type(2)));

constexpr int DM = 1024, TP = 16384, NSM = 512, MT = TP + NSM, INC = 2304, DFF = 2816, PLE = 256;
constexpr int ZQ = 0, ZF = 256, ZI = 512, ZG = 768, ZBU = 1024, ZBG = 1280, ZCQ = 1536, ZCK = 2048, ZCV = 2176;
constexpr float EPS = 1e-6f;
constexpr int NPOS = TP + 4;
constexpr size_t O_Y = 0, O_SPH = (size_t)MT * DM, O_SPC = O_SPH + 32768, O_SPK = O_SPC + 15360, O_SPV = O_SPK + 32768,
                 O_SSH = O_SPV + 32768, O_SSC = O_SSH + 4194304, O_SSK = O_SSC + 1966080, O_SSV = O_SSK + 4194304;
constexpr size_t MiB = 1u << 20;
constexpr size_t WS_CTL = 0, CTL_BYTES = 65536;
constexpr size_t WS_SS = 1 * MiB;
constexpr size_t WS_LB = WS_SS + 512 * 1024;
constexpr size_t WS_DVEC = WS_LB + 4096;
constexpr size_t WS_ROPE = 2 * MiB;
constexpr size_t WS_W = 7 * MiB;
constexpr size_t W_IN = 0, W_OUT = W_IN + (size_t)INC * DM * 2, W_GU = W_OUT + (size_t)DM * DM * 2, W_D = W_GU + (size_t)2 * DFF * DM * 2,
                 W_PG = W_D + (size_t)DM * DFF * 2, W_PP = W_PG + (size_t)DM * DM * 2, W_LAYER = W_PP + (size_t)DM * PLE * 2;
constexpr size_t WS_BUFA = 59 * MiB, WS_BUFB = 92 * MiB, WS_ZACT = 125 * MiB, WS_PB = 216 * MiB, WS_DS = 233 * MiB, WS_END = 249 * MiB;
static_assert(WS_W + 2 * W_LAYER <= WS_BUFA && WS_BUFA + (size_t)MT * DM * 2 <= WS_BUFB && WS_BUFB + (size_t)MT * DM * 2 <= WS_ZACT, "ws map");
static_assert(WS_ZACT + (size_t)MT * DFF * 2 <= WS_PB && WS_PB + (size_t)2 * MT * PLE * 2 <= WS_DS && WS_ROPE + (size_t)NPOS * 64 * 4 <= WS_W, "ws map");
constexpr int LDS_BYTES = 147456, MISC_OFF = 131072 + 320;

#define LSYNC() do { asm volatile("s_waitcnt lgkmcnt(0)" ::: "memory"); __builtin_amdgcn_s_barrier(); asm volatile("" ::: "memory"); } while (0)
#define LDS_WAIT() asm volatile("s_waitcnt lgkmcnt(0)" ::: "memory")
__device__ __forceinline__ float bf2f(unsigned short h) { return __uint_as_float(((unsigned)h) << 16); }
template <int CTRL> __device__ __forceinline__ float dppf(float v) { return __int_as_float(__builtin_amdgcn_update_dpp(0, __float_as_int(v), CTRL, 0xf, 0xf, true)); }
__device__ __forceinline__ float wave_sum(float v) {
    v += dppf<0xB1>(v);
    v += dppf<0x4E>(v);
    v += dppf<0x141>(v);
    v += dppf<0x140>(v);
    const float r0 = __int_as_float(__builtin_amdgcn_readlane(__float_as_int(v), 0)), r1 = __int_as_float(__builtin_amdgcn_readlane(__float_as_int(v), 16));
    const float r2 = __int_as_float(__builtin_amdgcn_readlane(__float_as_int(v), 32)), r3 = __int_as_float(__builtin_amdgcn_readlane(__float_as_int(v), 48));
    return (r0 + r1) + (r2 + r3);
}
__device__ __forceinline__ float quad_sum(float v) { v += dppf<0xB1>(v); v += dppf<0x4E>(v); return v; }
__device__ __forceinline__ float sigmoidf_(float x) { return __builtin_amdgcn_rcpf(1.0f + __expf(-x)); }
__device__ __forceinline__ float siluf_(float x) { return x * __builtin_amdgcn_rcpf(1.0f + __expf(-x)); }
#define UNPACK8(V_, o) do { (o)[0] = __uint_as_float((V_).x << 16); (o)[1] = __uint_as_float((V_).x & 0xffff0000u); (o)[2] = __uint_as_float((V_).y << 16); (o)[3] = __uint_as_float((V_).y & 0xffff0000u); \
    (o)[4] = __uint_as_float((V_).z << 16); (o)[5] = __uint_as_float((V_).z & 0xffff0000u); (o)[6] = __uint_as_float((V_).w << 16); (o)[7] = __uint_as_float((V_).w & 0xffff0000u); } while (0)

#define XB_TMO      128
#define XB_XCNT(j)  (256  + 64 * (j))
#define XB_XSUB(j)  (1280 + 64 * (j))
#define XB_XGEN(j)  (2304 + 64 * (j))
#define XB_TOP      3328
#define XB_TOPGEN   3392
#define XCD_BAR_WORDS 3456
#define XB_SPIN_CAP (1u << 18)

__device__ __forceinline__ unsigned xb_ld(unsigned* p)              { return __hip_atomic_load(p, __ATOMIC_RELAXED, __HIP_MEMORY_SCOPE_AGENT); }
__device__ __forceinline__ unsigned xb_add(unsigned* p, unsigned v) { return __hip_atomic_fetch_add(p, v, __ATOMIC_RELAXED, __HIP_MEMORY_SCOPE_AGENT); }
__device__ __forceinline__ unsigned xb_xcc_id() { return (unsigned)__builtin_amdgcn_s_getreg((3 << 11) | 20) & 0xFu; }
#define XB_SPIN(cond, bar) do { unsigned _sp = 0; while (cond) { __builtin_amdgcn_s_sleep(1); \
    if ((++_sp & 255u) == 0u) { if (xb_ld(&(bar)[XB_TMO])) break; if (_sp > XB_SPIN_CAP) { atomicAdd(&(bar)[XB_TMO], 1u); break; } } } } while (0)

struct XcdBarrier {
    unsigned* bar; unsigned x; int wv;
    volatile LAS unsigned* st;
};

__device__ __forceinline__ XcdBarrier xcd_barrier_post(unsigned* bar, volatile LAS unsigned* st) {
    XcdBarrier b; b.bar = bar; b.x = xb_xcc_id(); b.st = st;
    if (threadIdx.x == 0) (void)xb_add(&bar[XB_XCNT(b.x)], 1u);
    return b;
}
__device__ __forceinline__ void xcd_barrier_complete(unsigned* bar, unsigned x, unsigned& nloc, unsigned& nx) {
    const unsigned G = gridDim.x * gridDim.y * gridDim.z;
    unsigned sum, cnt, mine, sp = 0u;
    for (;;) {
        sum = 0u; cnt = 0u; mine = 0u;
#pragma unroll
        for (unsigned j = 0; j < 16; ++j) { const unsigned c = xb_ld(&bar[XB_XCNT(j)]); sum += c; cnt += (c > 0u) ? 1u : 0u; mine = (j == x) ? c : mine; }
        if (sum == G) break;
        __builtin_amdgcn_s_sleep(1);
        if ((++sp & 255u) == 0u) { if (xb_ld(&bar[XB_TMO])) break; if (sp > XB_SPIN_CAP) { atomicAdd(&bar[XB_TMO], 1u); break; } }
    }
    nloc = mine > 0u ? mine : 1u; nx = cnt > 0u ? cnt : 1u;
}

__device__ __forceinline__ void xcd_barrier(const XcdBarrier& b) {
    asm volatile("s_waitcnt vmcnt(0)" ::: "memory");
    __syncthreads();
    unsigned xm_ = ~0u; asm volatile("" : "+s"(xm_));
    int xw_ = b.wv; asm volatile("" : "+s"(xw_));
    if (xw_ == 0 && __builtin_amdgcn_mbcnt_hi(xm_, __builtin_amdgcn_mbcnt_lo(xm_, 0u)) == 0u) {
        unsigned* bar = b.bar;
        __builtin_amdgcn_s_waitcnt(0);
        unsigned nloc = b.st[0], nx = b.st[1];
        if (nloc == 0u) { xcd_barrier_complete(bar, b.x, nloc, nx); b.st[0] = nloc; b.st[1] = nx; }
        const unsigned old = xb_add(&bar[XB_XSUB(b.x)], 1u);
        const unsigned gen = old / nloc;
        if (old + 1u == (gen + 1u) * nloc) {
            __builtin_amdgcn_fence(__ATOMIC_RELEASE, "agent");
            asm volatile("s_waitcnt vmcnt(0)" ::: "memory");
            const unsigned og = xb_add(&bar[XB_TOP], 1u);
            const unsigned tg = og / nx;
            if (og + 1u == (tg + 1u) * nx) xb_add(&bar[XB_TOPGEN], 1u);
            else XB_SPIN(xb_ld(&bar[XB_TOPGEN]) == tg, bar);
            __builtin_amdgcn_fence(__ATOMIC_ACQUIRE, "agent");
            xb_add(&bar[XB_XGEN(b.x)], 1u);
            asm volatile("s_waitcnt vmcnt(0)" ::: "memory");
        } else {
            XB_SPIN(xb_ld(&bar[XB_XGEN(b.x)]) == gen, bar);
            __builtin_amdgcn_fence(__ATOMIC_ACQUIRE, "agent");
            asm volatile("s_waitcnt vmcnt(0)" ::: "memory");
        }
    }
    __syncthreads();
}

struct EpiZ {
    static constexpr bool PERM = true, AFTER_DRAIN = false;
    bf16_t* O; int ldc; const float* ss;
    __device__ __forceinline__ void operator()(const f32x4 (&acc)[2][2][4][2], const Unit& u, int wr, int wc, int fr, int fq) const {
        const int row0 = u.pm * 256 + wr * 64 + fr, col0 = u.pn * 256 + wc * 32 + 8 * fq;
#pragma unroll
        for (int ai = 0; ai < 2; ++ai)
#pragma unroll
            for (int m = 0; m < 4; ++m) {
                const int row = row0 + ai * 128 + m * 16; const float r = rsqrtf(ss[row] * (1.0f / DM) + EPS);
                bf16_t* rowp = O + (size_t)row * ldc + col0;
#pragma unroll
                for (int bj = 0; bj < 2; ++bj) { const f32x4 v0 = acc[ai][bj][m][0] * r, v1 = acc[ai][bj][m][1] * r;
                    u32x4 w; w.x = cvt_pk_bf16(v0[0], v0[1]); w.y = cvt_pk_bf16(v0[2], v0[3]); w.z = cvt_pk_bf16(v1[0], v1[1]); w.w = cvt_pk_bf16(v1[2], v1[3]);
                    *(u32x4*)(rowp + bj * 128) = w; }
            }
    }
};
typedef float f32x2 __attribute__((ext_vector_type(2)));
struct EpiGU {
    static constexpr bool PERM = true, AFTER_DRAIN = false;
    bf16_t* O; const float* ss;
    __device__ __forceinline__ void operator()(const f32x4 (&acc)[2][2][4][2], const Unit& u, int wr, int wc, int fr, int fq) const {
        const int row0 = u.pm * 256 + wr * 64 + fr, col0 = u.pn * 128 + wc * 32 + 8 * fq;
#pragma unroll
        for (int ai = 0; ai < 2; ++ai)
#pragma unroll
            for (int m = 0; m < 4; ++m) {
                const int row = row0 + ai * 128 + m * 16; const float r = rsqrtf(ss[row] * (1.0f / DM) + EPS);
                const float rn = r * -1.44269504f, r2 = r * r;
                unsigned w4[4];
#pragma unroll
                for (int n = 0; n < 2; ++n)
#pragma unroll
                    for (int e = 0; e < 4; e += 2) {
                        const f32x2 g2 = (f32x2){acc[ai][0][m][n][e], acc[ai][0][m][n][e + 1]}, u2 = (f32x2){acc[ai][1][m][n][e], acc[ai][1][m][n][e + 1]};
                        const f32x2 t = g2 * rn; f32x2 ex; ex.x = __builtin_amdgcn_exp2f(t.x); ex.y = __builtin_amdgcn_exp2f(t.y);
                        const f32x2 d = ex + 1.0f; f32x2 rc; rc.x = __builtin_amdgcn_rcpf(d.x); rc.y = __builtin_amdgcn_rcpf(d.y);
                        const f32x2 o = (g2 * u2) * (rc * r2);
                        w4[n * 2 + (e >> 1)] = cvt_pk_bf16(o.x, o.y);
                    }
                u32x4 w; w.x = w4[0]; w.y = w4[1]; w.z = w4[2]; w.w = w4[3];
                *(u32x4*)(O + (size_t)row * DFF + col0) = w;
            }
    }
};
struct EpiRes {
    static constexpr bool PERM = false, AFTER_DRAIN = false;
    const bf16_t* res; bf16_t* Ob; float* ss;
    __device__ __forceinline__ void operator()(const f32x4 (&acc)[2][2][4][2], const Unit& u, int wr, int wc, int fr, int fq) const {
        const int row0 = u.pm * 256 + wr * 64 + fr, col0 = u.pn * 256 + wc * 32 + 4 * fq;
#pragma unroll
        for (int ai = 0; ai < 2; ++ai)
#pragma unroll
            for (int m = 0; m < 4; ++m) {
                const int row = row0 + ai * 128 + m * 16; const size_t off = (size_t)row * DM + col0; float sq = 0.f;
#pragma unroll
                for (int bj = 0; bj < 2; ++bj)
#pragma unroll
                    for (int n = 0; n < 2; ++n) { const size_t o2 = off + bj * 128 + n * 16;
                        const u32x2 rw = *(const u32x2*)(res + o2);
                        f32x4 v = acc[ai][bj][m][n]; v[0] += __uint_as_float(rw.x << 16); v[1] += __uint_as_float(rw.x & 0xffff0000u); v[2] += __uint_as_float(rw.y << 16); v[3] += __uint_as_float(rw.y & 0xffff0000u);
                        u32x2 w; w.x = cvt_pk_bf16(v[0], v[1]); w.y = cvt_pk_bf16(v[2], v[3]); *(u32x2*)(Ob + o2) = w;
                        sq += (v[0] * v[0] + v[1] * v[1]) + (v[2] * v[2] + v[3] * v[3]); }
                sq += __shfl_xor(sq, 16); sq += __shfl_xor(sq, 32);
                if (fq == 0) unsafeAtomicAdd(ss + row, sq);
            }
    }
};
struct EpiGate {
    static constexpr bool PERM = false, AFTER_DRAIN = false;
    bf16_t* Gt; const float* ss;
    __device__ __forceinline__ void operator()(const f32x4 (&acc)[2][2][4][2], const Unit& u, int wr, int wc, int fr, int fq) const {
        const int row0 = u.pm * 256 + wr * 64 + fr, col0 = u.pn * 256 + wc * 32 + 4 * fq;
#pragma unroll
        for (int ai = 0; ai < 2; ++ai)
#pragma unroll
            for (int m = 0; m < 4; ++m) {
                const int row = row0 + ai * 128 + m * 16; const size_t off = (size_t)row * DM + col0; const float r = rsqrtf(ss[row] * (1.0f / DM) + EPS);
#pragma unroll
                for (int bj = 0; bj < 2; ++bj)
#pragma unroll
                    for (int n = 0; n < 2; ++n) { const f32x4 a = acc[ai][bj][m][n] * r;
                        u32x2 w; w.x = cvt_pk_bf16(sigmoidf_(a[0]), sigmoidf_(a[1])); w.y = cvt_pk_bf16(sigmoidf_(a[2]), sigmoidf_(a[3]));
                        *(u32x2*)(Gt + off + bj * 128 + n * 16) = w; }
            }
    }
};
struct EpiOut {
    static constexpr bool PERM = false, AFTER_DRAIN = false;
    const bf16_t* Gt; const bf16_t* res; float* Y; bf16_t* Ob; float* ss; int final_;
    __device__ __forceinline__ void operator()(const f32x4 (&acc)[2][2][4][2], const Unit& u, int wr, int wc, int fr, int fq) const {
        const int row0 = u.pm * 256 + wr * 64 + fr, col0 = u.pn * 256 + wc * 32 + 4 * fq;
#pragma unroll
        for (int ai = 0; ai < 2; ++ai)
#pragma unroll
            for (int m = 0; m < 4; ++m) {
                const int row = row0 + ai * 128 + m * 16; const size_t off = (size_t)row * DM + col0; float sq = 0.f;
#pragma unroll
                for (int bj = 0; bj < 2; ++bj)
#pragma unroll
                    for (int n = 0; n < 2; ++n) { const size_t o2 = off + bj * 128 + n * 16;
                        const u32x2 rw = *(const u32x2*)(res + o2), gw = *(const u32x2*)(Gt + o2);
                        const f32x4 a = acc[ai][bj][m][n]; f32x4 v;
                        v[0] = __uint_as_float(rw.x << 16) + __uint_as_float(gw.x << 16) * a[0]; v[1] = __uint_as_float(rw.x & 0xffff0000u) + __uint_as_float(gw.x & 0xffff0000u) * a[1];
                        v[2] = __uint_as_float(rw.y << 16) + __uint_as_float(gw.y << 16) * a[2]; v[3] = __uint_as_float(rw.y & 0xffff0000u) + __uint_as_float(gw.y & 0xffff0000u) * a[3];
                        if (final_) *(f32x4*)(Y + o2) = v;
                        else { u32x2 w; w.x = cvt_pk_bf16(v[0], v[1]); w.y = cvt_pk_bf16(v[2], v[3]); *(u32x2*)(Ob + o2) = w; }
                        sq += (v[0] * v[0] + v[1] * v[1]) + (v[2] * v[2] + v[3] * v[3]); }
                if (!final_) { sq += __shfl_xor(sq, 16); sq += __shfl_xor(sq, 32); if (fq == 0) unsafeAtomicAdd(ss + row, sq); }
            }
    }
};

template <class Epi>
__device__ __forceinline__ void small_gemm(LAS unsigned char* lds, const bf16_t* A, const bf16_t* Bt, int K, const Epi& E, int bid, int tid, int lane, int wave) {
    if (bid >= 256) return;
    const int r0 = 64 * (bid >> 5), c0 = 32 * (bid & 31), fr = lane & 15, g = lane >> 4, kw = K >> 3;
    f32x4 acc[4][2];
#pragma unroll
    for (int m = 0; m < 4; ++m) { acc[m][0] = (f32x4){0.f, 0.f, 0.f, 0.f}; acc[m][1] = (f32x4){0.f, 0.f, 0.f, 0.f}; }
    const bf16_t* ap = A + (size_t)(r0 + fr) * K + wave * kw + 8 * g;
    const bf16_t* bp = Bt + (size_t)(c0 + fr) * K + wave * kw + 8 * g;
#pragma unroll 4
    for (int ks = 0; ks < kw; ks += 32) {
        bf16x8 a[4], b[2];
#pragma unroll
        for (int m = 0; m < 4; ++m) a[m] = *(const bf16x8*)(ap + (size_t)m * 16 * K + ks);
#pragma unroll
        for (int n = 0; n < 2; ++n) b[n] = *(const bf16x8*)(bp + (size_t)n * 16 * K + ks);
#pragma unroll
        for (int m = 0; m < 4; ++m)
#pragma unroll
            for (int n = 0; n < 2; ++n) acc[m][n] = __builtin_amdgcn_mfma_f32_16x16x32_bf16(a[m], b[n], acc[m][n], 0, 0, 0);
    }
    LAS float* P = (LAS float*)lds + wave * (64 * 33);
    LSYNC();
#pragma unroll
    for (int m = 0; m < 4; ++m)
#pragma unroll
        for (int n = 0; n < 2; ++n)
#pragma unroll
            for (int r = 0; r < 4; ++r) P[(16 * m + 4 * g + r) * 33 + 16 * n + fr] = acc[m][n][r];
    LSYNC();
    const int row = tid >> 3, c4 = (tid & 7) * 4;
    f32x4 v = (f32x4){0.f, 0.f, 0.f, 0.f};
#pragma unroll
    for (int w2 = 0; w2 < 8; ++w2) { const LAS float* q = (const LAS float*)lds + w2 * (64 * 33) + row * 33 + c4; v[0] += q[0]; v[1] += q[1]; v[2] += q[2]; v[3] += q[3]; }
    LSYNC();
    E.apply(r0 + row, c0 + c4, v, tid);
}
struct SEpiRes {
    const bf16_t* res; bf16_t* Ob; float* ss;
    __device__ __forceinline__ void apply(int row, int col, f32x4 v, int tid) const {
        const size_t o = (size_t)row * DM + col; const u32x2 rw = *(const u32x2*)(res + o);
        v[0] += __uint_as_float(rw.x << 16); v[1] += __uint_as_float(rw.x & 0xffff0000u); v[2] += __uint_as_float(rw.y << 16); v[3] += __uint_as_float(rw.y & 0xffff0000u);
        u32x2 w; w.x = cvt_pk_bf16(v[0], v[1]); w.y = cvt_pk_bf16(v[2], v[3]); *(u32x2*)(Ob + o) = w;
        float sq = (v[0] * v[0] + v[1] * v[1]) + (v[2] * v[2] + v[3] * v[3]);
        sq += __shfl_xor(sq, 1); sq += __shfl_xor(sq, 2); sq += __shfl_xor(sq, 4);
        if ((tid & 7) == 0) unsafeAtomicAdd(ss + row, sq);
    }
};
struct SEpiGate {
    bf16_t* Gt; const float* ss;
    __device__ __forceinline__ void apply(int row, int col, f32x4 v, int tid) const {
        const float r = rsqrtf(ss[row] * (1.0f / DM) + EPS);
        u32x2 w; w.x = cvt_pk_bf16(sigmoidf_(v[0] * r), sigmoidf_(v[1] * r)); w.y = cvt_pk_bf16(sigmoidf_(v[2] * r), sigmoidf_(v[3] * r));
        *(u32x2*)(Gt + (size_t)row * DM + col) = w;
    }
};
struct SEpiOut {
    const bf16_t* Gt; const bf16_t* res; float* Y; bf16_t* Ob; float* ss; int final_;
    __device__ __forceinline__ void apply(int row, int col, f32x4 a, int tid) const {
        const size_t o = (size_t)row * DM + col; const u32x2 rw = *(const u32x2*)(res + o), gw = *(const u32x2*)(Gt + o); f32x4 v;
        v[0] = __uint_as_float(rw.x << 16) + __uint_as_float(gw.x << 16) * a[0]; v[1] = __uint_as_float(rw.x & 0xffff0000u) + __uint_as_float(gw.x & 0xffff0000u) * a[1];
        v[2] = __uint_as_float(rw.y << 16) + __uint_as_float(gw.y << 16) * a[2]; v[3] = __uint_as_float(rw.y & 0xffff0000u) + __uint_as_float(gw.y & 0xffff0000u) * a[3];
        if (final_) { *(f32x4*)(Y + o) = v; return; }
        u32x2 w; w.x = cvt_pk_bf16(v[0], v[1]); w.y = cvt_pk_bf16(v[2], v[3]); *(u32x2*)(Ob + o) = w;
        float sq = (v[0] * v[0] + v[1] * v[1]) + (v[2] * v[2] + v[3] * v[3]);
        sq += __shfl_xor(sq, 1); sq += __shfl_xor(sq, 2); sq += __shfl_xor(sq, 4);
        if ((tid & 7) == 0) unsafeAtomicAdd(ss + row, sq);
    }
};

__device__ __forceinline__ void transpose_item(const float* W, int K, int N, const float* gain, bf16_t* WT, int mode, LAS float* scr, int item, int lane) {
    const int nblk = N / 32, kb = item / nblk, nb = item % nblk, k0 = 64 * kb, n0 = 32 * nb;
    { const int kr = lane >> 3, nq = (lane & 7) * 4; f32x4 v[8]; float gv[8];
#pragma unroll
      for (int i = 0; i < 8; ++i) { v[i] = *(const f32x4*)(W + (size_t)(k0 + 8 * i + kr) * N + n0 + nq); gv[i] = gain ? gain[k0 + 8 * i + kr] : 1.0f; }
#pragma unroll
      for (int i = 0; i < 8; ++i) { LAS float* d = scr + (8 * i + kr) * 33 + nq; d[0] = v[i][0] * gv[i]; d[1] = v[i][1] * gv[i]; d[2] = v[i][2] * gv[i]; d[3] = v[i][3] * gv[i]; } }
    LDS_WAIT(); asm volatile("" ::: "memory");
    const int drow0 = (mode == 0) ? n0 : (256 * (n0 >> 7) + (n0 & 127) + (mode == 2 ? 128 : 0));
    const int c = lane & 7;
#pragma unroll
    for (int j = 0; j < 4; ++j) { const int n = (lane >> 3) + 8 * j; const LAS float* s = scr + (8 * c) * 33 + n;
        u32x4 o; o.x = cvt_pk_bf16(s[0 * 33], s[1 * 33]); o.y = cvt_pk_bf16(s[2 * 33], s[3 * 33]); o.z = cvt_pk_bf16(s[4 * 33], s[5 * 33]); o.w = cvt_pk_bf16(s[6 * 33], s[7 * 33]);
        *(u32x4*)(WT + (size_t)(drow0 + n) * K + k0 + 8 * c) = o; }
    LDS_WAIT(); asm volatile("" ::: "memory");
}

struct Args { const float* in[27]; float* out; unsigned char* ws; };
constexpr int PT_OFF = 131072 + 1024;
__device__ __forceinline__ int opaque(int x) { asm volatile("" : "+v"(x)); return x; }
__device__ __forceinline__ int lane_id_opaque() { unsigned m_ = ~0u; asm volatile("" : "+s"(m_)); return (int)__builtin_amdgcn_mbcnt_hi(m_, __builtin_amdgcn_mbcnt_lo(m_, 0u)); }
__device__ __forceinline__ const float* ptf(LAS unsigned char* lds, int i) {
    const unsigned long long v = ((LAS const unsigned long long*)(lds + PT_OFF))[i];
    const unsigned lo = __builtin_amdgcn_readfirstlane((unsigned)v), hi = __builtin_amdgcn_readfirstlane((unsigned)(v >> 32));
    return (const float*)(((unsigned long long)hi << 32) | lo);
}
#define IN(i) ptf(lds, (i))
#define OUTP ((float*)ptf(lds, 27))
#define WSP ((unsigned char*)ptf(lds, 28))

constexpr int CI_OUT = (DM / 64) * (INC / 32), CI_GG = CI_OUT + (DM / 64) * (DM / 32), CI_GU = CI_GG + (DM / 64) * (DFF / 32), CI_D = CI_GU + (DM / 64) * (DFF / 32),
              CI_PG = CI_D + (DFF / 64) * (DM / 32), CI_PP = CI_PG + (DM / 64) * (DM / 32), CI_LAYER = CI_PP + (PLE / 64) * (DM / 32);
__device__ __forceinline__ void convert_item(LAS unsigned char* lds, unsigned char* ws, LAS float* scr, int it, int lane) {
    const int l = it / CI_LAYER; int r = it - l * CI_LAYER;
    const float* W; const float* gain = nullptr; int K = DM, N = DM, mode = 0; size_t woff;
    if (r < CI_OUT) { W = IN(9) + (size_t)l * DM * INC; N = INC; gain = IN(19) + l * DM; woff = W_IN; }
    else if (r < CI_GG) { r -= CI_OUT; W = IN(18) + (size_t)l * DM * DM; woff = W_OUT; }
    else if (r < CI_GU) { r -= CI_GG; W = IN(21) + (size_t)l * DM * DFF; N = DFF; gain = IN(20) + l * DM; woff = W_GU; mode = 1; }
    else if (r < CI_D) { r -= CI_GU; W = IN(22) + (size_t)l * DM * DFF; N = DFF; gain = IN(20) + l * DM; woff = W_GU; mode = 2; }
    else if (r < CI_PG) { r -= CI_D; W = IN(23) + (size_t)l * DFF * DM; K = DFF; woff = W_D; }
    else if (r < CI_PP) { r -= CI_PG; W = IN(25) + (size_t)l * DM * DM; gain = IN(24) + l * DM; woff = W_PG; }
    else { r -= CI_PP; W = IN(26) + (size_t)l * PLE * DM; K = PLE; woff = W_PP; }
    transpose_item(W, K, N, gain, (bf16_t*)(ws + WS_W + (size_t)l * W_LAYER + woff), mode, scr, r, lane);
}
__device__ __forceinline__ void prologue(LAS unsigned char* lds, int wv) {
    { unsigned z_ = 0; asm volatile("" : "+s"(z_)); lds += z_; }
    int wave_ = wv; asm volatile("" : "+s"(wave_)); const int wave = wave_, lane = lane_id_opaque(), tid = wave * 64 + lane;
    const int G = gridDim.x, bid = blockIdx.x, gw = bid * 8 + wave, NGW = G * 8, gtid = bid * 512 + tid, NT = G * 512;
    unsigned char* ws = WSP;
    LAS float* scr = (LAS float*)(lds + wave * 16384);
#pragma unroll 1
    for (int k = gw; k < CI_D + (CI_D - CI_GG); k += NGW) convert_item(lds, ws, scr, (k < CI_D) ? k : (CI_LAYER + CI_GG + (k - CI_D)), lane);
    float* ss = (float*)(ws + WS_SS);
    bf16_t* bufA = (bf16_t*)(ws + WS_BUFA);
    const float* xP = IN(0); const float* xS = IN(1);
#pragma unroll 1
    for (int m0 = gw; m0 < MT; m0 += 2 * NGW) {
        f32x4 v[2][4];
#pragma unroll
        for (int q = 0; q < 2; ++q) { const int m = (m0 + q * NGW < MT) ? m0 + q * NGW : m0; const float* xr = (m < TP) ? xP + (size_t)m * DM : xS + (size_t)(m - TP) * DM;
#pragma unroll
            for (int j = 0; j < 4; ++j) v[q][j] = ((const f32x4*)xr)[lane + 64 * j]; }
#pragma unroll
        for (int q = 0; q < 2; ++q) { const int m = (m0 + q * NGW < MT) ? m0 + q * NGW : m0; float s = 0.f;
#pragma unroll
            for (int j = 0; j < 4; ++j) s += (v[q][j][0] * v[q][j][0] + v[q][j][1] * v[q][j][1]) + (v[q][j][2] * v[q][j][2] + v[q][j][3] * v[q][j][3]);
            s = wave_sum(s); if (lane == 0) ss[m] = s;
#pragma unroll
            for (int j = 0; j < 4; ++j) { u32x2 w; w.x = cvt_pk_bf16(v[q][j][0], v[q][j][1]); w.y = cvt_pk_bf16(v[q][j][2], v[q][j][3]); ((u32x2*)(bufA + (size_t)m * DM))[lane + 64 * j] = w; } }
    }
    float* rc = (float*)(ws + WS_ROPE); float* rs = rc + (size_t)NPOS * 32;
#pragma unroll 1
    for (int idx = gtid; idx < NPOS * 32; idx += NT) {
        const int pos = idx >> 5, d = idx & 31;
        const double inv = exp2(-(double)d * (13.287712379549449 / 32.0));
        double rev = (double)pos * inv * 0.15915494309189535; rev -= rint(rev);
        const float fr = (float)rev;
        rc[idx] = __builtin_amdgcn_cosf(fr); rs[idx] = __builtin_amdgcn_sinf(fr);
    }
    if (gtid < 256) { float* lb = (float*)(ws + WS_LB); const float* al = IN(8); const float a0 = al[gtid], a1 = al[256 + gtid]; lb[gtid] = 0.f; lb[256 + gtid] = 1.0f / (1.0f + expf(a0 - a1)); }
#pragma unroll 1
    for (int idx = gtid; idx < 5 * MT; idx += NT) ss[MT + idx] = 0.f;
}

__device__ __forceinline__ void hgrn_gates(float z, float lb, float& logf_, float& kin) {
    const float e = __expf(-fabsf(z));
    const float inv = __builtin_amdgcn_rcpf(1.0f + e);
    const float big = inv, small = e * inv;
    const float sp = (z >= 0.f) ? big : small;
    const float sn = (z >= 0.f) ? small : big;
    kin = (1.0f - lb) * sn;
    if (lb > 0.f) logf_ = __logf(lb + (1.0f - lb) * sp);
    else logf_ = fminf(z, 0.f) - __logf(1.0f + e);
}

#define HGRN_G(zbase, lbv, tot) \
    float Gl[8], kin[8]; float Gend = 0.f, Gref = 0.f; { float run = 0.f; \
    _Pragma("unroll") for (int i = 0; i < 8; ++i) { float g; hgrn_gates(bf2f((zbase)[(size_t)(8 * wave + i) * INC + ZF]), lbv, g, kin[i]); run += g; Gl[i] = run; } \
    (tot)[wave * 64 + lane] = run; LSYNC(); float off = 0.f; \
    _Pragma("unroll") for (int w2 = 0; w2 < 8; ++w2) { const float t = (tot)[w2 * 64 + lane]; if (w2 < wave) off += t; if (w2 < 4) Gref += t; Gend += t; } \
    _Pragma("unroll") for (int i = 0; i < 8; ++i) Gl[i] += off; }

#define HGRN_G2(zf, lbv, tot) \
    float Gl[8], kin[8]; float Gend = 0.f, Gref = 0.f; { float run = 0.f; \
    _Pragma("unroll") for (int i = 0; i < 8; ++i) { float g; hgrn_gates((zf)[i], lbv, g, kin[i]); run += g; Gl[i] = run; } \
    (tot)[wave * 64 + lane] = run; LSYNC(); float off = 0.f; \
    _Pragma("unroll") for (int w2 = 0; w2 < 8; ++w2) { const float t = (tot)[w2 * 64 + lane]; if (w2 < wave) off += t; if (w2 < 4) Gref += t; Gend += t; } \
    _Pragma("unroll") for (int i = 0; i < 8; ++i) Gl[i] += off; }
__device__ __forceinline__ void hgrn_ds_item(const unsigned (&zfu)[8], const unsigned (&vi)[8], const float* lbp, float* dS, float* dvec, LAS unsigned char* lds, int c, int h, int tid, int lane, int wave) {
    LAS bf16_t* KTt = (LAS bf16_t*)lds;
    LAS bf16_t* Vt = KTt + 64 * 72;
    LAS float* TOT = (LAS float*)(Vt + 64 * 72);
    float zf[8];
#pragma unroll
    for (int i = 0; i < 8; ++i) zf[i] = __uint_as_float(zfu[i] << 16);
    const float lbv = lbp[h * 64 + lane];
    LSYNC();
    HGRN_G2(zf, lbv, TOT)
    { float kt[8];
#pragma unroll
      for (int i = 0; i < 8; ++i) kt[i] = kin[i] * __expf(Gend - Gl[i]);
      u32x4 kw; kw.x = cvt_pk_bf16(kt[0], kt[1]); kw.y = cvt_pk_bf16(kt[2], kt[3]); kw.z = cvt_pk_bf16(kt[4], kt[5]); kw.w = cvt_pk_bf16(kt[6], kt[7]);
      u32x4 vw; vw.x = vi[0] | (vi[1] << 16); vw.y = vi[2] | (vi[3] << 16); vw.z = vi[4] | (vi[5] << 16); vw.w = vi[6] | (vi[7] << 16);
      *(LAS u32x4*)(KTt + lane * 72 + 8 * wave) = kw; *(LAS u32x4*)(Vt + lane * 72 + 8 * wave) = vw; }
    if (wave == 0) dvec[(c * 4 + h) * 64 + lane] = __expf(Gend);
    LSYNC();
    const int fr = lane & 15, g = lane >> 4, kt4 = wave >> 1, vt0 = 2 * (wave & 1);
    f32x4 acc[2] = {(f32x4){0.f, 0.f, 0.f, 0.f}, (f32x4){0.f, 0.f, 0.f, 0.f}};
#pragma unroll
    for (int ks = 0; ks < 2; ++ks) {
        const bf16x8 kb = *(const LAS bf16x8*)(KTt + (16 * kt4 + fr) * 72 + 32 * ks + 8 * g);
#pragma unroll
        for (int n = 0; n < 2; ++n) { const bf16x8 va = *(const LAS bf16x8*)(Vt + (16 * (vt0 + n) + fr) * 72 + 32 * ks + 8 * g);
            acc[n] = __builtin_amdgcn_mfma_f32_16x16x32_bf16(va, kb, acc[n], 0, 0, 0); }
    }
    float* dst = dS + (size_t)(c * 4 + h) * 4096 + (16 * kt4 + fr) * 64 + 4 * g;
#pragma unroll
    for (int n = 0; n < 2; ++n) *(f32x4*)(dst + 16 * (vt0 + n)) = acc[n];
}

__device__ __forceinline__ void hgrn_ds_pair(const bf16_t* z, const float* lbp, float* dS, float* dvec, LAS unsigned char* lds, int P, int lane, int wave) {
    const int sub = wave >> 2, wq = wave & 3, item = 2 * P + sub, c = item >> 2, h = item & 3, fr = lane & 15, g = lane >> 4;
    LAS bf16_t* KTt = (LAS bf16_t*)(lds + sub * 18432);
    LAS bf16_t* Vt = KTt + 64 * 72;
    LAS float* TOT = (LAS float*)(lds + 36864) + sub * 256;
    const bf16_t* zb = z + (size_t)(64 * c + 16 * wq) * INC + h * 64 + lane;
    unsigned zfu[16], vi[16];
#pragma unroll
    for (int i = 0; i < 16; ++i) { zfu[i] = zb[(size_t)i * INC + ZF]; vi[i] = zb[(size_t)i * INC + ZI]; }
    const float lbv = lbp[h * 64 + lane];
    LSYNC();
    float Gl[16], kin[16];
    { float run = 0.f;
#pragma unroll
      for (int i = 0; i < 16; ++i) { float gg; hgrn_gates(__uint_as_float(zfu[i] << 16), lbv, gg, kin[i]); run += gg; Gl[i] = run; }
      TOT[wq * 64 + lane] = run; }
    LSYNC();
    float off = 0.f, Gend = 0.f;
#pragma unroll
    for (int w2 = 0; w2 < 4; ++w2) { const float t = TOT[w2 * 64 + lane]; if (w2 < wq) off += t; Gend += t; }
    { float kt[16];
#pragma unroll
      for (int i = 0; i < 16; ++i) kt[i] = kin[i] * __expf(Gend - (Gl[i] + off));
      u32x4 k0, k1, v0, v1;
      k0.x = cvt_pk_bf16(kt[0], kt[1]); k0.y = cvt_pk_bf16(kt[2], kt[3]); k0.z = cvt_pk_bf16(kt[4], kt[5]); k0.w = cvt_pk_bf16(kt[6], kt[7]);
      k1.x = cvt_pk_bf16(kt[8], kt[9]); k1.y = cvt_pk_bf16(kt[10], kt[11]); k1.z = cvt_pk_bf16(kt[12], kt[13]); k1.w = cvt_pk_bf16(kt[14], kt[15]);
      v0.x = vi[0] | (vi[1] << 16); v0.y = vi[2] | (vi[3] << 16); v0.z = vi[4] | (vi[5] << 16); v0.w = vi[6] | (vi[7] << 16);
      v1.x = vi[8] | (vi[9] << 16); v1.y = vi[10] | (vi[11] << 16); v1.z = vi[12] | (vi[13] << 16); v1.w = vi[14] | (vi[15] << 16);
      *(LAS u32x4*)(KTt + lane * 72 + 16 * wq) = k0; *(LAS u32x4*)(KTt + lane * 72 + 16 * wq + 8) = k1;
      *(LAS u32x4*)(Vt + lane * 72 + 16 * wq) = v0; *(LAS u32x4*)(Vt + lane * 72 + 16 * wq + 8) = v1; }
    if (wq == 0) dvec[(c * 4 + h) * 64 + lane] = __expf(Gend);
    LSYNC();
    f32x4 acc[4];
#pragma unroll
    for (int n = 0; n < 4; ++n) acc[n] = (f32x4){0.f, 0.f, 0.f, 0.f};
#pragma unroll
    for (int ks = 0; ks < 2; ++ks) {
        const bf16x8 kb = *(const LAS bf16x8*)(KTt + (16 * wq + fr) * 72 + 32 * ks + 8 * g);
#pragma unroll
        for (int n = 0; n < 4; ++n) { const bf16x8 va = *(const LAS bf16x8*)(Vt + (16 * n + fr) * 72 + 32 * ks + 8 * g);
            acc[n] = __builtin_amdgcn_mfma_f32_16x16x32_bf16(va, kb, acc[n], 0, 0, 0); }
    }
    float* dst = dS + (size_t)(c * 4 + h) * 4096 + (16 * wq + fr) * 64 + 4 * g;
#pragma unroll
    for (int n = 0; n < 4; ++n) *(f32x4*)(dst + 16 * n) = acc[n];
}

__device__ __forceinline__ void hgrn_out_item(const bf16_t* z, const float* lbp, const float* dS, const float* onorm, bf16_t* mix, LAS unsigned char* lds, int c, int hp, int tid, int lane, int wave) {
    const int hh = wave >> 2, wq = wave & 3, h = 2 * hp + hh, fr = lane & 15, g = lane >> 4;
    LAS bf16_t* QT = (LAS bf16_t*)(lds + hh * 46080);
    LAS bf16_t* KT = QT + 4608;
    LAS bf16_t* QS = KT + 4608;
    LAS bf16_t* Vt = QS + 4608;
    LAS bf16_t* St = Vt + 4608;
    LAS float* TOT = (LAS float*)(lds + 92160) + hh * 256;
    const bf16_t* zb = z + (size_t)(64 * c + 16 * wq) * INC + h * 64 + lane;
    unsigned zfu[16], zqu[16], ziu[16];
#pragma unroll
    for (int i = 0; i < 16; ++i) { zfu[i] = zb[(size_t)i * INC + ZF]; zqu[i] = zb[(size_t)i * INC + ZQ]; ziu[i] = zb[(size_t)i * INC + ZI]; }
    f32x4 sv[4];
#pragma unroll
    for (int j4 = 0; j4 < 4; ++j4) sv[j4] = *(const f32x4*)(dS + (size_t)(c * 4 + h) * 4096 + j4 * 1024 + (wq * 64 + lane) * 4);
    const size_t mt = (size_t)(64 * c + 16 * wq + fr);
    u32x2 gz[4];
#pragma unroll
    for (int vt = 0; vt < 4; ++vt) gz[vt] = *(const u32x2*)(z + mt * INC + ZG + h * 64 + 16 * vt + 4 * g);
    const float lbv = lbp[h * 64 + lane];
    LSYNC();
    float Gl[16], kin[16];
    { float run = 0.f;
#pragma unroll
      for (int i = 0; i < 16; ++i) { float gg; hgrn_gates(__uint_as_float(zfu[i] << 16), lbv, gg, kin[i]); run += gg; Gl[i] = run; }
      TOT[wq * 64 + lane] = run; }
    LSYNC();
    float off = 0.f, Gref = 0.f;
#pragma unroll
    for (int w2 = 0; w2 < 4; ++w2) { const float t = TOT[w2 * 64 + lane]; if (w2 < wq) off += t; if (w2 < 2) Gref += t; }
#pragma unroll
    for (int i = 0; i < 16; ++i) { const float G = Gl[i] + off, q = __uint_as_float(zqu[i] << 16); const int s = 16 * wq + i;
        QT[s * 72 + lane] = (bf16_t)(cvt_pk_bf16(q * __expf(fminf(G - Gref, 80.f)), 0.f) & 0xffffu);
        KT[s * 72 + lane] = (bf16_t)(cvt_pk_bf16(kin[i] * __expf(fminf(Gref - G, 80.f)), 0.f) & 0xffffu);
        QS[s * 72 + lane] = (bf16_t)(cvt_pk_bf16(q * __expf(G), 0.f) & 0xffffu); }
    { u32x4 v0, v1; v0.x = ziu[0] | (ziu[1] << 16); v0.y = ziu[2] | (ziu[3] << 16); v0.z = ziu[4] | (ziu[5] << 16); v0.w = ziu[6] | (ziu[7] << 16);
      v1.x = ziu[8] | (ziu[9] << 16); v1.y = ziu[10] | (ziu[11] << 16); v1.z = ziu[12] | (ziu[13] << 16); v1.w = ziu[14] | (ziu[15] << 16);
      *(LAS u32x4*)(Vt + lane * 72 + 16 * wq) = v0; *(LAS u32x4*)(Vt + lane * 72 + 16 * wq + 8) = v1; }
#pragma unroll
    for (int j4 = 0; j4 < 4; ++j4) { const int e = j4 * 1024 + (wq * 64 + lane) * 4, k = e >> 6, v = e & 63;
#pragma unroll
        for (int i = 0; i < 4; ++i) St[(v + i) * 72 + k] = (bf16_t)(cvt_pk_bf16(sv[j4][i], 0.f) & 0xffffu); }
    LSYNC();
    const int tt = wq;
    bf16x8 qb0 = *(const LAS bf16x8*)(QT + (16 * tt + fr) * 72 + 8 * g), qb1 = *(const LAS bf16x8*)(QT + (16 * tt + fr) * 72 + 32 + 8 * g);
    f32x4 at[4];
#pragma unroll
    for (int st = 0; st < 4; ++st) {
        at[st] = (f32x4){0.f, 0.f, 0.f, 0.f};
        if (st <= tt) {
            const bf16x8 k0 = *(const LAS bf16x8*)(KT + (16 * st + fr) * 72 + 8 * g), k1 = *(const LAS bf16x8*)(KT + (16 * st + fr) * 72 + 32 + 8 * g);
            f32x4 acc = (f32x4){0.f, 0.f, 0.f, 0.f};
            acc = __builtin_amdgcn_mfma_f32_16x16x32_bf16(k0, qb0, acc, 0, 0, 0);
            acc = __builtin_amdgcn_mfma_f32_16x16x32_bf16(k1, qb1, acc, 0, 0, 0);
            if (st == tt) {
#pragma unroll
                for (int r = 0; r < 4; ++r) acc[r] = (4 * g + r <= fr) ? acc[r] : 0.f; }
            at[st] = acc;
        }
    }
    f32x4 o[4];
#pragma unroll
    for (int vt = 0; vt < 4; ++vt) o[vt] = (f32x4){0.f, 0.f, 0.f, 0.f};
#pragma unroll
    for (int u = 0; u < 2; ++u) {
        if (2 * u <= tt) {
            u32x4 pw; pw.x = cvt_pk_bf16(at[2 * u][0], at[2 * u][1]); pw.y = cvt_pk_bf16(at[2 * u][2], at[2 * u][3]);
            pw.z = cvt_pk_bf16(at[2 * u + 1][0], at[2 * u + 1][1]); pw.w = cvt_pk_bf16(at[2 * u + 1][2], at[2 * u + 1][3]);
            const bf16x8 pf = __builtin_bit_cast(bf16x8, pw);
#pragma unroll
            for (int vt = 0; vt < 4; ++vt) {
                const LAS bf16_t* vp = Vt + (16 * vt + fr) * 72 + 32 * u + 4 * g;
                u32x4 vw; const u32x2 lo = *(const LAS u32x2*)vp, hi = *(const LAS u32x2*)(vp + 16); vw.x = lo.x; vw.y = lo.y; vw.z = hi.x; vw.w = hi.y;
                o[vt] = __builtin_amdgcn_mfma_f32_16x16x32_bf16(__builtin_bit_cast(bf16x8, vw), pf, o[vt], 0, 0, 0);
            }
        }
    }
#pragma unroll
    for (int ks = 0; ks < 2; ++ks) {
        const bf16x8 qs = *(const LAS bf16x8*)(QS + (16 * tt + fr) * 72 + 32 * ks + 8 * g);
#pragma unroll
        for (int vt = 0; vt < 4; ++vt) { const bf16x8 sa = *(const LAS bf16x8*)(St + (16 * vt + fr) * 72 + 32 * ks + 8 * g);
            o[vt] = __builtin_amdgcn_mfma_f32_16x16x32_bf16(sa, qs, o[vt], 0, 0, 0); }
    }
    float sq = 0.f;
#pragma unroll
    for (int vt = 0; vt < 4; ++vt) sq += (o[vt][0] * o[vt][0] + o[vt][1] * o[vt][1]) + (o[vt][2] * o[vt][2] + o[vt][3] * o[vt][3]);
    sq += __shfl_xor(sq, 16); sq += __shfl_xor(sq, 32);
    const float rn = rsqrtf(sq * (1.0f / 64.0f) + EPS);
#pragma unroll
    for (int vt = 0; vt < 4; ++vt) {
        const f32x4 nv = *(const f32x4*)(onorm + 16 * vt + 4 * g);
        const float g0 = __uint_as_float(gz[vt].x << 16), g1 = __uint_as_float(gz[vt].x & 0xffff0000u), g2 = __uint_as_float(gz[vt].y << 16), g3 = __uint_as_float(gz[vt].y & 0xffff0000u);
        u32x2 w; w.x = cvt_pk_bf16(o[vt][0] * rn * nv[0] * siluf_(g0), o[vt][1] * rn * nv[1] * siluf_(g1)); w.y = cvt_pk_bf16(o[vt][2] * rn * nv[2] * siluf_(g2), o[vt][3] * rn * nv[3] * siluf_(g3));
        *(u32x2*)(mix + mt * DM + h * 64 + 16 * vt + 4 * g) = w;
    }
}

__device__ __forceinline__ void hgrn_sample_item(const bf16_t* z, const float* lbp, const float* S0, float* Sout, const float* onorm, bf16_t* mix, LAS unsigned char* lds, int b, int hp, int tid, int lane, int wave) {
    LAS float* F = (LAS float*)lds; LAS float* KI = F + 512; LAS float* Q = KI + 512; LAS float* V = Q + 512;
    LAS float* RED = V + 512;
    const int hh = wave >> 2, kq = wave & 3, h = 2 * hp + hh;
    float S[16];
    { const float* sp = S0 + (size_t)h * 4096 + (16 * kq) * 64 + lane;
#pragma unroll
      for (int i = 0; i < 16; ++i) S[i] = sp[i * 64]; }
    const int t0 = tid >> 7, hk = tid & 127;
    const bf16_t* zr = z + ((size_t)TP + 4 * b + t0) * INC + hp * 128 + hk;
    const float zf = bf2f(zr[ZF]), q0 = bf2f(zr[ZQ]), vi = bf2f(zr[ZI]); const float lb = lbp[hp * 128 + hk];
    LSYNC();
    { const float e = __expf(-fabsf(zf)); const float sp = (zf >= 0.f) ? 1.0f / (1.0f + e) : e / (1.0f + e); const float sn = (zf >= 0.f) ? e / (1.0f + e) : 1.0f / (1.0f + e);
      F[tid] = lb + (1.0f - lb) * sp; KI[tid] = (1.0f - lb) * sn; Q[tid] = q0; V[tid] = vi; }
    LSYNC();
#pragma unroll
    for (int t = 0; t < 4; ++t) {
        const float vt = V[t * 128 + hh * 64 + lane]; float part = 0.f;
#pragma unroll
        for (int i = 0; i < 16; ++i) { const int k = t * 128 + hh * 64 + 16 * kq + i; S[i] = F[k] * S[i] + KI[k] * vt; part += S[i] * Q[k]; }
        RED[((t * 2 + hh) * 4 + kq) * 64 + lane] = part;
    }
    { float* so = Sout + (size_t)h * 4096 + (16 * kq) * 64 + lane;
#pragma unroll
      for (int i = 0; i < 16; ++i) so[i * 64] = S[i]; }
    LSYNC();
    { const int t = wave >> 1, hh2 = wave & 1, h2 = 2 * hp + hh2; const size_t m = (size_t)TP + 4 * b + t;
      float o = 0.f;
#pragma unroll
      for (int k4 = 0; k4 < 4; ++k4) o += RED[((t * 2 + hh2) * 4 + k4) * 64 + lane];
      const float r = rsqrtf(wave_sum(o * o) * (1.0f / 64.0f) + EPS);
      const float res = o * r * onorm[lane] * siluf_(bf2f(z[m * INC + ZG + h2 * 64 + lane]));
      mix[m * DM + h2 * 64 + lane] = (bf16_t)(cvt_pk_bf16(res, 0.f) & 0xffffu); }
}

template <int NTOK>
__device__ __forceinline__ void conv_compute(const LAS float* U, int r0, size_t m0, const float* cw, const float* cb, const float* lng, const float* lnb, bf16_t* mix, int lane, int wave) {
    const int ch = 64 * (wave & 3) + lane;
    float w[31];
#pragma unroll
    for (int j = 0; j < 31; ++j) w[j] = cw[j * 256 + ch];
    const float bias = cb[ch], g = lng[ch], be = lnb[ch];
    constexpr int TG = (NTOK >= 4) ? 4 : NTOK;
#pragma unroll 1
    for (int tg = 0; tg < NTOK / TG; ++tg) {
        float y[TG];
#pragma unroll
        for (int t = 0; t < TG; ++t) y[t] = bias;
        const LAS float* up = U + (r0 + TG * tg) * 256 + ch;
#pragma unroll
        for (int j = 0; j < TG + 30; ++j) { const float u = up[j * 256];
#pragma unroll
            for (int t = 0; t < TG; ++t) { if (j - t >= 0 && j - t < 31) y[t] += w[j - t] * u; } }
#pragma unroll
        for (int t = 0; t < TG; ++t) {
            const float mu = wave_sum(y[t]) * (1.0f / 64.0f); const float d = y[t] - mu;
            const float var = wave_sum(d * d) * (1.0f / 64.0f);
            const float o = siluf_(d * rsqrtf(var + EPS) * g + be);
            mix[(m0 + TG * tg + t) * DM + 256 + ch] = (bf16_t)(cvt_pk_bf16(o, 0.f) & 0xffffu);
        }
    }
}
__device__ __forceinline__ void conv_prompt_item(const bf16_t* z, const float* cw, const float* cb, const float* lng, const float* lnb, bf16_t* mix, float* spc, LAS unsigned char* lds, int ct, int tid, int lane, int wave) {
    LAS float* U = (LAS float*)lds;
    const int t0 = 64 * ct;
    u32x4 ra[6], rb[6];
#pragma unroll
    for (int it = 0; it < 6; ++it) { const int r = it * 16 + (tid >> 5), cg8 = (tid & 31) * 8; int tok = t0 - 30 + r; tok = tok < 0 ? 0 : tok;
        const bf16_t* zr = z + (size_t)tok * INC; ra[it] = *(const u32x4*)(zr + ZBU + cg8); rb[it] = *(const u32x4*)(zr + ZBG + cg8); }
    LSYNC();
#pragma unroll
    for (int it = 0; it < 6; ++it) { const int r = it * 16 + (tid >> 5), cg8 = (tid & 31) * 8; const bool ok = (t0 - 30 + r) >= 0;
        float fa[8], fb[8], u[8]; UNPACK8(ra[it], fa); UNPACK8(rb[it], fb);
#pragma unroll
        for (int j = 0; j < 8; ++j) u[j] = ok ? fa[j] * sigmoidf_(fb[j]) : 0.f;
        *(LAS f32x4*)(U + r * 256 + cg8) = (f32x4){u[0], u[1], u[2], u[3]}; *(LAS f32x4*)(U + r * 256 + cg8 + 4) = (f32x4){u[4], u[5], u[6], u[7]}; }
    LSYNC();
    conv_compute<32>(U, 32 * (wave >> 2), (size_t)t0 + 32 * (wave >> 2), cw, cb, lng, lnb, mix, lane, wave);
    if (ct == 255) for (int idx = tid; idx < 30 * 256; idx += 512) spc[idx] = U[(64 + (idx >> 8)) * 256 + (idx & 255)];
}
__device__ __forceinline__ void conv_sample_item(const bf16_t* z, const float* sconv, const float* cw, const float* cb, const float* lng, const float* lnb, bf16_t* mix, float* ssc, LAS unsigned char* lds, int b, int tid, int lane, int wave) {
    LAS float* U = (LAS float*)lds;
    float hv[15];
#pragma unroll
    for (int it = 0; it < 15; ++it) hv[it] = sconv[(size_t)b * 30 * 256 + it * 512 + tid];
    float nu[2];
#pragma unroll
    for (int it = 0; it < 2; ++it) { const int idx = it * 512 + tid, t = idx >> 8, ch = idx & 255; const bf16_t* zr = z + ((size_t)TP + 4 * b + t) * INC;
        nu[it] = bf2f(zr[ZBU + ch]) * sigmoidf_(bf2f(zr[ZBG + ch])); }
    LSYNC();
#pragma unroll
    for (int it = 0; it < 15; ++it) U[it * 512 + tid] = hv[it];
#pragma unroll
    for (int it = 0; it < 2; ++it) U[30 * 256 + it * 512 + tid] = nu[it];
    LSYNC();
    conv_compute<2>(U, 2 * (wave >> 2), (size_t)TP + 4 * b + 2 * (wave >> 2), cw, cb, lng, lnb, mix, lane, wave);
#pragma unroll
    for (int it = 0; it < 15; ++it) ssc[(size_t)b * 30 * 256 + it * 512 + tid] = U[4 * 256 + it * 512 + tid];
}

constexpr float QSCALE = 0.125f * 1.44269504089f, LOG2E = 1.44269504089f;
constexpr int KSTR = 72, VSTR = 280;
#define NORM_ROPE(rowp, gain, pos, g, sh1, sh2, x1, x2) do { \
    const u32x4 _lo = *(const u32x4*)((rowp) + 8 * (g)), _hi = *(const u32x4*)((rowp) + 32 + 8 * (g)); float _a[8], _b[8]; UNPACK8(_lo, _a); UNPACK8(_hi, _b); \
    float _sq = 0.f; _Pragma("unroll") for (int _j = 0; _j < 8; ++_j) _sq += _a[_j] * _a[_j] + _b[_j] * _b[_j]; \
    _sq += __shfl_xor(_sq, sh1); _sq += __shfl_xor(_sq, sh2); const float _r = rsqrtf(_sq * (1.0f / 64.0f) + EPS); \
    const float* _cp = rope_c + (size_t)(pos) * 32 + 8 * (g); const float* _sp = rope_s + (size_t)(pos) * 32 + 8 * (g); \
    _Pragma("unroll") for (int _j = 0; _j < 8; ++_j) { const float _y1 = _a[_j] * _r * (gain)[8 * (g) + _j], _y2 = _b[_j] * _r * (gain)[32 + 8 * (g) + _j]; const float _c = _cp[_j], _s = _sp[_j]; \
        (x1)[_j] = _y1 * _c - _y2 * _s; (x2)[_j] = _y2 * _c + _y1 * _s; } } while (0)

__device__ __forceinline__ void attn_qtile(const LAS bf16_t* Kl, const LAS bf16_t* Vt, bf16x8 q0, bf16x8 q1, int i, int T0, int jmin, float sink, bf16_t* outp, int lane) {
    const int fr = lane & 15, g = lane >> 4;
    f32x4 s[9];
#pragma unroll
    for (int T = 0; T < 9; ++T) {
        const LAS bf16_t* kp = Kl + (16 * (T0 + T) + fr) * KSTR + 8 * g;
        const bf16x8 k0 = *(const LAS bf16x8*)kp, k1 = *(const LAS bf16x8*)(kp + 32);
        f32x4 acc = (f32x4){0.f, 0.f, 0.f, 0.f};
        acc = __builtin_amdgcn_mfma_f32_16x16x32_bf16(k0, q0, acc, 0, 0, 0);
        acc = __builtin_amdgcn_mfma_f32_16x16x32_bf16(k1, q1, acc, 0, 0, 0);
        s[T] = acc;
    }
    float mx = sink;
#pragma unroll
    for (int T = 0; T < 9; ++T)
#pragma unroll
        for (int r = 0; r < 4; ++r) { const int j = 16 * (T0 + T) + 4 * g + r;
            const bool valid = (T == 0) ? ((j >= i) && (j >= jmin)) : (T == 8) ? ((j <= i + 128) && (j >= jmin)) : (j >= jmin);
            s[T][r] = valid ? s[T][r] : -INFINITY; mx = fmaxf(mx, s[T][r]); }
    mx = fmaxf(mx, __shfl_xor(mx, 16)); mx = fmaxf(mx, __shfl_xor(mx, 32));
    float sum = 0.f;
#pragma unroll
    for (int T = 0; T < 9; ++T)
#pragma unroll
        for (int r = 0; r < 4; ++r) { const float p = __builtin_amdgcn_exp2f(s[T][r] - mx); s[T][r] = p; sum += p; }
    sum += __shfl_xor(sum, 16); sum += __shfl_xor(sum, 32);
    const float inv = 1.0f / (sum + __builtin_amdgcn_exp2f(sink - mx));
    f32x4 o[4];
#pragma unroll
    for (int dt = 0; dt < 4; ++dt) o[dt] = (f32x4){0.f, 0.f, 0.f, 0.f};
#pragma unroll
    for (int u = 0; u < 5; ++u) {
        u32x4 pw; pw.x = cvt_pk_bf16(s[2 * u][0], s[2 * u][1]); pw.y = cvt_pk_bf16(s[2 * u][2], s[2 * u][3]);
        if (u < 4) { pw.z = cvt_pk_bf16(s[2 * u + 1 > 8 ? 8 : 2 * u + 1][0], s[2 * u + 1 > 8 ? 8 : 2 * u + 1][1]); pw.w = cvt_pk_bf16(s[2 * u + 1 > 8 ? 8 : 2 * u + 1][2], s[2 * u + 1 > 8 ? 8 : 2 * u + 1][3]); }
        else { pw.z = 0u; pw.w = 0u; }
        const bf16x8 pf = __builtin_bit_cast(bf16x8, pw);
#pragma unroll
        for (int dt = 0; dt < 4; ++dt) {
            const LAS bf16_t* vp = Vt + (16 * dt + fr) * VSTR + 16 * (T0 + 2 * u) + 4 * g;
            u32x4 vw; const u32x2 lo = *(const LAS u32x2*)vp, hi = *(const LAS u32x2*)(vp + 16); vw.x = lo.x; vw.y = lo.y; vw.z = hi.x; vw.w = hi.y;
            o[dt] = __builtin_amdgcn_mfma_f32_16x16x32_bf16(__builtin_bit_cast(bf16x8, vw), pf, o[dt], 0, 0, 0);
        }
    }
#pragma unroll
    for (int dt = 0; dt < 4; ++dt) { u32x2 w; w.x = cvt_pk_bf16(o[dt][0] * inv, o[dt][1] * inv); w.y = cvt_pk_bf16(o[dt][2] * inv, o[dt][3] * inv); *(u32x2*)(outp + 16 * dt + 4 * g) = w; }
}

#define LOAD_QFRAG(zq, pos, q0, q1) do { float _x1[8], _x2[8]; const int _g = lane >> 4; NORM_ROPE(zq, qn, pos, _g, 16, 32, _x1, _x2); \
    u32x4 _w0, _w1; _w0.x = cvt_pk_bf16(_x1[0] * QSCALE, _x1[1] * QSCALE); _w0.y = cvt_pk_bf16(_x1[2] * QSCALE, _x1[3] * QSCALE); _w0.z = cvt_pk_bf16(_x1[4] * QSCALE, _x1[5] * QSCALE); _w0.w = cvt_pk_bf16(_x1[6] * QSCALE, _x1[7] * QSCALE); \
    _w1.x = cvt_pk_bf16(_x2[0] * QSCALE, _x2[1] * QSCALE); _w1.y = cvt_pk_bf16(_x2[2] * QSCALE, _x2[3] * QSCALE); _w1.z = cvt_pk_bf16(_x2[4] * QSCALE, _x2[5] * QSCALE); _w1.w = cvt_pk_bf16(_x2[6] * QSCALE, _x2[7] * QSCALE); \
    q0 = __builtin_bit_cast(bf16x8, _w0); q1 = __builtin_bit_cast(bf16x8, _w1); } while (0)

__device__ __forceinline__ void attn_prompt_item(const bf16_t* z, const float* qn, const float* kn, const float* sinks, const float* rope_c, const float* rope_s, bf16_t* mix, float* spk, float* spv,
                                                 LAS unsigned char* lds, int qb, int kvh, int tid, int lane, int wave) {
    LAS bf16_t* Kl = (LAS bf16_t*)lds;
    LAS bf16_t* Vt = Kl + 256 * KSTR;
    LSYNC();
    const int kbase = qb * 128 - 128;
#pragma unroll
    for (int it_ = 0; it_ < 2; ++it_) { const int task = tid + 512 * it_;
        const int j = task >> 2, g = task & 3, pos = kbase + j;
        u32x4 w0 = (u32x4){0u, 0u, 0u, 0u}, w1 = w0;
        float x1[8], x2[8];
        const int posc = pos < 0 ? 0 : pos;
        const bf16_t* zr = z + (size_t)posc * INC + ZCK + kvh * 64;
        NORM_ROPE(zr, kn, posc, g, 1, 2, x1, x2);
        if (pos >= 0) { w0.x = cvt_pk_bf16(x1[0], x1[1]); w0.y = cvt_pk_bf16(x1[2], x1[3]); w0.z = cvt_pk_bf16(x1[4], x1[5]); w0.w = cvt_pk_bf16(x1[6], x1[7]);
                        w1.x = cvt_pk_bf16(x2[0], x2[1]); w1.y = cvt_pk_bf16(x2[2], x2[3]); w1.z = cvt_pk_bf16(x2[4], x2[5]); w1.w = cvt_pk_bf16(x2[6], x2[7]); }
        *(LAS u32x4*)(Kl + j * KSTR + 8 * g) = w0; *(LAS u32x4*)(Kl + j * KSTR + 32 + 8 * g) = w1;
        if (qb == 127 && j >= 128) { float* o = spk + (size_t)(j - 128) * 128 + kvh * 64;
            *(f32x4*)(o + 8 * g) = (f32x4){x1[0], x1[1], x1[2], x1[3]}; *(f32x4*)(o + 8 * g + 4) = (f32x4){x1[4], x1[5], x1[6], x1[7]};
            *(f32x4*)(o + 32 + 8 * g) = (f32x4){x2[0], x2[1], x2[2], x2[3]}; *(f32x4*)(o + 32 + 8 * g + 4) = (f32x4){x2[4], x2[5], x2[6], x2[7]}; }
    }
#pragma unroll
    for (int it_ = 0; it_ < 4; ++it_) { const int task = tid + 512 * it_;
        const int j = task >> 3, c8 = (task & 7) * 8, pos = kbase + j;
        u32x4 w = (u32x4){0u, 0u, 0u, 0u};
        if (pos >= 0) w = *(const u32x4*)(z + (size_t)pos * INC + ZCV + kvh * 64 + c8);
        Vt[(c8 + 0) * VSTR + j] = (bf16_t)(w.x & 0xffffu); Vt[(c8 + 1) * VSTR + j] = (bf16_t)(w.x >> 16);
        Vt[(c8 + 2) * VSTR + j] = (bf16_t)(w.y & 0xffffu); Vt[(c8 + 3) * VSTR + j] = (bf16_t)(w.y >> 16);
        Vt[(c8 + 4) * VSTR + j] = (bf16_t)(w.z & 0xffffu); Vt[(c8 + 5) * VSTR + j] = (bf16_t)(w.z >> 16);
        Vt[(c8 + 6) * VSTR + j] = (bf16_t)(w.w & 0xffffu); Vt[(c8 + 7) * VSTR + j] = (bf16_t)(w.w >> 16);
        if (qb == 127 && j >= 128) { float f[8]; UNPACK8(w, f); float* o = spv + (size_t)(j - 128) * 128 + kvh * 64 + c8;
            *(f32x4*)o = (f32x4){f[0], f[1], f[2], f[3]}; *(f32x4*)(o + 4) = (f32x4){f[4], f[5], f[6], f[7]}; }
    }
    for (int idx = tid; idx < 64 * 24; idx += 512) Vt[(idx / 24) * VSTR + 256 + (idx % 24)] = 0;
    LSYNC();
    const int hq = kvh * 4 + (wave >> 1);
    const float sink = sinks[hq] * LOG2E;
    const int g4 = lane >> 4;
    float gq1[8], gq2[8];
#pragma unroll
    for (int j = 0; j < 8; ++j) { gq1[j] = qn[8 * g4 + j] * QSCALE; gq2[j] = qn[32 + 8 * g4 + j] * QSCALE; }
    const int pos0 = qb * 128 + (wave & 1) * 64 + (lane & 15);
    const bf16_t* zq0 = z + (size_t)pos0 * INC + ZCQ + hq * 64 + 8 * g4;
    const float* rc0 = rope_c + (size_t)pos0 * 32 + 8 * g4; const float* rs0 = rope_s + (size_t)pos0 * 32 + 8 * g4;
    u32x4 nlo = *(const u32x4*)zq0, nhi = *(const u32x4*)(zq0 + 32);
    f32x4 nc0 = *(const f32x4*)rc0, nc1 = *(const f32x4*)(rc0 + 4), ns0 = *(const f32x4*)rs0, ns1 = *(const f32x4*)(rs0 + 4);
#pragma unroll 1
    for (int a4 = 0; a4 < 4; ++a4) {
        const u32x4 lo = nlo, hi = nhi; const f32x4 c0 = nc0, c1 = nc1, s0 = ns0, s1 = ns1;
        { const int an = a4 < 3 ? a4 + 1 : 3; const bf16_t* zqn = zq0 + (size_t)(16 * an) * INC; const float* rcn = rc0 + (size_t)(16 * an) * 32; const float* rsn = rs0 + (size_t)(16 * an) * 32;
          nlo = *(const u32x4*)zqn; nhi = *(const u32x4*)(zqn + 32); nc0 = *(const f32x4*)rcn; nc1 = *(const f32x4*)(rcn + 4); ns0 = *(const f32x4*)rsn; ns1 = *(const f32x4*)(rsn + 4); }
        float a[8], b[8]; UNPACK8(lo, a); UNPACK8(hi, b);
        float sq = 0.f;
#pragma unroll
        for (int j = 0; j < 8; ++j) sq += a[j] * a[j] + b[j] * b[j];
        sq += __shfl_xor(sq, 16); sq += __shfl_xor(sq, 32);
        const float r = rsqrtf(sq * (1.0f / 64.0f) + EPS);
        float x1[8], x2[8];
#pragma unroll
        for (int j = 0; j < 8; ++j) { const float y1 = a[j] * r * gq1[j], y2 = b[j] * r * gq2[j]; const float c = j < 4 ? c0[j & 3] : c1[j & 3], s = j < 4 ? s0[j & 3] : s1[j & 3];
            x1[j] = y1 * c - y2 * s; x2[j] = y2 * c + y1 * s; }
        u32x4 w0, w1; w0.x = cvt_pk_bf16(x1[0], x1[1]); w0.y = cvt_pk_bf16(x1[2], x1[3]); w0.z = cvt_pk_bf16(x1[4], x1[5]); w0.w = cvt_pk_bf16(x1[6], x1[7]);
        w1.x = cvt_pk_bf16(x2[0], x2[1]); w1.y = cvt_pk_bf16(x2[2], x2[3]); w1.z = cvt_pk_bf16(x2[4], x2[5]); w1.w = cvt_pk_bf16(x2[6], x2[7]);
        const int i0 = (wave & 1) * 64 + 16 * a4, i = i0 + (lane & 15);
        const size_t m = (size_t)qb * 128 + i;
        attn_qtile(Kl, Vt, __builtin_bit_cast(bf16x8, w0), __builtin_bit_cast(bf16x8, w1), i, i0 >> 4, qb == 0 ? 128 : 0, sink, mix + m * DM + 512 + hq * 64, lane);
    }
}

__device__ __forceinline__ void attn_sample_item(const bf16_t* z, const float* ck, const float* cv, const float* qn, const float* kn, const float* sinks, const float* rope_c, const float* rope_s, bf16_t* mix,
                                                 float* ssk, float* ssv, LAS unsigned char* lds, int b, int kvh, int tid, int lane, int wave) {
    LAS bf16_t* Kl = (LAS bf16_t*)lds;
    LAS bf16_t* Vt = Kl + 256 * KSTR;
    LSYNC();
#pragma unroll
    for (int it_ = 0; it_ < 2; ++it_) { const int task = tid + 512 * it_;
        const int j = task >> 3, c8 = (task & 7) * 8;
        const float* kr = ck + (size_t)j * 128 + kvh * 64 + c8; const float* vr = cv + (size_t)j * 128 + kvh * 64 + c8;
        const f32x4 k0 = *(const f32x4*)kr, k1 = *(const f32x4*)(kr + 4), v0 = *(const f32x4*)vr, v1 = *(const f32x4*)(vr + 4);
        u32x4 w; w.x = cvt_pk_bf16(k0[0], k0[1]); w.y = cvt_pk_bf16(k0[2], k0[3]); w.z = cvt_pk_bf16(k1[0], k1[1]); w.w = cvt_pk_bf16(k1[2], k1[3]);
        *(LAS u32x4*)(Kl + j * KSTR + c8) = w;
        const float vf[8] = {v0[0], v0[1], v0[2], v0[3], v1[0], v1[1], v1[2], v1[3]};
#pragma unroll
        for (int e = 0; e < 8; ++e) Vt[(c8 + e) * VSTR + j] = (bf16_t)(cvt_pk_bf16(vf[e], 0.f) & 0xffffu);
        if (j >= 4) { float* ok = ssk + (size_t)(j - 4) * 128 + kvh * 64 + c8; float* ov = ssv + (size_t)(j - 4) * 128 + kvh * 64 + c8;
            *(f32x4*)ok = k0; *(f32x4*)(ok + 4) = k1; *(f32x4*)ov = v0; *(f32x4*)(ov + 4) = v1; }
    }
    if (tid < 16) {
        const int t = tid >> 2, g = tid & 3, j = 128 + t; const size_t m = (size_t)TP + 4 * b + t;
        float x1[8], x2[8];
        NORM_ROPE(z + m * INC + ZCK + kvh * 64, kn, TP + t, g, 1, 2, x1, x2);
        u32x4 w0, w1; w0.x = cvt_pk_bf16(x1[0], x1[1]); w0.y = cvt_pk_bf16(x1[2], x1[3]); w0.z = cvt_pk_bf16(x1[4], x1[5]); w0.w = cvt_pk_bf16(x1[6], x1[7]);
        w1.x = cvt_pk_bf16(x2[0], x2[1]); w1.y = cvt_pk_bf16(x2[2], x2[3]); w1.z = cvt_pk_bf16(x2[4], x2[5]); w1.w = cvt_pk_bf16(x2[6], x2[7]);
        *(LAS u32x4*)(Kl + j * KSTR + 8 * g) = w0; *(LAS u32x4*)(Kl + j * KSTR + 32 + 8 * g) = w1;
        float* o = ssk + (size_t)(j - 4) * 128 + kvh * 64;
        *(f32x4*)(o + 8 * g) = (f32x4){x1[0], x1[1], x1[2], x1[3]}; *(f32x4*)(o + 8 * g + 4) = (f32x4){x1[4], x1[5], x1[6], x1[7]};
        *(f32x4*)(o + 32 + 8 * g) = (f32x4){x2[0], x2[1], x2[2], x2[3]}; *(f32x4*)(o + 32 + 8 * g + 4) = (f32x4){x2[4], x2[5], x2[6], x2[7]};
    }
    if (tid >= 64 && tid < 64 + 32) {
        const int t = (tid - 64) >> 3, c8 = ((tid - 64) & 7) * 8, j = 128 + t; const size_t m = (size_t)TP + 4 * b + t;
        const u32x4 w = *(const u32x4*)(z + m * INC + ZCV + kvh * 64 + c8);
        Vt[(c8 + 0) * VSTR + j] = (bf16_t)(w.x & 0xffffu); Vt[(c8 + 1) * VSTR + j] = (bf16_t)(w.x >> 16);
        Vt[(c8 + 2) * VSTR + j] = (bf16_t)(w.y & 0xffffu); Vt[(c8 + 3) * VSTR + j] = (bf16_t)(w.y >> 16);
        Vt[(c8 + 4) * VSTR + j] = (bf16_t)(w.z & 0xffffu); Vt[(c8 + 5) * VSTR + j] = (bf16_t)(w.z >> 16);
        Vt[(c8 + 6) * VSTR + j] = (bf16_t)(w.w & 0xffffu); Vt[(c8 + 7) * VSTR + j] = (bf16_t)(w.w >> 16);
        float f[8]; UNPACK8(w, f); float* o = ssv + (size_t)(j - 4) * 128 + kvh * 64 + c8;
        *(f32x4*)o = (f32x4){f[0], f[1], f[2], f[3]}; *(f32x4*)(o + 4) = (f32x4){f[4], f[5], f[6], f[7]};
    }
    if (tid >= 128 && tid < 128 + 12 * 8) { const int j = 132 + ((tid - 128) >> 3), c8 = ((tid - 128) & 7) * 8; *(LAS u32x4*)(Kl + j * KSTR + c8) = (u32x4){0u, 0u, 0u, 0u}; }
    for (int idx = tid; idx < 64 * 28; idx += 512) Vt[(idx / 28) * VSTR + 132 + (idx % 28)] = 0;
    LSYNC();
    if (wave == 0) {
        const int q = lane & 15, hg = q >> 2, t = q & 3, hq = kvh * 4 + hg; const size_t m = (size_t)TP + 4 * b + t;
        bf16x8 q0, q1;
        LOAD_QFRAG(z + m * INC + ZCQ + hq * 64, TP + t, q0, q1);
        attn_qtile(Kl, Vt, q0, q1, t, 0, 0, sinks[hq] * LOG2E, mix + m * DM + 512 + hq * 64, lane);
    }
}

#define PHASE_HEAD { unsigned z_ = 0; asm volatile("" : "+s"(z_)); lds += z_; } int wave_ = wv; asm volatile("" : "+s"(wave_)); const int wave = wave_, lane = lane_id_opaque(), tid = wave * 64 + lane; const int G = gridDim.x, bid = blockIdx.x; unsigned char* ws = WSP; (void)lane; (void)wave; (void)G; (void)bid; (void)ws;
#define SSP(k) ((float*)(ws + WS_SS) + (size_t)(k) * MT)
#define WL(off) ((const bf16_t*)(ws + WS_W + (size_t)l * W_LAYER + (off)))

struct G1Order {
    pg8::StaticOrder so; unsigned* cnt; int c;
    __device__ __forceinline__ bool next(int i, Unit& u) const {
        if (c >= 64 && c < 82) { if (i == 0) { const int s = c - 64; u.pm = 64 + s / 9; u.pn = s % 9; return true; } return so.next(i - 1, u); }
        return so.next(i, u);
    }
    __device__ __forceinline__ void a_ready(const Unit&) const {}
    __device__ __forceinline__ void done(const Unit& u) const {
        if (u.pm >= 64) {
            asm volatile("s_waitcnt vmcnt(0)" ::: "memory");
            __builtin_amdgcn_fence(__ATOMIC_RELEASE, "agent");
            asm volatile("s_waitcnt vmcnt(0)" ::: "memory");
            if (lane_id_opaque() == 0) __hip_atomic_fetch_add(cnt, 1u, __ATOMIC_RELAXED, __HIP_MEMORY_SCOPE_AGENT);
        }
    }
};
__device__ __forceinline__ void phase_g1(LAS unsigned char* lds, int l, int wv) {
    PHASE_HEAD
    unsigned* cnt = (unsigned*)(ws + WS_CTL) + 8192 + 64 * l;
    { pg8::Gemm g{(const bf16_t*)(ws + WS_BUFA), WL(W_IN), MT, INC, DM}; G1Order S; S.so.init(TP, INC, G, bid); S.cnt = cnt; S.c = bid;
      EpiZ E{(bf16_t*)(ws + WS_ZACT), INC, SSP(3 * l)}; pg8::gemm_phase<EpiZ, G1Order, true, true>(lds, g, S, E, wv); }
    if (bid >= 82) {
        if (tid == 0) { unsigned sp = 0; while (__hip_atomic_load(cnt, __ATOMIC_RELAXED, __HIP_MEMORY_SCOPE_AGENT) < 144u) { __builtin_amdgcn_s_sleep(4); if (++sp > (1u << 22)) break; }
            __builtin_amdgcn_fence(__ATOMIC_ACQUIRE, "agent"); asm volatile("s_waitcnt vmcnt(0)" ::: "memory"); }
        __syncthreads();
        const bf16_t* z = (const bf16_t*)(ws + WS_ZACT); bf16_t* bufB = (bf16_t*)(ws + WS_BUFB);
        const float* lbp = (const float*)(ws + WS_LB) + l * 256;
        const float* rope_c = (const float*)(ws + WS_ROPE); const float* rope_s = rope_c + (size_t)NPOS * 32;
        float* out = OUTP;
#pragma unroll 1
        for (int it = bid - 82; it < 640; it += G - 82) {
            int r = it;
            if (r < 256) { const int b = r >> 1, hp = r & 1; const size_t so = ((size_t)(l * 128 + b) * 4) * 4096;
                hgrn_sample_item(z, lbp, IN(2) + so, out + O_SSH + so, IN(10) + l * 64, bufB, lds, b, hp, tid, lane, wave); continue; } r -= 256;
            if (r < 128) { conv_sample_item(z, IN(3) + (size_t)l * 128 * 7680, IN(11) + l * 31 * 256, IN(12) + l * 256, IN(13) + l * 256, IN(14) + l * 256, bufB, out + O_SSC + (size_t)l * 128 * 7680, lds, r, tid, lane, wave); continue; } r -= 128;
            { const int b = r >> 1, kvh = r & 1; const size_t co = (size_t)(l * 128 + b) * 16384;
              attn_sample_item(z, IN(4) + co, IN(5) + co, IN(15) + l * 64, IN(16) + l * 64, IN(17) + l * 8, rope_c, rope_s, bufB, out + O_SSK + co, out + O_SSV + co, lds, b, kvh, tid, lane, wave); }
        }
        LSYNC();
        { LAS float* scr = (LAS float*)(lds + wave * 16384);
          const int first = (l == 0) ? CI_D : (CI_LAYER + CI_OUT), cnt_ = (l == 0) ? (CI_LAYER - CI_D) : (CI_GG - CI_OUT);
#pragma unroll 1
          for (int k = (bid - 82) * 8 + wave; k < cnt_; k += (G - 82) * 8) convert_item(lds, ws, scr, first + k, lane); }
    }
}
__device__ __forceinline__ void phase_mix_a(LAS unsigned char* lds, int l, int wv) {
    PHASE_HEAD
    const bf16_t* z = (const bf16_t*)(ws + WS_ZACT); bf16_t* bufB = (bf16_t*)(ws + WS_BUFB);
    const float* lbp = (const float*)(ws + WS_LB) + l * 256; float* dvec = (float*)(ws + WS_DVEC); float* dS = (float*)(ws + WS_DS);
    const float* rope_c = (const float*)(ws + WS_ROPE); const float* rope_s = rope_c + (size_t)NPOS * 32;
    float* out = OUTP;
#pragma unroll 1
    for (int P = bid; P < 512; P += G) hgrn_ds_pair(z, lbp, dS, dvec, lds, P, lane, wave);
#pragma unroll 1
    for (int it = bid; it < 512; it += G) {
        int r = it;
        if (r < 256) { attn_prompt_item(z, IN(15) + l * 64, IN(16) + l * 64, IN(17) + l * 8, rope_c, rope_s, bufB, out + O_SPK + (size_t)l * 16384, out + O_SPV + (size_t)l * 16384, lds, r >> 1, r & 1, tid, lane, wave); continue; } r -= 256;
        conv_prompt_item(z, IN(11) + l * 31 * 256, IN(12) + l * 256, IN(13) + l * 256, IN(14) + l * 256, bufB, out + O_SPC + (size_t)l * 7680, lds, r, tid, lane, wave);
    }
}
__device__ __forceinline__ void phase_scan(LAS unsigned char* lds, int l, int wv) {
    PHASE_HEAD
    if (bid < 256) {
        float* dS = (float*)(ws + WS_DS); const float* dvec = (const float*)(ws + WS_DVEC);
        const int e = 64 * bid + lane, h = e >> 12, k = (e >> 6) & 63;
        LAS float* X = (LAS float*)lds;
        float v[32], d[32];
#pragma unroll
        for (int j = 0; j < 32; ++j) { const int c = 32 * wave + j; v[j] = dS[(size_t)c * 16384 + e]; d[j] = dvec[(c * 4 + h) * 64 + k]; }
        float A = 0.f, P = 1.f;
#pragma unroll
        for (int j = 0; j < 32; ++j) { const float t = v[j]; v[j] = A; A = d[j] * A + t; const float pd = d[j]; d[j] = P; P *= pd; }
        LSYNC();
        X[(wave * 2 + 0) * 64 + lane] = P; X[(wave * 2 + 1) * 64 + lane] = A;
        LSYNC();
        float S = 0.f;
#pragma unroll
        for (int w2 = 0; w2 < 8; ++w2) { const float p2 = X[(w2 * 2 + 0) * 64 + lane], a2 = X[(w2 * 2 + 1) * 64 + lane]; if (w2 < wave) S = p2 * S + a2; }
#pragma unroll
        for (int j = 0; j < 32; ++j) dS[(size_t)(32 * wave + j) * 16384 + e] = d[j] * S + v[j];
        if (wave == 7) OUTP[O_SPH + (size_t)l * 16384 + e] = P * S + A;
    }
}
__device__ __forceinline__ void phase_mix_c(LAS unsigned char* lds, int l, int wv) {
    PHASE_HEAD
    const bf16_t* z = (const bf16_t*)(ws + WS_ZACT); bf16_t* bufB = (bf16_t*)(ws + WS_BUFB);
    const float* lbp = (const float*)(ws + WS_LB) + l * 256; const float* dS = (const float*)(ws + WS_DS);
    const float* onorm = IN(10) + l * 64;
#pragma unroll 1
    for (int it = bid; it < 512; it += G) hgrn_out_item(z, lbp, dS, onorm, bufB, lds, it >> 1, it & 1, tid, lane, wave);
}
__device__ __forceinline__ void phase_g2(LAS unsigned char* lds, int l, int wv) {
    PHASE_HEAD
    bf16_t* bufA = (bf16_t*)(ws + WS_BUFA);
    pg8::Gemm g{(const bf16_t*)(ws + WS_BUFB), WL(W_OUT), TP, DM, DM}; pg8::StaticOrder S; S.init(TP, DM, G, bid);
    EpiRes E{bufA, bufA, SSP(3 * l + 1)};
    pg8::gemm_phase<EpiRes, pg8::StaticOrder, true, true>(lds, g, S, E, wv);
    SEpiRes SE{bufA + (size_t)TP * DM, bufA + (size_t)TP * DM, SSP(3 * l + 1) + TP};
    small_gemm(lds, (const bf16_t*)(ws + WS_BUFB) + (size_t)TP * DM, WL(W_OUT), DM, SE, bid, tid, lane, wave);
}
__device__ __forceinline__ void phase_g3(LAS unsigned char* lds, int l, int wv) {
    PHASE_HEAD
    pg8::Gemm g{(const bf16_t*)(ws + WS_BUFA), WL(W_GU), MT, 2 * DFF, DM}; pg8::StaticOrder S; S.init(MT, 2 * DFF, G, bid);
    EpiGU E{(bf16_t*)(ws + WS_ZACT), SSP(3 * l + 1)}; pg8::gemm_phase<EpiGU, pg8::StaticOrder, true, true>(lds, g, S, E, wv);
    if (bid >= 172) {
        bf16_t* pbl = (bf16_t*)(ws + WS_PB) + (size_t)l * MT * PLE;
        const float* pP = IN(6) + (size_t)l * TP * PLE; const float* pS = IN(7) + (size_t)l * NSM * PLE;
        const int gw2 = (bid - 172) * 8 + wave, NGW2 = (G - 172) * 8;
#pragma unroll 1
        for (int m0 = gw2; m0 < MT; m0 += 8 * NGW2) {
            f32x4 v[8];
#pragma unroll
            for (int q = 0; q < 8; ++q) { const int m = (m0 + q * NGW2 < MT) ? m0 + q * NGW2 : m0;
                const float* src = (m < TP) ? pP + (size_t)m * PLE : pS + (size_t)(m - TP) * PLE; v[q] = ((const f32x4*)src)[lane]; }
#pragma unroll
            for (int q = 0; q < 8; ++q) { const int m = (m0 + q * NGW2 < MT) ? m0 + q * NGW2 : m0;
                u32x2 w; w.x = cvt_pk_bf16(v[q][0], v[q][1]); w.y = cvt_pk_bf16(v[q][2], v[q][3]); ((u32x2*)(pbl + (size_t)m * PLE))[lane] = w; }
        }
        { LAS float* scr = (LAS float*)(lds + wave * 16384);
          const int first = (l == 0) ? CI_LAYER : (CI_LAYER + CI_D), cnt_ = (l == 0) ? CI_OUT : (CI_LAYER - CI_D);
#pragma unroll 1
          for (int k = (bid - 172) * 8 + wave; k < cnt_; k += (G - 172) * 8) convert_item(lds, ws, scr, first + k, lane); }
    }
}
__device__ __forceinline__ void phase_g4(LAS unsigned char* lds, int l, int wv) {
    PHASE_HEAD
    const bf16_t* bufA = (const bf16_t*)(ws + WS_BUFA); bf16_t* bufB = (bf16_t*)(ws + WS_BUFB);
    pg8::Gemm g{(const bf16_t*)(ws + WS_ZACT), WL(W_D), TP, DM, DFF}; pg8::StaticOrder S; S.init(TP, DM, G, bid);
    EpiRes E{bufA, bufB, SSP(3 * l + 2)}; pg8::gemm_phase<EpiRes, pg8::StaticOrder, true, true>(lds, g, S, E, wv);
    SEpiRes SE{bufA + (size_t)TP * DM, bufB + (size_t)TP * DM, SSP(3 * l + 2) + TP};
    small_gemm(lds, (const bf16_t*)(ws + WS_ZACT) + (size_t)TP * DFF, WL(W_D), DFF, SE, bid, tid, lane, wave);
}
__device__ __forceinline__ void phase_g5a(LAS unsigned char* lds, int l, int wv) {
    PHASE_HEAD
    pg8::Gemm g{(const bf16_t*)(ws + WS_BUFB), WL(W_PG), TP, DM, DM}; pg8::StaticOrder S; S.init(TP, DM, G, bid);
    EpiGate E{(bf16_t*)(ws + WS_ZACT), SSP(3 * l + 2)}; pg8::gemm_phase<EpiGate, pg8::StaticOrder, true, true>(lds, g, S, E, wv);
    SEpiGate SE{(bf16_t*)(ws + WS_ZACT) + (size_t)TP * DM, SSP(3 * l + 2) + TP};
    small_gemm(lds, (const bf16_t*)(ws + WS_BUFB) + (size_t)TP * DM, WL(W_PG), DM, SE, bid, tid, lane, wave);
}
__device__ __forceinline__ void phase_g5b(LAS unsigned char* lds, int l, int wv) {
    PHASE_HEAD
    const bf16_t* gt = (const bf16_t*)(ws + WS_ZACT); const bf16_t* bufB = (const bf16_t*)(ws + WS_BUFB); bf16_t* bufA = (bf16_t*)(ws + WS_BUFA); float* Y = OUTP + O_Y;
    pg8::Gemm g{(const bf16_t*)(ws + WS_PB) + (size_t)l * MT * PLE, WL(W_PP), TP, DM, PLE}; pg8::StaticOrder S; S.init(TP, DM, G, bid);
    EpiOut E{gt, bufB, Y, bufA, SSP(3), l}; pg8::gemm_phase<EpiOut, pg8::StaticOrder, true, true>(lds, g, S, E, wv);
    SEpiOut SE{gt + (size_t)TP * DM, bufB + (size_t)TP * DM, Y + (size_t)TP * DM, bufA + (size_t)TP * DM, SSP(3) + TP, l};
    small_gemm(lds, (const bf16_t*)(ws + WS_PB) + ((size_t)l * MT + TP) * PLE, WL(W_PP), PLE, SE, bid, tid, lane, wave);
}

__global__ void __launch_bounds__(512, 2) fwd_kernel(Args a) {
    extern __shared__ __attribute__((aligned(16))) unsigned char lds_raw[];
    LAS unsigned char* lds = (LAS unsigned char*)lds_raw;
    volatile LAS unsigned* MISC = (volatile LAS unsigned*)(lds + MISC_OFF);
    if (threadIdx.x < 32) MISC[threadIdx.x] = 0u;
    if (threadIdx.x == 0) {
        LAS unsigned long long* PT = (LAS unsigned long long*)(lds + PT_OFF);
#pragma unroll
        for (int i = 0; i < 27; ++i) PT[i] = (unsigned long long)a.in[i];
        PT[27] = (unsigned long long)a.out; PT[28] = (unsigned long long)a.ws;
    }
    __syncthreads();
    const int wv = __builtin_amdgcn_readfirstlane(threadIdx.x >> 6);
    XcdBarrier bar = xcd_barrier_post((unsigned*)(WSP + WS_CTL), MISC + 8); bar.wv = wv;
    prologue(lds, wv);
    if (gridDim.x == 0x7fffffffu) cg::this_grid().sync();
    xcd_barrier(bar);
#define LAYER(l) do { \
        phase_g1(lds, l, wv); xcd_barrier(bar); \
        phase_mix_a(lds, l, wv); xcd_barrier(bar); \
        phase_scan(lds, l, wv); xcd_barrier(bar); \
        phase_mix_c(lds, l, wv); xcd_barrier(bar); \
        phase_g2(lds, l, wv); xcd_barrier(bar); \
        phase_g3(lds, l, wv); xcd_barrier(bar); \
        phase_g4(lds, l, wv); xcd_barrier(bar); \
        phase_g5a(lds, l, wv); \
        phase_g5b(lds, l, wv); } while (0)
    LAYER(0);
    xcd_barrier(bar);
    LAYER(1);
}

extern "C" void kernel_launch(void* const* d_in, const int* in_sizes, int n_in, void* d_out, int out_size, void* d_ws, size_t ws_size, hipStream_t stream) {
    static int grid = 0;
    if (grid == 0) {
        if (n_in != 27 || ws_size < WS_END) { fprintf(stderr, "kernel_launch: unexpected n_in %d / ws %zu\n", n_in, ws_size); grid = -1; return; }
        int dev = 0, cus = 0, per_cu = 0;
        hipGetDevice(&dev); hipDeviceGetAttribute(&cus, hipDeviceAttributeMultiprocessorCount, dev);
        if (hipFuncSetAttribute((const void*)fwd_kernel, hipFuncAttributeMaxDynamicSharedMemorySize, LDS_BYTES) != hipSuccess) { fprintf(stderr, "kernel_launch: hipFuncSetAttribute failed\n"); grid = -1; return; }
        hipOccupancyMaxActiveBlocksPerMultiprocessor(&per_cu, (const void*)fwd_kernel, 512, LDS_BYTES);
        (void)hipGetLastError();
        if (per_cu < 1) { fprintf(stderr, "kernel_launch: occupancy query says %d blocks per CU\n", per_cu); }
        grid = cus;
    }
    if (grid < 0) return;
    hipMemsetAsync((char*)d_ws + WS_CTL, 0, CTL_BYTES, stream);
    Args a{};
    for (int i = 0; i < 27; ++i) a.in[i] = (const float*)d_in[i];
    a.out = (float*)d_out; a.ws = (unsigned char*)d_ws;
    void* args[] = {&a};
    hipError_t e = hipLaunchCooperativeKernel((const void*)fwd_kernel, dim3(grid), dim3(512), args, LDS_BYTES, stream);
    if (e != hipSuccess) fprintf(stderr, "cooperative launch failed: %s (grid %d)\n", hipGetErrorString(e), grid);
}
```
